# Optimizing an MI355X kernel written in HIP

```python
import functools
import jax, jax.numpy as jnp
from jax import lax
import numpy as np

D_MODEL = 2048
BATCH = 1
SEQ = 8192
DEPTH = 1

N_META = 16
HEAD_DIM = 128
Q_BLOCK = 128
ROPE_THETA = 10000.0
EPS = 1e-6
NEG = -1e30
A_HEADS = 8
A_WIDTH = A_HEADS * HEAD_DIM
A_KV_RANK = 512
IDX_HEADS = 16
IDX_DIM = 64
TOPK_MAX = 256
B_HEADS = 8
B_WIDTH = B_HEADS * HEAD_DIM
N_GROUPS = 4
EXPERTS_PER_GROUP = 4
N_EXPERTS = N_GROUPS * EXPERTS_PER_GROUP
TOP_K_IN_GROUP = 2
D_FF_EXPERT = 512
IN_SPLITS = (A_WIDTH, A_KV_RANK, IDX_HEADS * IDX_DIM, IDX_DIM, IDX_HEADS,
             B_WIDTH, B_WIDTH, B_WIDTH, B_HEADS, D_MODEL, D_MODEL)
IN_WIDTH = (A_WIDTH + A_KV_RANK + IDX_HEADS * IDX_DIM + IDX_DIM + IDX_HEADS
            + 3 * B_WIDTH + B_HEADS + 2 * D_MODEL)

kernel_name = 'hybrid_dsa_fox_hier_moe'


def rms_norm(x, g):
    xf = x.astype(jnp.float32)
    y = xf * lax.rsqrt(jnp.mean(xf * xf, axis=-1, keepdims=True) + EPS)
    return (y * g.astype(jnp.float32)).astype(x.dtype)


def rope(x, pos):
    half = x.shape[-1] // 2
    inv_freq = ROPE_THETA ** (-jnp.arange(half, dtype=jnp.float32) / half)
    ang = pos.astype(jnp.float32)[:, None] * inv_freq[None, :]
    cos = jnp.cos(ang)[:, None, :]
    sin = jnp.sin(ang)[:, None, :]
    xf = x.astype(jnp.float32)
    x1, x2 = xf[..., :half], xf[..., half:]
    return jnp.concatenate([x1 * cos - x2 * sin, x2 * cos + x1 * sin], axis=-1).astype(x.dtype)


def _dsa_block(q, qi, wi, pos, k, v, ki, topk):
    L = k.shape[1]
    causal = jnp.arange(L)[None, :] <= pos[:, None]
    dots = jnp.einsum('bqhd,bsd->bqhs', qi, ki).astype(jnp.float32)
    score = jnp.einsum('bqh,bqhs->bqs', wi.astype(jnp.float32), jax.nn.relu(dots)) * (IDX_DIM ** -0.5)
    score = jnp.where(causal[None], score, NEG)
    _, sel = lax.top_k(score, topk)
    valid = sel <= pos[None, :, None]
    k_sel = jax.vmap(lambda kb, sb: kb[sb])(k, sel)
    v_sel = jax.vmap(lambda vb, sb: vb[sb])(v, sel)
    logits = jnp.einsum('bqhd,bqkhd->bhqk', q, k_sel).astype(jnp.float32) * (HEAD_DIM ** -0.5)
    logits = jnp.where(valid[:, None], logits, NEG)
    p = jax.nn.softmax(logits, axis=-1).astype(v.dtype)
    return jnp.einsum('bhqk,bqkhd->bqhd', p, v_sel)


def _fox_block(q, cq, pos, k, v, c):
    L = k.shape[1]
    causal = jnp.arange(L)[None, :] <= pos[:, None]
    logits = jnp.einsum('bqhd,bshd->bhqs', q, k).astype(jnp.float32) * (HEAD_DIM ** -0.5)
    decay = jnp.transpose(cq, (0, 2, 1))[:, :, :, None] - jnp.transpose(c, (0, 2, 1))[:, :, None, :]
    logits = jnp.where(causal[None, None], logits + decay, NEG)
    p = jax.nn.softmax(logits, axis=-1).astype(v.dtype)
    return jnp.einsum('bhqs,bshd->bqhd', p, v)


def _sweep(block_fn, q_args, kv_args):
    B, L = q_args[0].shape[:2]
    n_real = L - N_META
    nb = n_real // Q_BLOCK
    pos = jnp.arange(L)
    meta_out = block_fn(*[a[:, :N_META] for a in q_args], pos[:N_META], *kv_args)

    def to_blocks(a):
        a = a[:, N_META:]
        a = a.reshape((B, nb, Q_BLOCK) + a.shape[2:])
        return jnp.moveaxis(a, 1, 0)

    blocks = tuple(to_blocks(a) for a in q_args)
    pos_blocks = pos[N_META:].reshape(nb, Q_BLOCK)
    out = lax.map(lambda xs: block_fn(*xs[0], xs[1], *kv_args), (blocks, pos_blocks))
    out = jnp.moveaxis(out, 0, 1).reshape((B, n_real) + out.shape[3:])
    return jnp.concatenate([meta_out, out], axis=1)


def token_mixer(x, g_mix, w_in, g_kv, w_kv_up, g_idx_k, b_f, w_branch_a, w_branch_b, w_out):
    B, L, _ = x.shape
    pos = jnp.arange(L)
    h = rms_norm(x, g_mix)
    proj = h @ w_in
    split_idx = np.cumsum(IN_SPLITS)[:-1].tolist()
    qa, ckv, qi, ki, wi, qb, kb, vb, fb, ga, gb = jnp.split(proj, split_idx, axis=-1)

    qa = rope(qa.reshape(B, L, A_HEADS, HEAD_DIM), pos)
    kva = rms_norm(ckv, g_kv) @ w_kv_up
    ka, va = jnp.split(kva, 2, axis=-1)
    ka = rope(ka.reshape(B, L, A_HEADS, HEAD_DIM), pos)
    va = va.reshape(B, L, A_HEADS, HEAD_DIM)
    qi = rope(qi.reshape(B, L, IDX_HEADS, IDX_DIM), pos)
    ki = rope(rms_norm(ki, g_idx_k)[:, :, None, :], pos)[:, :, 0, :]
    wi = wi * (IDX_HEADS ** -0.5)
    topk = min(TOPK_MAX, L // 4)
    ya = _sweep(functools.partial(_dsa_block, topk=topk), (qa, qi, wi), (ka, va, ki))
    ya = ya.reshape(B, L, A_WIDTH)

    logf = jax.nn.log_sigmoid(fb.astype(jnp.float32) + b_f.astype(jnp.float32))
    c = jnp.cumsum(logf, axis=1)
    qb = qb.reshape(B, L, B_HEADS, HEAD_DIM)
    kb = kb.reshape(B, L, B_HEADS, HEAD_DIM)
    vb = vb.reshape(B, L, B_HEADS, HEAD_DIM)
    yb = _sweep(_fox_block, (qb, c), (kb, vb, c)).reshape(B, L, B_WIDTH)

    merged = jax.nn.sigmoid(ga) * (ya @ w_branch_a) + jax.nn.sigmoid(gb) * (yb @ w_branch_b)
    return merged @ w_out


def hier_moe(x, g_ffn, w_group, b_group, w_expert, b_expert, w_gate_e, w_up_e, w_down_e):
    B, L, D = x.shape
    t = rms_norm(x, g_ffn).reshape(B * L, D)
    T = t.shape[0]
    g_logits = (t @ w_group).astype(jnp.float32) + b_group.astype(jnp.float32)
    g_prob = jax.nn.softmax(g_logits, axis=-1)
    g_sel = jnp.argmax(g_logits, axis=-1)
    p_group = jnp.take_along_axis(g_prob, g_sel[:, None], axis=-1)
    e_logits = ((t @ w_expert).astype(jnp.float32) + b_expert.astype(jnp.float32)).reshape(T, N_GROUPS, EXPERTS_PER_GROUP)
    e_logits = jnp.take_along_axis(e_logits, g_sel[:, None, None], axis=1)[:, 0]
    e_prob = jax.nn.softmax(e_logits, axis=-1)
    top_p, top_i = lax.top_k(e_prob, TOP_K_IN_GROUP)
    top_p = top_p / jnp.sum(top_p, axis=-1, keepdims=True)
    weight = p_group * top_p
    expert_id = g_sel[:, None] * EXPERTS_PER_GROUP + top_i
    gates = jnp.sum(jax.nn.one_hot(expert_id, N_EXPERTS, dtype=jnp.float32) * weight[..., None], axis=1)
    hg = jnp.einsum('td,edf->etf', t, w_gate_e)
    hu = jnp.einsum('td,edf->etf', t, w_up_e)
    act = jax.nn.silu(hg) * hu * gates.T[:, :, None].astype(hu.dtype)
    y = jnp.einsum('etf,efd->td', act, w_down_e)
    return y.reshape(B, L, D)


def setup_inputs(seed: int = 0) -> dict:
    key = jax.random.key(seed)
    ks = jax.random.split(key, 24)
    f32 = jnp.float32

    def nrm(k, shape, scale):
        return jax.random.normal(k, shape, f32) * scale

    def gain(k, shape):
        return 1.0 + 0.05 * jax.random.normal(k, shape, f32)

    return {
        'x': nrm(ks[0], (BATCH, SEQ, D_MODEL), 1.0),
        'meta_tokens': nrm(ks[1], (N_META, D_MODEL), 1.0),
        'g_mix': gain(ks[2], (DEPTH, D_MODEL)),
        'w_in': nrm(ks[3], (DEPTH, D_MODEL, IN_WIDTH), D_MODEL ** -0.5),
        'g_kv': gain(ks[4], (DEPTH, A_KV_RANK)),
        'w_kv_up': nrm(ks[5], (DEPTH, A_KV_RANK, 2 * A_WIDTH), A_KV_RANK ** -0.5),
        'g_idx_k': gain(ks[6], (DEPTH, IDX_DIM)),
        'b_f': 3.0 + nrm(ks[7], (DEPTH, B_HEADS), 0.5),
        'w_branch_a': nrm(ks[8], (DEPTH, A_WIDTH, D_MODEL), A_WIDTH ** -0.5),
        'w_branch_b': nrm(ks[9], (DEPTH, B_WIDTH, D_MODEL), B_WIDTH ** -0.5),
        'w_out': nrm(ks[10], (DEPTH, D_MODEL, D_MODEL), D_MODEL ** -0.5),
        'g_ffn': gain(ks[11], (DEPTH, D_MODEL)),
        'w_group': nrm(ks[12], (DEPTH, D_MODEL, N_GROUPS), D_MODEL ** -0.5),
        'b_group': nrm(ks[13], (DEPTH, N_GROUPS), 0.01),
        'w_expert': nrm(ks[14], (DEPTH, D_MODEL, N_EXPERTS), D_MODEL ** -0.5),
        'b_expert': nrm(ks[15], (DEPTH, N_EXPERTS), 0.01),
        'w_gate_e': nrm(ks[16], (DEPTH, N_EXPERTS, D_MODEL, D_FF_EXPERT), D_MODEL ** -0.5),
        'w_up_e': nrm(ks[17], (DEPTH, N_EXPERTS, D_MODEL, D_FF_EXPERT), D_MODEL ** -0.5),
        'w_down_e': nrm(ks[18], (DEPTH, N_EXPERTS, D_FF_EXPERT, D_MODEL), D_FF_EXPERT ** -0.5),
        'g_final': gain(ks[19], (D_MODEL,)),
    }


def reference(x, meta_tokens, g_mix, w_in, g_kv, w_kv_up, g_idx_k, b_f, w_branch_a, w_branch_b,
              w_out, g_ffn, w_group, b_group, w_expert, b_expert, w_gate_e, w_up_e, w_down_e, g_final):
    B = x.shape[0]
    meta = jnp.broadcast_to(meta_tokens[None].astype(x.dtype), (B, N_META, x.shape[-1]))
    h = jnp.concatenate([meta, x], axis=1)
    for l in range(DEPTH):
        h = h + token_mixer(h, g_mix[l], w_in[l], g_kv[l], w_kv_up[l], g_idx_k[l], b_f[l],
                            w_branch_a[l], w_branch_b[l], w_out[l])
        h = h + hier_moe(h, g_ffn[l], w_group[l], b_group[l], w_expert[l], b_expert[l],
                         w_gate_e[l], w_up_e[l], w_down_e[l])
    h = rms_norm(h, g_final)
    return h[:, N_META:]
```

```cpp
#include <hip/hip_runtime.h>
#include <hip/hip_bf16.h>
#include <cstdio>
#include <cstdint>

#ifndef MK_ONE_LAUNCH
#define MK_ONE_LAUNCH 0
#endif

namespace pg8 {
#define PG8_LAS __attribute__((address_space(3)))
typedef unsigned short bf16_t;
typedef short bf16x8 __attribute__((ext_vector_type(8)));
typedef float f32x4 __attribute__((ext_vector_type(4)));
typedef unsigned u32x4 __attribute__((ext_vector_type(4)));
constexpr int BM = 256, BK = 64, HALF = 128, HTB = HALF * BK * 2, STAGE_BYTES = 8 * HTB, NXCD = 8, WGM = 8;

__host__ __device__ __forceinline__ int lds_byte(int r, int c) { const int st = (r >> 4) * 2 + (c >> 5), rr = r & 15, cc = c & 31, ob = rr * 64 + cc * 2; return st * 1024 + (ob ^ (((ob >> 9) & 1) << 5)); }
__host__ __device__ __forceinline__ void stage_rc(int b, int& R, int& C) { const int st = b / 1024, sb = b % 1024, swz = sb ^ (((sb >> 9) & 1) << 5); R = (st >> 1) * 16 + swz / 64; C = (st & 1) * 32 + (swz % 64) / 2; }
__host__ __device__ __forceinline__ int perm32(int rho) { const int n = rho >> 4, i = rho & 15; return 8 * (i >> 2) + 4 * n + (i & 3); }

struct Unit { int pm, pn; size_t bofs; };
struct Gemm { const bf16_t* A; const bf16_t* Bt; int lda, ldb, K; };

struct StaticOrder {
    int nM, nN, nwg, G, c;
    __device__ void init(int nM_, int nN_, int G_, int c_) { nM = nM_; nN = nN_; nwg = nM * nN; G = G_; c = c_; }
    __device__ bool next(int i, Unit& u) const {
        const long L = (long)i * G + c; if (L >= nwg) return false;
        int wgid = (int)L; { const int q = nwg / NXCD, r = nwg % NXCD, xcd = wgid % NXCD, off = wgid / NXCD; wgid = (xcd < r ? xcd * (q + 1) : r * (q + 1) + (xcd - r) * q) + off; }
        const int nig = WGM * nN, gid = wgid / nig, fm = gid * WGM, gsz = (nM - fm) < WGM ? (nM - fm) : WGM;
        u.pm = fm + ((wgid % nig) % gsz); u.pn = (wgid % nig) / gsz; u.bofs = 0; return true;
    }
};
struct MoeOrder {
    int nM, nN, nwg, G, c; const PG8_LAS int* tb; size_t bstride;
    __device__ void init(int nM_, int nN_, int G_, int c_, const PG8_LAS int* tb_, size_t bs) { nM = nM_; nN = nN_; nwg = nM * nN; G = G_; c = c_; tb = tb_; bstride = bs; }
    __device__ bool next(int i, Unit& u) const {
        const long L = (long)i * G + c; if (L >= nwg) return false;
        const int wgid = (int)L;
        u.pn = wgid % nN; u.pm = wgid / nN;
        int e = 0;
#pragma unroll
        for (int k = 1; k < 16; ++k) e += (tb[k] <= u.pm) ? 1 : 0;
        u.bofs = (size_t)e * bstride; return true;
    }
};

__device__ __forceinline__ unsigned cvt_pk_bf16(float lo, float hi) { unsigned r; asm volatile("v_cvt_pk_bf16_f32 %0, %1, %2" : "=v"(r) : "v"(lo), "v"(hi)); return r; }

template <class Epi, class Sched>
__device__ __forceinline__ void gemm_phase(PG8_LAS unsigned char* lds, const Gemm g, const Sched& S, const Epi& E) {
    const int tid = threadIdx.x, wid = __builtin_amdgcn_readfirstlane(tid >> 6), lane = tid & 63, wr = wid >> 2, wc = wid & 3, fr = lane & 15, fq = lane >> 4;
    const int K = g.K, nt = K / BK;
    unsigned voffA[2], voffB[2];
#pragma unroll
    for (int i = 0; i < 2; ++i) { int R, C; stage_rc(tid * 16 + i * 8192, R, C); const int Rb = ((R & ~31) + perm32(R & 31));
        voffA[i] = (unsigned)(R * g.lda + C) * 2u; voffB[i] = (unsigned)(Rb * g.ldb + C) * 2u; }
    const size_t kstep = (size_t)(BK * 2);
    const size_t hstepA = (size_t)HALF * g.lda * 2, hstepB = (size_t)HALF * g.ldb * 2;
    const size_t tstepA = 2 * hstepA, tstepB = 2 * hstepB;
    const unsigned ldsw = (unsigned)wid * 1024u;
    const int aoff = lds_byte(wr * 64 + fr, fq * 8), boff = lds_byte(wc * 32 + fr, fq * 8);
#define PG8_SA(b, h) (((b) * 2 + (h)) * HTB)
#define PG8_SB(b, h) ((4 + (b) * 2 + (h)) * HTB)
#define PG8_STAGE(bufoff, gbase, voff) do { _Pragma("unroll") for (int _i = 0; _i < 2; ++_i) \
        __builtin_amdgcn_global_load_lds((const unsigned*)((const char*)(gbase) + (voff)[_i]), (PG8_LAS unsigned*)(lds + (bufoff) + ldsw + _i * 8192), 16, 0, 0); } while (0)
#define PG8_LDA(dst, b, h) do { _Pragma("unroll") for (int m = 0; m < 4; ++m) _Pragma("unroll") for (int k = 0; k < 2; ++k) dst[m][k] = *(const PG8_LAS bf16x8*)(lds + PG8_SA(b, h) + aoff + m * 2048 + k * 1024); } while (0)
#define PG8_LDB(dst, b, h) do { _Pragma("unroll") for (int n = 0; n < 2; ++n) _Pragma("unroll") for (int k = 0; k < 2; ++k) dst[n][k] = *(const PG8_LAS bf16x8*)(lds + PG8_SB(b, h) + boff + n * 2048 + k * 1024); } while (0)
#define PG8_MMA(ai, bj, At, Bt) do { __builtin_amdgcn_s_setprio(1); _Pragma("unroll") for (int m = 0; m < 4; ++m) _Pragma("unroll") for (int n = 0; n < 2; ++n) _Pragma("unroll") for (int k = 0; k < 2; ++k) \
        acc[ai][bj][m][n] = __builtin_amdgcn_mfma_f32_16x16x32_bf16(Bt[n][k], At[m][k], acc[ai][bj][m][n], 0, 0, 0); __builtin_amdgcn_s_setprio(0); } while (0)
#define PG8_WAIT_V(n) asm volatile("s_waitcnt vmcnt(" #n ")" ::: "memory")
#define PG8_WAIT_L(n) asm volatile("s_waitcnt lgkmcnt(" #n ")" ::: "memory")
#define PG8_BAR __builtin_amdgcn_s_barrier()
#define PG8_SCHED __builtin_amdgcn_sched_barrier(0)
    Unit cur, nxt; int ui = 0;
    if (!S.next(0, cur)) return;
    f32x4 acc[2][2][4][2];
#pragma unroll
    for (int a = 0; a < 2; ++a)
#pragma unroll
        for (int b = 0; b < 2; ++b)
#pragma unroll
            for (int m = 0; m < 4; ++m)
#pragma unroll
                for (int n = 0; n < 2; ++n) acc[a][b][m][n] = (f32x4){0.f, 0.f, 0.f, 0.f};
    bf16x8 At[4][2], B0[2][2], B1[2][2];
    const char* cA = (const char*)g.A + (size_t)cur.pm * tstepA; const char* cB = (const char*)g.Bt + cur.bofs + (size_t)cur.pn * tstepB;
    {
        PG8_STAGE(PG8_SB(0, 0), cB, voffB); PG8_STAGE(PG8_SB(0, 1), cB + hstepB, voffB); PG8_STAGE(PG8_SA(0, 0), cA, voffA); PG8_STAGE(PG8_SA(0, 1), cA + hstepA, voffA);
        if (wr == 1) PG8_BAR;
        PG8_WAIT_V(2); PG8_BAR;
        PG8_STAGE(PG8_SB(1, 0), cB + kstep, voffB); PG8_STAGE(PG8_SA(1, 0), cA + kstep, voffA); PG8_STAGE(PG8_SB(1, 1), cB + hstepB + kstep, voffB);
        PG8_WAIT_V(6); PG8_BAR;
    }
    for (;;) {
        const bool has_next = S.next(ui + 1, nxt);
        const char* nA = has_next ? (const char*)g.A + (size_t)nxt.pm * tstepA : cA; const char* nB = has_next ? (const char*)g.Bt + nxt.bofs + (size_t)nxt.pn * tstepB : cB;
        for (int t = 0; t < nt; t += 2) {
            const bool last = (t == nt - 2);
            const char* a1 = cA + (size_t)(t + 1) * kstep;
            const char* a2 = last ? nA : cA + (size_t)(t + 2) * kstep; const char* b2 = last ? nB : cB + (size_t)(t + 2) * kstep;
            const char* a3 = a2 + kstep; const char* b3 = b2 + kstep;
            PG8_LDB(B0, 0, 0); PG8_LDB(B1, 0, 1); PG8_SCHED; PG8_LDA(At, 0, 0); PG8_STAGE(PG8_SA(1, 1), a1 + hstepA, voffA);
            PG8_WAIT_V(8); PG8_WAIT_L(0); PG8_BAR; PG8_MMA(0, 0, At, B0); PG8_MMA(0, 1, At, B1); PG8_BAR; PG8_SCHED;
            PG8_LDA(At, 0, 1); PG8_STAGE(PG8_SB(0, 0), b2, voffB); PG8_STAGE(PG8_SB(0, 1), b2 + hstepB, voffB); PG8_STAGE(PG8_SA(0, 0), a2, voffA);
            PG8_WAIT_V(8); PG8_WAIT_L(0); PG8_BAR; PG8_MMA(1, 0, At, B0); PG8_MMA(1, 1, At, B1); PG8_BAR; PG8_SCHED;
            PG8_LDB(B0, 1, 0); PG8_LDB(B1, 1, 1); PG8_SCHED; PG8_LDA(At, 1, 0); PG8_STAGE(PG8_SA(0, 1), a2 + hstepA, voffA);
            PG8_WAIT_V(8); PG8_WAIT_L(0); PG8_BAR; PG8_MMA(0, 0, At, B0); PG8_MMA(0, 1, At, B1); PG8_BAR; PG8_SCHED;
            PG8_LDA(At, 1, 1); PG8_STAGE(PG8_SB(1, 0), b3, voffB); PG8_STAGE(PG8_SB(1, 1), b3 + hstepB, voffB); PG8_STAGE(PG8_SA(1, 0), a3, voffA);
            PG8_WAIT_V(8); PG8_WAIT_L(0); PG8_BAR; PG8_MMA(1, 0, At, B0); PG8_MMA(1, 1, At, B1); PG8_BAR; PG8_SCHED;
        }
        if (wr == 0) PG8_BAR;
        E(acc, cur, wr, wc, fr, fq);
        if (!has_next) break;
#pragma unroll
        for (int a = 0; a < 2; ++a)
#pragma unroll
            for (int b = 0; b < 2; ++b)
#pragma unroll
                for (int m = 0; m < 4; ++m)
#pragma unroll
                    for (int n = 0; n < 2; ++n) acc[a][b][m][n] = (f32x4){0.f, 0.f, 0.f, 0.f};
        cur = nxt; cA = nA; cB = nB; ++ui;
        if (wr == 1) PG8_BAR;
    }
    PG8_WAIT_V(0);
    PG8_BAR;
#undef PG8_SA
#undef PG8_SB
#undef PG8_STAGE
#undef PG8_LDA
#undef PG8_LDB
#undef PG8_MMA
#undef PG8_WAIT_V
#undef PG8_WAIT_L
#undef PG8_BAR
#undef PG8_SCHED
}
}

constexpr int NWAVES = 8;
constexpr int DM = 2048, SEQ = 8192, NMETA = 16, LTOK = SEQ + NMETA, LP = 8448;
constexpr int HD = 128, NH = 8, KVR = 512, IH = 16, IDD = 64, TOPK = 256;
constexpr int INW = 9816, PW = 9984;
constexpr int PC_QA = 0, PC_CKV = 1024, PC_QI = 1536, PC_KI = 2560, PC_WI = 2624, PC_FB = 2640, PC_QB = 2688, PC_KB = 3712, PC_VB = 4736, PC_GA = 5760, PC_GB = 7808, PC_END = 9856;
constexpr int NE = 16, DFF = 512, TSROWS = 20480;
constexpr float EPS = 1e-6f;
constexpr float LOG2E = 1.4426950408889634f;
constexpr float ATT_SCALE = 0.08838834764831845f;
constexpr int NTILE64 = 129;
constexpr int NPHASE = 15;

constexpr size_t MiB = 1u << 20;
constexpr size_t WS_CTL = 0, CTL_ZERO_BYTES = 1 * MiB;
constexpr size_t WS_ROPE128 = 1 * MiB;
constexpr size_t WS_ROPE64 = 5 * MiB + 256 * 1024;
constexpr size_t WS_KI = 7 * MiB + 512 * 1024;
constexpr size_t WS_WI = 8 * MiB + 768 * 1024;
constexpr size_t WS_LOGF = 9 * MiB + 512 * 1024;
constexpr size_t WS_CC = 9 * MiB + 896 * 1024;
constexpr size_t WS_ROUTE = 10 * MiB + 256 * 1024;
constexpr size_t WS_ROWTOK = 10 * MiB + 512 * 1024;
constexpr size_t WS_ROWW = 10 * MiB + 640 * 1024;
constexpr size_t WS_WAT = 12 * MiB, WS_WBT = 16 * MiB, WS_WOT = 20 * MiB, WS_WKVT = 28 * MiB;
constexpr size_t WS_PROJ = 30 * MiB;
constexpr size_t WS_KVA = 191 * MiB;
constexpr size_t WS_CKVN = 224 * MiB;
constexpr size_t WS_MASK = 224 * MiB;
constexpr size_t WS_R = 233 * MiB;
constexpr size_t WS_HN = WS_R, WS_WINT = WS_R + 33 * MiB, WS_SMALL = WS_R + 73 * MiB;
constexpr size_t WS_S = WS_R;
constexpr size_t WS_YA = WS_R, WS_YB = WS_R + 16 * MiB, WS_MERGED = WS_R + 32 * MiB, WS_M1 = WS_R + 64 * MiB;
constexpr size_t WS_H2 = 30 * MiB, WS_T = 94 * MiB, WS_WGUT = 126 * MiB, WS_WDT = 190 * MiB;
constexpr size_t WS_TS = WS_R, WS_ACT = WS_R + 80 * MiB, WS_Y = WS_R;
constexpr size_t WS_NEED = WS_R + 134 * MiB;
static_assert(WS_PROJ + (size_t)LP * PW * 2 <= WS_KVA && WS_KVA + (size_t)LP * 2048 * 2 <= WS_CKVN && WS_CKVN + (size_t)LP * 512 * 2 <= WS_R, "ws map");
static_assert(WS_WDT + (size_t)NE * 2048 * 512 * 2 <= WS_MASK && WS_M1 + (size_t)SEQ * 2048 * 4 <= WS_NEED && WS_ACT + (size_t)TSROWS * 512 * 2 <= WS_NEED, "ws map 2");
constexpr int CW_CNT = 64;
constexpr int CW_BAR = 4096;

constexpr int RING_OFF = 0, RING_BYTES = 131072;
constexpr int LDSCTL_OFF = RING_BYTES, MISC_OFF = LDSCTL_OFF + 320;
constexpr int LDS_BYTES = 147456;

#define GAS __attribute__((address_space(1)))
#define LAS __attribute__((address_space(3)))
typedef unsigned short bf16;
typedef unsigned v4u __attribute__((ext_vector_type(4)));
typedef unsigned v2u __attribute__((ext_vector_type(2)));
typedef float f32x4 __attribute__((ext_vector_type(4)));
typedef float f32x2 __attribute__((ext_vector_type(2)));
typedef short bf16x8 __attribute__((ext_vector_type(8)));
typedef GAS unsigned gu32;
#define RLX_AGENT __ATOMIC_RELAXED, __HIP_MEMORY_SCOPE_AGENT
#define LDS_WAIT() asm volatile("s_waitcnt lgkmcnt(0)" ::: "memory")
#define VM_WAIT() asm volatile("s_waitcnt vmcnt(0)" ::: "memory")
__device__ __forceinline__ unsigned f2bf(float f) { unsigned u = __builtin_bit_cast(unsigned, f); return (u + 0x7fffu + ((u >> 16) & 1u)) >> 16; }
__device__ __forceinline__ unsigned pk2(float lo, float hi) { return f2bf(lo) | (f2bf(hi) << 16); }
__device__ __forceinline__ float bf2f(unsigned h) { return __builtin_bit_cast(float, h << 16); }
__device__ __forceinline__ float bflo(unsigned w) { return __builtin_bit_cast(float, w << 16); }
__device__ __forceinline__ float bfhi(unsigned w) { return __builtin_bit_cast(float, w & 0xffff0000u); }

#define XB_TMO      128
#define XB_XCNT(j)  (256  + 64 * (j))
#define XB_XSUB(j)  (1280 + 64 * (j))
#define XB_XGEN(j)  (2304 + 64 * (j))
#define XB_TOP      3328
#define XB_TOPGEN   3392
#define XCD_BAR_WORDS 3456
#define XB_SPIN_CAP (1u << 22)
__device__ __forceinline__ unsigned xb_ld(unsigned* p)              { return __hip_atomic_load(p, __ATOMIC_RELAXED, __HIP_MEMORY_SCOPE_AGENT); }
__device__ __forceinline__ unsigned xb_add(unsigned* p, unsigned v) { return __hip_atomic_fetch_add(p, v, __ATOMIC_RELAXED, __HIP_MEMORY_SCOPE_AGENT); }
__device__ __forceinline__ unsigned xb_xcc_id() { return (unsigned)__builtin_amdgcn_s_getreg((3 << 11) | 20) & 0xFu; }
#define XB_SPIN(cond, bar) do { unsigned _sp = 0; while (cond) { __builtin_amdgcn_s_sleep(1); \
    if ((++_sp & 255u) == 0u) { if (xb_ld(&(bar)[XB_TMO])) break; if (_sp > XB_SPIN_CAP) { atomicAdd(&(bar)[XB_TMO], 1u); break; } } } } while (0)
struct XcdBarrier { unsigned* bar; unsigned x; volatile LAS unsigned* st; };
__device__ __forceinline__ XcdBarrier xcd_barrier_post(unsigned* bar, volatile LAS unsigned* st) {
    XcdBarrier b; b.bar = bar; b.x = xb_xcc_id(); b.st = st;
    if (threadIdx.x == 0) (void)xb_add(&bar[XB_XCNT(b.x)], 1u);
    return b;
}
__device__ __forceinline__ void xcd_barrier_complete(unsigned* bar, unsigned x, unsigned& nloc, unsigned& nx) {
    const unsigned G = gridDim.x * gridDim.y * gridDim.z;
    unsigned sum, cnt, mine, sp = 0u;
    for (;;) {
        sum = 0u; cnt = 0u; mine = 0u;
#pragma unroll
        for (unsigned j = 0; j < 16; ++j) { const unsigned c = xb_ld(&bar[XB_XCNT(j)]); sum += c; cnt += (c > 0u) ? 1u : 0u; mine = (j == x) ? c : mine; }
        if (sum == G) break;
        __builtin_amdgcn_s_sleep(1);
        if ((++sp & 255u) == 0u) { if (xb_ld(&bar[XB_TMO])) break; if (sp > XB_SPIN_CAP) { atomicAdd(&bar[XB_TMO], 1u); break; } }
    }
    nloc = mine > 0u ? mine : 1u; nx = cnt > 0u ? cnt : 1u;
}
__device__ __forceinline__ void xcd_barrier(const XcdBarrier& b) {
    asm volatile("s_waitcnt vmcnt(0)" ::: "memory");
    __syncthreads();
    if (threadIdx.x == 0) {
        unsigned* bar = b.bar;
        __builtin_amdgcn_s_waitcnt(0);
        unsigned nloc = b.st[0], nx = b.st[1];
        if (nloc == 0u) { xcd_barrier_complete(bar, b.x, nloc, nx); b.st[0] = nloc; b.st[1] = nx; }
        const unsigned old = xb_add(&bar[XB_XSUB(b.x)], 1u);
        const unsigned gen = old / nloc;
        if (old + 1u == (gen + 1u) * nloc) {
            __builtin_amdgcn_fence(__ATOMIC_RELEASE, "agent");
            asm volatile("s_waitcnt vmcnt(0)" ::: "memory");
            const unsigned og = xb_add(&bar[XB_TOP], 1u);
            const unsigned tg = og / nx;
            if (og + 1u == (tg + 1u) * nx) xb_add(&bar[XB_TOPGEN], 1u);
            else XB_SPIN(xb_ld(&bar[XB_TOPGEN]) == tg, bar);
            __builtin_amdgcn_fence(__ATOMIC_ACQUIRE, "agent");
            xb_add(&bar[XB_XGEN(b.x)], 1u);
            asm volatile("s_waitcnt vmcnt(0)" ::: "memory");
        } else {
            XB_SPIN(xb_ld(&bar[XB_XGEN(b.x)]) == gen, bar);
            __builtin_amdgcn_fence(__ATOMIC_ACQUIRE, "agent");
            asm volatile("s_waitcnt vmcnt(0)" ::: "memory");
        }
    }
    __syncthreads();
}

struct Args { const float* in[20]; float* out; unsigned char* ws; int ph_lo, ph_hi, li, pad; };
enum { I_X = 0, I_META, I_GMIX, I_WIN, I_GKV, I_WKVUP, I_GIDXK, I_BF, I_WBA, I_WBB, I_WOUT, I_GFFN, I_WGROUP, I_BGROUP, I_WEXPERT, I_BEXPERT, I_WGATE, I_WUP, I_WDOWN, I_GFINAL };

__device__ __forceinline__ float wave_sum(float v) {
#pragma unroll
    for (int o = 1; o < 64; o <<= 1) v += __shfl_xor(v, o);
    return v;
}
__device__ __forceinline__ int wave_isum(int v) {
#pragma unroll
    for (int o = 1; o < 64; o <<= 1) v += __shfl_xor(v, o);
    return __builtin_amdgcn_readfirstlane(v);
}
__device__ __forceinline__ float wave_max(float v) {
#pragma unroll
    for (int o = 1; o < 64; o <<= 1) v = fmaxf(v, __shfl_xor(v, o));
    return v;
}

__device__ __forceinline__ void transpose_item(const float* colp, size_t ldsrc, bf16* WT, int ldwt, int k0, int n0, LAS float* scr, int lane) {
#pragma unroll 8
    for (int i = 0; i < 32; ++i) { const int kk = 2 * i + (lane >> 5); scr[kk * 33 + (lane & 31)] = colp ? colp[(size_t)(k0 + kk) * ldsrc] : 0.f; }
    LDS_WAIT(); asm volatile("" ::: "memory");
    const int c = lane & 7;
#pragma unroll
    for (int j = 0; j < 4; ++j) { const int n = (lane >> 3) + 8 * j; const LAS float* s = scr + (8 * c) * 33 + n;
        v4u o; o.x = pk2(s[0 * 33], s[1 * 33]); o.y = pk2(s[2 * 33], s[3 * 33]); o.z = pk2(s[4 * 33], s[5 * 33]); o.w = pk2(s[6 * 33], s[7 * 33]);
        *(GAS v4u*)(WT + (size_t)(n0 + n) * ldwt + k0 + 8 * c) = o; }
    LDS_WAIT(); asm volatile("" ::: "memory");
}
__device__ __forceinline__ int win_src(int n) {
    if (n < PC_FB) return n;
    if (n < PC_FB + 8) return 5712 + (n - PC_FB);
    if (n < PC_QB) return -1;
    if (n < PC_GA) return 2640 + (n - PC_QB);
    if (n < PC_END) return 5720 + (n - PC_GA);
    return -1;
}

using pg8::Unit;
typedef pg8::f32x4 (AccT)[2][2][4][2];
#define EPI_FOREACH(...) \
    _Pragma("unroll") for (int ai = 0; ai < 2; ++ai) _Pragma("unroll") for (int m = 0; m < 4; ++m) _Pragma("unroll") for (int bj = 0; bj < 2; ++bj) { \
        const int row = u.pm * 256 + ai * 128 + wr * 64 + m * 16 + fr; const int col = u.pn * 256 + bj * 128 + wc * 32 + 8 * fq; \
        const f32x4 v0 = acc[ai][bj][m][0], v1 = acc[ai][bj][m][1]; __VA_ARGS__ }

struct EpiProj {
    bf16* P; float* SM;
    __device__ __forceinline__ void operator()(const AccT& acc, const Unit& u, int wr, int wc, int fr, int fq) const {
        EPI_FOREACH({ v4u w; w.x = pg8::cvt_pk_bf16(v0[0], v0[1]); w.y = pg8::cvt_pk_bf16(v0[2], v0[3]); w.z = pg8::cvt_pk_bf16(v1[0], v1[1]); w.w = pg8::cvt_pk_bf16(v1[2], v1[3]);
            *(v4u*)(P + (size_t)row * PW + col) = w;
            if (u.pn == 10 && bj == 0) { float* s = SM + (size_t)row * 128 + (col - 2560); *(f32x4*)s = v0; *(f32x4*)(s + 4) = v1; } })
    }
};
struct EpiBf16Plain {
    bf16* O; int ldc;
    __device__ __forceinline__ void operator()(const AccT& acc, const Unit& u, int wr, int wc, int fr, int fq) const {
        EPI_FOREACH({ v4u w; w.x = pg8::cvt_pk_bf16(v0[0], v0[1]); w.y = pg8::cvt_pk_bf16(v0[2], v0[3]); w.z = pg8::cvt_pk_bf16(v1[0], v1[1]); w.w = pg8::cvt_pk_bf16(v1[2], v1[3]);
            *(v4u*)(O + (size_t)row * ldc + col) = w; })
    }
};
__device__ __forceinline__ float sigmoidf_(float x) { return 1.f / (1.f + __expf(-x)); }
struct EpiBranchA {
    const bf16* P; float* M1;
    __device__ __forceinline__ void operator()(const AccT& acc, const Unit& u, int wr, int wc, int fr, int fq) const {
        EPI_FOREACH({ const v4u gw = *(const v4u*)(P + (size_t)(row + NMETA) * PW + PC_GA + col);
            f32x4 o0, o1;
            o0[0] = sigmoidf_(bflo(gw.x)) * v0[0]; o0[1] = sigmoidf_(bfhi(gw.x)) * v0[1]; o0[2] = sigmoidf_(bflo(gw.y)) * v0[2]; o0[3] = sigmoidf_(bfhi(gw.y)) * v0[3];
            o1[0] = sigmoidf_(bflo(gw.z)) * v1[0]; o1[1] = sigmoidf_(bfhi(gw.z)) * v1[1]; o1[2] = sigmoidf_(bflo(gw.w)) * v1[2]; o1[3] = sigmoidf_(bfhi(gw.w)) * v1[3];
            float* d = M1 + (size_t)row * 2048 + col; *(f32x4*)d = o0; *(f32x4*)(d + 4) = o1; })
    }
};
struct EpiBranchB {
    const bf16* P; const float* M1; bf16* MG;
    __device__ __forceinline__ void operator()(const AccT& acc, const Unit& u, int wr, int wc, int fr, int fq) const {
        EPI_FOREACH({ const v4u gw = *(const v4u*)(P + (size_t)(row + NMETA) * PW + PC_GB + col);
            const float* d = M1 + (size_t)row * 2048 + col; const f32x4 a0 = *(const f32x4*)d, a1 = *(const f32x4*)(d + 4);
            f32x4 o0, o1;
            o0[0] = a0[0] + sigmoidf_(bflo(gw.x)) * v0[0]; o0[1] = a0[1] + sigmoidf_(bfhi(gw.x)) * v0[1]; o0[2] = a0[2] + sigmoidf_(bflo(gw.y)) * v0[2]; o0[3] = a0[3] + sigmoidf_(bfhi(gw.y)) * v0[3];
            o1[0] = a1[0] + sigmoidf_(bflo(gw.z)) * v1[0]; o1[1] = a1[1] + sigmoidf_(bfhi(gw.z)) * v1[1]; o1[2] = a1[2] + sigmoidf_(bflo(gw.w)) * v1[2]; o1[3] = a1[3] + sigmoidf_(bfhi(gw.w)) * v1[3];
            v4u w; w.x = pg8::cvt_pk_bf16(o0[0], o0[1]); w.y = pg8::cvt_pk_bf16(o0[2], o0[3]); w.z = pg8::cvt_pk_bf16(o1[0], o1[1]); w.w = pg8::cvt_pk_bf16(o1[2], o1[3]);
            *(v4u*)(MG + (size_t)row * 2048 + col) = w; })
    }
};
struct EpiOut {
    const float* X; float* H2;
    __device__ __forceinline__ void operator()(const AccT& acc, const Unit& u, int wr, int wc, int fr, int fq) const {
        EPI_FOREACH({ const float* xs = X + (size_t)row * 2048 + col; float* d = H2 + (size_t)row * 2048 + col;
            *(f32x4*)d = *(const f32x4*)xs + v0; *(f32x4*)(d + 4) = *(const f32x4*)(xs + 4) + v1; })
    }
};
struct EpiGateUp {
    bf16* ACT; const float* ROWW;
    __device__ __forceinline__ void operator()(const AccT& acc, const Unit& u, int wr, int wc, int fr, int fq) const {
#pragma unroll
        for (int ai = 0; ai < 2; ++ai)
#pragma unroll
            for (int m = 0; m < 4; ++m) {
                const int row = u.pm * 256 + ai * 128 + wr * 64 + m * 16 + fr; const int col = u.pn * 128 + wc * 32 + 8 * fq;
                const float rw = ROWW[row];
                float o[8];
#pragma unroll
                for (int n = 0; n < 2; ++n)
#pragma unroll
                    for (int j = 0; j < 4; ++j) { const float gv = acc[ai][0][m][n][j], uv = acc[ai][1][m][n][j]; o[n * 4 + j] = gv * sigmoidf_(gv) * uv * rw; }
                v4u w; w.x = pg8::cvt_pk_bf16(o[0], o[1]); w.y = pg8::cvt_pk_bf16(o[2], o[3]); w.z = pg8::cvt_pk_bf16(o[4], o[5]); w.w = pg8::cvt_pk_bf16(o[6], o[7]);
                *(v4u*)(ACT + (size_t)row * 512 + col) = w;
            }
    }
};
struct EpiDown {
    bf16* Y; const int* ROWTOK;
    __device__ __forceinline__ void operator()(const AccT& acc, const Unit& u, int wr, int wc, int fr, int fq) const {
#pragma unroll
        for (int ai = 0; ai < 2; ++ai)
#pragma unroll
            for (int m = 0; m < 4; ++m) {
                const int row = u.pm * 256 + ai * 128 + wr * 64 + m * 16 + fr; const int rt = ROWTOK[row];
                if (rt >= 0) { bf16* d = Y + ((size_t)(rt & 1) * SEQ + (rt >> 1)) * 2048 + u.pn * 256 + wc * 32 + 8 * fq;
#pragma unroll
                    for (int bj = 0; bj < 2; ++bj) { const f32x4 v0 = acc[ai][bj][m][0], v1 = acc[ai][bj][m][1];
                        v4u w; w.x = pg8::cvt_pk_bf16(v0[0], v0[1]); w.y = pg8::cvt_pk_bf16(v0[2], v0[3]); w.z = pg8::cvt_pk_bf16(v1[0], v1[1]); w.w = pg8::cvt_pk_bf16(v1[2], v1[3]);
                        *(v4u*)(d + bj * 128) = w; } }
            }
    }
};

__device__ __forceinline__ size_t s_row_off(int qr) { const int b = qr >> 8; const size_t pitch = 320 + 256 * b; return (size_t)256 * (320 * (size_t)b + 128 * (size_t)b * (b - 1)) + (size_t)(qr & 255) * pitch; }
__device__ __forceinline__ unsigned f2key(float f) { const unsigned u = __builtin_bit_cast(unsigned, f); return u ^ ((u >> 31) ? 0xFFFFFFFFu : 0x80000000u); }

__device__ __forceinline__ void phase_prologue(const Args& a, LAS unsigned char* lds, int gw, int NGW, int wave, int lane) {
    unsigned char* ws = a.ws;
    LAS float* scr = (LAS float*)(lds + RING_OFF + wave * 16384);
    constexpr int I_IN = 32 * (PW / 32), I_KV = 8 * 64, I_A = 16 * 64, I_O = 32 * 64;
    constexpr int NITEMS = I_IN + I_KV + 2 * I_A + I_O;
    for (int it = gw; it < NITEMS; it += NGW) {
        int r = it;
        if (r < I_IN) { const int nblk = PW / 32, kb = r / nblk, nb = r % nblk; const int sc = win_src(nb * 32 + (lane & 31));
            transpose_item(sc >= 0 ? a.in[I_WIN] + sc : nullptr, INW, (bf16*)(ws + WS_WINT), 2048, 64 * kb, 32 * nb, scr, lane); continue; } r -= I_IN;
        if (r < I_KV) { const int kb = r / 64, nb = r % 64; transpose_item(a.in[I_WKVUP] + nb * 32 + (lane & 31), 2048, (bf16*)(ws + WS_WKVT), 512, 64 * kb, 32 * nb, scr, lane); continue; } r -= I_KV;
        if (r < I_A) { const int kb = r / 64, nb = r % 64; transpose_item(a.in[I_WBA] + nb * 32 + (lane & 31), 2048, (bf16*)(ws + WS_WAT), 1024, 64 * kb, 32 * nb, scr, lane); continue; } r -= I_A;
        if (r < I_A) { const int kb = r / 64, nb = r % 64; transpose_item(a.in[I_WBB] + nb * 32 + (lane & 31), 2048, (bf16*)(ws + WS_WBT), 1024, 64 * kb, 32 * nb, scr, lane); continue; } r -= I_A;
        { const int kb = r / 64, nb = r % 64; transpose_item(a.in[I_WOUT] + nb * 32 + (lane & 31), 2048, (bf16*)(ws + WS_WOT), 2048, 64 * kb, 32 * nb, scr, lane); }
    }
    const f32x4* gm = (const f32x4*)a.in[I_GMIX];
    for (int p = gw; p < LP; p += NGW) {
        bf16* orow = (bf16*)(ws + WS_HN) + (size_t)p * 2048;
        if (p >= LTOK) { for (int j = 0; j < 8; ++j) *(v2u*)(orow + 4 * (lane + 64 * j)) = (v2u){0u, 0u}; continue; }
        const float* xrow = p < NMETA ? a.in[I_META] + (size_t)p * 2048 : a.in[I_X] + (size_t)(p - NMETA) * 2048;
        f32x4 v[8]; float s = 0.f;
#pragma unroll
        for (int j = 0; j < 8; ++j) { v[j] = ((const f32x4*)xrow)[lane + 64 * j]; s += (v[j][0] * v[j][0] + v[j][1] * v[j][1]) + (v[j][2] * v[j][2] + v[j][3] * v[j][3]); }
        const float rstd = 1.f / sqrtf(wave_sum(s) * (1.f / 2048.f) + EPS);
#pragma unroll
        for (int j = 0; j < 8; ++j) { const f32x4 g = gm[lane + 64 * j]; v2u o; o.x = pk2(v[j][0] * rstd * g[0], v[j][1] * rstd * g[1]); o.y = pk2(v[j][2] * rstd * g[2], v[j][3] * rstd * g[3]);
            *(v2u*)(orow + 4 * (lane + 64 * j)) = o; }
    }
    const int gt = gw * 64 + lane, NGT = NGW * 64;
    for (int i = gt; i < LTOK * 64; i += NGT) { const int p = i >> 6, f = i & 63; const double inv = exp(-9.210340371976184 * (double)f / 64.0); const double ang = (double)p * inv;
        double sn, cs; sincos(ang, &sn, &cs); ((f32x2*)(ws + WS_ROPE128))[i] = (f32x2){(float)cs, (float)sn}; }
    for (int i = gt; i < LTOK * 32; i += NGT) { const int p = i >> 5, f = i & 31; const double inv = exp(-9.210340371976184 * (double)f / 32.0); const double ang = (double)p * inv;
        double sn, cs; sincos(ang, &sn, &cs); ((f32x2*)(ws + WS_ROPE64))[i] = (f32x2){(float)cs, (float)sn}; }
}

__device__ __forceinline__ void phase_post1(const Args& a, int gw, int NGW, int lane) {
    unsigned char* ws = a.ws;
    bf16* PROJ = (bf16*)(ws + WS_PROJ); const float* SM = (const float*)(ws + WS_SMALL);
    const f32x2* R128 = (const f32x2*)(ws + WS_ROPE128); const f32x2* R64 = (const f32x2*)(ws + WS_ROPE64);
    for (int p = gw; p < LP; p += NGW) {
        bf16* prow = PROJ + (size_t)p * PW;
        bf16* ck = (bf16*)(ws + WS_CKVN) + (size_t)p * 512; bf16* ki = (bf16*)(ws + WS_KI) + (size_t)p * 64;
        if (p >= LTOK) { *(v4u*)(ck + 8 * lane) = (v4u){0u, 0u, 0u, 0u}; if (lane < 8) *(v4u*)(ki + 8 * lane) = (v4u){0u, 0u, 0u, 0u};
            if (lane < 16) ((float*)(ws + WS_WI))[(size_t)p * 16 + lane] = 0.f; continue; }
        const f32x2 cs = R128[(size_t)p * 64 + lane];
#pragma unroll
        for (int t = 0; t < 8; ++t) { bf16* q = prow + PC_QA + t * 128 + lane; const float x1 = bf2f(q[0]), x2 = bf2f(q[64]);
            q[0] = (bf16)f2bf(x1 * cs[0] - x2 * cs[1]); q[64] = (bf16)f2bf(x2 * cs[0] + x1 * cs[1]); }
        { const f32x2 c2 = R64[(size_t)p * 32 + (lane & 31)];
#pragma unroll
          for (int t = 0; t < 8; ++t) { const int hd = 2 * t + (lane >> 5); bf16* q = prow + PC_QI + hd * 64 + (lane & 31); const float x1 = bf2f(q[0]), x2 = bf2f(q[32]);
              q[0] = (bf16)f2bf(x1 * c2[0] - x2 * c2[1]); q[32] = (bf16)f2bf(x2 * c2[0] + x1 * c2[1]); } }
        { const v4u w = *(const v4u*)(prow + PC_CKV + 8 * lane); float x[8] = {bflo(w.x), bfhi(w.x), bflo(w.y), bfhi(w.y), bflo(w.z), bfhi(w.z), bflo(w.w), bfhi(w.w)};
          float s = 0.f;
#pragma unroll
          for (int j = 0; j < 8; ++j) s += x[j] * x[j];
          const float rstd = 1.f / sqrtf(wave_sum(s) * (1.f / 512.f) + EPS);
          const float* g = a.in[I_GKV] + 8 * lane; v4u o;
          o.x = pk2(x[0] * rstd * g[0], x[1] * rstd * g[1]); o.y = pk2(x[2] * rstd * g[2], x[3] * rstd * g[3]); o.z = pk2(x[4] * rstd * g[4], x[5] * rstd * g[5]); o.w = pk2(x[6] * rstd * g[6], x[7] * rstd * g[7]);
          *(v4u*)(ck + 8 * lane) = o; }
        { const float v = SM[(size_t)p * 128 + lane]; const float rstd = 1.f / sqrtf(wave_sum(v * v) * (1.f / 64.f) + EPS);
          const float n = v * rstd * a.in[I_GIDXK][lane]; const float pr = __shfl_xor(n, 32); const f32x2 c2 = R64[(size_t)p * 32 + (lane & 31)];
          const float y = lane < 32 ? n * c2[0] - pr * c2[1] : n * c2[0] + pr * c2[1];
          ki[lane] = (bf16)f2bf(y); }
        if (lane < 16) ((float*)(ws + WS_WI))[(size_t)p * 16 + lane] = SM[(size_t)p * 128 + 64 + lane] * (0.25f * 0.125f);
        if (lane < 8) { const float z = SM[(size_t)p * 128 + 80 + lane] + a.in[I_BF][lane]; ((float*)(ws + WS_LOGF))[(size_t)p * 8 + lane] = fminf(z, 0.f) - log1pf(expf(-fabsf(z))); }
    }
}

__device__ __forceinline__ void phase_post2(const Args& a, int gw, int NGW, int wave, int lane, int vcu) {
    unsigned char* ws = a.ws;
    bf16* KVA = (bf16*)(ws + WS_KVA); const f32x2* R128 = (const f32x2*)(ws + WS_ROPE128);
    for (int p = gw; p < LTOK; p += NGW) {
        bf16* krow = KVA + (size_t)p * 2048; const f32x2 cs = R128[(size_t)p * 64 + lane];
#pragma unroll
        for (int t = 0; t < 8; ++t) { bf16* q = krow + t * 128 + lane; const float x1 = bf2f(q[0]), x2 = bf2f(q[64]);
            q[0] = (bf16)f2bf(x1 * cs[0] - x2 * cs[1]); q[64] = (bf16)f2bf(x2 * cs[0] + x1 * cs[1]); }
    }
    if (vcu == 0) {
        const float* LF = (const float*)(ws + WS_LOGF); float* CC = (float*)(ws + WS_CC); const int h = wave;
        float s = 0.f;
        for (int i = 0; i < 129; ++i) { const int p = lane * 129 + i; if (p < LTOK) s += LF[(size_t)p * 8 + h]; }
        float inc = s;
#pragma unroll
        for (int o = 1; o < 64; o <<= 1) { const float t = __shfl_up(inc, o); if (lane >= o) inc += t; }
        float run = inc - s;
        for (int i = 0; i < 129; ++i) { const int p = lane * 129 + i; if (p < LTOK) { run += LF[(size_t)p * 8 + h]; CC[(size_t)p * 8 + h] = run; } }
    }
}

__device__ __forceinline__ void phase_indexer(const Args& a, LAS unsigned char* lds, int gw, int NGW, int wave, int lane) {
    unsigned char* ws = a.ws;
    const bf16* PROJ = (const bf16*)(ws + WS_PROJ); const bf16* KI = (const bf16*)(ws + WS_KI); const float* WI = (const float*)(ws + WS_WI); float* S = (float*)(ws + WS_S);
    LAS float* qs = (LAS float*)(lds + wave * 8192);
    for (int qr = gw; qr < SEQ; qr += NGW) {
        const int pos = qr + NMETA;
        { const bf16* qrow = PROJ + (size_t)pos * PW + PC_QI + 16 * lane; const v4u w0 = *(const v4u*)qrow, w1 = *(const v4u*)(qrow + 8);
          LAS float* d = qs + 16 * lane;
          d[0] = bflo(w0.x); d[1] = bfhi(w0.x); d[2] = bflo(w0.y); d[3] = bfhi(w0.y); d[4] = bflo(w0.z); d[5] = bfhi(w0.z); d[6] = bflo(w0.w); d[7] = bfhi(w0.w);
          d[8] = bflo(w1.x); d[9] = bfhi(w1.x); d[10] = bflo(w1.y); d[11] = bfhi(w1.y); d[12] = bflo(w1.z); d[13] = bfhi(w1.z); d[14] = bflo(w1.w); d[15] = bfhi(w1.w);
          if (lane < 16) qs[1024 + lane] = WI[(size_t)pos * 16 + lane]; }
        LDS_WAIT(); asm volatile("" ::: "memory");
        float* Srow = S + s_row_off(qr);
        const int ntile = pos / 64 + 1;
        for (int j = 0; j < ntile; ++j) {
            const int key = j * 64 + lane;
            float kf[64];
            { const v4u* kp = (const v4u*)(KI + (size_t)key * 64);
#pragma unroll
              for (int c = 0; c < 8; ++c) { const v4u w = kp[c]; kf[8 * c] = bflo(w.x); kf[8 * c + 1] = bfhi(w.x); kf[8 * c + 2] = bflo(w.y); kf[8 * c + 3] = bfhi(w.y);
                  kf[8 * c + 4] = bflo(w.z); kf[8 * c + 5] = bfhi(w.z); kf[8 * c + 6] = bflo(w.w); kf[8 * c + 7] = bfhi(w.w); } }
            float score = 0.f;
#pragma unroll 1
            for (int h = 0; h < 16; ++h) { float d = 0.f;
#pragma unroll
                for (int c = 0; c < 16; ++c) { const f32x4 q = *(const LAS f32x4*)(qs + h * 64 + 4 * c); d += q[0] * kf[4 * c] + q[1] * kf[4 * c + 1] + q[2] * kf[4 * c + 2] + q[3] * kf[4 * c + 3]; }
                score += qs[1024 + h] * fmaxf(d, 0.f); }
            if (key <= pos) Srow[key] = score;
        }
        LDS_WAIT(); asm volatile("" ::: "memory");
    }
}

__device__ __forceinline__ void phase_select(const Args& a, int gw, int NGW, int lane) {
    unsigned char* ws = a.ws;
    const float* S = (const float*)(ws + WS_S); unsigned long long* MASK = (unsigned long long*)(ws + WS_MASK);
    for (int qr = gw; qr < SEQ; qr += NGW) {
        const int pos = qr + NMETA, n = pos + 1;
        const float* Srow = S + s_row_off(qr);
        unsigned key[NTILE64];
#pragma unroll
        for (int j = 0; j < NTILE64; ++j) { const int idx = j * 64 + lane; const float sv = Srow[idx < n ? idx : n - 1]; key[j] = idx < n ? f2key(sv) : 0u; }
        unsigned T = 0u; int need = 0;
        if (n > TOPK) {
            for (int b = 31; b >= 0; --b) {
                const unsigned cand = T | (1u << b); int cl = 0;
#pragma unroll
                for (int j = 0; j < NTILE64; ++j) cl += (key[j] >= cand) ? 1 : 0;
                const int cnt = wave_isum(cl);
                if (cnt >= TOPK) T = cand;
            }
            int gl = 0;
#pragma unroll
            for (int j = 0; j < NTILE64; ++j) gl += (key[j] > T) ? 1 : 0;
            need = TOPK - wave_isum(gl);
        } else { T = 1u; need = 0; }
#pragma unroll
        for (int j = 0; j < NTILE64; ++j) {
            unsigned long long w = __ballot(key[j] > T);
            if (n <= TOPK) w = __ballot(key[j] >= T);
            else if (need > 0) { unsigned long long eq = __ballot(key[j] == T); int c = __popcll(eq);
                while (c > need) { eq &= ~(1ull << (63 - __builtin_clzll(eq))); --c; }
                w |= eq; need -= c; }
            if (lane == 0) MASK[(size_t)j * SEQ + qr] = w;
        }
    }
}

template <bool DSAMODE>
__device__ __forceinline__ void attn_naive(const Args& a, LAS unsigned char* lds, int gw, int NGW, int wave, int lane) {
    unsigned char* ws = a.ws;
    const bf16* PROJ = (const bf16*)(ws + WS_PROJ); const bf16* KVA = (const bf16*)(ws + WS_KVA);
    const bf16* Q = DSAMODE ? PROJ + PC_QA : PROJ + PC_QB; const int ldq = PW;
    const bf16* Kp = DSAMODE ? KVA : PROJ + PC_KB; const int ldk = DSAMODE ? 2048 : PW;
    const bf16* Vp = DSAMODE ? KVA + 1024 : PROJ + PC_VB; const int ldv = DSAMODE ? 2048 : PW;
    bf16* O = (bf16*)(ws + (DSAMODE ? WS_YA : WS_YB));
    const unsigned long long* MASK = (const unsigned long long*)(ws + WS_MASK); const float* CC = (const float*)(ws + WS_CC);
    LAS float* qs = (LAS float*)(lds + wave * 1024);
    for (int item = gw; item < SEQ * NH; item += NGW) {
        const int qr = item >> 3, h = item & 7, pos = qr + NMETA;
        { const unsigned w = *(const unsigned*)(Q + (size_t)pos * ldq + h * 128 + 2 * lane); qs[2 * lane] = bflo(w) * (ATT_SCALE * LOG2E); qs[2 * lane + 1] = bfhi(w) * (ATT_SCALE * LOG2E); }
        LDS_WAIT(); asm volatile("" ::: "memory");
        const float cq = DSAMODE ? 0.f : CC[(size_t)pos * 8 + h];
        float m = -1e30f, l = 0.f, o0 = 0.f, o1 = 0.f;
        const int ntile = pos / 64 + 1;
        for (int j = 0; j < ntile; ++j) {
            const int key = j * 64 + lane; bool valid = key <= pos;
            if (DSAMODE) { const unsigned long long w = MASK[(size_t)j * SEQ + qr]; if (w == 0ull) continue; valid = valid && ((w >> lane) & 1ull); }
            float s = -__builtin_inff();
            if (valid) { const v4u* kp = (const v4u*)(Kp + (size_t)key * ldk + h * 128); float d = 0.f;
#pragma unroll
                for (int c = 0; c < 16; ++c) { const v4u w = kp[c]; const f32x4 q0 = *(const LAS f32x4*)(qs + 8 * c), q1 = *(const LAS f32x4*)(qs + 8 * c + 4);
                    d += q0[0] * bflo(w.x) + q0[1] * bfhi(w.x) + q0[2] * bflo(w.y) + q0[3] * bfhi(w.y) + q1[0] * bflo(w.z) + q1[1] * bfhi(w.z) + q1[2] * bflo(w.w) + q1[3] * bfhi(w.w); }
                s = d; if (!DSAMODE) s += (cq - CC[(size_t)key * 8 + h]) * LOG2E; }
            const float tmax = wave_max(s); const float mn = fmaxf(m, tmax); const float alpha = __builtin_amdgcn_exp2f(m - mn);
            const float p = valid ? __builtin_amdgcn_exp2f(s - mn) : 0.f;
            l = l * alpha + wave_sum(p); o0 *= alpha; o1 *= alpha; m = mn;
            unsigned long long pm = __ballot(p > 0.f);
            while (pm) { const int sl = __builtin_ctzll(pm); pm &= pm - 1; const float ps = __shfl(p, sl);
                const unsigned vv = *(const unsigned*)(Vp + (size_t)(j * 64 + sl) * ldv + h * 128 + 2 * lane); o0 += ps * bflo(vv); o1 += ps * bfhi(vv); }
        }
        const float rl = 1.f / l;
        *(unsigned*)(O + (size_t)qr * 1024 + h * 128 + 2 * lane) = pk2(o0 * rl, o1 * rl);
        LDS_WAIT(); asm volatile("" ::: "memory");
    }
}

__device__ __forceinline__ void phase_moe_weights(const Args& a, LAS unsigned char* lds, int gw, int NGW, int wave, int lane) {
    unsigned char* ws = a.ws;
    LAS float* scr = (LAS float*)(lds + RING_OFF + wave * 16384);
    constexpr int I_GU = 32 * 32, I_D = 8 * 64;
    for (int it = gw; it < NE * (I_GU + I_D); it += NGW) {
        const int e = it / (I_GU + I_D); int r = it % (I_GU + I_D);
        if (r < I_GU) { const int kb = r / 32, nb = r % 32; const int n = nb * 32 + (lane & 31); const int pn = n >> 8, half = (n >> 7) & 1, j = n & 127;
            const float* src = (half ? a.in[I_WUP] : a.in[I_WGATE]) + (size_t)e * 2048 * 512 + 128 * pn + j;
            transpose_item(src, 512, (bf16*)(ws + WS_WGUT) + (size_t)e * 1024 * 2048, 2048, 64 * kb, 32 * nb, scr, lane); }
        else { r -= I_GU; const int kb = r / 64, nb = r % 64;
            transpose_item(a.in[I_WDOWN] + (size_t)e * 512 * 2048 + nb * 32 + (lane & 31), 2048, (bf16*)(ws + WS_WDT) + (size_t)e * 2048 * 512, 512, 64 * kb, 32 * nb, scr, lane); }
    }
}

__device__ __forceinline__ void phase_route(const Args& a, int gw, int NGW, int lane) {
    unsigned char* ws = a.ws;
    const float* H2 = (const float*)(ws + WS_H2); bf16* T = (bf16*)(ws + WS_T); unsigned* cnt = (unsigned*)(ws + WS_CTL) + CW_CNT;
    { int* rt = (int*)(ws + WS_ROWTOK); for (int i = gw * 64 + lane; i < TSROWS; i += NGW * 64) rt[i] = -1; }
    const f32x4* gf = (const f32x4*)a.in[I_GFFN];
    for (int tok = gw; tok < SEQ; tok += NGW) {
        const f32x4* hr = (const f32x4*)(H2 + (size_t)tok * 2048);
        float s = 0.f;
#pragma unroll
        for (int j = 0; j < 8; ++j) { const f32x4 hv = hr[lane + 64 * j]; s += (hv[0] * hv[0] + hv[1] * hv[1]) + (hv[2] * hv[2] + hv[3] * hv[3]); }
        const float rstd = 1.f / sqrtf(wave_sum(s) * (1.f / 2048.f) + EPS);
        float lg[20];
#pragma unroll
        for (int i = 0; i < 20; ++i) lg[i] = 0.f;
#pragma unroll 1
        for (int j = 0; j < 8; ++j) { const f32x4 hv = hr[lane + 64 * j]; const f32x4 g = gf[lane + 64 * j]; f32x4 t; t[0] = hv[0] * rstd * g[0]; t[1] = hv[1] * rstd * g[1]; t[2] = hv[2] * rstd * g[2]; t[3] = hv[3] * rstd * g[3];
            v2u o; o.x = pk2(t[0], t[1]); o.y = pk2(t[2], t[3]); *(v2u*)(T + (size_t)tok * 2048 + 4 * (lane + 64 * j)) = o;
#pragma unroll
            for (int c = 0; c < 4; ++c) { const int k = 4 * (lane + 64 * j) + c; const f32x4 wg = *(const f32x4*)(a.in[I_WGROUP] + (size_t)k * 4);
                lg[0] += t[c] * wg[0]; lg[1] += t[c] * wg[1]; lg[2] += t[c] * wg[2]; lg[3] += t[c] * wg[3];
                const f32x4* we = (const f32x4*)(a.in[I_WEXPERT] + (size_t)k * 16);
#pragma unroll
                for (int q = 0; q < 4; ++q) { const f32x4 w4 = we[q]; lg[4 + 4 * q] += t[c] * w4[0]; lg[5 + 4 * q] += t[c] * w4[1]; lg[6 + 4 * q] += t[c] * w4[2]; lg[7 + 4 * q] += t[c] * w4[3]; } } }
#pragma unroll
        for (int i = 0; i < 20; ++i) lg[i] = wave_sum(lg[i]);
        float gl[4];
#pragma unroll
        for (int i = 0; i < 4; ++i) gl[i] = lg[i] + a.in[I_BGROUP][i];
        int gs = 0; float gmx = gl[0];
#pragma unroll
        for (int i = 1; i < 4; ++i) if (gl[i] > gmx) { gmx = gl[i]; gs = i; }
        float den = 0.f;
#pragma unroll
        for (int i = 0; i < 4; ++i) den += expf(gl[i] - gmx);
        const float pg = 1.f / den;
        float el[4];
#pragma unroll
        for (int i = 0; i < 4; ++i) { el[i] = 0.f;
#pragma unroll
            for (int g = 0; g < 4; ++g) if (gs == g) el[i] = lg[4 + 4 * g + i] + a.in[I_BEXPERT][4 * g + i]; }
        int i0 = 0; float m0 = el[0];
#pragma unroll
        for (int i = 1; i < 4; ++i) if (el[i] > m0) { m0 = el[i]; i0 = i; }
        int i1 = -1; float m1 = -__builtin_inff();
#pragma unroll
        for (int i = 0; i < 4; ++i) if (i != i0 && el[i] > m1) { m1 = el[i]; i1 = i; }
        const float ex = expf(m1 - m0); const float p0 = 1.f / (1.f + ex), p1 = ex / (1.f + ex);
        if (lane == 0) { const int e0 = gs * 4 + i0, e1 = gs * 4 + i1;
            const unsigned s0 = __hip_atomic_fetch_add(cnt + e0, 1u, RLX_AGENT), s1 = __hip_atomic_fetch_add(cnt + e1, 1u, RLX_AGENT);
            unsigned* r = (unsigned*)(ws + WS_ROUTE) + (size_t)tok * 8;
            r[0] = (unsigned)e0; r[1] = s0; r[2] = __builtin_bit_cast(unsigned, pg * p0); r[3] = (unsigned)e1; r[4] = s1; r[5] = __builtin_bit_cast(unsigned, pg * p1); }
    }
}
__device__ __forceinline__ void moe_tile_bases(const Args& a, volatile LAS int* tb) {
    if (threadIdx.x == 0) { const unsigned* cnt = (const unsigned*)(a.ws + WS_CTL) + CW_CNT; int acc = 0;
        for (int e = 0; e < 16; ++e) { tb[e] = acc; acc += (int)((__hip_atomic_load(cnt + e, RLX_AGENT) + 255u) >> 8); } tb[16] = acc; }
    __syncthreads();
}
__device__ __forceinline__ void phase_gather(const Args& a, volatile LAS int* tb, int gw, int NGW, int lane) {
    unsigned char* ws = a.ws;
    const bf16* T = (const bf16*)(ws + WS_T); bf16* TS = (bf16*)(ws + WS_TS); int* RT = (int*)(ws + WS_ROWTOK); float* RW = (float*)(ws + WS_ROWW);
    for (int tok = gw; tok < SEQ; tok += NGW) {
        const unsigned* r = (const unsigned*)(ws + WS_ROUTE) + (size_t)tok * 8;
        const v4u* src = (const v4u*)(T + (size_t)tok * 2048); v4u d[4];
#pragma unroll
        for (int j = 0; j < 4; ++j) d[j] = src[lane + 64 * j];
#pragma unroll
        for (int k = 0; k < 2; ++k) { const int e = (int)r[3 * k]; const int row = tb[e] * 256 + (int)r[3 * k + 1];
            v4u* dst = (v4u*)(TS + (size_t)row * 2048);
#pragma unroll
            for (int j = 0; j < 4; ++j) dst[lane + 64 * j] = d[j];
            if (lane == 0) { RT[row] = tok * 2 + k; RW[row] = __builtin_bit_cast(float, r[3 * k + 2]); } }
    }
}
__device__ __forceinline__ void phase_final(const Args& a, int gw, int NGW, int lane) {
    unsigned char* ws = a.ws;
    const float* H2 = (const float*)(ws + WS_H2); const bf16* Y = (const bf16*)(ws + WS_Y); const f32x4* gf = (const f32x4*)a.in[I_GFINAL];
    for (int tok = gw; tok < SEQ; tok += NGW) {
        const f32x4* hr = (const f32x4*)(H2 + (size_t)tok * 2048); const v2u* y0 = (const v2u*)(Y + (size_t)tok * 2048); const v2u* y1 = (const v2u*)(Y + ((size_t)SEQ + tok) * 2048);
        f32x4 v[8]; float s = 0.f;
#pragma unroll
        for (int j = 0; j < 8; ++j) { const f32x4 hv = hr[lane + 64 * j]; const v2u a0 = y0[lane + 64 * j], a1 = y1[lane + 64 * j];
            v[j][0] = hv[0] + bflo(a0.x) + bflo(a1.x); v[j][1] = hv[1] + bfhi(a0.x) + bfhi(a1.x); v[j][2] = hv[2] + bflo(a0.y) + bflo(a1.y); v[j][3] = hv[3] + bfhi(a0.y) + bfhi(a1.y);
            s += (v[j][0] * v[j][0] + v[j][1] * v[j][1]) + (v[j][2] * v[j][2] + v[j][3] * v[j][3]); }
        const float rstd = 1.f / sqrtf(wave_sum(s) * (1.f / 2048.f) + EPS);
        f32x4* orow = (f32x4*)(a.out + (size_t)tok * 2048);
#pragma unroll
        for (int j = 0; j < 8; ++j) { const f32x4 g = gf[lane + 64 * j]; orow[lane + 64 * j] = (f32x4){v[j][0] * rstd * g[0], v[j][1] * rstd * g[1], v[j][2] * rstd * g[2], v[j][3] * rstd * g[3]}; }
    }
}

__global__ void __launch_bounds__(NWAVES * 64, 2) mk_fwd(Args args) {
    extern __shared__ __attribute__((aligned(16))) unsigned char lds_raw[];
    LAS unsigned char* lds = (LAS unsigned char*)lds_raw;
    volatile LAS unsigned* MISC = (volatile LAS unsigned*)(lds + MISC_OFF);
    volatile LAS int* TB = (volatile LAS int*)(lds + MISC_OFF + 64);
    const int tid = threadIdx.x;
    const int G = gridDim.x; const int bx = blockIdx.x; const int vcu = (G % 8 == 0) ? (bx % 8) * (G / 8) + bx / 8 : bx;
    const int NGW = G * NWAVES;
#define TIDS() int tid_ = threadIdx.x; asm volatile("" : "+v"(tid_)); const int lane = tid_ & 63, wave = __builtin_amdgcn_readfirstlane(tid_ >> 6), gw = vcu * NWAVES + wave; (void)lane; (void)gw;
    unsigned char* ws = args.ws;
    gu32* ctl = (gu32*)(ws + WS_CTL);
    for (int u = tid; u < (LDS_BYTES - LDSCTL_OFF) / 4; u += NWAVES * 64) ((LAS unsigned*)(lds + LDSCTL_OFF))[u] = 0u;
    __syncthreads();
    XcdBarrier bar; bar.bar = (unsigned*)(ctl + CW_BAR); bar.x = 0; bar.st = nullptr;
    if (MK_ONE_LAUNCH) bar = xcd_barrier_post((unsigned*)(ctl + CW_BAR), MISC + 8);
    const int lo = args.ph_lo, hi = args.ph_hi;
#ifndef PHASE_MASK
#define PHASE_MASK 0x7fff
#endif
#define IN(k) (((PHASE_MASK >> (k)) & 1) && lo <= (k) && (k) < hi)
#define SEAM(k) do { if (IN(k) && IN((k) + 1)) xcd_barrier(bar); } while (0)

    if (IN(0)) { TIDS(); phase_prologue(args, lds, gw, NGW, wave, lane); } SEAM(0);
    if (IN(1)) {
        pg8::Gemm g{(const bf16*)(ws + WS_HN), (const bf16*)(ws + WS_WINT), 2048, 2048, 2048}; pg8::StaticOrder S; S.init(LP / 256, PW / 256, G, bx);
        EpiProj E{(bf16*)(ws + WS_PROJ), (float*)(ws + WS_SMALL)};
        pg8::gemm_phase(lds + RING_OFF, g, S, E);
    } SEAM(1);
    if (IN(2)) { TIDS(); phase_post1(args, gw, NGW, lane); } SEAM(2);
    if (IN(3)) {
        pg8::Gemm g{(const bf16*)(ws + WS_CKVN), (const bf16*)(ws + WS_WKVT), 512, 512, 512}; pg8::StaticOrder S; S.init(LP / 256, 8, G, bx);
        EpiBf16Plain E{(bf16*)(ws + WS_KVA), 2048};
        pg8::gemm_phase(lds + RING_OFF, g, S, E);
    } SEAM(3);
    if (IN(4)) { TIDS(); phase_post2(args, gw, NGW, wave, lane, vcu); } SEAM(4);
    if (IN(5)) { TIDS(); phase_indexer(args, lds, gw, NGW, wave, lane); } SEAM(5);
    if (IN(6)) { TIDS(); phase_select(args, gw, NGW, lane); } SEAM(6);
    if (IN(7)) { TIDS(); attn_naive<false>(args, lds, gw, NGW, wave, lane); attn_naive<true>(args, lds, gw, NGW, wave, lane); } SEAM(7);
    if (IN(8)) {
        { pg8::Gemm g{(const bf16*)(ws + WS_YA), (const bf16*)(ws + WS_WAT), 1024, 1024, 1024}; pg8::StaticOrder S; S.init(SEQ / 256, 8, G, bx);
          EpiBranchA E{(const bf16*)(ws + WS_PROJ), (float*)(ws + WS_M1)};
          pg8::gemm_phase(lds + RING_OFF, g, S, E); }
        VM_WAIT(); __syncthreads();
        { pg8::Gemm g{(const bf16*)(ws + WS_YB), (const bf16*)(ws + WS_WBT), 1024, 1024, 1024}; pg8::StaticOrder S; S.init(SEQ / 256, 8, G, bx);
          EpiBranchB E{(const bf16*)(ws + WS_PROJ), (const float*)(ws + WS_M1), (bf16*)(ws + WS_MERGED)};
          pg8::gemm_phase(lds + RING_OFF, g, S, E); }
    } SEAM(8);
    if (IN(9)) {
        { TIDS(); phase_moe_weights(args, lds, gw, NGW, wave, lane); }
        VM_WAIT(); __syncthreads();
        pg8::Gemm g{(const bf16*)(ws + WS_MERGED), (const bf16*)(ws + WS_WOT), 2048, 2048, 2048}; pg8::StaticOrder S; S.init(SEQ / 256, 8, G, bx);
        EpiOut E{args.in[I_X], (float*)(ws + WS_H2)};
        pg8::gemm_phase(lds + RING_OFF, g, S, E);
    } SEAM(9);
    if (IN(10)) { TIDS(); phase_route(args, gw, NGW, lane); } SEAM(10);
    if (IN(11)) { TIDS(); moe_tile_bases(args, TB); phase_gather(args, TB, gw, NGW, lane); } SEAM(11);
    if (IN(12)) {
        moe_tile_bases(args, TB);
        pg8::Gemm g{(const bf16*)(ws + WS_TS), (const bf16*)(ws + WS_WGUT), 2048, 2048, 2048}; pg8::MoeOrder S; S.init(TB[16], 4, G, bx, (const LAS int*)TB, (size_t)1024 * 2048 * 2);
        EpiGateUp E{(bf16*)(ws + WS_ACT), (const float*)(ws + WS_ROWW)};
        pg8::gemm_phase(lds + RING_OFF, g, S, E);
    } SEAM(12);
    if (IN(13)) {
        moe_tile_bases(args, TB);
        pg8::Gemm g{(const bf16*)(ws + WS_ACT), (const bf16*)(ws + WS_WDT), 512, 512, 512}; pg8::MoeOrder S; S.init(TB[16], 8, G, bx, (const LAS int*)TB, (size_t)2048 * 512 * 2);
        EpiDown E{(bf16*)(ws + WS_Y), (const int*)(ws + WS_ROWTOK)};
        pg8::gemm_phase(lds + RING_OFF, g, S, E);
    } SEAM(13);
    if (IN(14)) { TIDS(); phase_final(args, gw, NGW, lane); }
#undef IN
#undef SEAM
}

extern "C" void kernel_launch(void* const* d_in, const int* in_sizes, int n_in, void* d_out, int out_size, void* d_ws, size_t ws_size, hipStream_t stream) {
    static int grid = 0;
    if (grid == 0) {
        if (n_in != 20 || out_size != SEQ * DM || ws_size < WS_NEED) { fprintf(stderr, "kernel_launch: unexpected shapes (n_in %d, out %d, ws %zu need %zu)\n", n_in, out_size, ws_size, (size_t)WS_NEED); grid = -1; return; }
        int dev = 0, cus = 0;
        if (hipGetDevice(&dev) != hipSuccess || hipDeviceGetAttribute(&cus, hipDeviceAttributeMultiprocessorCount, dev) != hipSuccess) { grid = -1; return; }
        if (hipFuncSetAttribute((const void*)mk_fwd, hipFuncAttributeMaxDynamicSharedMemorySize, LDS_BYTES) != hipSuccess) { fprintf(stderr, "kernel_launch: hipFuncSetAttribute failed\n"); grid = -1; return; }
        int per_cu = 0;
        if (hipOccupancyMaxActiveBlocksPerMultiprocessor(&per_cu, (const void*)mk_fwd, NWAVES * 64, LDS_BYTES) != hipSuccess || per_cu < 1) fprintf(stderr, "kernel_launch: occupancy query says %d\n", per_cu);
        (void)hipGetLastError();
        grid = cus;
    }
    if (grid < 0) return;
    (void)hipMemsetAsync((char*)d_ws + WS_CTL, 0, CTL_ZERO_BYTES, stream);
    Args a{};
    for (int i = 0; i < 20; ++i) a.in[i] = (const float*)d_in[i];
    a.out = (float*)d_out; a.ws = (unsigned char*)d_ws;
    if (MK_ONE_LAUNCH) {
        a.ph_lo = 0; a.ph_hi = NPHASE; a.li = 0;
        hipLaunchKernelGGL(mk_fwd, dim3(grid), dim3(NWAVES * 64), LDS_BYTES, stream, a);
    } else {
        for (int p = 0; p < NPHASE; ++p) { a.ph_lo = p; a.ph_hi = p + 1; a.li = p; hipLaunchKernelGGL(mk_fwd, dim3(grid), dim3(NWAVES * 64), LDS_BYTES, stream, a); }
    }
}
```

```cpp
#include <hip/hip_runtime.h>
#include <hip/hip_bf16.h>
#include <cstdio>
#include <cstdint>

#ifndef MK_ONE_LAUNCH
#define MK_ONE_LAUNCH 1
#endif

namespace pg8 {
#define PG8_LAS __attribute__((address_space(3)))
typedef unsigned short bf16_t;
typedef short bf16x8 __attribute__((ext_vector_type(8)));
typedef float f32x4 __attribute__((ext_vector_type(4)));
typedef unsigned u32x4 __attribute__((ext_vector_type(4)));
constexpr int BM = 256, BK = 64, HALF = 128, HTB = HALF * BK * 2, STAGE_BYTES = 8 * HTB, NXCD = 8, WGM = 8;

__host__ __device__ __forceinline__ int lds_byte(int r, int c) { const int st = (r >> 4) * 2 + (c >> 5), rr = r & 15, cc = c & 31, ob = rr * 64 + cc * 2; return st * 1024 + (ob ^ (((ob >> 9) & 1) << 5)); }
__host__ __device__ __forceinline__ void stage_rc(int b, int& R, int& C) { const int st = b / 1024, sb = b % 1024, swz = sb ^ (((sb >> 9) & 1) << 5); R = (st >> 1) * 16 + swz / 64; C = (st & 1) * 32 + (swz % 64) / 2; }
__host__ __device__ __forceinline__ int perm32(int rho) { const int n = rho >> 4, i = rho & 15; return 8 * (i >> 2) + 4 * n + (i & 3); }

struct Unit { int pm, pn; size_t bofs; };
struct Gemm { const bf16_t* A; const bf16_t* Bt; int lda, ldb, K; };

struct StaticOrder {
    int nM, nN, nwg, G, c;
    __device__ void init(int nM_, int nN_, int G_, int c_) { nM = nM_; nN = nN_; nwg = nM * nN; G = G_; c = c_; }
    __device__ bool next(int i, Unit& u) const {
        const long L = (long)i * G + c; if (L >= nwg) return false;
        int wgid = (int)L; { const int q = nwg / NXCD, r = nwg % NXCD, xcd = wgid % NXCD, off = wgid / NXCD; wgid = (xcd < r ? xcd * (q + 1) : r * (q + 1) + (xcd - r) * q) + off; }
        const int nig = WGM * nN, gid = wgid / nig, fm = gid * WGM, gsz = (nM - fm) < WGM ? (nM - fm) : WGM;
        u.pm = fm + ((wgid % nig) % gsz); u.pn = (wgid % nig) / gsz; u.bofs = 0; return true;
    }
};
struct MoeOrder {
    int nM, nN, nwg, G, c; const PG8_LAS int* tb; size_t bstride;
    __device__ void init(int nM_, int nN_, int G_, int c_, const PG8_LAS int* tb_, size_t bs) { nM = nM_; nN = nN_; nwg = nM * nN; G = G_; c = c_; tb = tb_; bstride = bs; }
    __device__ bool next(int i, Unit& u) const {
        const long L = (long)i * G + c; if (L >= nwg) return false;
        const int wgid = (int)L;
        u.pn = wgid % nN; u.pm = wgid / nN;
        int e = 0;
#pragma unroll
        for (int k = 1; k < 16; ++k) e += (tb[k] <= u.pm) ? 1 : 0;
        u.bofs = (size_t)e * bstride; return true;
    }
};

__device__ __forceinline__ unsigned cvt_pk_bf16(float lo, float hi) { unsigned r; asm volatile("v_cvt_pk_bf16_f32 %0, %1, %2" : "=v"(r) : "v"(lo), "v"(hi)); return r; }

template <class Epi, class Sched>
__device__ __forceinline__ void gemm_phase(PG8_LAS unsigned char* lds, const Gemm g, const Sched& S, const Epi& E) {
    const int tid = threadIdx.x, wid = __builtin_amdgcn_readfirstlane(tid >> 6), lane = tid & 63, wr = wid >> 2, wc = wid & 3, fr = lane & 15, fq = lane >> 4;
    const int K = g.K, nt = K / BK;
    unsigned voffA[2], voffB[2];
#pragma unroll
    for (int i = 0; i < 2; ++i) { int R, C; stage_rc(tid * 16 + i * 8192, R, C); const int Rb = ((R & ~31) + perm32(R & 31));
        voffA[i] = (unsigned)(R * g.lda + C) * 2u; voffB[i] = (unsigned)(Rb * g.ldb + C) * 2u; }
    const size_t kstep = (size_t)(BK * 2);
    const size_t hstepA = (size_t)HALF * g.lda * 2, hstepB = (size_t)HALF * g.ldb * 2;
    const size_t tstepA = 2 * hstepA, tstepB = 2 * hstepB;
    const unsigned ldsw = (unsigned)wid * 1024u;
    const int aoff = lds_byte(wr * 64 + fr, fq * 8), boff = lds_byte(wc * 32 + fr, fq * 8);
#define PG8_SA(b, h) (((b) * 2 + (h)) * HTB)
#define PG8_SB(b, h) ((4 + (b) * 2 + (h)) * HTB)
#define PG8_STAGE(bufoff, gbase, voff) do { _Pragma("unroll") for (int _i = 0; _i < 2; ++_i) \
        __builtin_amdgcn_global_load_lds((const unsigned*)((const char*)(gbase) + (voff)[_i]), (PG8_LAS unsigned*)(lds + (bufoff) + ldsw + _i * 8192), 16, 0, 0); } while (0)
#define PG8_LDA(dst, b, h) do { _Pragma("unroll") for (int m = 0; m < 4; ++m) _Pragma("unroll") for (int k = 0; k < 2; ++k) dst[m][k] = *(const PG8_LAS bf16x8*)(lds + PG8_SA(b, h) + aoff + m * 2048 + k * 1024); } while (0)
#define PG8_LDB(dst, b, h) do { _Pragma("unroll") for (int n = 0; n < 2; ++n) _Pragma("unroll") for (int k = 0; k < 2; ++k) dst[n][k] = *(const PG8_LAS bf16x8*)(lds + PG8_SB(b, h) + boff + n * 2048 + k * 1024); } while (0)
#define PG8_MMA(ai, bj, At, Bt) do { __builtin_amdgcn_s_setprio(1); _Pragma("unroll") for (int m = 0; m < 4; ++m) _Pragma("unroll") for (int n = 0; n < 2; ++n) _Pragma("unroll") for (int k = 0; k < 2; ++k) \
        acc[ai][bj][m][n] = __builtin_amdgcn_mfma_f32_16x16x32_bf16(Bt[n][k], At[m][k], acc[ai][bj][m][n], 0, 0, 0); __builtin_amdgcn_s_setprio(0); } while (0)
#define PG8_WAIT_V(n) asm volatile("s_waitcnt vmcnt(" #n ")" ::: "memory")
#define PG8_WAIT_L(n) asm volatile("s_waitcnt lgkmcnt(" #n ")" ::: "memory")
#define PG8_BAR __builtin_amdgcn_s_barrier()
#define PG8_SCHED __builtin_amdgcn_sched_barrier(0)
    Unit cur, nxt; int ui = 0;
    if (!S.next(0, cur)) return;
    f32x4 acc[2][2][4][2];
#pragma unroll
    for (int a = 0; a < 2; ++a)
#pragma unroll
        for (int b = 0; b < 2; ++b)
#pragma unroll
            for (int m = 0; m < 4; ++m)
#pragma unroll
                for (int n = 0; n < 2; ++n) acc[a][b][m][n] = (f32x4){0.f, 0.f, 0.f, 0.f};
    bf16x8 At[4][2], B0[2][2], B1[2][2];
    const char* cA = (const char*)g.A + (size_t)cur.pm * tstepA; const char* cB = (const char*)g.Bt + cur.bofs + (size_t)cur.pn * tstepB;
    {
        PG8_STAGE(PG8_SB(0, 0), cB, voffB); PG8_STAGE(PG8_SB(0, 1), cB + hstepB, voffB); PG8_STAGE(PG8_SA(0, 0), cA, voffA); PG8_STAGE(PG8_SA(0, 1), cA + hstepA, voffA);
        if (wr == 1) PG8_BAR;
        PG8_WAIT_V(2); PG8_BAR;
        PG8_STAGE(PG8_SB(1, 0), cB + kstep, voffB); PG8_STAGE(PG8_SA(1, 0), cA + kstep, voffA); PG8_STAGE(PG8_SB(1, 1), cB + hstepB + kstep, voffB);
        PG8_WAIT_V(6); PG8_BAR;
    }
    for (;;) {
        const bool has_next = S.next(ui + 1, nxt);
        const char* nA = has_next ? (const char*)g.A + (size_t)nxt.pm * tstepA : cA; const char* nB = has_next ? (const char*)g.Bt + nxt.bofs + (size_t)nxt.pn * tstepB : cB;
        for (int t = 0; t < nt; t += 2) {
            const bool last = (t == nt - 2);
            const char* a1 = cA + (size_t)(t + 1) * kstep;
            const char* a2 = last ? nA : cA + (size_t)(t + 2) * kstep; const char* b2 = last ? nB : cB + (size_t)(t + 2) * kstep;
            const char* a3 = a2 + kstep; const char* b3 = b2 + kstep;
            PG8_LDB(B0, 0, 0); PG8_LDB(B1, 0, 1); PG8_SCHED; PG8_LDA(At, 0, 0); PG8_STAGE(PG8_SA(1, 1), a1 + hstepA, voffA);
            PG8_WAIT_V(8); PG8_WAIT_L(0); PG8_BAR; PG8_MMA(0, 0, At, B0); PG8_MMA(0, 1, At, B1); PG8_BAR; PG8_SCHED;
            PG8_LDA(At, 0, 1); PG8_STAGE(PG8_SB(0, 0), b2, voffB); PG8_STAGE(PG8_SB(0, 1), b2 + hstepB, voffB); PG8_STAGE(PG8_SA(0, 0), a2, voffA);
            PG8_WAIT_V(8); PG8_WAIT_L(0); PG8_BAR; PG8_MMA(1, 0, At, B0); PG8_MMA(1, 1, At, B1); PG8_BAR; PG8_SCHED;
            PG8_LDB(B0, 1, 0); PG8_LDB(B1, 1, 1); PG8_SCHED; PG8_LDA(At, 1, 0); PG8_STAGE(PG8_SA(0, 1), a2 + hstepA, voffA);
            PG8_WAIT_V(8); PG8_WAIT_L(0); PG8_BAR; PG8_MMA(0, 0, At, B0); PG8_MMA(0, 1, At, B1); PG8_BAR; PG8_SCHED;
            PG8_LDA(At, 1, 1); PG8_STAGE(PG8_SB(1, 0), b3, voffB); PG8_STAGE(PG8_SB(1, 1), b3 + hstepB, voffB); PG8_STAGE(PG8_SA(1, 0), a3, voffA);
            PG8_WAIT_V(8); PG8_WAIT_L(0); PG8_BAR; PG8_MMA(1, 0, At, B0); PG8_MMA(1, 1, At, B1); PG8_BAR; PG8_SCHED;
        }
        if (wr == 0) PG8_BAR;
        E(acc, cur, wr, wc, fr, fq);
        if (!has_next) break;
#pragma unroll
        for (int a = 0; a < 2; ++a)
#pragma unroll
            for (int b = 0; b < 2; ++b)
#pragma unroll
                for (int m = 0; m < 4; ++m)
#pragma unroll
                    for (int n = 0; n < 2; ++n) acc[a][b][m][n] = (f32x4){0.f, 0.f, 0.f, 0.f};
        cur = nxt; cA = nA; cB = nB; ++ui;
        if (wr == 1) PG8_BAR;
    }
    PG8_WAIT_V(0);
    PG8_BAR;
#undef PG8_SA
#undef PG8_SB
#undef PG8_STAGE
#undef PG8_LDA
#undef PG8_LDB
#undef PG8_MMA
#undef PG8_WAIT_V
#undef PG8_WAIT_L
#undef PG8_BAR
#undef PG8_SCHED
}
}

constexpr int NWAVES = 8;
constexpr int DM = 2048, SEQ = 8192, NMETA = 16, LTOK = SEQ + NMETA, LP = 8448;
constexpr int HD = 128, NH = 8, KVR = 512, IH = 16, IDD = 64, TOPK = 256;
constexpr int INW = 9816, PW = 9984;
constexpr int PC_QA = 0, PC_CKV = 1024, PC_QI = 1536, PC_KI = 2560, PC_WI = 2624, PC_FB = 2640, PC_QB = 2688, PC_KB = 3712, PC_VB = 4736, PC_GA = 5760, PC_GB = 7808, PC_END = 9856;
constexpr int NE = 16, DFF = 512, TSROWS = 20480;
constexpr float EPS = 1e-6f;
constexpr float LOG2E = 1.4426950408889634f;
constexpr float ATT_SCALE = 0.08838834764831845f;
constexpr int NTILE64 = 129;
constexpr int NPHASE = 15;

constexpr size_t MiB = 1u << 20;
constexpr size_t WS_CTL = 0, CTL_ZERO_BYTES = 1 * MiB;
constexpr size_t WS_ROPE128 = 1 * MiB;
constexpr size_t WS_ROPE64 = 5 * MiB + 256 * 1024;
constexpr size_t WS_KI = 7 * MiB + 512 * 1024;
constexpr size_t WS_WI = 8 * MiB + 768 * 1024;
constexpr size_t WS_LOGF = 9 * MiB + 512 * 1024;
constexpr size_t WS_CC = 9 * MiB + 896 * 1024;
constexpr size_t WS_ROUTE = 10 * MiB + 256 * 1024;
constexpr size_t WS_ROWTOK = 10 * MiB + 512 * 1024;
constexpr size_t WS_ROWW = 10 * MiB + 640 * 1024;
constexpr size_t WS_WAT = 12 * MiB, WS_WBT = 16 * MiB, WS_WOT = 20 * MiB, WS_WKVT = 28 * MiB;
constexpr size_t WS_PROJ = 30 * MiB;
constexpr size_t WS_KVA = 191 * MiB;
constexpr size_t WS_CKVN = 224 * MiB;
constexpr size_t WS_MASK = 224 * MiB;
constexpr size_t WS_R = 233 * MiB;
constexpr size_t WS_HN = WS_R, WS_WINT = WS_R + 33 * MiB, WS_SMALL = WS_R + 73 * MiB;
constexpr size_t WS_S = WS_R;
constexpr size_t WS_YA = WS_R, WS_YB = WS_R + 16 * MiB, WS_MERGED = WS_R + 32 * MiB, WS_M1 = WS_R + 64 * MiB;
constexpr size_t WS_H2 = 30 * MiB, WS_T = 94 * MiB, WS_WGUT = 126 * MiB, WS_WDT = 190 * MiB;
constexpr size_t WS_TS = WS_R, WS_ACT = WS_R + 80 * MiB, WS_Y = WS_R;
constexpr size_t WS_NEED = WS_R + 134 * MiB;
static_assert(WS_PROJ + (size_t)LP * PW * 2 <= WS_KVA && WS_KVA + (size_t)LP * 2048 * 2 <= WS_CKVN && WS_CKVN + (size_t)LP * 512 * 2 <= WS_R, "ws map");
static_assert(WS_WDT + (size_t)NE * 2048 * 512 * 2 <= WS_MASK && WS_M1 + (size_t)SEQ * 2048 * 4 <= WS_NEED && WS_ACT + (size_t)TSROWS * 512 * 2 <= WS_NEED, "ws map 2");
constexpr int CW_CNT = 64;
constexpr int CW_BAR = 4096;

constexpr int RING_OFF = 0, RING_BYTES = 131072;
constexpr int LDSCTL_OFF = RING_BYTES, MISC_OFF = LDSCTL_OFF + 320;
constexpr int LDS_BYTES = 147456;

#define GAS __attribute__((address_space(1)))
#define LAS __attribute__((address_space(3)))
typedef unsigned short bf16;
typedef unsigned v4u __attribute__((ext_vector_type(4)));
typedef unsigned v2u __attribute__((ext_vector_type(2)));
typedef float f32x4 __attribute__((ext_vector_type(4)));
typedef float f32x2 __attribute__((ext_vector_type(2)));
typedef short bf16x8 __attribute__((ext_vector_type(8)));
typedef GAS unsigned gu32;
#define RLX_AGENT __ATOMIC_RELAXED, __HIP_MEMORY_SCOPE_AGENT
#define LDS_WAIT() asm volatile("s_waitcnt lgkmcnt(0)" ::: "memory")
#define VM_WAIT() asm volatile("s_waitcnt vmcnt(0)" ::: "memory")
__device__ __forceinline__ unsigned f2bf(float f) { unsigned u = __builtin_bit_cast(unsigned, f); return (u + 0x7fffu + ((u >> 16) & 1u)) >> 16; }
__device__ __forceinline__ unsigned pk2(float lo, float hi) { return f2bf(lo) | (f2bf(hi) << 16); }
__device__ __forceinline__ float bf2f(unsigned h) { return __builtin_bit_cast(float, h << 16); }
__device__ __forceinline__ float bflo(unsigned w) { return __builtin_bit_cast(float, w << 16); }
__device__ __forceinline__ float bfhi(unsigned w) { return __builtin_bit_cast(float, w & 0xffff0000u); }

#define XB_TMO      128
#define XB_XCNT(j)  (256  + 64 * (j))
#define XB_XSUB(j)  (1280 + 64 * (j))
#define XB_XGEN(j)  (2304 + 64 * (j))
#define XB_TOP      3328
#define XB_TOPGEN   3392
#define XCD_BAR_WORDS 3456
#define XB_SPIN_CAP (1u << 22)
__device__ __forceinline__ unsigned xb_ld(unsigned* p)              { return __hip_atomic_load(p, __ATOMIC_RELAXED, __HIP_MEMORY_SCOPE_AGENT); }
__device__ __forceinline__ unsigned xb_add(unsigned* p, unsigned v) { return __hip_atomic_fetch_add(p, v, __ATOMIC_RELAXED, __HIP_MEMORY_SCOPE_AGENT); }
__device__ __forceinline__ unsigned xb_xcc_id() { return (unsigned)__builtin_amdgcn_s_getreg((3 << 11) | 20) & 0xFu; }
#define XB_SPIN(cond, bar) do { unsigned _sp = 0; while (cond) { __builtin_amdgcn_s_sleep(1); \
    if ((++_sp & 255u) == 0u) { if (xb_ld(&(bar)[XB_TMO])) break; if (_sp > XB_SPIN_CAP) { atomicAdd(&(bar)[XB_TMO], 1u); break; } } } } while (0)
struct XcdBarrier { unsigned* bar; unsigned x; volatile LAS unsigned* st; };
__device__ __forceinline__ XcdBarrier xcd_barrier_post(unsigned* bar, volatile LAS unsigned* st) {
    XcdBarrier b; b.bar = bar; b.x = xb_xcc_id(); b.st = st;
    if (threadIdx.x == 0) (void)xb_add(&bar[XB_XCNT(b.x)], 1u);
    return b;
}
__device__ __forceinline__ void xcd_barrier_complete(unsigned* bar, unsigned x, unsigned& nloc, unsigned& nx) {
    const unsigned G = gridDim.x * gridDim.y * gridDim.z;
    unsigned sum, cnt, mine, sp = 0u;
    for (;;) {
        sum = 0u; cnt = 0u; mine = 0u;
#pragma unroll
        for (unsigned j = 0; j < 16; ++j) { const unsigned c = xb_ld(&bar[XB_XCNT(j)]); sum += c; cnt += (c > 0u) ? 1u : 0u; mine = (j == x) ? c : mine; }
        if (sum == G) break;
        __builtin_amdgcn_s_sleep(1);
        if ((++sp & 255u) == 0u) { if (xb_ld(&bar[XB_TMO])) break; if (sp > XB_SPIN_CAP) { atomicAdd(&bar[XB_TMO], 1u); break; } }
    }
    nloc = mine > 0u ? mine : 1u; nx = cnt > 0u ? cnt : 1u;
}
__device__ __forceinline__ void xcd_barrier(const XcdBarrier& b) {
    asm volatile("s_waitcnt vmcnt(0)" ::: "memory");
    __syncthreads();
    if (threadIdx.x == 0) {
        unsigned* bar = b.bar;
        __builtin_amdgcn_s_waitcnt(0);
        unsigned nloc = b.st[0], nx = b.st[1];
        if (nloc == 0u) { xcd_barrier_complete(bar, b.x, nloc, nx); b.st[0] = nloc; b.st[1] = nx; }
        const unsigned old = xb_add(&bar[XB_XSUB(b.x)], 1u);
        const unsigned gen = old / nloc;
        if (old + 1u == (gen + 1u) * nloc) {
            __builtin_amdgcn_fence(__ATOMIC_RELEASE, "agent");
            asm volatile("s_waitcnt vmcnt(0)" ::: "memory");
            const unsigned og = xb_add(&bar[XB_TOP], 1u);
            const unsigned tg = og / nx;
            if (og + 1u == (tg + 1u) * nx) xb_add(&bar[XB_TOPGEN], 1u);
            else XB_SPIN(xb_ld(&bar[XB_TOPGEN]) == tg, bar);
            __builtin_amdgcn_fence(__ATOMIC_ACQUIRE, "agent");
            xb_add(&bar[XB_XGEN(b.x)], 1u);
            asm volatile("s_waitcnt vmcnt(0)" ::: "memory");
        } else {
            XB_SPIN(xb_ld(&bar[XB_XGEN(b.x)]) == gen, bar);
            __builtin_amdgcn_fence(__ATOMIC_ACQUIRE, "agent");
            asm volatile("s_waitcnt vmcnt(0)" ::: "memory");
        }
    }
    __syncthreads();
}

struct Args { const float* in[20]; float* out; unsigned char* ws; int ph_lo, ph_hi, li, pad; };
enum { I_X = 0, I_META, I_GMIX, I_WIN, I_GKV, I_WKVUP, I_GIDXK, I_BF, I_WBA, I_WBB, I_WOUT, I_GFFN, I_WGROUP, I_BGROUP, I_WEXPERT, I_BEXPERT, I_WGATE, I_WUP, I_WDOWN, I_GFINAL };

__device__ __forceinline__ float wave_sum(float v) {
#pragma unroll
    for (int o = 1; o < 64; o <<= 1) v += __shfl_xor(v, o);
    return v;
}
__device__ __forceinline__ int wave_isum(int v) {
#pragma unroll
    for (int o = 1; o < 64; o <<= 1) v += __shfl_xor(v, o);
    return __builtin_amdgcn_readfirstlane(v);
}
__device__ __forceinline__ float wave_max(float v) {
#pragma unroll
    for (int o = 1; o < 64; o <<= 1) v = fmaxf(v, __shfl_xor(v, o));
    return v;
}

__device__ __forceinline__ void transpose_item(const float* colp, size_t ldsrc, bf16* WT, int ldwt, int k0, int n0, LAS float* scr, int lane) {
#pragma unroll 8
    for (int i = 0; i < 32; ++i) { const int kk = 2 * i + (lane >> 5); scr[kk * 33 + (lane & 31)] = colp ? colp[(size_t)(k0 + kk) * ldsrc] : 0.f; }
    LDS_WAIT(); asm volatile("" ::: "memory");
    const int c = lane & 7;
#pragma unroll
    for (int j = 0; j < 4; ++j) { const int n = (lane >> 3) + 8 * j; const LAS float* s = scr + (8 * c) * 33 + n;
        v4u o; o.x = pk2(s[0 * 33], s[1 * 33]); o.y = pk2(s[2 * 33], s[3 * 33]); o.z = pk2(s[4 * 33], s[5 * 33]); o.w = pk2(s[6 * 33], s[7 * 33]);
        *(GAS v4u*)(WT + (size_t)(n0 + n) * ldwt + k0 + 8 * c) = o; }
    LDS_WAIT(); asm volatile("" ::: "memory");
}
__device__ __forceinline__ int win_src(int n) {
    if (n < PC_FB) return n;
    if (n < PC_FB + 8) return 5712 + (n - PC_FB);
    if (n < PC_QB) return -1;
    if (n < PC_GA) return 2640 + (n - PC_QB);
    if (n < PC_END) return 5720 + (n - PC_GA);
    return -1;
}

using pg8::Unit;
typedef pg8::f32x4 (AccT)[2][2][4][2];
#define EPI_FOREACH(...) \
    _Pragma("unroll") for (int ai = 0; ai < 2; ++ai) _Pragma("unroll") for (int m = 0; m < 4; ++m) _Pragma("unroll") for (int bj = 0; bj < 2; ++bj) { \
        const int row = u.pm * 256 + ai * 128 + wr * 64 + m * 16 + fr; const int col = u.pn * 256 + bj * 128 + wc * 32 + 8 * fq; \
        const f32x4 v0 = acc[ai][bj][m][0], v1 = acc[ai][bj][m][1]; __VA_ARGS__ }

struct EpiProj {
    bf16* P; float* SM;
    __device__ __forceinline__ void operator()(const AccT& acc, const Unit& u, int wr, int wc, int fr, int fq) const {
        EPI_FOREACH({ v4u w; w.x = pg8::cvt_pk_bf16(v0[0], v0[1]); w.y = pg8::cvt_pk_bf16(v0[2], v0[3]); w.z = pg8::cvt_pk_bf16(v1[0], v1[1]); w.w = pg8::cvt_pk_bf16(v1[2], v1[3]);
            *(v4u*)(P + (size_t)row * PW + col) = w;
            if (u.pn == 10 && bj == 0) { float* s = SM + (size_t)row * 128 + (col - 2560); *(f32x4*)s = v0; *(f32x4*)(s + 4) = v1; } })
    }
};
struct EpiBf16Plain {
    bf16* O; int ldc;
    __device__ __forceinline__ void operator()(const AccT& acc, const Unit& u, int wr, int wc, int fr, int fq) const {
        EPI_FOREACH({ v4u w; w.x = pg8::cvt_pk_bf16(v0[0], v0[1]); w.y = pg8::cvt_pk_bf16(v0[2], v0[3]); w.z = pg8::cvt_pk_bf16(v1[0], v1[1]); w.w = pg8::cvt_pk_bf16(v1[2], v1[3]);
            *(v4u*)(O + (size_t)row * ldc + col) = w; })
    }
};
__device__ __forceinline__ float sigmoidf_(float x) { return 1.f / (1.f + __expf(-x)); }
struct EpiBranchA {
    const bf16* P; float* M1;
    __device__ __forceinline__ void operator()(const AccT& acc, const Unit& u, int wr, int wc, int fr, int fq) const {
        EPI_FOREACH({ const v4u gw = *(const v4u*)(P + (size_t)(row + NMETA) * PW + PC_GA + col);
            f32x4 o0, o1;
            o0[0] = sigmoidf_(bflo(gw.x)) * v0[0]; o0[1] = sigmoidf_(bfhi(gw.x)) * v0[1]; o0[2] = sigmoidf_(bflo(gw.y)) * v0[2]; o0[3] = sigmoidf_(bfhi(gw.y)) * v0[3];
            o1[0] = sigmoidf_(bflo(gw.z)) * v1[0]; o1[1] = sigmoidf_(bfhi(gw.z)) * v1[1]; o1[2] = sigmoidf_(bflo(gw.w)) * v1[2]; o1[3] = sigmoidf_(bfhi(gw.w)) * v1[3];
            float* d = M1 + (size_t)row * 2048 + col; *(f32x4*)d = o0; *(f32x4*)(d + 4) = o1; })
    }
};
struct EpiBranchB {
    const bf16* P; const float* M1; bf16* MG;
    __device__ __forceinline__ void operator()(const AccT& acc, const Unit& u, int wr, int wc, int fr, int fq) const {
        EPI_FOREACH({ const v4u gw = *(const v4u*)(P + (size_t)(row + NMETA) * PW + PC_GB + col);
            const float* d = M1 + (size_t)row * 2048 + col; const f32x4 a0 = *(const f32x4*)d, a1 = *(const f32x4*)(d + 4);
            f32x4 o0, o1;
            o0[0] = a0[0] + sigmoidf_(bflo(gw.x)) * v0[0]; o0[1] = a0[1] + sigmoidf_(bfhi(gw.x)) * v0[1]; o0[2] = a0[2] + sigmoidf_(bflo(gw.y)) * v0[2]; o0[3] = a0[3] + sigmoidf_(bfhi(gw.y)) * v0[3];
            o1[0] = a1[0] + sigmoidf_(bflo(gw.z)) * v1[0]; o1[1] = a1[1] + sigmoidf_(bfhi(gw.z)) * v1[1]; o1[2] = a1[2] + sigmoidf_(bflo(gw.w)) * v1[2]; o1[3] = a1[3] + sigmoidf_(bfhi(gw.w)) * v1[3];
            v4u w; w.x = pg8::cvt_pk_bf16(o0[0], o0[1]); w.y = pg8::cvt_pk_bf16(o0[2], o0[3]); w.z = pg8::cvt_pk_bf16(o1[0], o1[1]); w.w = pg8::cvt_pk_bf16(o1[2], o1[3]);
            *(v4u*)(MG + (size_t)row * 2048 + col) = w; })
    }
};
struct EpiOut {
    const float* X; float* H2;
    __device__ __forceinline__ void operator()(const AccT& acc, const Unit& u, int wr, int wc, int fr, int fq) const {
        EPI_FOREACH({ const float* xs = X + (size_t)row * 2048 + col; float* d = H2 + (size_t)row * 2048 + col;
            *(f32x4*)d = *(const f32x4*)xs + v0; *(f32x4*)(d + 4) = *(const f32x4*)(xs + 4) + v1; })
    }
};
struct EpiGateUp {
    bf16* ACT; const float* ROWW;
    __device__ __forceinline__ void operator()(const AccT& acc, const Unit& u, int wr, int wc, int fr, int fq) const {
#pragma unroll
        for (int ai = 0; ai < 2; ++ai)
#pragma unroll
            for (int m = 0; m < 4; ++m) {
                const int row = u.pm * 256 + ai * 128 + wr * 64 + m * 16 + fr; const int col = u.pn * 128 + wc * 32 + 8 * fq;
                const float rw = ROWW[row];
                float o[8];
#pragma unroll
                for (int n = 0; n < 2; ++n)
#pragma unroll
                    for (int j = 0; j < 4; ++j) { const float gv = acc[ai][0][m][n][j], uv = acc[ai][1][m][n][j]; o[n * 4 + j] = gv * sigmoidf_(gv) * uv * rw; }
                v4u w; w.x = pg8::cvt_pk_bf16(o[0], o[1]); w.y = pg8::cvt_pk_bf16(o[2], o[3]); w.z = pg8::cvt_pk_bf16(o[4], o[5]); w.w = pg8::cvt_pk_bf16(o[6], o[7]);
                *(v4u*)(ACT + (size_t)row * 512 + col) = w;
            }
    }
};
struct EpiDown {
    bf16* Y; const int* ROWTOK;
    __device__ __forceinline__ void operator()(const AccT& acc, const Unit& u, int wr, int wc, int fr, int fq) const {
#pragma unroll
        for (int ai = 0; ai < 2; ++ai)
#pragma unroll
            for (int m = 0; m < 4; ++m) {
                const int row = u.pm * 256 + ai * 128 + wr * 64 + m * 16 + fr; const int rt = ROWTOK[row];
                if (rt >= 0) { bf16* d = Y + ((size_t)(rt & 1) * SEQ + (rt >> 1)) * 2048 + u.pn * 256 + wc * 32 + 8 * fq;
#pragma unroll
                    for (int bj = 0; bj < 2; ++bj) { const f32x4 v0 = acc[ai][bj][m][0], v1 = acc[ai][bj][m][1];
                        v4u w; w.x = pg8::cvt_pk_bf16(v0[0], v0[1]); w.y = pg8::cvt_pk_bf16(v0[2], v0[3]); w.z = pg8::cvt_pk_bf16(v1[0], v1[1]); w.w = pg8::cvt_pk_bf16(v1[2], v1[3]);
                        *(v4u*)(d + bj * 128) = w; } }
            }
    }
};

__device__ __forceinline__ size_t s_row_off(int qr) { const int b = qr >> 8; const size_t pitch = 320 + 256 * b; return (size_t)256 * (320 * (size_t)b + 128 * (size_t)b * (b - 1)) + (size_t)(qr & 255) * pitch; }
__device__ __forceinline__ unsigned f2key(float f) { const unsigned u = __builtin_bit_cast(unsigned, f); return u ^ ((u >> 31) ? 0xFFFFFFFFu : 0x80000000u); }

__device__ __forceinline__ void phase_prologue(const Args& a, LAS unsigned char* lds, int gw, int NGW, int wave, int lane) {
    unsigned char* ws = a.ws;
    LAS float* scr = (LAS float*)(lds + RING_OFF + wave * 16384);
    constexpr int I_IN = 32 * (PW / 32), I_KV = 8 * 64, I_A = 16 * 64, I_O = 32 * 64;
    constexpr int NITEMS = I_IN + I_KV + 2 * I_A + I_O;
    for (int it = gw; it < NITEMS; it += NGW) {
        int r = it;
        if (r < I_IN) { const int nblk = PW / 32, kb = r / nblk, nb = r % nblk; const int sc = win_src(nb * 32 + (lane & 31));
            transpose_item(sc >= 0 ? a.in[I_WIN] + sc : nullptr, INW, (bf16*)(ws + WS_WINT), 2048, 64 * kb, 32 * nb, scr, lane); continue; } r -= I_IN;
        if (r < I_KV) { const int kb = r / 64, nb = r % 64; transpose_item(a.in[I_WKVUP] + nb * 32 + (lane & 31), 2048, (bf16*)(ws + WS_WKVT), 512, 64 * kb, 32 * nb, scr, lane); continue; } r -= I_KV;
        if (r < I_A) { const int kb = r / 64, nb = r % 64; transpose_item(a.in[I_WBA] + nb * 32 + (lane & 31), 2048, (bf16*)(ws + WS_WAT), 1024, 64 * kb, 32 * nb, scr, lane); continue; } r -= I_A;
        if (r < I_A) { const int kb = r / 64, nb = r % 64; transpose_item(a.in[I_WBB] + nb * 32 + (lane & 31), 2048, (bf16*)(ws + WS_WBT), 1024, 64 * kb, 32 * nb, scr, lane); continue; } r -= I_A;
        { const int kb = r / 64, nb = r % 64; transpose_item(a.in[I_WOUT] + nb * 32 + (lane & 31), 2048, (bf16*)(ws + WS_WOT), 2048, 64 * kb, 32 * nb, scr, lane); }
    }
    const f32x4* gm = (const f32x4*)a.in[I_GMIX];
    for (int p = gw; p < LP; p += NGW) {
        bf16* orow = (bf16*)(ws + WS_HN) + (size_t)p * 2048;
        if (p >= LTOK) { for (int j = 0; j < 8; ++j) *(v2u*)(orow + 4 * (lane + 64 * j)) = (v2u){0u, 0u}; continue; }
        const float* xrow = p < NMETA ? a.in[I_META] + (size_t)p * 2048 : a.in[I_X] + (size_t)(p - NMETA) * 2048;
        f32x4 v[8]; float s = 0.f;
#pragma unroll
        for (int j = 0; j < 8; ++j) { v[j] = ((const f32x4*)xrow)[lane + 64 * j]; s += (v[j][0] * v[j][0] + v[j][1] * v[j][1]) + (v[j][2] * v[j][2] + v[j][3] * v[j][3]); }
        const float rstd = 1.f / sqrtf(wave_sum(s) * (1.f / 2048.f) + EPS);
#pragma unroll
        for (int j = 0; j < 8; ++j) { const f32x4 g = gm[lane + 64 * j]; v2u o; o.x = pk2(v[j][0] * rstd * g[0], v[j][1] * rstd * g[1]); o.y = pk2(v[j][2] * rstd * g[2], v[j][3] * rstd * g[3]);
            *(v2u*)(orow + 4 * (lane + 64 * j)) = o; }
    }
    const int gt = gw * 64 + lane, NGT = NGW * 64;
    for (int i = gt; i < LTOK * 64; i += NGT) { const int p = i >> 6, f = i & 63; const double inv = exp(-9.210340371976184 * (double)f / 64.0); const double ang = (double)p * inv;
        double sn, cs; sincos(ang, &sn, &cs); ((f32x2*)(ws + WS_ROPE128))[i] = (f32x2){(float)cs, (float)sn}; }
    for (int i = gt; i < LTOK * 32; i += NGT) { const int p = i >> 5, f = i & 31; const double inv = exp(-9.210340371976184 * (double)f / 32.0); const double ang = (double)p * inv;
        double sn, cs; sincos(ang, &sn, &cs); ((f32x2*)(ws + WS_ROPE64))[i] = (f32x2){(float)cs, (float)sn}; }
}

__device__ __forceinline__ void phase_post1(const Args& a, int gw, int NGW, int lane) {
    unsigned char* ws = a.ws;
    bf16* PROJ = (bf16*)(ws + WS_PROJ); const float* SM = (const float*)(ws + WS_SMALL);
    const f32x2* R128 = (const f32x2*)(ws + WS_ROPE128); const f32x2* R64 = (const f32x2*)(ws + WS_ROPE64);
    for (int p = gw; p < LP; p += NGW) {
        bf16* prow = PROJ + (size_t)p * PW;
        bf16* ck = (bf16*)(ws + WS_CKVN) + (size_t)p * 512; bf16* ki = (bf16*)(ws + WS_KI) + (size_t)p * 64;
        if (p >= LTOK) { *(v4u*)(ck + 8 * lane) = (v4u){0u, 0u, 0u, 0u}; if (lane < 8) *(v4u*)(ki + 8 * lane) = (v4u){0u, 0u, 0u, 0u};
            if (lane < 16) ((float*)(ws + WS_WI))[(size_t)p * 16 + lane] = 0.f; continue; }
        const f32x2 cs = R128[(size_t)p * 64 + lane];
#pragma unroll
        for (int t = 0; t < 8; ++t) { bf16* q = prow + PC_QA + t * 128 + lane; const float x1 = bf2f(q[0]), x2 = bf2f(q[64]);
            q[0] = (bf16)f2bf(x1 * cs[0] - x2 * cs[1]); q[64] = (bf16)f2bf(x2 * cs[0] + x1 * cs[1]); }
        { const f32x2 c2 = R64[(size_t)p * 32 + (lane & 31)];
#pragma unroll
          for (int t = 0; t < 8; ++t) { const int hd = 2 * t + (lane >> 5); bf16* q = prow + PC_QI + hd * 64 + (lane & 31); const float x1 = bf2f(q[0]), x2 = bf2f(q[32]);
              q[0] = (bf16)f2bf(x1 * c2[0] - x2 * c2[1]); q[32] = (bf16)f2bf(x2 * c2[0] + x1 * c2[1]); } }
        { const v4u w = *(const v4u*)(prow + PC_CKV + 8 * lane); float x[8] = {bflo(w.x), bfhi(w.x), bflo(w.y), bfhi(w.y), bflo(w.z), bfhi(w.z), bflo(w.w), bfhi(w.w)};
          float s = 0.f;
#pragma unroll
          for (int j = 0; j < 8; ++j) s += x[j] * x[j];
          const float rstd = 1.f / sqrtf(wave_sum(s) * (1.f / 512.f) + EPS);
          const float* g = a.in[I_GKV] + 8 * lane; v4u o;
          o.x = pk2(x[0] * rstd * g[0], x[1] * rstd * g[1]); o.y = pk2(x[2] * rstd * g[2], x[3] * rstd * g[3]); o.z = pk2(x[4] * rstd * g[4], x[5] * rstd * g[5]); o.w = pk2(x[6] * rstd * g[6], x[7] * rstd * g[7]);
          *(v4u*)(ck + 8 * lane) = o; }
        { const float v = SM[(size_t)p * 128 + lane]; const float rstd = 1.f / sqrtf(wave_sum(v * v) * (1.f / 64.f) + EPS);
          const float n = v * rstd * a.in[I_GIDXK][lane]; const float pr = __shfl_xor(n, 32); const f32x2 c2 = R64[(size_t)p * 32 + (lane & 31)];
          const float y = lane < 32 ? n * c2[0] - pr * c2[1] : n * c2[0] + pr * c2[1];
          ki[lane] = (bf16)f2bf(y); }
        if (lane < 16) ((float*)(ws + WS_WI))[(size_t)p * 16 + lane] = SM[(size_t)p * 128 + 64 + lane] * (0.25f * 0.125f);
        if (lane < 8) { const float z = SM[(size_t)p * 128 + 80 + lane] + a.in[I_BF][lane]; ((float*)(ws + WS_LOGF))[(size_t)p * 8 + lane] = fminf(z, 0.f) - log1pf(expf(-fabsf(z))); }
    }
}

__device__ __forceinline__ void phase_post2(const Args& a, int gw, int NGW, int wave, int lane, int vcu) {
    unsigned char* ws = a.ws;
    bf16* KVA = (bf16*)(ws + WS_KVA); const f32x2* R128 = (const f32x2*)(ws + WS_ROPE128);
    for (int p = gw; p < LTOK; p += NGW) {
        bf16* krow = KVA + (size_t)p * 2048; const f32x2 cs = R128[(size_t)p * 64 + lane];
#pragma unroll
        for (int t = 0; t < 8; ++t) { bf16* q = krow + t * 128 + lane; const float x1 = bf2f(q[0]), x2 = bf2f(q[64]);
            q[0] = (bf16)f2bf(x1 * cs[0] - x2 * cs[1]); q[64] = (bf16)f2bf(x2 * cs[0] + x1 * cs[1]); }
    }
    if (vcu == 0) {
        const float* LF = (const float*)(ws + WS_LOGF); float* CC = (float*)(ws + WS_CC); const int h = wave;
        float s = 0.f;
        for (int i = 0; i < 129; ++i) { const int p = lane * 129 + i; if (p < LTOK) s += LF[(size_t)p * 8 + h]; }
        float inc = s;
#pragma unroll
        for (int o = 1; o < 64; o <<= 1) { const float t = __shfl_up(inc, o); if (lane >= o) inc += t; }
        float run = inc - s;
        for (int i = 0; i < 129; ++i) { const int p = lane * 129 + i; if (p < LTOK) { run += LF[(size_t)p * 8 + h]; CC[(size_t)p * 8 + h] = run; } }
    }
}

__device__ __forceinline__ void phase_indexer(const Args& a, LAS unsigned char* lds, int gw, int NGW, int wave, int lane) {
    unsigned char* ws = a.ws;
    const bf16* PROJ = (const bf16*)(ws + WS_PROJ); const bf16* KI = (const bf16*)(ws + WS_KI); const float* WI = (const float*)(ws + WS_WI); float* S = (float*)(ws + WS_S);
    LAS float* qs = (LAS float*)(lds + wave * 8192);
    for (int qr = gw; qr < SEQ; qr += NGW) {
        const int pos = qr + NMETA;
        { const bf16* qrow = PROJ + (size_t)pos * PW + PC_QI + 16 * lane; const v4u w0 = *(const v4u*)qrow, w1 = *(const v4u*)(qrow + 8);
          LAS float* d = qs + 16 * lane;
          d[0] = bflo(w0.x); d[1] = bfhi(w0.x); d[2] = bflo(w0.y); d[3] = bfhi(w0.y); d[4] = bflo(w0.z); d[5] = bfhi(w0.z); d[6] = bflo(w0.w); d[7] = bfhi(w0.w);
          d[8] = bflo(w1.x); d[9] = bfhi(w1.x); d[10] = bflo(w1.y); d[11] = bfhi(w1.y); d[12] = bflo(w1.z); d[13] = bfhi(w1.z); d[14] = bflo(w1.w); d[15] = bfhi(w1.w);
          if (lane < 16) qs[1024 + lane] = WI[(size_t)pos * 16 + lane]; }
        LDS_WAIT(); asm volatile("" ::: "memory");
        float* Srow = S + s_row_off(qr);
        const int ntile = pos / 64 + 1;
        for (int j = 0; j < ntile; ++j) {
            const int key = j * 64 + lane;
            float kf[64];
            { const v4u* kp = (const v4u*)(KI + (size_t)key * 64);
#pragma unroll
              for (int c = 0; c < 8; ++c) { const v4u w = kp[c]; kf[8 * c] = bflo(w.x); kf[8 * c + 1] = bfhi(w.x); kf[8 * c + 2] = bflo(w.y); kf[8 * c + 3] = bfhi(w.y);
                  kf[8 * c + 4] = bflo(w.z); kf[8 * c + 5] = bfhi(w.z); kf[8 * c + 6] = bflo(w.w); kf[8 * c + 7] = bfhi(w.w); } }
            float score = 0.f;
#pragma unroll 1
            for (int h = 0; h < 16; ++h) { float d = 0.f;
#pragma unroll
                for (int c = 0; c < 16; ++c) { const f32x4 q = *(const LAS f32x4*)(qs + h * 64 + 4 * c); d += q[0] * kf[4 * c] + q[1] * kf[4 * c + 1] + q[2] * kf[4 * c + 2] + q[3] * kf[4 * c + 3]; }
                score += qs[1024 + h] * fmaxf(d, 0.f); }
            if (key <= pos) Srow[key] = score;
        }
        LDS_WAIT(); asm volatile("" ::: "memory");
    }
}

__device__ __forceinline__ void phase_select(const Args& a, int gw, int NGW, int lane) {
    unsigned char* ws = a.ws;
    const float* S = (const float*)(ws + WS_S); unsigned long long* MASK = (unsigned long long*)(ws + WS_MASK);
    for (int qr = gw; qr < SEQ; qr += NGW) {
        const int pos = qr + NMETA, n = pos + 1;
        const float* Srow = S + s_row_off(qr);
        unsigned key[NTILE64];
#pragma unroll
        for (int j = 0; j < NTILE64; ++j) { const int idx = j * 64 + lane; const float sv = Srow[idx < n ? idx : n - 1]; key[j] = idx < n ? f2key(sv) : 0u; }
        unsigned T = 0u; int need = 0;
        if (n > TOPK) {
            for (int b = 31; b >= 0; --b) {
                const unsigned cand = T | (1u << b); int cl = 0;
#pragma unroll
                for (int j = 0; j < NTILE64; ++j) cl += (key[j] >= cand) ? 1 : 0;
                const int cnt = wave_isum(cl);
                if (cnt >= TOPK) T = cand;
            }
            int gl = 0;
#pragma unroll
            for (int j = 0; j < NTILE64; ++j) gl += (key[j] > T) ? 1 : 0;
            need = TOPK - wave_isum(gl);
        } else { T = 1u; need = 0; }
#pragma unroll
        for (int j = 0; j < NTILE64; ++j) {
            unsigned long long w = __ballot(key[j] > T);
            if (n <= TOPK) w = __ballot(key[j] >= T);
            else if (need > 0) { unsigned long long eq = __ballot(key[j] == T); int c = __popcll(eq);
                while (c > need) { eq &= ~(1ull << (63 - __builtin_clzll(eq))); --c; }
                w |= eq; need -= c; }
            if (lane == 0) MASK[(size_t)j * SEQ + qr] = w;
        }
    }
}

template <bool DSAMODE>
__device__ __forceinline__ void attn_naive(const Args& a, LAS unsigned char* lds, int gw, int NGW, int wave, int lane) {
    unsigned char* ws = a.ws;
    const bf16* PROJ = (const bf16*)(ws + WS_PROJ); const bf16* KVA = (const bf16*)(ws + WS_KVA);
    const bf16* Q = DSAMODE ? PROJ + PC_QA : PROJ + PC_QB; const int ldq = PW;
    const bf16* Kp = DSAMODE ? KVA : PROJ + PC_KB; const int ldk = DSAMODE ? 2048 : PW;
    const bf16* Vp = DSAMODE ? KVA + 1024 : PROJ + PC_VB; const int ldv = DSAMODE ? 2048 : PW;
    bf16* O = (bf16*)(ws + (DSAMODE ? WS_YA : WS_YB));
    const unsigned long long* MASK = (const unsigned long long*)(ws + WS_MASK); const float* CC = (const float*)(ws + WS_CC);
    LAS float* qs = (LAS float*)(lds + wave * 1024);
    for (int item = gw; item < SEQ * NH; item += NGW) {
        const int qr = item >> 3, h = item & 7, pos = qr + NMETA;
        { const unsigned w = *(const unsigned*)(Q + (size_t)pos * ldq + h * 128 + 2 * lane); qs[2 * lane] = bflo(w) * (ATT_SCALE * LOG2E); qs[2 * lane + 1] = bfhi(w) * (ATT_SCALE * LOG2E); }
        LDS_WAIT(); asm volatile("" ::: "memory");
        const float cq = DSAMODE ? 0.f : CC[(size_t)pos * 8 + h];
        float m = -1e30f, l = 0.f, o0 = 0.f, o1 = 0.f;
        const int ntile = pos / 64 + 1;
        for (int j = 0; j < ntile; ++j) {
            const int key = j * 64 + lane; bool valid = key <= pos;
            if (DSAMODE) { const unsigned long long w = MASK[(size_t)j * SEQ + qr]; if (w == 0ull) continue; valid = valid && ((w >> lane) & 1ull); }
            float s = -__builtin_inff();
            if (valid) { const v4u* kp = (const v4u*)(Kp + (size_t)key * ldk + h * 128); float d = 0.f;
#pragma unroll
                for (int c = 0; c < 16; ++c) { const v4u w = kp[c]; const f32x4 q0 = *(const LAS f32x4*)(qs + 8 * c), q1 = *(const LAS f32x4*)(qs + 8 * c + 4);
                    d += q0[0] * bflo(w.x) + q0[1] * bfhi(w.x) + q0[2] * bflo(w.y) + q0[3] * bfhi(w.y) + q1[0] * bflo(w.z) + q1[1] * bfhi(w.z) + q1[2] * bflo(w.w) + q1[3] * bfhi(w.w); }
                s = d; if (!DSAMODE) s += (cq - CC[(size_t)key * 8 + h]) * LOG2E; }
            const float tmax = wave_max(s); const float mn = fmaxf(m, tmax); const float alpha = __builtin_amdgcn_exp2f(m - mn);
            const float p = valid ? __builtin_amdgcn_exp2f(s - mn) : 0.f;
            l = l * alpha + wave_sum(p); o0 *= alpha; o1 *= alpha; m = mn;
            unsigned long long pm = __ballot(p > 0.f);
            while (pm) { const int sl = __builtin_ctzll(pm); pm &= pm - 1; const float ps = __shfl(p, sl);
                const unsigned vv = *(const unsigned*)(Vp + (size_t)(j * 64 + sl) * ldv + h * 128 + 2 * lane); o0 += ps * bflo(vv); o1 += ps * bfhi(vv); }
        }
        const float rl = 1.f / l;
        *(unsigned*)(O + (size_t)qr * 1024 + h * 128 + 2 * lane) = pk2(o0 * rl, o1 * rl);
        LDS_WAIT(); asm volatile("" ::: "memory");
    }
}

__device__ __forceinline__ void phase_moe_weights(const Args& a, LAS unsigned char* lds, int gw, int NGW, int wave, int lane) {
    unsigned char* ws = a.ws;
    LAS float* scr = (LAS float*)(lds + RING_OFF + wave * 16384);
    constexpr int I_GU = 32 * 32, I_D = 8 * 64;
    for (int it = gw; it < NE * (I_GU + I_D); it += NGW) {
        const int e = it / (I_GU + I_D); int r = it % (I_GU + I_D);
        if (r < I_GU) { const int kb = r / 32, nb = r % 32; const int n = nb * 32 + (lane & 31); const int pn = n >> 8, half = (n >> 7) & 1, j = n & 127;
            const float* src = (half ? a.in[I_WUP] : a.in[I_WGATE]) + (size_t)e * 2048 * 512 + 128 * pn + j;
            transpose_item(src, 512, (bf16*)(ws + WS_WGUT) + (size_t)e * 1024 * 2048, 2048, 64 * kb, 32 * nb, scr, lane); }
        else { r -= I_GU; const int kb = r / 64, nb = r % 64;
            transpose_item(a.in[I_WDOWN] + (size_t)e * 512 * 2048 + nb * 32 + (lane & 31), 2048, (bf16*)(ws + WS_WDT) + (size_t)e * 2048 * 512, 512, 64 * kb, 32 * nb, scr, lane); }
    }
}

__device__ __forceinline__ void phase_route(const Args& a, int gw, int NGW, int lane) {
    unsigned char* ws = a.ws;
    const float* H2 = (const float*)(ws + WS_H2); bf16* T = (bf16*)(ws + WS_T); unsigned* cnt = (unsigned*)(ws + WS_CTL) + CW_CNT;
    { int* rt = (int*)(ws + WS_ROWTOK); for (int i = gw * 64 + lane; i < TSROWS; i += NGW * 64) rt[i] = -1; }
    const f32x4* gf = (const f32x4*)a.in[I_GFFN];
    for (int tok = gw; tok < SEQ; tok += NGW) {
        const f32x4* hr = (const f32x4*)(H2 + (size_t)tok * 2048);
        float s = 0.f;
#pragma unroll
        for (int j = 0; j < 8; ++j) { const f32x4 hv = hr[lane + 64 * j]; s += (hv[0] * hv[0] + hv[1] * hv[1]) + (hv[2] * hv[2] + hv[3] * hv[3]); }
        const float rstd = 1.f / sqrtf(wave_sum(s) * (1.f / 2048.f) + EPS);
        float lg[20];
#pragma unroll
        for (int i = 0; i < 20; ++i) lg[i] = 0.f;
#pragma unroll 1
        for (int j = 0; j < 8; ++j) { const f32x4 hv = hr[lane + 64 * j]; const f32x4 g = gf[lane + 64 * j]; f32x4 t; t[0] = hv[0] * rstd * g[0]; t[1] = hv[1] * rstd * g[1]; t[2] = hv[2] * rstd * g[2]; t[3] = hv[3] * rstd * g[3];
            v2u o; o.x = pk2(t[0], t[1]); o.y = pk2(t[2], t[3]); *(v2u*)(T + (size_t)tok * 2048 + 4 * (lane + 64 * j)) = o;
#pragma unroll
            for (int c = 0; c < 4; ++c) { const int k = 4 * (lane + 64 * j) + c; const f32x4 wg = *(const f32x4*)(a.in[I_WGROUP] + (size_t)k * 4);
                lg[0] += t[c] * wg[0]; lg[1] += t[c] * wg[1]; lg[2] += t[c] * wg[2]; lg[3] += t[c] * wg[3];
                const f32x4* we = (const f32x4*)(a.in[I_WEXPERT] + (size_t)k * 16);
#pragma unroll
                for (int q = 0; q < 4; ++q) { const f32x4 w4 = we[q]; lg[4 + 4 * q] += t[c] * w4[0]; lg[5 + 4 * q] += t[c] * w4[1]; lg[6 + 4 * q] += t[c] * w4[2]; lg[7 + 4 * q] += t[c] * w4[3]; } } }
#pragma unroll
        for (int i = 0; i < 20; ++i) lg[i] = wave_sum(lg[i]);
        float gl[4];
#pragma unroll
        for (int i = 0; i < 4; ++i) gl[i] = lg[i] + a.in[I_BGROUP][i];
        int gs = 0; float gmx = gl[0];
#pragma unroll
        for (int i = 1; i < 4; ++i) if (gl[i] > gmx) { gmx = gl[i]; gs = i; }
        float den = 0.f;
#pragma unroll
        for (int i = 0; i < 4; ++i) den += expf(gl[i] - gmx);
        const float pg = 1.f / den;
        float el[4];
#pragma unroll
        for (int i = 0; i < 4; ++i) { el[i] = 0.f;
#pragma unroll
            for (int g = 0; g < 4; ++g) if (gs == g) el[i] = lg[4 + 4 * g + i] + a.in[I_BEXPERT][4 * g + i]; }
        int i0 = 0; float m0 = el[0];
#pragma unroll
        for (int i = 1; i < 4; ++i) if (el[i] > m0) { m0 = el[i]; i0 = i; }
        int i1 = -1; float m1 = -__builtin_inff();
#pragma unroll
        for (int i = 0; i < 4; ++i) if (i != i0 && el[i] > m1) { m1 = el[i]; i1 = i; }
        const float ex = expf(m1 - m0); const float p0 = 1.f / (1.f + ex), p1 = ex / (1.f + ex);
        if (lane == 0) { const int e0 = gs * 4 + i0, e1 = gs * 4 + i1;
            const unsigned s0 = __hip_atomic_fetch_add(cnt + e0, 1u, RLX_AGENT), s1 = __hip_atomic_fetch_add(cnt + e1, 1u, RLX_AGENT);
            unsigned* r = (unsigned*)(ws + WS_ROUTE) + (size_t)tok * 8;
            r[0] = (unsigned)e0; r[1] = s0; r[2] = __builtin_bit_cast(unsigned, pg * p0); r[3] = (unsigned)e1; r[4] = s1; r[5] = __builtin_bit_cast(unsigned, pg * p1); }
    }
}
__device__ __forceinline__ void moe_tile_bases(const Args& a, volatile LAS int* tb) {
    if (threadIdx.x == 0) { const unsigned* cnt = (const unsigned*)(a.ws + WS_CTL) + CW_CNT; int acc = 0;
        for (int e = 0; e < 16; ++e) { tb[e] = acc; acc += (int)((__hip_atomic_load(cnt + e, RLX_AGENT) + 255u) >> 8); } tb[16] = acc; }
    __syncthreads();
}
__device__ __forceinline__ void phase_gather(const Args& a, volatile LAS int* tb, int gw, int NGW, int lane) {
    unsigned char* ws = a.ws;
    const bf16* T = (const bf16*)(ws + WS_T); bf16* TS = (bf16*)(ws + WS_TS); int* RT = (int*)(ws + WS_ROWTOK); float* RW = (float*)(ws + WS_ROWW);
    for (int tok = gw; tok < SEQ; tok += NGW) {
        const unsigned* r = (const unsigned*)(ws + WS_ROUTE) + (size_t)tok * 8;
        const v4u* src = (const v4u*)(T + (size_t)tok * 2048); v4u d[4];
#pragma unroll
        for (int j = 0; j < 4; ++j) d[j] = src[lane + 64 * j];
#pragma unroll
        for (int k = 0; k < 2; ++k) { const int e = (int)r[3 * k]; const int row = tb[e] * 256 + (int)r[3 * k + 1];
            v4u* dst = (v4u*)(TS + (size_t)row * 2048);
#pragma unroll
            for (int j = 0; j < 4; ++j) dst[lane + 64 * j] = d[j];
            if (lane == 0) { RT[row] = tok * 2 + k; RW[row] = __builtin_bit_cast(float, r[3 * k + 2]); } }
    }
}
__device__ __forceinline__ void phase_final(const Args& a, int gw, int NGW, int lane) {
    unsigned char* ws = a.ws;
    const float* H2 = (const float*)(ws + WS_H2); const bf16* Y = (const bf16*)(ws + WS_Y); const f32x4* gf = (const f32x4*)a.in[I_GFINAL];
    for (int tok = gw; tok < SEQ; tok += NGW) {
        const f32x4* hr = (const f32x4*)(H2 + (size_t)tok * 2048); const v2u* y0 = (const v2u*)(Y + (size_t)tok * 2048); const v2u* y1 = (const v2u*)(Y + ((size_t)SEQ + tok) * 2048);
        f32x4 v[8]; float s = 0.f;
#pragma unroll
        for (int j = 0; j < 8; ++j) { const f32x4 hv = hr[lane + 64 * j]; const v2u a0 = y0[lane + 64 * j], a1 = y1[lane + 64 * j];
            v[j][0] = hv[0] + bflo(a0.x) + bflo(a1.x); v[j][1] = hv[1] + bfhi(a0.x) + bfhi(a1.x); v[j][2] = hv[2] + bflo(a0.y) + bflo(a1.y); v[j][3] = hv[3] + bfhi(a0.y) + bfhi(a1.y);
            s += (v[j][0] * v[j][0] + v[j][1] * v[j][1]) + (v[j][2] * v[j][2] + v[j][3] * v[j][3]); }
        const float rstd = 1.f / sqrtf(wave_sum(s) * (1.f / 2048.f) + EPS);
        f32x4* orow = (f32x4*)(a.out + (size_t)tok * 2048);
#pragma unroll
        for (int j = 0; j < 8; ++j) { const f32x4 g = gf[lane + 64 * j]; orow[lane + 64 * j] = (f32x4){v[j][0] * rstd * g[0], v[j][1] * rstd * g[1], v[j][2] * rstd * g[2], v[j][3] * rstd * g[3]}; }
    }
}

__global__ void __launch_bounds__(NWAVES * 64, 2) mk_fwd(Args args) {
    extern __shared__ __attribute__((aligned(16))) unsigned char lds_raw[];
    LAS unsigned char* lds = (LAS unsigned char*)lds_raw;
    volatile LAS unsigned* MISC = (volatile LAS unsigned*)(lds + MISC_OFF);
    volatile LAS int* TB = (volatile LAS int*)(lds + MISC_OFF + 64);
    const int tid = threadIdx.x;
    const int G = gridDim.x; const int bx = blockIdx.x; const int vcu = (G % 8 == 0) ? (bx % 8) * (G / 8) + bx / 8 : bx;
    const int NGW = G * NWAVES;
#define TIDS() int tid_ = threadIdx.x; asm volatile("" : "+v"(tid_)); const int lane = tid_ & 63, wave = __builtin_amdgcn_readfirstlane(tid_ >> 6), gw = vcu * NWAVES + wave; (void)lane; (void)gw;
    unsigned char* ws = args.ws;
    gu32* ctl = (gu32*)(ws + WS_CTL);
    for (int u = tid; u < (LDS_BYTES - LDSCTL_OFF) / 4; u += NWAVES * 64) ((LAS unsigned*)(lds + LDSCTL_OFF))[u] = 0u;
    __syncthreads();
    XcdBarrier bar; bar.bar = (unsigned*)(ctl + CW_BAR); bar.x = 0; bar.st = nullptr;
    if (MK_ONE_LAUNCH) bar = xcd_barrier_post((unsigned*)(ctl + CW_BAR), MISC + 8);
    const int lo = args.ph_lo, hi = args.ph_hi;
#ifndef PHASE_MASK
#define PHASE_MASK 0x7fff
#endif
#define IN(k) (((PHASE_MASK >> (k)) & 1) && lo <= (k) && (k) < hi)
#define SEAM(k) do { if (IN(k) && IN((k) + 1)) xcd_barrier(bar); } while (0)

    if (IN(0)) { TIDS(); phase_prologue(args, lds, gw, NGW, wave, lane); } SEAM(0);
    if (IN(1)) {
        pg8::Gemm g{(const bf16*)(ws + WS_HN), (const bf16*)(ws + WS_WINT), 2048, 2048, 2048}; pg8::StaticOrder S; S.init(LP / 256, PW / 256, G, bx);
        EpiProj E{(bf16*)(ws + WS_PROJ), (float*)(ws + WS_SMALL)};
        pg8::gemm_phase(lds + RING_OFF, g, S, E);
    } SEAM(1);
    if (IN(2)) { TIDS(); phase_post1(args, gw, NGW, lane); } SEAM(2);
    if (IN(3)) {
        pg8::Gemm g{(const bf16*)(ws + WS_CKVN), (const bf16*)(ws + WS_WKVT), 512, 512, 512}; pg8::StaticOrder S; S.init(LP / 256, 8, G, bx);
        EpiBf16Plain E{(bf16*)(ws + WS_KVA), 2048};
        pg8::gemm_phase(lds + RING_OFF, g, S, E);
    } SEAM(3);
    if (IN(4)) { TIDS(); phase_post2(args, gw, NGW, wave, lane, vcu); } SEAM(4);
    if (IN(5)) { TIDS(); phase_indexer(args, lds, gw, NGW, wave, lane); } SEAM(5);
    if (IN(6)) { TIDS(); phase_select(args, gw, NGW, lane); } SEAM(6);
    if (IN(7)) { TIDS(); attn_naive<false>(args, lds, gw, NGW, wave, lane); attn_naive<true>(args, lds, gw, NGW, wave, lane); } SEAM(7);
    if (IN(8)) {
        { pg8::Gemm g{(const bf16*)(ws + WS_YA), (const bf16*)(ws + WS_WAT), 1024, 1024, 1024}; pg8::StaticOrder S; S.init(SEQ / 256, 8, G, bx);
          EpiBranchA E{(const bf16*)(ws + WS_PROJ), (float*)(ws + WS_M1)};
          pg8::gemm_phase(lds + RING_OFF, g, S, E); }
        VM_WAIT(); __syncthreads();
        { pg8::Gemm g{(const bf16*)(ws + WS_YB), (const bf16*)(ws + WS_WBT), 1024, 1024, 1024}; pg8::StaticOrder S; S.init(SEQ / 256, 8, G, bx);
          EpiBranchB E{(const bf16*)(ws + WS_PROJ), (const float*)(ws + WS_M1), (bf16*)(ws + WS_MERGED)};
          pg8::gemm_phase(lds + RING_OFF, g, S, E); }
    } SEAM(8);
    if (IN(9)) {
        { TIDS(); phase_moe_weights(args, lds, gw, NGW, wave, lane); }
        VM_WAIT(); __syncthreads();
        pg8::Gemm g{(const bf16*)(ws + WS_MERGED), (const bf16*)(ws + WS_WOT), 2048, 2048, 2048}; pg8::StaticOrder S; S.init(SEQ / 256, 8, G, bx);
        EpiOut E{args.in[I_X], (float*)(ws + WS_H2)};
        pg8::gemm_phase(lds + RING_OFF, g, S, E);
    } SEAM(9);
    if (IN(10)) { TIDS(); phase_route(args, gw, NGW, lane); } SEAM(10);
    if (IN(11)) { TIDS(); moe_tile_bases(args, TB); phase_gather(args, TB, gw, NGW, lane); } SEAM(11);
    if (IN(12)) {
        moe_tile_bases(args, TB);
        pg8::Gemm g{(const bf16*)(ws + WS_TS), (const bf16*)(ws + WS_WGUT), 2048, 2048, 2048}; pg8::MoeOrder S; S.init(TB[16], 4, G, bx, (const LAS int*)TB, (size_t)1024 * 2048 * 2);
        EpiGateUp E{(bf16*)(ws + WS_ACT), (const float*)(ws + WS_ROWW)};
        pg8::gemm_phase(lds + RING_OFF, g, S, E);
    } SEAM(12);
    if (IN(13)) {
        moe_tile_bases(args, TB);
        pg8::Gemm g{(const bf16*)(ws + WS_ACT), (const bf16*)(ws + WS_WDT), 512, 512, 512}; pg8::MoeOrder S; S.init(TB[16], 8, G, bx, (const LAS int*)TB, (size_t)2048 * 512 * 2);
        EpiDown E{(bf16*)(ws + WS_Y), (const int*)(ws + WS_ROWTOK)};
        pg8::gemm_phase(lds + RING_OFF, g, S, E);
    } SEAM(13);
    if (IN(14)) { TIDS(); phase_final(args, gw, NGW, lane); }
#undef IN
#undef SEAM
}

extern "C" void kernel_launch(void* const* d_in, const int* in_sizes, int n_in, void* d_out, int out_size, void* d_ws, size_t ws_size, hipStream_t stream) {
    static int grid = 0;
    if (grid == 0) {
        if (n_in != 20 || out_size != SEQ * DM || ws_size < WS_NEED) { fprintf(stderr, "kernel_launch: unexpected shapes (n_in %d, out %d, ws %zu need %zu)\n", n_in, out_size, ws_size, (size_t)WS_NEED); grid = -1; return; }
        int dev = 0, cus = 0;
        if (hipGetDevice(&dev) != hipSuccess || hipDeviceGetAttribute(&cus, hipDeviceAttributeMultiprocessorCount, dev) != hipSuccess) { grid = -1; return; }
        if (hipFuncSetAttribute((const void*)mk_fwd, hipFuncAttributeMaxDynamicSharedMemorySize, LDS_BYTES) != hipSuccess) { fprintf(stderr, "kernel_launch: hipFuncSetAttribute failed\n"); grid = -1; return; }
        int per_cu = 0;
        if (hipOccupancyMaxActiveBlocksPerMultiprocessor(&per_cu, (const void*)mk_fwd, NWAVES * 64, LDS_BYTES) != hipSuccess || per_cu < 1) fprintf(stderr, "kernel_launch: occupancy query says %d\n", per_cu);
        (void)hipGetLastError();
        grid = cus;
    }
    if (grid < 0) return;
    (void)hipMemsetAsync((char*)d_ws + WS_CTL, 0, CTL_ZERO_BYTES, stream);
    Args a{};
    for (int i = 0; i < 20; ++i) a.in[i] = (const float*)d_in[i];
    a.out = (float*)d_out; a.ws = (unsigned char*)d_ws;
    if (MK_ONE_LAUNCH) {
        a.ph_lo = 0; a.ph_hi = NPHASE; a.li = 0;
        hipLaunchKernelGGL(mk_fwd, dim3(grid), dim3(NWAVES * 64), LDS_BYTES, stream, a);
    } else {
        for (int p = 0; p < NPHASE; ++p) { a.ph_lo = p; a.ph_hi = p + 1; a.li = p; hipLaunchKernelGGL(mk_fwd, dim3(grid), dim3(NWAVES * 64), LDS_BYTES, stream, a); }
    }
}
```

```cpp
#include <hip/hip_runtime.h>
#include <hip/hip_bf16.h>
#include <cstdio>
#include <cstdint>

#ifndef MK_ONE_LAUNCH
#define MK_ONE_LAUNCH 1
#endif

namespace pg8 {
#define PG8_LAS __attribute__((address_space(3)))
typedef unsigned short bf16_t;
typedef short bf16x8 __attribute__((ext_vector_type(8)));
typedef float f32x4 __attribute__((ext_vector_type(4)));
typedef unsigned u32x4 __attribute__((ext_vector_type(4)));
constexpr int BM = 256, BK = 64, HALF = 128, HTB = HALF * BK * 2, STAGE_BYTES = 8 * HTB, NXCD = 8, WGM = 8;

__host__ __device__ __forceinline__ int lds_byte(int r, int c) { const int st = (r >> 4) * 2 + (c >> 5), rr = r & 15, cc = c & 31, ob = rr * 64 + cc * 2; return st * 1024 + (ob ^ (((ob >> 9) & 1) << 5)); }
__host__ __device__ __forceinline__ void stage_rc(int b, int& R, int& C) { const int st = b / 1024, sb = b % 1024, swz = sb ^ (((sb >> 9) & 1) << 5); R = (st >> 1) * 16 + swz / 64; C = (st & 1) * 32 + (swz % 64) / 2; }
__host__ __device__ __forceinline__ int perm32(int rho) { const int n = rho >> 4, i = rho & 15; return 8 * (i >> 2) + 4 * n + (i & 3); }

struct Unit { int pm, pn; size_t bofs; };
struct Gemm { const bf16_t* A; const bf16_t* Bt; int lda, ldb, K; };

struct StaticOrder {
    int nM, nN, nwg, G, c;
    __device__ void init(int nM_, int nN_, int G_, int c_) { nM = nM_; nN = nN_; nwg = nM * nN; G = G_; c = c_; }
    __device__ bool next(int i, Unit& u) const {
        const long L = (long)i * G + c; if (L >= nwg) return false;
        int wgid = (int)L; { const int q = nwg / NXCD, r = nwg % NXCD, xcd = wgid % NXCD, off = wgid / NXCD; wgid = (xcd < r ? xcd * (q + 1) : r * (q + 1) + (xcd - r) * q) + off; }
        const int nig = WGM * nN, gid = wgid / nig, fm = gid * WGM, gsz = (nM - fm) < WGM ? (nM - fm) : WGM;
        u.pm = fm + ((wgid % nig) % gsz); u.pn = (wgid % nig) / gsz; u.bofs = 0; return true;
    }
};
struct MoeOrder {
    int nM, nN, nwg, G, c; const PG8_LAS int* tb; size_t bstride;
    __device__ void init(int nM_, int nN_, int G_, int c_, const PG8_LAS int* tb_, size_t bs) { nM = nM_; nN = nN_; nwg = nM * nN; G = G_; c = c_; tb = tb_; bstride = bs; }
    __device__ bool next(int i, Unit& u) const {
        const long L = (long)i * G + c; if (L >= nwg) return false;
        const int wgid = (int)L;
        u.pn = wgid % nN; u.pm = wgid / nN;
        int e = 0;
#pragma unroll
        for (int k = 1; k < 16; ++k) e += (tb[k] <= u.pm) ? 1 : 0;
        u.bofs = (size_t)e * bstride; return true;
    }
};

__device__ __forceinline__ unsigned cvt_pk_bf16(float lo, float hi) { unsigned r; asm volatile("v_cvt_pk_bf16_f32 %0, %1, %2" : "=v"(r) : "v"(lo), "v"(hi)); return r; }

template <class Epi, class Sched>
__device__ __forceinline__ void gemm_phase(PG8_LAS unsigned char* lds, const Gemm g, const Sched& S, const Epi& E) {
    const int tid = threadIdx.x, wid = __builtin_amdgcn_readfirstlane(tid >> 6), lane = tid & 63, wr = wid >> 2, wc = wid & 3, fr = lane & 15, fq = lane >> 4;
    const int K = g.K, nt = K / BK;
    unsigned voffA[2], voffB[2];
#pragma unroll
    for (int i = 0; i < 2; ++i) { int R, C; stage_rc(tid * 16 + i * 8192, R, C); const int Rb = ((R & ~31) + perm32(R & 31));
        voffA[i] = (unsigned)(R * g.lda + C) * 2u; voffB[i] = (unsigned)(Rb * g.ldb + C) * 2u; }
    const size_t kstep = (size_t)(BK * 2);
    const size_t hstepA = (size_t)HALF * g.lda * 2, hstepB = (size_t)HALF * g.ldb * 2;
    const size_t tstepA = 2 * hstepA, tstepB = 2 * hstepB;
    const unsigned ldsw = (unsigned)wid * 1024u;
    const int aoff = lds_byte(wr * 64 + fr, fq * 8), boff = lds_byte(wc * 32 + fr, fq * 8);
#define PG8_SA(b, h) (((b) * 2 + (h)) * HTB)
#define PG8_SB(b, h) ((4 + (b) * 2 + (h)) * HTB)
#define PG8_STAGE(bufoff, gbase, voff) do { _Pragma("unroll") for (int _i = 0; _i < 2; ++_i) \
        __builtin_amdgcn_global_load_lds((const unsigned*)((const char*)(gbase) + (voff)[_i]), (PG8_LAS unsigned*)(lds + (bufoff) + ldsw + _i * 8192), 16, 0, 0); } while (0)
#define PG8_LDA(dst, b, h) do { _Pragma("unroll") for (int m = 0; m < 4; ++m) _Pragma("unroll") for (int k = 0; k < 2; ++k) dst[m][k] = *(const PG8_LAS bf16x8*)(lds + PG8_SA(b, h) + aoff + m * 2048 + k * 1024); } while (0)
#define PG8_LDB(dst, b, h) do { _Pragma("unroll") for (int n = 0; n < 2; ++n) _Pragma("unroll") for (int k = 0; k < 2; ++k) dst[n][k] = *(const PG8_LAS bf16x8*)(lds + PG8_SB(b, h) + boff + n * 2048 + k * 1024); } while (0)
#define PG8_MMA(ai, bj, At, Bt) do { __builtin_amdgcn_s_setprio(1); _Pragma("unroll") for (int m = 0; m < 4; ++m) _Pragma("unroll") for (int n = 0; n < 2; ++n) _Pragma("unroll") for (int k = 0; k < 2; ++k) \
        acc[ai][bj][m][n] = __builtin_amdgcn_mfma_f32_16x16x32_bf16(Bt[n][k], At[m][k], acc[ai][bj][m][n], 0, 0, 0); __builtin_amdgcn_s_setprio(0); } while (0)
#define PG8_WAIT_V(n) asm volatile("s_waitcnt vmcnt(" #n ")" ::: "memory")
#define PG8_WAIT_L(n) asm volatile("s_waitcnt lgkmcnt(" #n ")" ::: "memory")
#define PG8_BAR __builtin_amdgcn_s_barrier()
#define PG8_SCHED __builtin_amdgcn_sched_barrier(0)
    Unit cur, nxt; int ui = 0;
    if (!S.next(0, cur)) return;
    f32x4 acc[2][2][4][2];
#pragma unroll
    for (int a = 0; a < 2; ++a)
#pragma unroll
        for (int b = 0; b < 2; ++b)
#pragma unroll
            for (int m = 0; m < 4; ++m)
#pragma unroll
                for (int n = 0; n < 2; ++n) acc[a][b][m][n] = (f32x4){0.f, 0.f, 0.f, 0.f};
    bf16x8 At[4][2], B0[2][2], B1[2][2];
    const char* cA = (const char*)g.A + (size_t)cur.pm * tstepA; const char* cB = (const char*)g.Bt + cur.bofs + (size_t)cur.pn * tstepB;
    {
        PG8_STAGE(PG8_SB(0, 0), cB, voffB); PG8_STAGE(PG8_SB(0, 1), cB + hstepB, voffB); PG8_STAGE(PG8_SA(0, 0), cA, voffA); PG8_STAGE(PG8_SA(0, 1), cA + hstepA, voffA);
        if (wr == 1) PG8_BAR;
        PG8_WAIT_V(2); PG8_BAR;
        PG8_STAGE(PG8_SB(1, 0), cB + kstep, voffB); PG8_STAGE(PG8_SA(1, 0), cA + kstep, voffA); PG8_STAGE(PG8_SB(1, 1), cB + hstepB + kstep, voffB);
        PG8_WAIT_V(6); PG8_BAR;
    }
    for (;;) {
        const bool has_next = S.next(ui + 1, nxt);
        const char* nA = has_next ? (const char*)g.A + (size_t)nxt.pm * tstepA : cA; const char* nB = has_next ? (const char*)g.Bt + nxt.bofs + (size_t)nxt.pn * tstepB : cB;
        for (int t = 0; t < nt; t += 2) {
            const bool last = (t == nt - 2);
            const char* a1 = cA + (size_t)(t + 1) * kstep;
            const char* a2 = last ? nA : cA + (size_t)(t + 2) * kstep; const char* b2 = last ? nB : cB + (size_t)(t + 2) * kstep;
            const char* a3 = a2 + kstep; const char* b3 = b2 + kstep;
            PG8_LDB(B0, 0, 0); PG8_LDB(B1, 0, 1); PG8_SCHED; PG8_LDA(At, 0, 0); PG8_STAGE(PG8_SA(1, 1), a1 + hstepA, voffA);
            PG8_WAIT_V(8); PG8_WAIT_L(0); PG8_BAR; PG8_MMA(0, 0, At, B0); PG8_MMA(0, 1, At, B1); PG8_BAR; PG8_SCHED;
            PG8_LDA(At, 0, 1); PG8_STAGE(PG8_SB(0, 0), b2, voffB); PG8_STAGE(PG8_SB(0, 1), b2 + hstepB, voffB); PG8_STAGE(PG8_SA(0, 0), a2, voffA);
            PG8_WAIT_V(8); PG8_WAIT_L(0); PG8_BAR; PG8_MMA(1, 0, At, B0); PG8_MMA(1, 1, At, B1); PG8_BAR; PG8_SCHED;
            PG8_LDB(B0, 1, 0); PG8_LDB(B1, 1, 1); PG8_SCHED; PG8_LDA(At, 1, 0); PG8_STAGE(PG8_SA(0, 1), a2 + hstepA, voffA);
            PG8_WAIT_V(8); PG8_WAIT_L(0); PG8_BAR; PG8_MMA(0, 0, At, B0); PG8_MMA(0, 1, At, B1); PG8_BAR; PG8_SCHED;
            PG8_LDA(At, 1, 1); PG8_STAGE(PG8_SB(1, 0), b3, voffB); PG8_STAGE(PG8_SB(1, 1), b3 + hstepB, voffB); PG8_STAGE(PG8_SA(1, 0), a3, voffA);
            PG8_WAIT_V(8); PG8_WAIT_L(0); PG8_BAR; PG8_MMA(1, 0, At, B0); PG8_MMA(1, 1, At, B1); PG8_BAR; PG8_SCHED;
        }
        if (wr == 0) PG8_BAR;
        E(acc, cur, wr, wc, fr, fq);
        if (!has_next) break;
#pragma unroll
        for (int a = 0; a < 2; ++a)
#pragma unroll
            for (int b = 0; b < 2; ++b)
#pragma unroll
                for (int m = 0; m < 4; ++m)
#pragma unroll
                    for (int n = 0; n < 2; ++n) acc[a][b][m][n] = (f32x4){0.f, 0.f, 0.f, 0.f};
        cur = nxt; cA = nA; cB = nB; ++ui;
        if (wr == 1) PG8_BAR;
    }
    PG8_WAIT_V(0);
    PG8_BAR;
#undef PG8_SA
#undef PG8_SB
#undef PG8_STAGE
#undef PG8_LDA
#undef PG8_LDB
#undef PG8_MMA
#undef PG8_WAIT_V
#undef PG8_WAIT_L
#undef PG8_BAR
#undef PG8_SCHED
}
}

constexpr int NWAVES = 8;
constexpr int DM = 2048, SEQ = 8192, NMETA = 16, LTOK = SEQ + NMETA, LP = 8448;
constexpr int HD = 128, NH = 8, KVR = 512, IH = 16, IDD = 64, TOPK = 256;
constexpr int INW = 9816, PW = 9984;
constexpr int PC_QA = 0, PC_CKV = 1024, PC_QI = 1536, PC_KI = 2560, PC_WI = 2624, PC_FB = 2640, PC_QB = 2688, PC_KB = 3712, PC_VB = 4736, PC_GA = 5760, PC_GB = 7808, PC_END = 9856;
constexpr int NE = 16, DFF = 512, TSROWS = 20480;
constexpr float EPS = 1e-6f;
constexpr float LOG2E = 1.4426950408889634f;
constexpr float ATT_SCALE = 0.08838834764831845f;
constexpr int NTILE64 = 129;
constexpr int NPHASE = 15;


namespace att {
typedef short bf16x8 __attribute__((ext_vector_type(8)));
typedef short s16x4 __attribute__((ext_vector_type(4)));
typedef float f32x16 __attribute__((ext_vector_type(16)));
typedef float f32x4 __attribute__((ext_vector_type(4)));
typedef unsigned u32x4 __attribute__((ext_vector_type(4)));
typedef unsigned short bf16;
constexpr int NW = 8, QBLK = 32, KVBLK = 64, QB = NW * QBLK, D = 128;
constexpr int SHM_V = KVBLK * D * 2, SHM_K = KVBLK * D * 2;
constexpr int OFF_WS = 2 * SHM_V + 2 * SHM_K, OFF_BIAS = OFF_WS + NW * 64 * 4, OFF_Q = OFF_BIAS + 2 * 64 * 4, LDS_TOTAL = OFF_Q + NW * 8192;
constexpr float SCALE = 0.08838834764831845f, THR = 8.f;
#define KSWZ(row, colB) ((row) * 256 + ((colB) ^ (((row) & 7) << 4)))
#define SBAR() __builtin_amdgcn_sched_barrier(0)
__device__ __forceinline__ int v_st(int k, int c) { const int kk = (k & ~0xC) | ((k & 4) << 1) | ((k & 8) >> 1); return ((kk >> 3) * 4 + (c >> 5)) * 512 + ((kk & 7) * 32 + (c & 31)) * 2; }
__device__ __forceinline__ int v_rd_base(int lane) { return ((lane & 3) << 3) | (((lane >> 2) & 3) << 6) | (((lane >> 4) & 1) << 5) | (((lane >> 5) & 1) << 8); }
constexpr int v_rd_off(int d0, int ks, int half) { return d0 * 512 + ks * 4096 + half * 2048; }
__device__ __forceinline__ int crow(int r, int hi) { return (r & 3) + 8 * (r >> 2) + 4 * hi; }
__device__ __forceinline__ unsigned cvtpk(float lo, float hi) { unsigned r; asm volatile("v_cvt_pk_bf16_f32 %0, %1, %2" : "=v"(r) : "v"(lo), "v"(hi)); return r; }
__device__ __forceinline__ void mask_causal(f32x16& p0, f32x16& p1, int dq) {
    const float NEG = -__builtin_inff();
#pragma unroll
    for (int r = 0; r < 16; ++r) { const int c = (r & 3) + 8 * (r >> 2); if (dq - c < 0) p0[r] = NEG; if (dq - c - 32 < 0) p1[r] = NEG; }
}
__device__ __forceinline__ void mask_bits(f32x16& p0, f32x16& p1, unsigned long long w, int hi) {
    const float NEG = -__builtin_inff();
    const unsigned wl = (unsigned)w >> (4 * hi), wh = (unsigned)(w >> 32) >> (4 * hi);
#pragma unroll
    for (int r = 0; r < 16; ++r) { const int c = (r & 3) + 8 * (r >> 2); if (!((wl >> c) & 1u)) p0[r] = NEG; if (!((wh >> c) & 1u)) p1[r] = NEG; }
}
__device__ __forceinline__ void partialSM(f32x16& p0, f32x16& p1, float& m_reg, float& mn, float& alpha) {
    float pmax = p0[0];
#pragma unroll
    for (int r = 1; r < 16; ++r) pmax = fmaxf(pmax, p0[r]);
#pragma unroll
    for (int r = 0; r < 16; ++r) pmax = fmaxf(pmax, p1[r]);
    { auto rr = __builtin_amdgcn_permlane32_swap(__float_as_uint(pmax), __float_as_uint(pmax), false, false);
      pmax = fmaxf(__uint_as_float(rr[0]), __uint_as_float(rr[1])); }
    constexpr float C2 = 1.4426950408889634f * SCALE;
    if (__builtin_expect(__all((pmax - m_reg) * SCALE <= THR), 1)) { mn = m_reg; alpha = 1.f; }
    else { mn = fmaxf(m_reg, pmax); alpha = __builtin_amdgcn_exp2f((m_reg - mn) * C2); m_reg = mn; }
    const float mnL = -mn * C2;
#pragma unroll
    for (int r = 0; r < 16; ++r) p0[r] = fmaf(p0[r], C2, mnL);
#pragma unroll
    for (int r = 0; r < 16; ++r) p1[r] = fmaf(p1[r], C2, mnL);
#pragma unroll
    for (int r = 0; r < 16; ++r) p0[r] = __builtin_amdgcn_exp2f(p0[r]);
}
__device__ __forceinline__ void finishSM(f32x16& p0, f32x16& p1, float alpha, float& l_reg, bf16x8& pa0, bf16x8& pa1, bf16x8& pa2, bf16x8& pa3) {
#pragma unroll
    for (int r = 0; r < 16; ++r) p1[r] = __builtin_amdgcn_exp2f(p1[r]);
    float ps = 0;
#pragma unroll
    for (int r = 0; r < 16; ++r) ps += p0[r];
#pragma unroll
    for (int r = 0; r < 16; ++r) ps += p1[r];
    { auto rr = __builtin_amdgcn_permlane32_swap(__float_as_uint(ps), __float_as_uint(ps), false, false);
      ps = __uint_as_float(rr[0]) + __uint_as_float(rr[1]); }
    l_reg = l_reg * alpha + ps;
#define PK4(P, B_, OUT) do { unsigned a0 = cvtpk(P[B_+0], P[B_+1]), a1 = cvtpk(P[B_+2], P[B_+3]);                          \
        unsigned b0 = cvtpk(P[B_+4], P[B_+5]), b1 = cvtpk(P[B_+6], P[B_+7]);                                             \
        auto r0 = __builtin_amdgcn_permlane32_swap(a0, b0, false, false); auto r1 = __builtin_amdgcn_permlane32_swap(a1, b1, false, false); \
        u32x4 w = {r0[0], r1[0], r0[1], r1[1]}; OUT = *reinterpret_cast<bf16x8*>(&w); } while (0)
    PK4(p0, 0, pa0); PK4(p0, 8, pa1); PK4(p1, 0, pa2); PK4(p1, 8, pa3);
#undef PK4
}
template <int KB, int MODE>
__device__ __forceinline__ void qkt(f32x16& p0, f32x16& p1, const char* lds, int r32, int hi, const char* qsp) {
    const char* K_lds = lds + 2 * SHM_V;
    if (MODE == 0) { const float* bb = (const float*)(lds + OFF_BIAS + KB * 256) + 4 * hi;
#pragma unroll
        for (int g = 0; g < 4; ++g) { const f32x4 b0 = *(const f32x4*)(bb + 8 * g), b1 = *(const f32x4*)(bb + 32 + 8 * g);
            p0[4 * g] = b0[0]; p0[4 * g + 1] = b0[1]; p0[4 * g + 2] = b0[2]; p0[4 * g + 3] = b0[3];
            p1[4 * g] = b1[0]; p1[4 * g + 1] = b1[1]; p1[4 * g + 2] = b1[2]; p1[4 * g + 3] = b1[3]; } }
    else { p0 = f32x16{}; p1 = f32x16{}; }
    const char* kb[4];
#pragma unroll
    for (int dd = 0; dd < 4; ++dd) kb[dd] = K_lds + KB * SHM_K + KSWZ(r32, (dd * 16 + hi * 8) * 2);
#pragma unroll
    for (int d0 = 0; d0 < 8; ++d0) { const char* a = kb[d0 & 3] + (d0 >> 2) * 128;
        bf16x8 b0 = *reinterpret_cast<const bf16x8*>(a);
        bf16x8 b1 = *reinterpret_cast<const bf16x8*>(a + 32 * 256);
        const bf16x8 q = *reinterpret_cast<const bf16x8*>(qsp + d0 * 1024);
        p0 = __builtin_amdgcn_mfma_f32_32x32x16_bf16(b0, q, p0, 0, 0, 0);
        p1 = __builtin_amdgcn_mfma_f32_32x32x16_bf16(b1, q, p1, 0, 0, 0); }
}
template <int VB>
__device__ __forceinline__ void pv_tile(f32x16* o, int vb0, bf16x8 pa0, bf16x8 pa1, bf16x8 pa2, bf16x8 pa3) {
#define TRRD(dst, off) asm volatile("ds_read_b64_tr_b16 %0, %1 offset:%2" : "=&v"(dst) : "v"(vb0), "i"(off) : "memory")
#define PV_D0(d0) do { s16x4 l0, l1, l2, l3, h0, h1, h2, h3; constexpr int b_ = VB * SHM_V + v_rd_off(d0, 0, 0); \
        TRRD(l0, b_); TRRD(h0, b_ + 2048); TRRD(l1, b_ + 4096); TRRD(h1, b_ + 6144); TRRD(l2, b_ + 8192); TRRD(h2, b_ + 10240); TRRD(l3, b_ + 12288); TRRD(h3, b_ + 14336); \
        asm volatile("s_waitcnt lgkmcnt(0)" ::: "memory"); SBAR(); \
        o[d0] = __builtin_amdgcn_mfma_f32_32x32x16_bf16(pa0, (bf16x8){l0[0], l0[1], l0[2], l0[3], h0[0], h0[1], h0[2], h0[3]}, o[d0], 0, 0, 0);   \
        o[d0] = __builtin_amdgcn_mfma_f32_32x32x16_bf16(pa1, (bf16x8){l1[0], l1[1], l1[2], l1[3], h1[0], h1[1], h1[2], h1[3]}, o[d0], 0, 0, 0);   \
        o[d0] = __builtin_amdgcn_mfma_f32_32x32x16_bf16(pa2, (bf16x8){l2[0], l2[1], l2[2], l2[3], h2[0], h2[1], h2[2], h2[3]}, o[d0], 0, 0, 0);   \
        o[d0] = __builtin_amdgcn_mfma_f32_32x32x16_bf16(pa3, (bf16x8){l3[0], l3[1], l3[2], l3[3], h3[0], h3[1], h3[2], h3[3]}, o[d0], 0, 0, 0); } while (0)
    PV_D0(0); PV_D0(1); PV_D0(2); PV_D0(3);
#undef PV_D0
#undef TRRD
}
struct BlockRef { const bf16* Q; const bf16* K; const bf16* V; bf16* O; int P0; const float* cb; float cref; const unsigned long long* mk; };
struct Seam { bf16x8 st_v0, st_v1, st_k0, st_k1; float st_b; };
#define ROWP(p, k0, rr) ((p) + (size_t)((k0) + (rr)) * LDKV + sc)
#define VMW() asm volatile("s_waitcnt vmcnt(0)" ::: "memory")
#define LD8(p) (*reinterpret_cast<const bf16x8*>(p))
#define SLOAD_H(R, k0) do { S.st_v0 = LD8(ROWP((R).V, k0, sr)); S.st_v1 = LD8(ROWP((R).V, k0, 32 + sr)); S.st_k0 = LD8(ROWP((R).K, k0, sr)); S.st_k1 = LD8(ROWP((R).K, k0, 32 + sr)); \
        if (MODE == 0 && wid == 0) S.st_b = ((R).cref - (R).cb[(k0) + lane]) * (1.0f / SCALE); } while (0)
#define SWRITE_HK(bf) do { *(bf16x8*)(K_lds + (bf) * SHM_K + kws) = S.st_k0; *(bf16x8*)(K_lds + (bf) * SHM_K + kws + 32 * 256) = S.st_k1; \
        if (MODE == 0 && wid == 0) ((float*)(lds + OFF_BIAS))[(bf) * 64 + lane] = S.st_b; } while (0)
#define SWRITE_HV(bf) do { *(bf16x8*)(V_lds + (bf) * SHM_V + vst0) = S.st_v0; *(bf16x8*)(V_lds + (bf) * SHM_V + vst1) = S.st_v1; } while (0)
#define SWRITE_H(bf) do { SWRITE_HV(bf); SWRITE_HK(bf); } while (0)
template <int MODE, int LDQ, int LDKV, int LDO>
__device__ __forceinline__ void prime(const BlockRef& cur, char* lds, Seam& S) {
    const int tid = threadIdx.x, wid = __builtin_amdgcn_readfirstlane(tid >> 6), lane = tid & 63, r32 = lane & 31, hi = lane >> 5;
    const int sr = tid >> 4, sc = (tid & 15) * 8, kws = KSWZ(sr, sc * 2); char* K_lds = lds + 2 * SHM_V;
    char* qsp = lds + OFF_Q + wid * 8192 + lane * 16;
    bf16x8 tq[8];
#pragma unroll
    for (int d0 = 0; d0 < 8; ++d0) tq[d0] = LD8(cur.Q + (size_t)(wid * QBLK + r32) * LDQ + d0 * 16 + hi * 8);
    SLOAD_H(cur, 0); VMW();
#pragma unroll
    for (int d0 = 0; d0 < 8; ++d0) *(bf16x8*)(qsp + d0 * 1024) = tq[d0];
    SWRITE_HK(0);
    __syncthreads();
}
template <int MODE, int LDQ, int LDKV, int LDO>
__device__ __forceinline__ void block(const BlockRef& cur, const BlockRef& nxt, char* lds, Seam& S) {
    const int tid = threadIdx.x, wid = __builtin_amdgcn_readfirstlane(tid >> 6), lane = tid & 63, r32 = lane & 31, hi = lane >> 5;
    const int NT = (cur.P0 + QB - 1) / KVBLK + 1;
    const int qlo = cur.P0 + wid * QBLK, qm = qlo + r32 - 4 * hi;
    char* V_lds = lds; char* K_lds = lds + 2 * SHM_V;
    float* wsf = (float*)(lds + OFF_WS) + wid * 64; float* li_l = wsf, * al_l = wsf + 32;
    char* qsp = lds + OFF_Q + wid * 8192 + lane * 16;
    float m_reg = -1e30f, l_reg = 0; f32x16 o[4] = {};
    const int sr = tid >> 4, sc = (tid & 15) * 8, vst0 = v_st(sr, sc), vst1 = v_st(32 + sr, sc), kws = KSWZ(sr, sc * 2);
    const int vb0 = (int)(uintptr_t)V_lds + v_rd_base(lane);
    const unsigned long long* mkl = cur.mk + wid * QBLK + r32;
#define RESC(a) do { if (__any((a) < 1.f)) { if (hi == 0) al_l[r32] = (a); asm volatile("s_waitcnt lgkmcnt(0)" ::: "memory");              \
                     _Pragma("unroll") for (int d_ = 0; d_ < 4; ++d_) _Pragma("unroll") for (int r = 0; r < 16; ++r) o[d_][r] *= al_l[crow(r, hi)]; } } while (0)
#define KBASE(t) ((t) * KVBLK)
#define MLOAD(t) (MODE == 1 ? mkl[(size_t)(t) * SEQ] : 0ull)
#define MASKT(P0_, P1_, t, w_) do { if (MODE == 1) mask_bits(P0_, P1_, w_, hi); else { const int kb_ = KBASE(t); if (kb_ + KVBLK - 1 > qlo) mask_causal(P0_, P1_, qm - kb_); } } while (0)
    f32x16 pA0, pA1, pB0, pB1; float mnA, mnB, alA, alB; bf16x8 pa0, pa1, pa2, pa3;
    unsigned long long mw = MLOAD(0);
    SWRITE_HV(0); SBAR();
    if (NT > 1) { SLOAD_H(cur, KBASE(1)); }
    SBAR(); qkt<0, MODE>(pA0, pA1, lds, r32, hi, qsp);
    MASKT(pA0, pA1, 0, mw); partialSM(pA0, pA1, m_reg, mnA, alA);
    if (NT > 1) { VMW(); SWRITE_H(1); }
    __syncthreads();
#define HALF_STEP(PX0, PX1, mnX, alX, PY0, PY1, alY, t, KB, VB, SB) do {                                                      \
        SBAR(); mw = MLOAD(t); qkt<KB, MODE>(PX0, PX1, lds, r32, hi, qsp);                                                    \
        finishSM(PY0, PY1, alY, l_reg, pa0, pa1, pa2, pa3); SBAR();                                                           \
        if ((t) + 1 < NT) { SLOAD_H(cur, KBASE((t) + 1)); SBAR(); }                                                           \
        pv_tile<VB>(o, vb0, pa0, pa1, pa2, pa3); MASKT(PX0, PX1, (t), mw); partialSM(PX0, PX1, m_reg, mnX, alX);              \
        __syncthreads();                                                                                                      \
        if ((t) + 1 < NT) { VMW(); SWRITE_H(SB); }                                                                            \
        RESC(alX); __syncthreads(); } while (0)
    for (int t = 1; t + 1 < NT; t += 2) {
        HALF_STEP(pB0, pB1, mnB, alB, pA0, pA1, alA, t, 1, 0, 0);
        HALF_STEP(pA0, pA1, mnA, alA, pB0, pB1, alB, t + 1, 0, 1, 1);
    }
    const bool even = (NT & 1) == 0;
    if (even) { SBAR(); mw = MLOAD(NT - 1); qkt<1, MODE>(pB0, pB1, lds, r32, hi, qsp); SBAR(); }
    SLOAD_H(nxt, 0); SBAR();
    bf16x8 tq[8];
#pragma unroll
    for (int d0 = 0; d0 < 8; ++d0) tq[d0] = LD8(nxt.Q + (size_t)(wid * QBLK + r32) * LDQ + d0 * 16 + hi * 8);
    SBAR();
    finishSM(pA0, pA1, alA, l_reg, pa0, pa1, pa2, pa3); SBAR();
    pv_tile<0>(o, vb0, pa0, pa1, pa2, pa3);
    if (even) { MASKT(pB0, pB1, NT - 1, mw); partialSM(pB0, pB1, m_reg, mnB, alB); __syncthreads(); RESC(alB);
        finishSM(pB0, pB1, alB, l_reg, pa0, pa1, pa2, pa3); SBAR(); pv_tile<1>(o, vb0, pa0, pa1, pa2, pa3); }
    SBAR(); VMW();
#pragma unroll
    for (int d0 = 0; d0 < 8; ++d0) *(bf16x8*)(qsp + d0 * 1024) = tq[d0];
    SWRITE_HK(0); SBAR();
    if (hi == 0) li_l[r32] = l_reg; asm volatile("s_waitcnt lgkmcnt(0)" ::: "memory");
    float rli[16];
#pragma unroll
    for (int r = 0; r < 16; ++r) rli[r] = __builtin_amdgcn_rcpf(li_l[crow(r, hi)]);
    bf16* Ow = cur.O + (size_t)(wid * QBLK) * LDO;
#pragma unroll
    for (int r = 0; r < 16; ++r) { const int orow = crow(r, hi);
#pragma unroll
        for (int d0 = 0; d0 < 4; ++d0) { const float v = o[d0][r] * rli[r];
            const float vn = __shfl_xor(v, 1);
            if ((r32 & 1) == 0) *(unsigned*)(Ow + (size_t)orow * LDO + d0 * 32 + r32) = cvtpk(v, vn); } }
    __syncthreads();
#undef RESC
#undef KBASE
#undef MLOAD
#undef MASKT
#undef HALF_STEP
}
#undef ROWP
#undef VMW
#undef LD8
#undef SLOAD_H
#undef SWRITE_HK
#undef SWRITE_HV
#undef SWRITE_H
#undef KSWZ
#undef SBAR
}

constexpr size_t MiB = 1u << 20;
constexpr size_t WS_CTL = 0, CTL_ZERO_BYTES = 1 * MiB;
constexpr size_t WS_ROPE128 = 1 * MiB;
constexpr size_t WS_ROPE64 = 5 * MiB + 256 * 1024;
constexpr size_t WS_KI = 7 * MiB + 512 * 1024;
constexpr size_t WS_WI = 8 * MiB + 768 * 1024;
constexpr size_t WS_LOGF = 9 * MiB + 512 * 1024;
constexpr size_t WS_CC = 9 * MiB + 896 * 1024;
constexpr size_t WS_ROUTE = 10 * MiB + 256 * 1024;
constexpr size_t WS_ROWTOK = 10 * MiB + 512 * 1024;
constexpr size_t WS_ROWW = 10 * MiB + 640 * 1024;
constexpr size_t WS_CCT = 11 * MiB;
constexpr size_t WS_WAT = 12 * MiB, WS_WBT = 16 * MiB, WS_WOT = 20 * MiB, WS_WKVT = 28 * MiB;
constexpr size_t WS_PROJ = 30 * MiB;
constexpr size_t WS_KVA = 191 * MiB;
constexpr size_t WS_CKVN = 224 * MiB;
constexpr size_t WS_MASK = 224 * MiB;
constexpr size_t WS_R = 233 * MiB;
constexpr size_t WS_HN = WS_R, WS_WINT = WS_R + 33 * MiB, WS_SMALL = WS_R + 73 * MiB;
constexpr size_t WS_S = WS_R;
constexpr size_t WS_YA = WS_R, WS_YB = WS_R + 16 * MiB, WS_MERGED = WS_R + 32 * MiB, WS_M1 = WS_R + 64 * MiB;
constexpr size_t WS_H2 = 30 * MiB, WS_T = 94 * MiB, WS_WGUT = 126 * MiB, WS_WDT = 190 * MiB;
constexpr size_t WS_TS = WS_R, WS_ACT = WS_R + 80 * MiB, WS_Y = WS_R;
constexpr size_t WS_NEED = WS_R + 134 * MiB;
static_assert(WS_PROJ + (size_t)LP * PW * 2 <= WS_KVA && WS_KVA + (size_t)LP * 2048 * 2 <= WS_CKVN && WS_CKVN + (size_t)LP * 512 * 2 <= WS_R, "ws map");
static_assert(WS_WDT + (size_t)NE * 2048 * 512 * 2 <= WS_MASK && WS_M1 + (size_t)SEQ * 2048 * 4 <= WS_NEED && WS_ACT + (size_t)TSROWS * 512 * 2 <= WS_NEED, "ws map 2");
constexpr int CW_CNT = 64;
constexpr int CW_BAR = 4096;

constexpr int RING_OFF = 0, RING_BYTES = 131072;
constexpr int LDSCTL_OFF = 143360, MISC_OFF = LDSCTL_OFF + 320;
constexpr int LDS_BYTES = 147456;

#define GAS __attribute__((address_space(1)))
#define LAS __attribute__((address_space(3)))
typedef unsigned short bf16;
typedef unsigned v4u __attribute__((ext_vector_type(4)));
typedef unsigned v2u __attribute__((ext_vector_type(2)));
typedef float f32x4 __attribute__((ext_vector_type(4)));
typedef float f32x2 __attribute__((ext_vector_type(2)));
typedef short bf16x8 __attribute__((ext_vector_type(8)));
typedef GAS unsigned gu32;
#define RLX_AGENT __ATOMIC_RELAXED, __HIP_MEMORY_SCOPE_AGENT
#define LDS_WAIT() asm volatile("s_waitcnt lgkmcnt(0)" ::: "memory")
#define VM_WAIT() asm volatile("s_waitcnt vmcnt(0)" ::: "memory")
__device__ __forceinline__ unsigned f2bf(float f) { unsigned u = __builtin_bit_cast(unsigned, f); return (u + 0x7fffu + ((u >> 16) & 1u)) >> 16; }
__device__ __forceinline__ unsigned pk2(float lo, float hi) { return f2bf(lo) | (f2bf(hi) << 16); }
__device__ __forceinline__ float bf2f(unsigned h) { return __builtin_bit_cast(float, h << 16); }
__device__ __forceinline__ float bflo(unsigned w) { return __builtin_bit_cast(float, w << 16); }
__device__ __forceinline__ float bfhi(unsigned w) { return __builtin_bit_cast(float, w & 0xffff0000u); }

#define XB_TMO      128
#define XB_XCNT(j)  (256  + 64 * (j))
#define XB_XSUB(j)  (1280 + 64 * (j))
#define XB_XGEN(j)  (2304 + 64 * (j))
#define XB_TOP      3328
#define XB_TOPGEN   3392
#define XCD_BAR_WORDS 3456
#define XB_SPIN_CAP (1u << 22)
__device__ __forceinline__ unsigned xb_ld(unsigned* p)              { return __hip_atomic_load(p, __ATOMIC_RELAXED, __HIP_MEMORY_SCOPE_AGENT); }
__device__ __forceinline__ unsigned xb_add(unsigned* p, unsigned v) { return __hip_atomic_fetch_add(p, v, __ATOMIC_RELAXED, __HIP_MEMORY_SCOPE_AGENT); }
__device__ __forceinline__ unsigned xb_xcc_id() { return (unsigned)__builtin_amdgcn_s_getreg((3 << 11) | 20) & 0xFu; }
#define XB_SPIN(cond, bar) do { unsigned _sp = 0; while (cond) { __builtin_amdgcn_s_sleep(1); \
    if ((++_sp & 255u) == 0u) { if (xb_ld(&(bar)[XB_TMO])) break; if (_sp > XB_SPIN_CAP) { atomicAdd(&(bar)[XB_TMO], 1u); break; } } } } while (0)
struct XcdBarrier { unsigned* bar; unsigned x; volatile LAS unsigned* st; };
__device__ __forceinline__ XcdBarrier xcd_barrier_post(unsigned* bar, volatile LAS unsigned* st) {
    XcdBarrier b; b.bar = bar; b.x = xb_xcc_id(); b.st = st;
    if (threadIdx.x == 0) (void)xb_add(&bar[XB_XCNT(b.x)], 1u);
    return b;
}
__device__ __forceinline__ void xcd_barrier_complete(unsigned* bar, unsigned x, unsigned& nloc, unsigned& nx) {
    const unsigned G = gridDim.x * gridDim.y * gridDim.z;
    unsigned sum, cnt, mine, sp = 0u;
    for (;;) {
        sum = 0u; cnt = 0u; mine = 0u;
#pragma unroll
        for (unsigned j = 0; j < 16; ++j) { const unsigned c = xb_ld(&bar[XB_XCNT(j)]); sum += c; cnt += (c > 0u) ? 1u : 0u; mine = (j == x) ? c : mine; }
        if (sum == G) break;
        __builtin_amdgcn_s_sleep(1);
        if ((++sp & 255u) == 0u) { if (xb_ld(&bar[XB_TMO])) break; if (sp > XB_SPIN_CAP) { atomicAdd(&bar[XB_TMO], 1u); break; } }
    }
    nloc = mine > 0u ? mine : 1u; nx = cnt > 0u ? cnt : 1u;
}
__device__ __forceinline__ void xcd_barrier(const XcdBarrier& b) {
    asm volatile("s_waitcnt vmcnt(0)" ::: "memory");
    __syncthreads();
    if (threadIdx.x == 0) {
        unsigned* bar = b.bar;
        __builtin_amdgcn_s_waitcnt(0);
        unsigned nloc = b.st[0], nx = b.st[1];
        if (nloc == 0u) { xcd_barrier_complete(bar, b.x, nloc, nx); b.st[0] = nloc; b.st[1] = nx; }
        const unsigned old = xb_add(&bar[XB_XSUB(b.x)], 1u);
        const unsigned gen = old / nloc;
        if (old + 1u == (gen + 1u) * nloc) {
            __builtin_amdgcn_fence(__ATOMIC_RELEASE, "agent");
            asm volatile("s_waitcnt vmcnt(0)" ::: "memory");
            const unsigned og = xb_add(&bar[XB_TOP], 1u);
            const unsigned tg = og / nx;
            if (og + 1u == (tg + 1u) * nx) xb_add(&bar[XB_TOPGEN], 1u);
            else XB_SPIN(xb_ld(&bar[XB_TOPGEN]) == tg, bar);
            __builtin_amdgcn_fence(__ATOMIC_ACQUIRE, "agent");
            xb_add(&bar[XB_XGEN(b.x)], 1u);
            asm volatile("s_waitcnt vmcnt(0)" ::: "memory");
        } else {
            XB_SPIN(xb_ld(&bar[XB_XGEN(b.x)]) == gen, bar);
            __builtin_amdgcn_fence(__ATOMIC_ACQUIRE, "agent");
            asm volatile("s_waitcnt vmcnt(0)" ::: "memory");
        }
    }
    __syncthreads();
}

struct Args { const float* in[20]; float* out; unsigned char* ws; int ph_lo, ph_hi, li, pad; };
enum { I_X = 0, I_META, I_GMIX, I_WIN, I_GKV, I_WKVUP, I_GIDXK, I_BF, I_WBA, I_WBB, I_WOUT, I_GFFN, I_WGROUP, I_BGROUP, I_WEXPERT, I_BEXPERT, I_WGATE, I_WUP, I_WDOWN, I_GFINAL };

__device__ __forceinline__ float wave_sum(float v) {
#pragma unroll
    for (int o = 1; o < 64; o <<= 1) v += __shfl_xor(v, o);
    return v;
}
__device__ __forceinline__ int wave_isum(int v) {
#pragma unroll
    for (int o = 1; o < 64; o <<= 1) v += __shfl_xor(v, o);
    return __builtin_amdgcn_readfirstlane(v);
}
__device__ __forceinline__ float wave_max(float v) {
#pragma unroll
    for (int o = 1; o < 64; o <<= 1) v = fmaxf(v, __shfl_xor(v, o));
    return v;
}

__device__ __forceinline__ void transpose_item(const float* colp, size_t ldsrc, bf16* WT, int ldwt, int k0, int n0, LAS float* scr, int lane) {
#pragma unroll 8
    for (int i = 0; i < 32; ++i) { const int kk = 2 * i + (lane >> 5); scr[kk * 33 + (lane & 31)] = colp ? colp[(size_t)(k0 + kk) * ldsrc] : 0.f; }
    LDS_WAIT(); asm volatile("" ::: "memory");
    const int c = lane & 7;
#pragma unroll
    for (int j = 0; j < 4; ++j) { const int n = (lane >> 3) + 8 * j; const LAS float* s = scr + (8 * c) * 33 + n;
        v4u o; o.x = pk2(s[0 * 33], s[1 * 33]); o.y = pk2(s[2 * 33], s[3 * 33]); o.z = pk2(s[4 * 33], s[5 * 33]); o.w = pk2(s[6 * 33], s[7 * 33]);
        *(GAS v4u*)(WT + (size_t)(n0 + n) * ldwt + k0 + 8 * c) = o; }
    LDS_WAIT(); asm volatile("" ::: "memory");
}
__device__ __forceinline__ int win_src(int n) {
    if (n < PC_FB) return n;
    if (n < PC_FB + 8) return 5712 + (n - PC_FB);
    if (n < PC_QB) return -1;
    if (n < PC_GA) return 2640 + (n - PC_QB);
    if (n < PC_END) return 5720 + (n - PC_GA);
    return -1;
}

using pg8::Unit;
typedef pg8::f32x4 (AccT)[2][2][4][2];
#define EPI_FOREACH(...) \
    _Pragma("unroll") for (int ai = 0; ai < 2; ++ai) _Pragma("unroll") for (int m = 0; m < 4; ++m) _Pragma("unroll") for (int bj = 0; bj < 2; ++bj) { \
        const int row = u.pm * 256 + ai * 128 + wr * 64 + m * 16 + fr; const int col = u.pn * 256 + bj * 128 + wc * 32 + 8 * fq; \
        const f32x4 v0 = acc[ai][bj][m][0], v1 = acc[ai][bj][m][1]; __VA_ARGS__ }

struct EpiProj {
    bf16* P; float* SM;
    __device__ __forceinline__ void operator()(const AccT& acc, const Unit& u, int wr, int wc, int fr, int fq) const {
        EPI_FOREACH({ v4u w; w.x = pg8::cvt_pk_bf16(v0[0], v0[1]); w.y = pg8::cvt_pk_bf16(v0[2], v0[3]); w.z = pg8::cvt_pk_bf16(v1[0], v1[1]); w.w = pg8::cvt_pk_bf16(v1[2], v1[3]);
            *(v4u*)(P + (size_t)row * PW + col) = w;
            if (u.pn == 10 && bj == 0) { float* s = SM + (size_t)row * 128 + (col - 2560); *(f32x4*)s = v0; *(f32x4*)(s + 4) = v1; } })
    }
};
struct EpiBf16Plain {
    bf16* O; int ldc;
    __device__ __forceinline__ void operator()(const AccT& acc, const Unit& u, int wr, int wc, int fr, int fq) const {
        EPI_FOREACH({ v4u w; w.x = pg8::cvt_pk_bf16(v0[0], v0[1]); w.y = pg8::cvt_pk_bf16(v0[2], v0[3]); w.z = pg8::cvt_pk_bf16(v1[0], v1[1]); w.w = pg8::cvt_pk_bf16(v1[2], v1[3]);
            *(v4u*)(O + (size_t)row * ldc + col) = w; })
    }
};
__device__ __forceinline__ float sigmoidf_(float x) { return 1.f / (1.f + __expf(-x)); }
struct EpiBranchA {
    const bf16* P; float* M1;
    __device__ __forceinline__ void operator()(const AccT& acc, const Unit& u, int wr, int wc, int fr, int fq) const {
        EPI_FOREACH({ const v4u gw = *(const v4u*)(P + (size_t)(row + NMETA) * PW + PC_GA + col);
            f32x4 o0, o1;
            o0[0] = sigmoidf_(bflo(gw.x)) * v0[0]; o0[1] = sigmoidf_(bfhi(gw.x)) * v0[1]; o0[2] = sigmoidf_(bflo(gw.y)) * v0[2]; o0[3] = sigmoidf_(bfhi(gw.y)) * v0[3];
            o1[0] = sigmoidf_(bflo(gw.z)) * v1[0]; o1[1] = sigmoidf_(bfhi(gw.z)) * v1[1]; o1[2] = sigmoidf_(bflo(gw.w)) * v1[2]; o1[3] = sigmoidf_(bfhi(gw.w)) * v1[3];
            float* d = M1 + (size_t)row * 2048 + col; *(f32x4*)d = o0; *(f32x4*)(d + 4) = o1; })
    }
};
struct EpiBranchB {
    const bf16* P; const float* M1; bf16* MG;
    __device__ __forceinline__ void operator()(const AccT& acc, const Unit& u, int wr, int wc, int fr, int fq) const {
        EPI_FOREACH({ const v4u gw = *(const v4u*)(P + (size_t)(row + NMETA) * PW + PC_GB + col);
            const float* d = M1 + (size_t)row * 2048 + col; const f32x4 a0 = *(const f32x4*)d, a1 = *(const f32x4*)(d + 4);
            f32x4 o0, o1;
            o0[0] = a0[0] + sigmoidf_(bflo(gw.x)) * v0[0]; o0[1] = a0[1] + sigmoidf_(bfhi(gw.x)) * v0[1]; o0[2] = a0[2] + sigmoidf_(bflo(gw.y)) * v0[2]; o0[3] = a0[3] + sigmoidf_(bfhi(gw.y)) * v0[3];
            o1[0] = a1[0] + sigmoidf_(bflo(gw.z)) * v1[0]; o1[1] = a1[1] + sigmoidf_(bfhi(gw.z)) * v1[1]; o1[2] = a1[2] + sigmoidf_(bflo(gw.w)) * v1[2]; o1[3] = a1[3] + sigmoidf_(bfhi(gw.w)) * v1[3];
            v4u w; w.x = pg8::cvt_pk_bf16(o0[0], o0[1]); w.y = pg8::cvt_pk_bf16(o0[2], o0[3]); w.z = pg8::cvt_pk_bf16(o1[0], o1[1]); w.w = pg8::cvt_pk_bf16(o1[2], o1[3]);
            *(v4u*)(MG + (size_t)row * 2048 + col) = w; })
    }
};
struct EpiOut {
    const float* X; float* H2;
    __device__ __forceinline__ void operator()(const AccT& acc, const Unit& u, int wr, int wc, int fr, int fq) const {
        EPI_FOREACH({ const float* xs = X + (size_t)row * 2048 + col; float* d = H2 + (size_t)row * 2048 + col;
            *(f32x4*)d = *(const f32x4*)xs + v0; *(f32x4*)(d + 4) = *(const f32x4*)(xs + 4) + v1; })
    }
};
struct EpiGateUp {
    bf16* ACT; const float* ROWW;
    __device__ __forceinline__ void operator()(const AccT& acc, const Unit& u, int wr, int wc, int fr, int fq) const {
#pragma unroll
        for (int ai = 0; ai < 2; ++ai)
#pragma unroll
            for (int m = 0; m < 4; ++m) {
                const int row = u.pm * 256 + ai * 128 + wr * 64 + m * 16 + fr; const int col = u.pn * 128 + wc * 32 + 8 * fq;
                const float rw = ROWW[row];
                float o[8];
#pragma unroll
                for (int n = 0; n < 2; ++n)
#pragma unroll
                    for (int j = 0; j < 4; ++j) { const float gv = acc[ai][0][m][n][j], uv = acc[ai][1][m][n][j]; o[n * 4 + j] = gv * sigmoidf_(gv) * uv * rw; }
                v4u w; w.x = pg8::cvt_pk_bf16(o[0], o[1]); w.y = pg8::cvt_pk_bf16(o[2], o[3]); w.z = pg8::cvt_pk_bf16(o[4], o[5]); w.w = pg8::cvt_pk_bf16(o[6], o[7]);
                *(v4u*)(ACT + (size_t)row * 512 + col) = w;
            }
    }
};
struct EpiDown {
    bf16* Y; const int* ROWTOK;
    __device__ __forceinline__ void operator()(const AccT& acc, const Unit& u, int wr, int wc, int fr, int fq) const {
#pragma unroll
        for (int ai = 0; ai < 2; ++ai)
#pragma unroll
            for (int m = 0; m < 4; ++m) {
                const int row = u.pm * 256 + ai * 128 + wr * 64 + m * 16 + fr; const int rt = ROWTOK[row];
                if (rt >= 0) { bf16* d = Y + ((size_t)(rt & 1) * SEQ + (rt >> 1)) * 2048 + u.pn * 256 + wc * 32 + 8 * fq;
#pragma unroll
                    for (int bj = 0; bj < 2; ++bj) { const f32x4 v0 = acc[ai][bj][m][0], v1 = acc[ai][bj][m][1];
                        v4u w; w.x = pg8::cvt_pk_bf16(v0[0], v0[1]); w.y = pg8::cvt_pk_bf16(v0[2], v0[3]); w.z = pg8::cvt_pk_bf16(v1[0], v1[1]); w.w = pg8::cvt_pk_bf16(v1[2], v1[3]);
                        *(v4u*)(d + bj * 128) = w; } }
            }
    }
};

__device__ __forceinline__ size_t s_row_off(int qr) { const int b = qr >> 8; const size_t pitch = 320 + 256 * b; return (size_t)256 * (320 * (size_t)b + 128 * (size_t)b * (b - 1)) + (size_t)(qr & 255) * pitch; }
__device__ __forceinline__ unsigned f2key(float f) { const unsigned u = __builtin_bit_cast(unsigned, f); return u ^ ((u >> 31) ? 0xFFFFFFFFu : 0x80000000u); }

__device__ __forceinline__ void phase_prologue(const Args& a, LAS unsigned char* lds, int gw, int NGW, int wave, int lane) {
    unsigned char* ws = a.ws;
    LAS float* scr = (LAS float*)(lds + RING_OFF + wave * 16384);
    constexpr int I_IN = 32 * (PW / 32), I_KV = 8 * 64, I_A = 16 * 64, I_O = 32 * 64;
    constexpr int NITEMS = I_IN + I_KV + 2 * I_A + I_O;
    for (int it = gw; it < NITEMS; it += NGW) {
        int r = it;
        if (r < I_IN) { const int nblk = PW / 32, kb = r / nblk, nb = r % nblk; const int sc = win_src(nb * 32 + (lane & 31));
            transpose_item(sc >= 0 ? a.in[I_WIN] + sc : nullptr, INW, (bf16*)(ws + WS_WINT), 2048, 64 * kb, 32 * nb, scr, lane); continue; } r -= I_IN;
        if (r < I_KV) { const int kb = r / 64, nb = r % 64; transpose_item(a.in[I_WKVUP] + nb * 32 + (lane & 31), 2048, (bf16*)(ws + WS_WKVT), 512, 64 * kb, 32 * nb, scr, lane); continue; } r -= I_KV;
        if (r < I_A) { const int kb = r / 64, nb = r % 64; transpose_item(a.in[I_WBA] + nb * 32 + (lane & 31), 2048, (bf16*)(ws + WS_WAT), 1024, 64 * kb, 32 * nb, scr, lane); continue; } r -= I_A;
        if (r < I_A) { const int kb = r / 64, nb = r % 64; transpose_item(a.in[I_WBB] + nb * 32 + (lane & 31), 2048, (bf16*)(ws + WS_WBT), 1024, 64 * kb, 32 * nb, scr, lane); continue; } r -= I_A;
        { const int kb = r / 64, nb = r % 64; transpose_item(a.in[I_WOUT] + nb * 32 + (lane & 31), 2048, (bf16*)(ws + WS_WOT), 2048, 64 * kb, 32 * nb, scr, lane); }
    }
    const f32x4* gm = (const f32x4*)a.in[I_GMIX];
    for (int p = gw; p < LP; p += NGW) {
        bf16* orow = (bf16*)(ws + WS_HN) + (size_t)p * 2048;
        if (p >= LTOK) { for (int j = 0; j < 8; ++j) *(v2u*)(orow + 4 * (lane + 64 * j)) = (v2u){0u, 0u}; continue; }
        const float* xrow = p < NMETA ? a.in[I_META] + (size_t)p * 2048 : a.in[I_X] + (size_t)(p - NMETA) * 2048;
        f32x4 v[8]; float s = 0.f;
#pragma unroll
        for (int j = 0; j < 8; ++j) { v[j] = ((const f32x4*)xrow)[lane + 64 * j]; s += (v[j][0] * v[j][0] + v[j][1] * v[j][1]) + (v[j][2] * v[j][2] + v[j][3] * v[j][3]); }
        const float rstd = 1.f / sqrtf(wave_sum(s) * (1.f / 2048.f) + EPS);
#pragma unroll
        for (int j = 0; j < 8; ++j) { const f32x4 g = gm[lane + 64 * j]; v2u o; o.x = pk2(v[j][0] * rstd * g[0], v[j][1] * rstd * g[1]); o.y = pk2(v[j][2] * rstd * g[2], v[j][3] * rstd * g[3]);
            *(v2u*)(orow + 4 * (lane + 64 * j)) = o; }
    }
    const int gt = gw * 64 + lane, NGT = NGW * 64;
    for (int i = gt; i < LTOK * 64; i += NGT) { const int p = i >> 6, f = i & 63; const double inv = exp(-9.210340371976184 * (double)f / 64.0); const double ang = (double)p * inv;
        double sn, cs; sincos(ang, &sn, &cs); ((f32x2*)(ws + WS_ROPE128))[i] = (f32x2){(float)cs, (float)sn}; }
    for (int i = gt; i < LTOK * 32; i += NGT) { const int p = i >> 5, f = i & 31; const double inv = exp(-9.210340371976184 * (double)f / 32.0); const double ang = (double)p * inv;
        double sn, cs; sincos(ang, &sn, &cs); ((f32x2*)(ws + WS_ROPE64))[i] = (f32x2){(float)cs, (float)sn}; }
}

__device__ __forceinline__ void phase_post1(const Args& a, int gw, int NGW, int lane) {
    unsigned char* ws = a.ws;
    bf16* PROJ = (bf16*)(ws + WS_PROJ); const float* SM = (const float*)(ws + WS_SMALL);
    const f32x2* R128 = (const f32x2*)(ws + WS_ROPE128); const f32x2* R64 = (const f32x2*)(ws + WS_ROPE64);
    for (int p = gw; p < LP; p += NGW) {
        bf16* prow = PROJ + (size_t)p * PW;
        bf16* ck = (bf16*)(ws + WS_CKVN) + (size_t)p * 512; bf16* ki = (bf16*)(ws + WS_KI) + (size_t)p * 64;
        if (p >= LTOK) { *(v4u*)(ck + 8 * lane) = (v4u){0u, 0u, 0u, 0u}; if (lane < 8) *(v4u*)(ki + 8 * lane) = (v4u){0u, 0u, 0u, 0u};
            if (lane < 16) ((float*)(ws + WS_WI))[(size_t)p * 16 + lane] = 0.f; continue; }
        const f32x2 cs = R128[(size_t)p * 64 + lane];
#pragma unroll
        for (int t = 0; t < 8; ++t) { bf16* q = prow + PC_QA + t * 128 + lane; const float x1 = bf2f(q[0]), x2 = bf2f(q[64]);
            q[0] = (bf16)f2bf(x1 * cs[0] - x2 * cs[1]); q[64] = (bf16)f2bf(x2 * cs[0] + x1 * cs[1]); }
        { const f32x2 c2 = R64[(size_t)p * 32 + (lane & 31)];
#pragma unroll
          for (int t = 0; t < 8; ++t) { const int hd = 2 * t + (lane >> 5); bf16* q = prow + PC_QI + hd * 64 + (lane & 31); const float x1 = bf2f(q[0]), x2 = bf2f(q[32]);
              q[0] = (bf16)f2bf(x1 * c2[0] - x2 * c2[1]); q[32] = (bf16)f2bf(x2 * c2[0] + x1 * c2[1]); } }
        { const v4u w = *(const v4u*)(prow + PC_CKV + 8 * lane); float x[8] = {bflo(w.x), bfhi(w.x), bflo(w.y), bfhi(w.y), bflo(w.z), bfhi(w.z), bflo(w.w), bfhi(w.w)};
          float s = 0.f;
#pragma unroll
          for (int j = 0; j < 8; ++j) s += x[j] * x[j];
          const float rstd = 1.f / sqrtf(wave_sum(s) * (1.f / 512.f) + EPS);
          const float* g = a.in[I_GKV] + 8 * lane; v4u o;
          o.x = pk2(x[0] * rstd * g[0], x[1] * rstd * g[1]); o.y = pk2(x[2] * rstd * g[2], x[3] * rstd * g[3]); o.z = pk2(x[4] * rstd * g[4], x[5] * rstd * g[5]); o.w = pk2(x[6] * rstd * g[6], x[7] * rstd * g[7]);
          *(v4u*)(ck + 8 * lane) = o; }
        { const float v = SM[(size_t)p * 128 + lane]; const float rstd = 1.f / sqrtf(wave_sum(v * v) * (1.f / 64.f) + EPS);
          const float n = v * rstd * a.in[I_GIDXK][lane]; const float pr = __shfl_xor(n, 32); const f32x2 c2 = R64[(size_t)p * 32 + (lane & 31)];
          const float y = lane < 32 ? n * c2[0] - pr * c2[1] : n * c2[0] + pr * c2[1];
          ki[lane] = (bf16)f2bf(y); }
        if (lane < 16) ((float*)(ws + WS_WI))[(size_t)p * 16 + lane] = SM[(size_t)p * 128 + 64 + lane] * (0.25f * 0.125f);
        if (lane < 8) { const float z = SM[(size_t)p * 128 + 80 + lane] + a.in[I_BF][lane]; ((float*)(ws + WS_LOGF))[(size_t)p * 8 + lane] = fminf(z, 0.f) - log1pf(expf(-fabsf(z))); }
    }
}

__device__ __forceinline__ void phase_post2(const Args& a, int gw, int NGW, int wave, int lane, int vcu) {
    unsigned char* ws = a.ws;
    bf16* KVA = (bf16*)(ws + WS_KVA); const f32x2* R128 = (const f32x2*)(ws + WS_ROPE128);
    for (int p = gw; p < LTOK; p += NGW) {
        bf16* krow = KVA + (size_t)p * 2048; const f32x2 cs = R128[(size_t)p * 64 + lane];
#pragma unroll
        for (int t = 0; t < 8; ++t) { bf16* q = krow + t * 128 + lane; const float x1 = bf2f(q[0]), x2 = bf2f(q[64]);
            q[0] = (bf16)f2bf(x1 * cs[0] - x2 * cs[1]); q[64] = (bf16)f2bf(x2 * cs[0] + x1 * cs[1]); }
    }
    if (vcu == 0) {
        const float* LF = (const float*)(ws + WS_LOGF); float* CC = (float*)(ws + WS_CC); const int h = wave;
        float s = 0.f;
        for (int i = 0; i < 129; ++i) { const int p = lane * 129 + i; if (p < LTOK) s += LF[(size_t)p * 8 + h]; }
        float inc = s;
#pragma unroll
        for (int o = 1; o < 64; o <<= 1) { const float t = __shfl_up(inc, o); if (lane >= o) inc += t; }
        float run = inc - s;
        float* CCT = (float*)(ws + WS_CCT) + (size_t)h * LP;
        for (int i = 0; i < 129; ++i) { const int p = lane * 129 + i; if (p < LTOK) { run += LF[(size_t)p * 8 + h]; CC[(size_t)p * 8 + h] = run; } if (p < LP) CCT[p] = run; }
    }
}

__device__ __forceinline__ void phase_indexer(const Args& a, LAS unsigned char* lds, int gw, int NGW, int wave, int lane) {
    unsigned char* ws = a.ws;
    const bf16* PROJ = (const bf16*)(ws + WS_PROJ); const bf16* KI = (const bf16*)(ws + WS_KI); const float* WI = (const float*)(ws + WS_WI); float* S = (float*)(ws + WS_S);
    LAS float* qs = (LAS float*)(lds + wave * 8192);
    for (int qr = gw; qr < SEQ; qr += NGW) {
        const int pos = qr + NMETA;
        { const bf16* qrow = PROJ + (size_t)pos * PW + PC_QI + 16 * lane; const v4u w0 = *(const v4u*)qrow, w1 = *(const v4u*)(qrow + 8);
          LAS float* d = qs + 16 * lane;
          d[0] = bflo(w0.x); d[1] = bfhi(w0.x); d[2] = bflo(w0.y); d[3] = bfhi(w0.y); d[4] = bflo(w0.z); d[5] = bfhi(w0.z); d[6] = bflo(w0.w); d[7] = bfhi(w0.w);
          d[8] = bflo(w1.x); d[9] = bfhi(w1.x); d[10] = bflo(w1.y); d[11] = bfhi(w1.y); d[12] = bflo(w1.z); d[13] = bfhi(w1.z); d[14] = bflo(w1.w); d[15] = bfhi(w1.w);
          if (lane < 16) qs[1024 + lane] = WI[(size_t)pos * 16 + lane]; }
        LDS_WAIT(); asm volatile("" ::: "memory");
        float* Srow = S + s_row_off(qr);
        const int ntile = pos / 64 + 1;
        for (int j = 0; j < ntile; ++j) {
            const int key = j * 64 + lane;
            float kf[64];
            { const v4u* kp = (const v4u*)(KI + (size_t)key * 64);
#pragma unroll
              for (int c = 0; c < 8; ++c) { const v4u w = kp[c]; kf[8 * c] = bflo(w.x); kf[8 * c + 1] = bfhi(w.x); kf[8 * c + 2] = bflo(w.y); kf[8 * c + 3] = bfhi(w.y);
                  kf[8 * c + 4] = bflo(w.z); kf[8 * c + 5] = bfhi(w.z); kf[8 * c + 6] = bflo(w.w); kf[8 * c + 7] = bfhi(w.w); } }
            float score = 0.f;
#pragma unroll 1
            for (int h = 0; h < 16; ++h) { float d = 0.f;
#pragma unroll
                for (int c = 0; c < 16; ++c) { const f32x4 q = *(const LAS f32x4*)(qs + h * 64 + 4 * c); d += q[0] * kf[4 * c] + q[1] * kf[4 * c + 1] + q[2] * kf[4 * c + 2] + q[3] * kf[4 * c + 3]; }
                score += qs[1024 + h] * fmaxf(d, 0.f); }
            if (key <= pos) Srow[key] = score;
        }
        LDS_WAIT(); asm volatile("" ::: "memory");
    }
}

__device__ __forceinline__ void phase_select(const Args& a, int gw, int NGW, int lane) {
    unsigned char* ws = a.ws;
    const float* S = (const float*)(ws + WS_S); unsigned long long* MASK = (unsigned long long*)(ws + WS_MASK);
    for (int qr = gw; qr < SEQ; qr += NGW) {
        const int pos = qr + NMETA, n = pos + 1;
        const float* Srow = S + s_row_off(qr);
        unsigned key[NTILE64];
#pragma unroll
        for (int j = 0; j < NTILE64; ++j) { const int idx = j * 64 + lane; const float sv = Srow[idx < n ? idx : n - 1]; key[j] = idx < n ? f2key(sv) : 0u; }
        unsigned T = 0u; int need = 0;
        if (n > TOPK) {
            for (int b = 31; b >= 0; --b) {
                const unsigned cand = T | (1u << b); int cl = 0;
#pragma unroll
                for (int j = 0; j < NTILE64; ++j) cl += (key[j] >= cand) ? 1 : 0;
                const int cnt = wave_isum(cl);
                if (cnt >= TOPK) T = cand;
            }
            int gl = 0;
#pragma unroll
            for (int j = 0; j < NTILE64; ++j) gl += (key[j] > T) ? 1 : 0;
            need = TOPK - wave_isum(gl);
        } else { T = 1u; need = 0; }
#pragma unroll
        for (int j = 0; j < NTILE64; ++j) {
            unsigned long long w = __ballot(key[j] > T);
            if (n <= TOPK) w = __ballot(key[j] >= T);
            else if (need > 0) { unsigned long long eq = __ballot(key[j] == T); int c = __popcll(eq);
                while (c > need) { eq &= ~(1ull << (63 - __builtin_clzll(eq))); --c; }
                w |= eq; need -= c; }
            if (lane == 0) MASK[(size_t)j * SEQ + qr] = w;
        }
    }
}

template <bool DSAMODE>
__device__ __forceinline__ void attn_naive(const Args& a, LAS unsigned char* lds, int gw, int NGW, int wave, int lane) {
    unsigned char* ws = a.ws;
    const bf16* PROJ = (const bf16*)(ws + WS_PROJ); const bf16* KVA = (const bf16*)(ws + WS_KVA);
    const bf16* Q = DSAMODE ? PROJ + PC_QA : PROJ + PC_QB; const int ldq = PW;
    const bf16* Kp = DSAMODE ? KVA : PROJ + PC_KB; const int ldk = DSAMODE ? 2048 : PW;
    const bf16* Vp = DSAMODE ? KVA + 1024 : PROJ + PC_VB; const int ldv = DSAMODE ? 2048 : PW;
    bf16* O = (bf16*)(ws + (DSAMODE ? WS_YA : WS_YB));
    const unsigned long long* MASK = (const unsigned long long*)(ws + WS_MASK); const float* CC = (const float*)(ws + WS_CC);
    LAS float* qs = (LAS float*)(lds + wave * 1024);
    for (int item = gw; item < SEQ * NH; item += NGW) {
        const int qr = item >> 3, h = item & 7, pos = qr + NMETA;
        { const unsigned w = *(const unsigned*)(Q + (size_t)pos * ldq + h * 128 + 2 * lane); qs[2 * lane] = bflo(w) * (ATT_SCALE * LOG2E); qs[2 * lane + 1] = bfhi(w) * (ATT_SCALE * LOG2E); }
        LDS_WAIT(); asm volatile("" ::: "memory");
        const float cq = DSAMODE ? 0.f : CC[(size_t)pos * 8 + h];
        float m = -1e30f, l = 0.f, o0 = 0.f, o1 = 0.f;
        const int ntile = pos / 64 + 1;
        for (int j = 0; j < ntile; ++j) {
            const int key = j * 64 + lane; bool valid = key <= pos;
            if (DSAMODE) { const unsigned long long w = MASK[(size_t)j * SEQ + qr]; if (w == 0ull) continue; valid = valid && ((w >> lane) & 1ull); }
            float s = -__builtin_inff();
            if (valid) { const v4u* kp = (const v4u*)(Kp + (size_t)key * ldk + h * 128); float d = 0.f;
#pragma unroll
                for (int c = 0; c < 16; ++c) { const v4u w = kp[c]; const f32x4 q0 = *(const LAS f32x4*)(qs + 8 * c), q1 = *(const LAS f32x4*)(qs + 8 * c + 4);
                    d += q0[0] * bflo(w.x) + q0[1] * bfhi(w.x) + q0[2] * bflo(w.y) + q0[3] * bfhi(w.y) + q1[0] * bflo(w.z) + q1[1] * bfhi(w.z) + q1[2] * bflo(w.w) + q1[3] * bfhi(w.w); }
                s = d; if (!DSAMODE) s += (cq - CC[(size_t)key * 8 + h]) * LOG2E; }
            const float tmax = wave_max(s); const float mn = fmaxf(m, tmax); const float alpha = __builtin_amdgcn_exp2f(m - mn);
            const float p = valid ? __builtin_amdgcn_exp2f(s - mn) : 0.f;
            l = l * alpha + wave_sum(p); o0 *= alpha; o1 *= alpha; m = mn;
            unsigned long long pm = __ballot(p > 0.f);
            while (pm) { const int sl = __builtin_ctzll(pm); pm &= pm - 1; const float ps = __shfl(p, sl);
                const unsigned vv = *(const unsigned*)(Vp + (size_t)(j * 64 + sl) * ldv + h * 128 + 2 * lane); o0 += ps * bflo(vv); o1 += ps * bfhi(vv); }
        }
        const float rl = 1.f / l;
        *(unsigned*)(O + (size_t)qr * 1024 + h * 128 + 2 * lane) = pk2(o0 * rl, o1 * rl);
        LDS_WAIT(); asm volatile("" ::: "memory");
    }
}


template <int MODE>
__device__ __forceinline__ att::BlockRef attn_ref(unsigned char* ws, int h, int b) {
    att::BlockRef r; r.P0 = NMETA + 256 * b;
    const bf16* PROJ = (const bf16*)(ws + WS_PROJ); const bf16* KVA = (const bf16*)(ws + WS_KVA);
    r.Q = PROJ + (size_t)r.P0 * PW + (MODE ? PC_QA : PC_QB) + h * 128;
    r.K = MODE ? KVA + h * 128 : PROJ + PC_KB + h * 128;
    r.V = MODE ? KVA + 1024 + h * 128 : PROJ + PC_VB + h * 128;
    r.O = (bf16*)(ws + (MODE ? WS_YA : WS_YB)) + (size_t)(256 * b) * 1024 + h * 128;
    r.cb = (const float*)(ws + WS_CCT) + (size_t)h * LP; r.cref = MODE ? 0.f : r.cb[r.P0];
    r.mk = (const unsigned long long*)(ws + WS_MASK) + 256 * b;
    return r;
}
template <int MODE>
__device__ __forceinline__ void attn_item(unsigned char* ws, char* lds, int h, int y) {
    constexpr int LDKV = MODE ? 2048 : PW;
    const att::BlockRef r0 = attn_ref<MODE>(ws, h, y), r1 = attn_ref<MODE>(ws, h, 31 - y);
    att::Seam S;
    att::prime<MODE, PW, LDKV, 1024>(r0, lds, S);
    for (int pass = 0; pass < 2; ++pass) { const att::BlockRef cur = pass ? r1 : r0;
        att::block<MODE, PW, LDKV, 1024>(cur, r1, lds, S); }
}
__device__ __forceinline__ void phase_attn(const Args& a, char* lds, int vcu, int G) {
    for (int it = vcu; it < 256; it += G) { const int h = it >> 5, i = it & 31, y = i & 15;
        if (i < 16) attn_item<0>(a.ws, lds, h, y); else attn_item<1>(a.ws, lds, h, y); }
}

__device__ __forceinline__ void phase_moe_weights(const Args& a, LAS unsigned char* lds, int gw, int NGW, int wave, int lane) {
    unsigned char* ws = a.ws;
    LAS float* scr = (LAS float*)(lds + RING_OFF + wave * 16384);
    constexpr int I_GU = 32 * 32, I_D = 8 * 64;
    for (int it = gw; it < NE * (I_GU + I_D); it += NGW) {
        const int e = it / (I_GU + I_D); int r = it % (I_GU + I_D);
        if (r < I_GU) { const int kb = r / 32, nb = r % 32; const int n = nb * 32 + (lane & 31); const int pn = n >> 8, half = (n >> 7) & 1, j = n & 127;
            const float* src = (half ? a.in[I_WUP] : a.in[I_WGATE]) + (size_t)e * 2048 * 512 + 128 * pn + j;
            transpose_item(src, 512, (bf16*)(ws + WS_WGUT) + (size_t)e * 1024 * 2048, 2048, 64 * kb, 32 * nb, scr, lane); }
        else { r -= I_GU; const int kb = r / 64, nb = r % 64;
            transpose_item(a.in[I_WDOWN] + (size_t)e * 512 * 2048 + nb * 32 + (lane & 31), 2048, (bf16*)(ws + WS_WDT) + (size_t)e * 2048 * 512, 512, 64 * kb, 32 * nb, scr, lane); }
    }
}

__device__ __forceinline__ void phase_route(const Args& a, int gw, int NGW, int lane) {
    unsigned char* ws = a.ws;
    const float* H2 = (const float*)(ws + WS_H2); bf16* T = (bf16*)(ws + WS_T); unsigned* cnt = (unsigned*)(ws + WS_CTL) + CW_CNT;
    { int* rt = (int*)(ws + WS_ROWTOK); for (int i = gw * 64 + lane; i < TSROWS; i += NGW * 64) rt[i] = -1; }
    const f32x4* gf = (const f32x4*)a.in[I_GFFN];
    for (int tok = gw; tok < SEQ; tok += NGW) {
        const f32x4* hr = (const f32x4*)(H2 + (size_t)tok * 2048);
        float s = 0.f;
#pragma unroll
        for (int j = 0; j < 8; ++j) { const f32x4 hv = hr[lane + 64 * j]; s += (hv[0] * hv[0] + hv[1] * hv[1]) + (hv[2] * hv[2] + hv[3] * hv[3]); }
        const float rstd = 1.f / sqrtf(wave_sum(s) * (1.f / 2048.f) + EPS);
        float lg[20];
#pragma unroll
        for (int i = 0; i < 20; ++i) lg[i] = 0.f;
#pragma unroll 1
        for (int j = 0; j < 8; ++j) { const f32x4 hv = hr[lane + 64 * j]; const f32x4 g = gf[lane + 64 * j]; f32x4 t; t[0] = hv[0] * rstd * g[0]; t[1] = hv[1] * rstd * g[1]; t[2] = hv[2] * rstd * g[2]; t[3] = hv[3] * rstd * g[3];
            v2u o; o.x = pk2(t[0], t[1]); o.y = pk2(t[2], t[3]); *(v2u*)(T + (size_t)tok * 2048 + 4 * (lane + 64 * j)) = o;
#pragma unroll
            for (int c = 0; c < 4; ++c) { const int k = 4 * (lane + 64 * j) + c; const f32x4 wg = *(const f32x4*)(a.in[I_WGROUP] + (size_t)k * 4);
                lg[0] += t[c] * wg[0]; lg[1] += t[c] * wg[1]; lg[2] += t[c] * wg[2]; lg[3] += t[c] * wg[3];
                const f32x4* we = (const f32x4*)(a.in[I_WEXPERT] + (size_t)k * 16);
#pragma unroll
                for (int q = 0; q < 4; ++q) { const f32x4 w4 = we[q]; lg[4 + 4 * q] += t[c] * w4[0]; lg[5 + 4 * q] += t[c] * w4[1]; lg[6 + 4 * q] += t[c] * w4[2]; lg[7 + 4 * q] += t[c] * w4[3]; } } }
#pragma unroll
        for (int i = 0; i < 20; ++i) lg[i] = wave_sum(lg[i]);
        float gl[4];
#pragma unroll
        for (int i = 0; i < 4; ++i) gl[i] = lg[i] + a.in[I_BGROUP][i];
        int gs = 0; float gmx = gl[0];
#pragma unroll
        for (int i = 1; i < 4; ++i) if (gl[i] > gmx) { gmx = gl[i]; gs = i; }
        float den = 0.f;
#pragma unroll
        for (int i = 0; i < 4; ++i) den += expf(gl[i] - gmx);
        const float pg = 1.f / den;
        float el[4];
#pragma unroll
        for (int i = 0; i < 4; ++i) { el[i] = 0.f;
#pragma unroll
            for (int g = 0; g < 4; ++g) if (gs == g) el[i] = lg[4 + 4 * g + i] + a.in[I_BEXPERT][4 * g + i]; }
        int i0 = 0; float m0 = el[0];
#pragma unroll
        for (int i = 1; i < 4; ++i) if (el[i] > m0) { m0 = el[i]; i0 = i; }
        int i1 = -1; float m1 = -__builtin_inff();
#pragma unroll
        for (int i = 0; i < 4; ++i) if (i != i0 && el[i] > m1) { m1 = el[i]; i1 = i; }
        const float ex = expf(m1 - m0); const float p0 = 1.f / (1.f + ex), p1 = ex / (1.f + ex);
        if (lane == 0) { const int e0 = gs * 4 + i0, e1 = gs * 4 + i1;
            const unsigned s0 = __hip_atomic_fetch_add(cnt + e0, 1u, RLX_AGENT), s1 = __hip_atomic_fetch_add(cnt + e1, 1u, RLX_AGENT);
            unsigned* r = (unsigned*)(ws + WS_ROUTE) + (size_t)tok * 8;
            r[0] = (unsigned)e0; r[1] = s0; r[2] = __builtin_bit_cast(unsigned, pg * p0); r[3] = (unsigned)e1; r[4] = s1; r[5] = __builtin_bit_cast(unsigned, pg * p1); }
    }
}
__device__ __forceinline__ void moe_tile_bases(const Args& a, volatile LAS int* tb) {
    if (threadIdx.x == 0) { const unsigned* cnt = (const unsigned*)(a.ws + WS_CTL) + CW_CNT; int acc = 0;
        for (int e = 0; e < 16; ++e) { tb[e] = acc; acc += (int)((__hip_atomic_load(cnt + e, RLX_AGENT) + 255u) >> 8); } tb[16] = acc; }
    __syncthreads();
}
__device__ __forceinline__ void phase_gather(const Args& a, volatile LAS int* tb, int gw, int NGW, int lane) {
    unsigned char* ws = a.ws;
    const bf16* T = (const bf16*)(ws + WS_T); bf16* TS = (bf16*)(ws + WS_TS); int* RT = (int*)(ws + WS_ROWTOK); float* RW = (float*)(ws + WS_ROWW);
    for (int tok = gw; tok < SEQ; tok += NGW) {
        const unsigned* r = (const unsigned*)(ws + WS_ROUTE) + (size_t)tok * 8;
        const v4u* src = (const v4u*)(T + (size_t)tok * 2048); v4u d[4];
#pragma unroll
        for (int j = 0; j < 4; ++j) d[j] = src[lane + 64 * j];
#pragma unroll
        for (int k = 0; k < 2; ++k) { const int e = (int)r[3 * k]; const int row = tb[e] * 256 + (int)r[3 * k + 1];
            v4u* dst = (v4u*)(TS + (size_t)row * 2048);
#pragma unroll
            for (int j = 0; j < 4; ++j) dst[lane + 64 * j] = d[j];
            if (lane == 0) { RT[row] = tok * 2 + k; RW[row] = __builtin_bit_cast(float, r[3 * k + 2]); } }
    }
}
__device__ __forceinline__ void phase_final(const Args& a, int gw, int NGW, int lane) {
    unsigned char* ws = a.ws;
    const float* H2 = (const float*)(ws + WS_H2); const bf16* Y = (const bf16*)(ws + WS_Y); const f32x4* gf = (const f32x4*)a.in[I_GFINAL];
    for (int tok = gw; tok < SEQ; tok += NGW) {
        const f32x4* hr = (const f32x4*)(H2 + (size_t)tok * 2048); const v2u* y0 = (const v2u*)(Y + (size_t)tok * 2048); const v2u* y1 = (const v2u*)(Y + ((size_t)SEQ + tok) * 2048);
        f32x4 v[8]; float s = 0.f;
#pragma unroll
        for (int j = 0; j < 8; ++j) { const f32x4 hv = hr[lane + 64 * j]; const v2u a0 = y0[lane + 64 * j], a1 = y1[lane + 64 * j];
            v[j][0] = hv[0] + bflo(a0.x) + bflo(a1.x); v[j][1] = hv[1] + bfhi(a0.x) + bfhi(a1.x); v[j][2] = hv[2] + bflo(a0.y) + bflo(a1.y); v[j][3] = hv[3] + bfhi(a0.y) + bfhi(a1.y);
            s += (v[j][0] * v[j][0] + v[j][1] * v[j][1]) + (v[j][2] * v[j][2] + v[j][3] * v[j][3]); }
        const float rstd = 1.f / sqrtf(wave_sum(s) * (1.f / 2048.f) + EPS);
        f32x4* orow = (f32x4*)(a.out + (size_t)tok * 2048);
#pragma unroll
        for (int j = 0; j < 8; ++j) { const f32x4 g = gf[lane + 64 * j]; orow[lane + 64 * j] = (f32x4){v[j][0] * rstd * g[0], v[j][1] * rstd * g[1], v[j][2] * rstd * g[2], v[j][3] * rstd * g[3]}; }
    }
}

__global__ void __launch_bounds__(NWAVES * 64, 2) mk_fwd(Args args) {
    extern __shared__ __attribute__((aligned(16))) unsigned char lds_raw[];
    LAS unsigned char* lds = (LAS unsigned char*)lds_raw;
    volatile LAS unsigned* MISC = (volatile LAS unsigned*)(lds + MISC_OFF);
    volatile LAS int* TB = (volatile LAS int*)(lds + MISC_OFF + 64);
    const int tid = threadIdx.x;
    const int G = gridDim.x; const int bx = blockIdx.x; const int vcu = (G % 8 == 0) ? (bx % 8) * (G / 8) + bx / 8 : bx;
    const int NGW = G * NWAVES;
#define TIDS() int tid_ = threadIdx.x; asm volatile("" : "+v"(tid_)); const int lane = tid_ & 63, wave = __builtin_amdgcn_readfirstlane(tid_ >> 6), gw = vcu * NWAVES + wave; (void)lane; (void)gw;
    unsigned char* ws = args.ws;
    gu32* ctl = (gu32*)(ws + WS_CTL);
    for (int u = tid; u < (LDS_BYTES - LDSCTL_OFF) / 4; u += NWAVES * 64) ((LAS unsigned*)(lds + LDSCTL_OFF))[u] = 0u;
    __syncthreads();
    XcdBarrier bar; bar.bar = (unsigned*)(ctl + CW_BAR); bar.x = 0; bar.st = nullptr;
    if (MK_ONE_LAUNCH) bar = xcd_barrier_post((unsigned*)(ctl + CW_BAR), MISC + 8);
    const int lo = args.ph_lo, hi = args.ph_hi;
#ifndef PHASE_MASK
#define PHASE_MASK 0x7fff
#endif
#define IN(k) (((PHASE_MASK >> (k)) & 1) && lo <= (k) && (k) < hi)
#define SEAM(k) do { if (IN(k) && IN((k) + 1)) xcd_barrier(bar); } while (0)

    if (IN(0)) { TIDS(); phase_prologue(args, lds, gw, NGW, wave, lane); } SEAM(0);
    if (IN(1)) {
        pg8::Gemm g{(const bf16*)(ws + WS_HN), (const bf16*)(ws + WS_WINT), 2048, 2048, 2048}; pg8::StaticOrder S; S.init(LP / 256, PW / 256, G, bx);
        EpiProj E{(bf16*)(ws + WS_PROJ), (float*)(ws + WS_SMALL)};
        pg8::gemm_phase(lds + RING_OFF, g, S, E);
    } SEAM(1);
    if (IN(2)) { TIDS(); phase_post1(args, gw, NGW, lane); } SEAM(2);
    if (IN(3)) {
        pg8::Gemm g{(const bf16*)(ws + WS_CKVN), (const bf16*)(ws + WS_WKVT), 512, 512, 512}; pg8::StaticOrder S; S.init(LP / 256, 8, G, bx);
        EpiBf16Plain E{(bf16*)(ws + WS_KVA), 2048};
        pg8::gemm_phase(lds + RING_OFF, g, S, E);
    } SEAM(3);
    if (IN(4)) { TIDS(); phase_post2(args, gw, NGW, wave, lane, vcu); } SEAM(4);
    if (IN(5)) { TIDS(); phase_indexer(args, lds, gw, NGW, wave, lane); } SEAM(5);
    if (IN(6)) { TIDS(); phase_select(args, gw, NGW, lane); } SEAM(6);
    if (IN(7)) { phase_attn(args, (char*)lds_raw + RING_OFF, vcu, G); } SEAM(7);
    if (IN(8)) {
        { pg8::Gemm g{(const bf16*)(ws + WS_YA), (const bf16*)(ws + WS_WAT), 1024, 1024, 1024}; pg8::StaticOrder S; S.init(SEQ / 256, 8, G, bx);
          EpiBranchA E{(const bf16*)(ws + WS_PROJ), (float*)(ws + WS_M1)};
          pg8::gemm_phase(lds + RING_OFF, g, S, E); }
        VM_WAIT(); __syncthreads();
        { pg8::Gemm g{(const bf16*)(ws + WS_YB), (const bf16*)(ws + WS_WBT), 1024, 1024, 1024}; pg8::StaticOrder S; S.init(SEQ / 256, 8, G, bx);
          EpiBranchB E{(const bf16*)(ws + WS_PROJ), (const float*)(ws + WS_M1), (bf16*)(ws + WS_MERGED)};
          pg8::gemm_phase(lds + RING_OFF, g, S, E); }
    } SEAM(8);
    if (IN(9)) {
        { TIDS(); phase_moe_weights(args, lds, gw, NGW, wave, lane); }
        VM_WAIT(); __syncthreads();
        pg8::Gemm g{(const bf16*)(ws + WS_MERGED), (const bf16*)(ws + WS_WOT), 2048, 2048, 2048}; pg8::StaticOrder S; S.init(SEQ / 256, 8, G, bx);
        EpiOut E{args.in[I_X], (float*)(ws + WS_H2)};
        pg8::gemm_phase(lds + RING_OFF, g, S, E);
    } SEAM(9);
    if (IN(10)) { TIDS(); phase_route(args, gw, NGW, lane); } SEAM(10);
    if (IN(11)) { TIDS(); moe_tile_bases(args, TB); phase_gather(args, TB, gw, NGW, lane); } SEAM(11);
    if (IN(12)) {
        moe_tile_bases(args, TB);
        pg8::Gemm g{(const bf16*)(ws + WS_TS), (const bf16*)(ws + WS_WGUT), 2048, 2048, 2048}; pg8::MoeOrder S; S.init(TB[16], 4, G, bx, (const LAS int*)TB, (size_t)1024 * 2048 * 2);
        EpiGateUp E{(bf16*)(ws + WS_ACT), (const float*)(ws + WS_ROWW)};
        pg8::gemm_phase(lds + RING_OFF, g, S, E);
    } SEAM(12);
    if (IN(13)) {
        moe_tile_bases(args, TB);
        pg8::Gemm g{(const bf16*)(ws + WS_ACT), (const bf16*)(ws + WS_WDT), 512, 512, 512}; pg8::MoeOrder S; S.init(TB[16], 8, G, bx, (const LAS int*)TB, (size_t)2048 * 512 * 2);
        EpiDown E{(bf16*)(ws + WS_Y), (const int*)(ws + WS_ROWTOK)};
        pg8::gemm_phase(lds + RING_OFF, g, S, E);
    } SEAM(13);
    if (IN(14)) { TIDS(); phase_final(args, gw, NGW, lane); }
#undef IN
#undef SEAM
}

extern "C" void kernel_launch(void* const* d_in, const int* in_sizes, int n_in, void* d_out, int out_size, void* d_ws, size_t ws_size, hipStream_t stream) {
    static int grid = 0;
    if (grid == 0) {
        if (n_in != 20 || out_size != SEQ * DM || ws_size < WS_NEED) { fprintf(stderr, "kernel_launch: unexpected shapes (n_in %d, out %d, ws %zu need %zu)\n", n_in, out_size, ws_size, (size_t)WS_NEED); grid = -1; return; }
        int dev = 0, cus = 0;
        if (hipGetDevice(&dev) != hipSuccess || hipDeviceGetAttribute(&cus, hipDeviceAttributeMultiprocessorCount, dev) != hipSuccess) { grid = -1; return; }
        if (hipFuncSetAttribute((const void*)mk_fwd, hipFuncAttributeMaxDynamicSharedMemorySize, LDS_BYTES) != hipSuccess) { fprintf(stderr, "kernel_launch: hipFuncSetAttribute failed\n"); grid = -1; return; }
        int per_cu = 0;
        if (hipOccupancyMaxActiveBlocksPerMultiprocessor(&per_cu, (const void*)mk_fwd, NWAVES * 64, LDS_BYTES) != hipSuccess || per_cu < 1) fprintf(stderr, "kernel_launch: occupancy query says %d\n", per_cu);
        (void)hipGetLastError();
        grid = cus;
    }
    if (grid < 0) return;
    (void)hipMemsetAsync((char*)d_ws + WS_CTL, 0, CTL_ZERO_BYTES, stream);
    Args a{};
    for (int i = 0; i < 20; ++i) a.in[i] = (const float*)d_in[i];
    a.out = (float*)d_out; a.ws = (unsigned char*)d_ws;
    if (MK_ONE_LAUNCH) {
        a.ph_lo = 0; a.ph_hi = NPHASE; a.li = 0;
        hipLaunchKernelGGL(mk_fwd, dim3(grid), dim3(NWAVES * 64), LDS_BYTES, stream, a);
    } else {
        for (int p = 0; p < NPHASE; ++p) { a.ph_lo = p; a.ph_hi = p + 1; a.li = p; hipLaunchKernelGGL(mk_fwd, dim3(grid), dim3(NWAVES * 64), LDS_BYTES, stream, a); }
    }
}
```

```cpp
#include <hip/hip_runtime.h>
#include <hip/hip_bf16.h>
#include <cstdio>
#include <cstdint>

#ifndef MK_ONE_LAUNCH
#define MK_ONE_LAUNCH 1
#endif
#define PROBE_DOUBLE -1
#ifndef PROBE_TS_A
#define PROBE_TS_A -1
#define PROBE_TS_B -1
#endif
#define PROBE_TS_SCALE_US 3000.0f
#ifndef PROBE_TS_BLOCK
#define PROBE_TS_BLOCK 0
#endif
#define TSA(a_, i) do { if (PROBE_TS_A >= 0 && blockIdx.x == PROBE_TS_BLOCK && threadIdx.x == 0) ((unsigned long long*)((a_).ws + WS_CTL + 65536))[i] = __builtin_amdgcn_s_memrealtime(); } while (0)
#define TS(i) do { if (PROBE_TS_A >= 0 && blockIdx.x == PROBE_TS_BLOCK && threadIdx.x == 0) ((unsigned long long*)(args.ws + WS_CTL + 65536))[i] = __builtin_amdgcn_s_memrealtime(); } while (0)

namespace pg8 {
#define PG8_LAS __attribute__((address_space(3)))
typedef unsigned short bf16_t;
typedef short bf16x8 __attribute__((ext_vector_type(8)));
typedef float f32x4 __attribute__((ext_vector_type(4)));
typedef unsigned u32x4 __attribute__((ext_vector_type(4)));
constexpr int BM = 256, BK = 64, HALF = 128, HTB = HALF * BK * 2, STAGE_BYTES = 8 * HTB, NXCD = 8, WGM = 8;

__host__ __device__ __forceinline__ int lds_byte(int r, int c) { const int st = (r >> 4) * 2 + (c >> 5), rr = r & 15, cc = c & 31, ob = rr * 64 + cc * 2; return st * 1024 + (ob ^ (((ob >> 9) & 1) << 5)); }
__host__ __device__ __forceinline__ void stage_rc(int b, int& R, int& C) { const int st = b / 1024, sb = b % 1024, swz = sb ^ (((sb >> 9) & 1) << 5); R = (st >> 1) * 16 + swz / 64; C = (st & 1) * 32 + (swz % 64) / 2; }
__host__ __device__ __forceinline__ int perm32(int rho) { const int n = rho >> 4, i = rho & 15; return 8 * (i >> 2) + 4 * n + (i & 3); }

struct Unit { int pm, pn; size_t bofs; int rb; };
struct Gemm { const bf16_t* A; const bf16_t* Bt; int lda, ldb, K; const int* rowsrc; };

struct StaticOrder {
    int nM, nN, nwg, G, c;
    __device__ void init(int nM_, int nN_, int G_, int c_) { nM = nM_; nN = nN_; nwg = nM * nN; G = G_; c = c_; }
    __device__ bool next(int i, Unit& u) const {
        const long L = (long)i * G + c; if (L >= nwg) return false;
        int wgid = (int)L; { const int q = nwg / NXCD, r = nwg % NXCD, xcd = wgid % NXCD, off = wgid / NXCD; wgid = (xcd < r ? xcd * (q + 1) : r * (q + 1) + (xcd - r) * q) + off; }
        const int nig = WGM * nN, gid = wgid / nig, fm = gid * WGM, gsz = (nM - fm) < WGM ? (nM - fm) : WGM;
        u.pm = fm + ((wgid % nig) % gsz); u.pn = (wgid % nig) / gsz; u.bofs = 0; u.rb = u.pm * 256; return true;
    }
};
struct MoeOrder {
    int pm_lo, nN, nwg, G, c; const PG8_LAS int* tb; size_t bstride;
    __device__ void init(int pm_lo_, int npm, int nN_, int G_, int c_, const PG8_LAS int* tb_, size_t bs) { pm_lo = pm_lo_; nN = nN_; nwg = (npm > 0 && c_ >= 0 && c_ < G_) ? npm * nN_ : 0; G = G_; c = c_; tb = tb_; bstride = bs; }
    __device__ bool next(int i, Unit& u) const {
        const long L = (long)i * G + c; if (c < 0 || L >= nwg) return false;
        const int wgid = (int)L;
        u.pn = wgid % nN; u.pm = pm_lo + wgid / nN;
        int e = 0;
#pragma unroll
        for (int k = 1; k < 16; ++k) e += (tb[k] <= u.pm) ? 1 : 0;
        u.bofs = (size_t)e * bstride; u.rb = e * 8192 + (u.pm - tb[e]) * 256; return true;
    }
};

__device__ __forceinline__ unsigned cvt_pk_bf16(float lo, float hi) { unsigned r; asm volatile("v_cvt_pk_bf16_f32 %0, %1, %2" : "=v"(r) : "v"(lo), "v"(hi)); return r; }

template <class Epi, class Sched, bool GATHER = false>
__device__ __forceinline__ void gemm_phase(PG8_LAS unsigned char* lds, const Gemm g, const Sched& S, const Epi& E) {
    int tid = threadIdx.x; asm volatile("" : "+v"(tid));
    const int wid = __builtin_amdgcn_readfirstlane(tid >> 6), lane = tid & 63, wr = wid >> 2, wc = wid & 3, fr = lane & 15, fq = lane >> 4;
    const int K = g.K, nt = K / BK;
    unsigned voffA[2], voffB[2];
#pragma unroll
    for (int i = 0; i < 2; ++i) { int R, C; stage_rc(tid * 16 + i * 8192, R, C); const int Rb = ((R & ~31) + perm32(R & 31));
        voffA[i] = (unsigned)(R * g.lda + C) * 2u; voffB[i] = (unsigned)(Rb * g.ldb + C) * 2u; }
    int gR[2], gC[2];
#pragma unroll
    for (int i = 0; i < 2; ++i) stage_rc(tid * 16 + i * 8192, gR[i], gC[i]);
    unsigned cvA[2][2] = {{0u, 0u}, {0u, 0u}}, nvA[2][2] = {{0u, 0u}, {0u, 0u}};
#define PG8_GLOAD(dst, rb_) do { _Pragma("unroll") for (int h_ = 0; h_ < 2; ++h_) _Pragma("unroll") for (int i_ = 0; i_ < 2; ++i_) { \
        const int rt_ = g.rowsrc[(rb_) + h_ * HALF + gR[i_]]; dst[h_][i_] = (unsigned)((rt_ >= 0 ? rt_ >> 1 : 0) * g.lda + gC[i_]) * 2u; } } while (0)
    const size_t kstep = (size_t)(BK * 2);
    const size_t hstepA = (size_t)HALF * g.lda * 2, hstepB = (size_t)HALF * g.ldb * 2;
    const size_t tstepA = 2 * hstepA, tstepB = 2 * hstepB;
    const unsigned ldsw = (unsigned)wid * 1024u;
    const int aoff = lds_byte(wr * 64 + fr, fq * 8), boff = lds_byte(wc * 32 + fr, fq * 8);
#define PG8_SA(b, h) (((b) * 2 + (h)) * HTB)
#define PG8_SB(b, h) ((4 + (b) * 2 + (h)) * HTB)
#define PG8_STAGE(bufoff, gbase, voff) do { _Pragma("unroll") for (int _i = 0; _i < 2; ++_i) \
        __builtin_amdgcn_global_load_lds((const unsigned*)((const char*)(gbase) + (voff)[_i]), (PG8_LAS unsigned*)(lds + (bufoff) + ldsw + _i * 8192), 16, 0, 0); } while (0)
#define PG8_LDA(dst, b, h) do { _Pragma("unroll") for (int m = 0; m < 4; ++m) _Pragma("unroll") for (int k = 0; k < 2; ++k) dst[m][k] = *(const PG8_LAS bf16x8*)(lds + PG8_SA(b, h) + aoff + m * 2048 + k * 1024); } while (0)
#define PG8_LDB(dst, b, h) do { _Pragma("unroll") for (int n = 0; n < 2; ++n) _Pragma("unroll") for (int k = 0; k < 2; ++k) dst[n][k] = *(const PG8_LAS bf16x8*)(lds + PG8_SB(b, h) + boff + n * 2048 + k * 1024); } while (0)
#define PG8_MMA(ai, bj, At, Bt) do { __builtin_amdgcn_s_setprio(1); _Pragma("unroll") for (int m = 0; m < 4; ++m) _Pragma("unroll") for (int n = 0; n < 2; ++n) _Pragma("unroll") for (int k = 0; k < 2; ++k) \
        acc[ai][bj][m][n] = __builtin_amdgcn_mfma_f32_16x16x32_bf16(Bt[n][k], At[m][k], acc[ai][bj][m][n], 0, 0, 0); __builtin_amdgcn_s_setprio(0); } while (0)
#define PG8_WAIT_V(n) asm volatile("s_waitcnt vmcnt(" #n ")" ::: "memory")
#define PG8_WAIT_L(n) asm volatile("s_waitcnt lgkmcnt(" #n ")" ::: "memory")
#define PG8_BAR __builtin_amdgcn_s_barrier()
#define PG8_SCHED __builtin_amdgcn_sched_barrier(0)
    Unit cur, nxt; int ui = 0;
    if (!S.next(0, cur)) return;
    f32x4 acc[2][2][4][2];
#pragma unroll
    for (int a = 0; a < 2; ++a)
#pragma unroll
        for (int b = 0; b < 2; ++b)
#pragma unroll
            for (int m = 0; m < 4; ++m)
#pragma unroll
                for (int n = 0; n < 2; ++n) acc[a][b][m][n] = (f32x4){0.f, 0.f, 0.f, 0.f};
    bf16x8 At[4][2], B0[2][2], B1[2][2];
    const char* cA = (const char*)g.A + (size_t)cur.pm * tstepA; const char* cB = (const char*)g.Bt + cur.bofs + (size_t)cur.pn * tstepB;
    const char* gA = (const char*)g.A;
    if constexpr (GATHER) { PG8_GLOAD(cvA, cur.rb); }
    {
        PG8_STAGE(PG8_SB(0, 0), cB, voffB); PG8_STAGE(PG8_SB(0, 1), cB + hstepB, voffB);
        if constexpr (GATHER) { PG8_STAGE(PG8_SA(0, 0), gA, cvA[0]); PG8_STAGE(PG8_SA(0, 1), gA, cvA[1]); } else { PG8_STAGE(PG8_SA(0, 0), cA, voffA); PG8_STAGE(PG8_SA(0, 1), cA + hstepA, voffA); }
        if (wr == 1) PG8_BAR;
        PG8_WAIT_V(2); PG8_BAR;
        PG8_STAGE(PG8_SB(1, 0), cB + kstep, voffB);
        if constexpr (GATHER) { PG8_STAGE(PG8_SA(1, 0), gA + kstep, cvA[0]); } else { PG8_STAGE(PG8_SA(1, 0), cA + kstep, voffA); }
        PG8_STAGE(PG8_SB(1, 1), cB + hstepB + kstep, voffB);
        PG8_WAIT_V(6); PG8_BAR;
    }
    for (;;) {
        const bool has_next = S.next(ui + 1, nxt);
        const char* nA = has_next ? (const char*)g.A + (size_t)nxt.pm * tstepA : cA; const char* nB = has_next ? (const char*)g.Bt + nxt.bofs + (size_t)nxt.pn * tstepB : cB;
        if constexpr (GATHER) { if (has_next) { PG8_GLOAD(nvA, nxt.rb); } else {
#pragma unroll
            for (int h_ = 0; h_ < 2; ++h_) { nvA[h_][0] = cvA[h_][0]; nvA[h_][1] = cvA[h_][1]; } } }
        for (int t = 0; t < nt; t += 2) {
            if constexpr (Epi::HAS_MID) { if (t == nt / 2) E.mid(acc, cur, wr, wc, fr, fq); }
            const bool last = (t == nt - 2);
            const char* a1 = cA + (size_t)(t + 1) * kstep;
            const char* a2 = last ? nA : cA + (size_t)(t + 2) * kstep; const char* b2 = last ? nB : cB + (size_t)(t + 2) * kstep;
            const char* a3 = a2 + kstep; const char* b3 = b2 + kstep;
            unsigned sv[2][2]; const char* g2 = gA;
            if constexpr (GATHER) { g2 = last ? gA : gA + (size_t)(t + 2) * kstep;
#pragma unroll
                for (int h_ = 0; h_ < 2; ++h_) { sv[h_][0] = last ? nvA[h_][0] : cvA[h_][0]; sv[h_][1] = last ? nvA[h_][1] : cvA[h_][1]; } }
            PG8_LDB(B0, 0, 0); PG8_LDB(B1, 0, 1); PG8_SCHED; PG8_LDA(At, 0, 0);
            if constexpr (GATHER) { PG8_STAGE(PG8_SA(1, 1), gA + (size_t)(t + 1) * kstep, cvA[1]); } else { PG8_STAGE(PG8_SA(1, 1), a1 + hstepA, voffA); }
            PG8_WAIT_V(8); PG8_WAIT_L(0); PG8_BAR; PG8_MMA(0, 0, At, B0); PG8_MMA(0, 1, At, B1); PG8_BAR; PG8_SCHED;
            PG8_LDA(At, 0, 1); PG8_STAGE(PG8_SB(0, 0), b2, voffB); PG8_STAGE(PG8_SB(0, 1), b2 + hstepB, voffB);
            if constexpr (GATHER) { PG8_STAGE(PG8_SA(0, 0), g2, sv[0]); } else { PG8_STAGE(PG8_SA(0, 0), a2, voffA); }
            PG8_WAIT_V(8); PG8_WAIT_L(0); PG8_BAR; PG8_MMA(1, 0, At, B0); PG8_MMA(1, 1, At, B1); PG8_BAR; PG8_SCHED;
            PG8_LDB(B0, 1, 0); PG8_LDB(B1, 1, 1); PG8_SCHED; PG8_LDA(At, 1, 0);
            if constexpr (GATHER) { PG8_STAGE(PG8_SA(0, 1), g2, sv[1]); } else { PG8_STAGE(PG8_SA(0, 1), a2 + hstepA, voffA); }
            PG8_WAIT_V(8); PG8_WAIT_L(0); PG8_BAR; PG8_MMA(0, 0, At, B0); PG8_MMA(0, 1, At, B1); PG8_BAR; PG8_SCHED;
            PG8_LDA(At, 1, 1); PG8_STAGE(PG8_SB(1, 0), b3, voffB); PG8_STAGE(PG8_SB(1, 1), b3 + hstepB, voffB);
            if constexpr (GATHER) { PG8_STAGE(PG8_SA(1, 0), g2 + kstep, sv[0]); } else { PG8_STAGE(PG8_SA(1, 0), a3, voffA); }
            PG8_WAIT_V(8); PG8_WAIT_L(0); PG8_BAR; PG8_MMA(1, 0, At, B0); PG8_MMA(1, 1, At, B1); PG8_BAR; PG8_SCHED;
        }
        if (wr == 0) PG8_BAR;
        E(acc, cur, wr, wc, fr, fq);
        if (!has_next) break;
#pragma unroll
        for (int a = 0; a < 2; ++a)
#pragma unroll
            for (int b = 0; b < 2; ++b)
#pragma unroll
                for (int m = 0; m < 4; ++m)
#pragma unroll
                    for (int n = 0; n < 2; ++n) acc[a][b][m][n] = (f32x4){0.f, 0.f, 0.f, 0.f};
        cur = nxt; cA = nA; cB = nB; ++ui;
        if constexpr (GATHER) {
#pragma unroll
            for (int h_ = 0; h_ < 2; ++h_) { cvA[h_][0] = nvA[h_][0]; cvA[h_][1] = nvA[h_][1]; } }
        if (wr == 1) PG8_BAR;
    }
    PG8_WAIT_V(0);
    PG8_BAR;
#undef PG8_GLOAD
#undef PG8_SA
#undef PG8_SB
#undef PG8_STAGE
#undef PG8_LDA
#undef PG8_LDB
#undef PG8_MMA
#undef PG8_WAIT_V
#undef PG8_WAIT_L
#undef PG8_BAR
#undef PG8_SCHED
}
}

constexpr int NWAVES = 8;
constexpr int DM = 2048, SEQ = 8192, NMETA = 16, LTOK = SEQ + NMETA, LP = 8448;
constexpr int HD = 128, NH = 8, KVR = 512, IH = 16, IDD = 64, TOPK = 256;
constexpr int INW = 9816, PW = 9984;
constexpr int PC_QA = 0, PC_CKV = 1024, PC_QI = 1536, PC_KI = 2560, PC_WI = 2624, PC_FB = 2640, PC_QB = 2688, PC_KB = 3712, PC_VB = 4736, PC_GA = 5760, PC_GB = 7808, PC_END = 9856;
constexpr int NE = 16, DFF = 512, TSROWS = 20480;
constexpr float EPS = 1e-6f;
constexpr float LOG2E = 1.4426950408889634f;
constexpr float ATT_SCALE = 0.08838834764831845f;
constexpr int NTILE64 = 129;
constexpr int NPHASE = 14;


namespace att {
typedef short bf16x8 __attribute__((ext_vector_type(8)));
typedef short s16x4 __attribute__((ext_vector_type(4)));
typedef float f32x16 __attribute__((ext_vector_type(16)));
typedef float f32x4 __attribute__((ext_vector_type(4)));
typedef unsigned u32x4 __attribute__((ext_vector_type(4)));
typedef unsigned short bf16;
constexpr int NW = 8, QBLK = 32, KVBLK = 64, QB = NW * QBLK, D = 128;
constexpr int SHM_V = KVBLK * D * 2, SHM_K = KVBLK * D * 2;
constexpr int NVS = 3;
constexpr int OFF_WS = NVS * SHM_V + 2 * SHM_K, OFF_BIAS = OFF_WS + NW * 64 * 4, OFF_Q = OFF_BIAS + 2 * 64 * 4, LDS_TOTAL = OFF_Q + NW * 8192;
constexpr float SCALE = 0.08838834764831845f, THR = 8.f;
#define KSWZ(row, colB) ((row) * 256 + ((colB) ^ (((row) & 7) << 4)))
#define SBAR() __builtin_amdgcn_sched_barrier(0)
__device__ __forceinline__ int v_st(int k, int c) { const int kk = (k & ~0xC) | ((k & 4) << 1) | ((k & 8) >> 1); return ((kk >> 3) * 4 + (c >> 5)) * 512 + ((kk & 7) * 32 + (c & 31)) * 2; }
__device__ __forceinline__ int v_rd_base(int lane) { return ((lane & 3) << 3) | (((lane >> 2) & 3) << 6) | (((lane >> 4) & 1) << 5) | (((lane >> 5) & 1) << 8); }
constexpr int v_rd_off(int d0, int ks, int half) { return d0 * 512 + ks * 4096 + half * 2048; }
__device__ __forceinline__ int crow(int r, int hi) { return (r & 3) + 8 * (r >> 2) + 4 * hi; }
__device__ __forceinline__ unsigned cvtpk(float lo, float hi) { unsigned r; asm volatile("v_cvt_pk_bf16_f32 %0, %1, %2" : "=v"(r) : "v"(lo), "v"(hi)); return r; }
__device__ __forceinline__ void mask_causal(f32x16& p0, f32x16& p1, int dq) {
    const float NEG = -__builtin_inff();
#pragma unroll
    for (int r = 0; r < 16; ++r) { const int c = (r & 3) + 8 * (r >> 2); if (dq - c < 0) p0[r] = NEG; if (dq - c - 32 < 0) p1[r] = NEG; }
}
__device__ __forceinline__ void mask_bits(f32x16& p0, f32x16& p1, unsigned long long w, int hi) {
    const float NEG = -__builtin_inff();
    const unsigned wl = (unsigned)w >> (4 * hi), wh = (unsigned)(w >> 32) >> (4 * hi);
#pragma unroll
    for (int r = 0; r < 16; ++r) { const int c = (r & 3) + 8 * (r >> 2);
        const unsigned m0 = (unsigned)__builtin_amdgcn_sbfe((int)wl, c, 1), m1 = (unsigned)__builtin_amdgcn_sbfe((int)wh, c, 1);
        p0[r] = __uint_as_float((__float_as_uint(p0[r]) & m0) | (__float_as_uint(NEG) & ~m0)); p1[r] = __uint_as_float((__float_as_uint(p1[r]) & m1) | (__float_as_uint(NEG) & ~m1)); }
}
__device__ __forceinline__ void partialSM(f32x16& p0, f32x16& p1, float& m_reg, float& mn, float& alpha) {
    float pmax = p0[0];
#pragma unroll
    for (int r = 1; r < 16; ++r) pmax = fmaxf(pmax, p0[r]);
#pragma unroll
    for (int r = 0; r < 16; ++r) pmax = fmaxf(pmax, p1[r]);
    { auto rr = __builtin_amdgcn_permlane32_swap(__float_as_uint(pmax), __float_as_uint(pmax), false, false);
      pmax = fmaxf(__uint_as_float(rr[0]), __uint_as_float(rr[1])); }
    constexpr float C2 = 1.4426950408889634f * SCALE;
    if (__builtin_expect(__all((pmax - m_reg) * SCALE <= THR), 1)) { mn = m_reg; alpha = 1.f; }
    else { mn = fmaxf(m_reg, pmax); alpha = __builtin_amdgcn_exp2f((m_reg - mn) * C2); m_reg = mn; }
    const float mnL = -mn * C2;
#pragma unroll
    for (int r = 0; r < 16; ++r) p0[r] = fmaf(p0[r], C2, mnL);
#pragma unroll
    for (int r = 0; r < 16; ++r) p1[r] = fmaf(p1[r], C2, mnL);
#pragma unroll
    for (int r = 0; r < 16; ++r) p0[r] = __builtin_amdgcn_exp2f(p0[r]);
}
__device__ __forceinline__ void finishSM(f32x16& p0, f32x16& p1, float alpha, float& l_reg, bf16x8& pa0, bf16x8& pa1, bf16x8& pa2, bf16x8& pa3) {
#pragma unroll
    for (int r = 0; r < 16; ++r) p1[r] = __builtin_amdgcn_exp2f(p1[r]);
    float ps = 0;
#pragma unroll
    for (int r = 0; r < 16; ++r) ps += p0[r];
#pragma unroll
    for (int r = 0; r < 16; ++r) ps += p1[r];
    { auto rr = __builtin_amdgcn_permlane32_swap(__float_as_uint(ps), __float_as_uint(ps), false, false);
      ps = __uint_as_float(rr[0]) + __uint_as_float(rr[1]); }
    l_reg = l_reg * alpha + ps;
#define PK4(P, B_, OUT) do { unsigned a0 = cvtpk(P[B_+0], P[B_+1]), a1 = cvtpk(P[B_+2], P[B_+3]);                          \
        unsigned b0 = cvtpk(P[B_+4], P[B_+5]), b1 = cvtpk(P[B_+6], P[B_+7]);                                             \
        auto r0 = __builtin_amdgcn_permlane32_swap(a0, b0, false, false); auto r1 = __builtin_amdgcn_permlane32_swap(a1, b1, false, false); \
        u32x4 w = {r0[0], r1[0], r0[1], r1[1]}; OUT = *reinterpret_cast<bf16x8*>(&w); } while (0)
    PK4(p0, 0, pa0); PK4(p0, 8, pa1); PK4(p1, 0, pa2); PK4(p1, 8, pa3);
#undef PK4
}
template <int KB, int MODE>
__device__ __forceinline__ void qkt(f32x16& p0, f32x16& p1, const char* lds, int r32, int hi, const char* qsp) {
    const char* K_lds = lds + NVS * SHM_V;
    if (MODE == 0) { const float* bb = (const float*)(lds + OFF_BIAS + KB * 256) + 4 * hi;
#pragma unroll
        for (int g = 0; g < 4; ++g) { const f32x4 b0 = *(const f32x4*)(bb + 8 * g), b1 = *(const f32x4*)(bb + 32 + 8 * g);
            p0[4 * g] = b0[0]; p0[4 * g + 1] = b0[1]; p0[4 * g + 2] = b0[2]; p0[4 * g + 3] = b0[3];
            p1[4 * g] = b1[0]; p1[4 * g + 1] = b1[1]; p1[4 * g + 2] = b1[2]; p1[4 * g + 3] = b1[3]; } }
    else { p0 = f32x16{}; p1 = f32x16{}; }
    const char* kb[4];
#pragma unroll
    for (int dd = 0; dd < 4; ++dd) kb[dd] = K_lds + KB * SHM_K + KSWZ(r32, (dd * 16 + hi * 8) * 2);
#pragma unroll
    for (int d0 = 0; d0 < 8; ++d0) { const char* a = kb[d0 & 3] + (d0 >> 2) * 128;
        bf16x8 b0 = *reinterpret_cast<const bf16x8*>(a);
        bf16x8 b1 = *reinterpret_cast<const bf16x8*>(a + 32 * 256);
        const bf16x8 q = *reinterpret_cast<const bf16x8*>(qsp + d0 * 1024);
        p0 = __builtin_amdgcn_mfma_f32_32x32x16_bf16(b0, q, p0, 0, 0, 0);
        p1 = __builtin_amdgcn_mfma_f32_32x32x16_bf16(b1, q, p1, 0, 0, 0); }
}
__device__ __forceinline__ void pv_tile(f32x16* o, int vb0, bf16x8 pa0, bf16x8 pa1, bf16x8 pa2, bf16x8 pa3) {
#define TRRD(dst, off) asm volatile("ds_read_b64_tr_b16 %0, %1 offset:%2" : "=&v"(dst) : "v"(vb0), "i"(off) : "memory")
#define PV_D0(d0) do { s16x4 l0, l1, l2, l3, h0, h1, h2, h3; constexpr int b_ = v_rd_off(d0, 0, 0); \
        TRRD(l0, b_); TRRD(h0, b_ + 2048); TRRD(l1, b_ + 4096); TRRD(h1, b_ + 6144); TRRD(l2, b_ + 8192); TRRD(h2, b_ + 10240); TRRD(l3, b_ + 12288); TRRD(h3, b_ + 14336); \
        asm volatile("s_waitcnt lgkmcnt(0)" ::: "memory"); SBAR(); \
        o[d0] = __builtin_amdgcn_mfma_f32_32x32x16_bf16(pa0, (bf16x8){l0[0], l0[1], l0[2], l0[3], h0[0], h0[1], h0[2], h0[3]}, o[d0], 0, 0, 0);   \
        o[d0] = __builtin_amdgcn_mfma_f32_32x32x16_bf16(pa1, (bf16x8){l1[0], l1[1], l1[2], l1[3], h1[0], h1[1], h1[2], h1[3]}, o[d0], 0, 0, 0);   \
        o[d0] = __builtin_amdgcn_mfma_f32_32x32x16_bf16(pa2, (bf16x8){l2[0], l2[1], l2[2], l2[3], h2[0], h2[1], h2[2], h2[3]}, o[d0], 0, 0, 0);   \
        o[d0] = __builtin_amdgcn_mfma_f32_32x32x16_bf16(pa3, (bf16x8){l3[0], l3[1], l3[2], l3[3], h3[0], h3[1], h3[2], h3[3]}, o[d0], 0, 0, 0); } while (0)
    PV_D0(0); PV_D0(1); PV_D0(2); PV_D0(3);
#undef PV_D0
#undef TRRD
}
struct ItemRef { const bf16* Q; const bf16* K; const bf16* V; bf16* O; int P0, t_lo, t_hi; const float* cb; float cref; const unsigned long long* mk; float* part; float kn2; };
constexpr float FOX_TAU = 30.5f;
constexpr int PART_FLOATS = 256 * 128 + 512;
struct Seam { bf16x8 st_v0, st_v1, st_k0, st_k1; float st_b; };
#define ROWP(p, k0, rr) ((p) + (size_t)((k0) + (rr)) * LDKV + sc)
#define VMW() asm volatile("s_waitcnt vmcnt(0)" ::: "memory")
#define LD8(p) (*reinterpret_cast<const bf16x8*>(p))
#define SLOAD_H(R, k0) do { S.st_v0 = LD8(ROWP((R).V, k0, sr)); S.st_v1 = LD8(ROWP((R).V, k0, 32 + sr)); S.st_k0 = LD8(ROWP((R).K, k0, sr)); S.st_k1 = LD8(ROWP((R).K, k0, 32 + sr)); \
        if (MODE == 0 && wid == 0) S.st_b = ((R).cref - (R).cb[(k0) + lane]) * (1.0f / SCALE); } while (0)
#define SWRITE_HK(bf) do { *(bf16x8*)(K_lds + (bf) * SHM_K + kws) = S.st_k0; *(bf16x8*)(K_lds + (bf) * SHM_K + kws + 32 * 256) = S.st_k1; \
        if (MODE == 0 && wid == 0) ((float*)(lds + OFF_BIAS))[(bf) * 64 + lane] = S.st_b; } while (0)
#define SWRITE_HV(bf) do { *(bf16x8*)(V_lds + (bf) * SHM_V + vst0) = S.st_v0; *(bf16x8*)(V_lds + (bf) * SHM_V + vst1) = S.st_v1; } while (0)
#define SWRITE_H(bf) do { SWRITE_HV(bf); SWRITE_HK(bf); } while (0)
template <int MODE, int LDQ, int LDKV, int LDO>
__device__ __forceinline__ void run_item(const ItemRef& cur, char* lds) {
    int tid = threadIdx.x; asm volatile("" : "+v"(tid));
    const int wid = __builtin_amdgcn_readfirstlane(tid >> 6), lane = tid & 63, r32 = lane & 31, hi = lane >> 5;
    int t_lo = cur.t_lo;
    const int qlo = cur.P0 + wid * QBLK, qm = qlo + r32 - 4 * hi;
    char* V_lds = lds; char* K_lds = lds + NVS * SHM_V;
    float* wsf = (float*)(lds + OFF_WS) + wid * 64; float* li_l = wsf, * al_l = wsf + 32;
    char* qsp = lds + OFF_Q + wid * 8192 + lane * 16;
    float m_reg = -1e30f, l_reg = 0; f32x16 o[4] = {};
    const int sr = tid >> 4, sc = (tid & 15) * 8, vst0 = v_st(sr, sc), vst1 = v_st(32 + sr, sc), kws = KSWZ(sr, sc * 2);
    const int vb0 = (int)(uintptr_t)V_lds + v_rd_base(lane);
    const unsigned long long* mkl = cur.mk + wid * QBLK + r32;
    Seam S;
#define RESC(a) do { if (__any((a) < 1.f)) { if (hi == 0) al_l[r32] = (a); asm volatile("s_waitcnt lgkmcnt(0)" ::: "memory");              \
                     _Pragma("unroll") for (int d_ = 0; d_ < 4; ++d_) _Pragma("unroll") for (int r = 0; r < 16; ++r) o[d_][r] *= al_l[crow(r, hi)]; } } while (0)
#define KBASE(t) ((t_lo + (t)) * KVBLK)
#define MLOAD(t) (MODE == 1 ? mkl[(size_t)(t_lo + (t)) * SEQ] : 0ull)
#define MASKT(P0_, P1_, t, w_) do { if (MODE == 1) mask_bits(P0_, P1_, w_, hi); else { const int kb_ = KBASE(t); if (kb_ + KVBLK - 1 > qlo) mask_causal(P0_, P1_, qm - kb_); } } while (0)
    { bf16x8 tq[8];
#pragma unroll
      for (int d0 = 0; d0 < 8; ++d0) tq[d0] = LD8(cur.Q + (size_t)(wid * QBLK + r32) * LDQ + d0 * 16 + hi * 8);
      if (MODE == 0) {
          float q2 = 0.f;
#pragma unroll
          for (int d0 = 0; d0 < 8; ++d0)
#pragma unroll
              for (int j = 0; j < 8; ++j) { const float x = __uint_as_float((unsigned)(unsigned short)tq[d0][j] << 16); q2 = fmaf(x, x, q2); }
          q2 += __shfl_xor(q2, 32);
#pragma unroll
          for (int ofs = 1; ofs < 32; ofs <<= 1) q2 = fmaxf(q2, __shfl_xor(q2, ofs));
          if (lane == 0) al_l[0] = q2;
          __syncthreads();
          float Q2 = 0.f;
#pragma unroll
          for (int w = 0; w < NW; ++w) Q2 = fmaxf(Q2, ((const float*)(lds + OFF_WS))[w * 64 + 32]);
          const float D = FOX_TAU + 2.002f * SCALE * sqrtf(Q2 * cur.kn2);
          const float cthr = cur.cb[cur.P0] + D; int cntskip = 0;
#pragma unroll
          for (int i = 0; i < 3; ++i) { const int t = lane + 64 * i; const bool sk = t < cur.t_hi && cur.cb[t * KVBLK + KVBLK - 1] >= cthr; cntskip += __popcll(__ballot(sk)); }
          t_lo = cntskip < cur.t_hi - 1 ? cntskip : cur.t_hi - 1;
          __syncthreads();
      }
      SLOAD_H(cur, KBASE(0)); VMW();
#pragma unroll
      for (int d0 = 0; d0 < 8; ++d0) *(bf16x8*)(qsp + d0 * 1024) = tq[d0];
      SWRITE_HK(0); }
    const int NT = cur.t_hi - t_lo;
    __syncthreads();
    f32x16 pA0, pA1, pB0, pB1; float mnA, mnB, alA, alB; bf16x8 pa0, pa1, pa2, pa3;
    unsigned long long mw = MLOAD(0);
    SWRITE_HV(0); SBAR();
    if (NT > 1) { SLOAD_H(cur, KBASE(1)); }
    SBAR(); qkt<0, MODE>(pA0, pA1, lds, r32, hi, qsp);
    MASKT(pA0, pA1, 0, mw); partialSM(pA0, pA1, m_reg, mnA, alA);
    if (NT > 1) { VMW(); SWRITE_H(1); }
    __syncthreads();
    int vs = 0;
#define HALF_STEP(PX0, PX1, mnX, alX, PY0, PY1, alY, t, KB, SB) do {                                                          \
        SBAR(); mw = MLOAD(t); qkt<KB, MODE>(PX0, PX1, lds, r32, hi, qsp);                                                    \
        finishSM(PY0, PY1, alY, l_reg, pa0, pa1, pa2, pa3); SBAR();                                                           \
        if ((t) + 1 < NT) { SLOAD_H(cur, KBASE((t) + 1)); SBAR(); }                                                           \
        pv_tile(o, vb0 + vs * SHM_V, pa0, pa1, pa2, pa3); MASKT(PX0, PX1, (t), mw); partialSM(PX0, PX1, m_reg, mnX, alX);     \
        if ((t) + 1 < NT) { const int vn_ = vs >= 1 ? vs - 1 : 2; VMW(); SWRITE_HK(SB); SWRITE_HV(vn_); }                      \
        RESC(alX); vs = vs == 2 ? 0 : vs + 1; __syncthreads(); } while (0)
    for (int t = 1; t + 1 < NT; t += 2) {
        HALF_STEP(pB0, pB1, mnB, alB, pA0, pA1, alA, t, 1, 0);
        HALF_STEP(pA0, pA1, mnA, alA, pB0, pB1, alB, t + 1, 0, 1);
    }
    const bool even = (NT & 1) == 0;
    if (even) { SBAR(); mw = MLOAD(NT - 1); qkt<1, MODE>(pB0, pB1, lds, r32, hi, qsp); SBAR(); }
    finishSM(pA0, pA1, alA, l_reg, pa0, pa1, pa2, pa3); SBAR();
    pv_tile(o, vb0 + vs * SHM_V, pa0, pa1, pa2, pa3);
    if (even) { MASKT(pB0, pB1, NT - 1, mw); partialSM(pB0, pB1, m_reg, mnB, alB); __syncthreads(); RESC(alB);
        finishSM(pB0, pB1, alB, l_reg, pa0, pa1, pa2, pa3); SBAR(); pv_tile(o, vb0 + (vs == 2 ? 0 : vs + 1) * SHM_V, pa0, pa1, pa2, pa3); }
    SBAR();
    if (cur.part) {
        float* po = cur.part + (size_t)(wid * 64 + lane) * 64;
#pragma unroll
        for (int d0 = 0; d0 < 4; ++d0)
#pragma unroll
            for (int g = 0; g < 4; ++g) *(f32x4*)(po + d0 * 16 + 4 * g) = (f32x4){o[d0][4 * g], o[d0][4 * g + 1], o[d0][4 * g + 2], o[d0][4 * g + 3]};
        if (hi == 0) { cur.part[256 * 128 + wid * QBLK + r32] = m_reg; cur.part[256 * 128 + 256 + wid * QBLK + r32] = l_reg; }
    } else {
        if (hi == 0) li_l[r32] = l_reg; asm volatile("s_waitcnt lgkmcnt(0)" ::: "memory");
        float rli[16];
#pragma unroll
        for (int r = 0; r < 16; ++r) rli[r] = __builtin_amdgcn_rcpf(li_l[crow(r, hi)]);
        bf16* Ow = cur.O + (size_t)(wid * QBLK) * LDO;
#pragma unroll
        for (int r = 0; r < 16; ++r) { const int orow = crow(r, hi);
#pragma unroll
            for (int d0 = 0; d0 < 4; ++d0) { const float v = o[d0][r] * rli[r];
                const float vn = __shfl_xor(v, 1);
                if ((r32 & 1) == 0) *(unsigned*)(Ow + (size_t)orow * LDO + d0 * 32 + r32) = cvtpk(v, vn); } }
    }
    __syncthreads();
#undef RESC
#undef KBASE
#undef MLOAD
#undef MASKT
#undef HALF_STEP
}
template <int LDO>
__device__ __forceinline__ void combine_item(const float* p1, const float* p2, bf16* O, char* lds) {
    int tid = threadIdx.x; asm volatile("" : "+v"(tid));
    const int wid = __builtin_amdgcn_readfirstlane(tid >> 6), lane = tid & 63, r32 = lane & 31, hi = lane >> 5;
    float* wsf = (float*)(lds + OFF_WS) + wid * 64;
    constexpr float C2 = 1.4426950408889634f * SCALE;
    { const int row = wid * QBLK + r32; const float m1 = p1[256 * 128 + row], m2 = p2[256 * 128 + row], l1 = p1[256 * 128 + 256 + row], l2 = p2[256 * 128 + 256 + row];
      const float m = fmaxf(m1, m2), f1 = __builtin_amdgcn_exp2f((m1 - m) * C2), f2 = __builtin_amdgcn_exp2f((m2 - m) * C2); const float rl = 1.f / (l1 * f1 + l2 * f2);
      if (hi == 0) { wsf[r32] = f1 * rl; wsf[32 + r32] = f2 * rl; } }
    asm volatile("s_waitcnt lgkmcnt(0)" ::: "memory");
    const float* q1 = p1 + (size_t)(wid * 64 + lane) * 64; const float* q2 = p2 + (size_t)(wid * 64 + lane) * 64;
    bf16* Ow = O + (size_t)(wid * QBLK) * LDO;
#pragma unroll
    for (int d0 = 0; d0 < 4; ++d0)
#pragma unroll
        for (int g = 0; g < 4; ++g) { const f32x4 a = *(const f32x4*)(q1 + d0 * 16 + 4 * g), b = *(const f32x4*)(q2 + d0 * 16 + 4 * g);
#pragma unroll
            for (int j = 0; j < 4; ++j) { const int r = 4 * g + j, orow = crow(r, hi); const float v = a[j] * wsf[orow] + b[j] * wsf[32 + orow];
                const float vn = __shfl_xor(v, 1);
                if ((r32 & 1) == 0) *(unsigned*)(Ow + (size_t)orow * LDO + d0 * 32 + r32) = cvtpk(v, vn); } }
    __syncthreads();
}
#undef ROWP
#undef VMW
#undef LD8
#undef SLOAD_H
#undef SWRITE_HK
#undef SWRITE_HV
#undef SWRITE_H
#undef KSWZ
#undef SBAR
}

constexpr size_t MiB = 1u << 20;
constexpr size_t WS_CTL = 0, CTL_ZERO_BYTES = 1 * MiB;
constexpr size_t WS_ROPE128 = 1 * MiB;
constexpr size_t WS_ROPE64 = 5 * MiB + 256 * 1024;
constexpr size_t WS_WRT = 7 * MiB + 288 * 1024;
constexpr size_t WS_KI = 7 * MiB + 512 * 1024;
constexpr size_t WS_WI = 8 * MiB + 768 * 1024;
constexpr size_t WS_LOGF = 9 * MiB + 512 * 1024;
constexpr size_t WS_CC = 9 * MiB + 896 * 1024;
constexpr size_t WS_ROUTE = 10 * MiB + 256 * 1024;
constexpr size_t WS_ROWTOK = 7 * MiB + 512 * 1024;
constexpr size_t WS_ROWW = 8 * MiB;
constexpr size_t WS_CCT = 11 * MiB;
constexpr size_t WS_WAT = 12 * MiB, WS_WBT = 16 * MiB, WS_WOT = 20 * MiB, WS_WKVT = 28 * MiB;
constexpr size_t WS_PROJ = 30 * MiB;
constexpr size_t WS_KVA = 191 * MiB;
constexpr size_t WS_CKVN = 224 * MiB;
constexpr size_t WS_MASK = 224 * MiB;
constexpr size_t WS_R = 233 * MiB;
constexpr size_t WS_HN = WS_R, WS_WINT = WS_R + 33 * MiB, WS_SMALL = WS_R + 73 * MiB;
constexpr size_t WS_S = WS_R;
constexpr size_t WS_YA = WS_R, WS_YB = WS_R + 16 * MiB, WS_MERGED = WS_R + 32 * MiB, WS_M1 = WS_R + 64 * MiB;
constexpr size_t WS_H2 = 30 * MiB, WS_T = 94 * MiB, WS_ACT = 126 * MiB, WS_WDT = 190 * MiB;
constexpr size_t WS_WGUT = WS_R + 66 * MiB;
constexpr size_t WS_SQ2 = 222 * MiB;
constexpr size_t WS_TS = WS_R, WS_Y = WS_R;
constexpr size_t WS_NEED = WS_R + 134 * MiB;
static_assert(WS_PROJ + (size_t)LP * PW * 2 <= WS_KVA && WS_KVA + (size_t)LP * 2048 * 2 <= WS_CKVN && WS_CKVN + (size_t)LP * 512 * 2 <= WS_R, "ws map");
static_assert(WS_WDT + (size_t)NE * 2048 * 512 * 2 <= WS_MASK && WS_M1 + (size_t)SEQ * 2048 * 4 <= WS_NEED && WS_ACT + (size_t)TSROWS * 512 * 2 <= WS_WDT && WS_WGUT + (size_t)NE * 1024 * 2048 * 2 <= WS_NEED, "ws map 2");
constexpr size_t WS_SSQ = 11 * MiB + 288 * 1024;
constexpr int CW_CNT = 64;
constexpr int CW_KMAX = 2112;
constexpr int CW_BAR = 4096;

constexpr int RING_OFF = 0, RING_BYTES = 131072;
constexpr int LDSCTL_OFF = 155648, MISC_OFF = LDSCTL_OFF + 320;
constexpr int LDS_BYTES = 159744;

#define GAS __attribute__((address_space(1)))
#define LAS __attribute__((address_space(3)))
typedef unsigned short bf16;
typedef unsigned v4u __attribute__((ext_vector_type(4)));
typedef unsigned v2u __attribute__((ext_vector_type(2)));
typedef float f32x4 __attribute__((ext_vector_type(4)));
typedef float f32x2 __attribute__((ext_vector_type(2)));
typedef short bf16x8 __attribute__((ext_vector_type(8)));
typedef GAS unsigned gu32;
#define RLX_AGENT __ATOMIC_RELAXED, __HIP_MEMORY_SCOPE_AGENT
#define LDS_WAIT() asm volatile("s_waitcnt lgkmcnt(0)" ::: "memory")
#define VM_WAIT() asm volatile("s_waitcnt vmcnt(0)" ::: "memory")
__device__ __forceinline__ unsigned f2bf(float f) { unsigned u = __builtin_bit_cast(unsigned, f); return (u + 0x7fffu + ((u >> 16) & 1u)) >> 16; }
__device__ __forceinline__ unsigned pk2(float lo, float hi) { return f2bf(lo) | (f2bf(hi) << 16); }
__device__ __forceinline__ float bf2f(unsigned h) { return __builtin_bit_cast(float, h << 16); }
__device__ __forceinline__ float bflo(unsigned w) { return __builtin_bit_cast(float, w << 16); }
__device__ __forceinline__ float bfhi(unsigned w) { return __builtin_bit_cast(float, w & 0xffff0000u); }

#define XB_TMO      128
#define XB_XCNT(j)  (256  + 64 * (j))
#define XB_XSUB(j)  (1280 + 64 * (j))
#define XB_XGEN(j)  (2304 + 64 * (j))
#define XB_TOP      3328
#define XB_TOPGEN   3392
#define XCD_BAR_WORDS 3456
#define XB_SPIN_CAP (1u << 22)
__device__ __forceinline__ unsigned xb_ld(unsigned* p)              { return __hip_atomic_load(p, __ATOMIC_RELAXED, __HIP_MEMORY_SCOPE_AGENT); }
__device__ __forceinline__ unsigned xb_add(unsigned* p, unsigned v) { return __hip_atomic_fetch_add(p, v, __ATOMIC_RELAXED, __HIP_MEMORY_SCOPE_AGENT); }
__device__ __forceinline__ unsigned xb_xcc_id() { return (unsigned)__builtin_amdgcn_s_getreg((3 << 11) | 20) & 0xFu; }
#define XB_SPIN(cond, bar) do { unsigned _sp = 0; while (cond) { __builtin_amdgcn_s_sleep(1); \
    if ((++_sp & 255u) == 0u) { if (xb_ld(&(bar)[XB_TMO])) break; if (_sp > XB_SPIN_CAP) { atomicAdd(&(bar)[XB_TMO], 1u); break; } } } } while (0)
struct XcdBarrier { unsigned* bar; unsigned x; volatile LAS unsigned* st; };
__device__ __forceinline__ XcdBarrier xcd_barrier_post(unsigned* bar, volatile LAS unsigned* st) {
    XcdBarrier b; b.bar = bar; b.x = xb_xcc_id(); b.st = st;
    if (threadIdx.x == 0) (void)xb_add(&bar[XB_XCNT(b.x)], 1u);
    return b;
}
__device__ __forceinline__ void xcd_barrier_complete(unsigned* bar, unsigned x, unsigned& nloc, unsigned& nx) {
    const unsigned G = gridDim.x * gridDim.y * gridDim.z;
    unsigned sum, cnt, mine, sp = 0u;
    for (;;) {
        sum = 0u; cnt = 0u; mine = 0u;
#pragma unroll
        for (unsigned j = 0; j < 16; ++j) { const unsigned c = xb_ld(&bar[XB_XCNT(j)]); sum += c; cnt += (c > 0u) ? 1u : 0u; mine = (j == x) ? c : mine; }
        if (sum == G) break;
        __builtin_amdgcn_s_sleep(1);
        if ((++sp & 255u) == 0u) { if (xb_ld(&bar[XB_TMO])) break; if (sp > XB_SPIN_CAP) { atomicAdd(&bar[XB_TMO], 1u); break; } }
    }
    nloc = mine > 0u ? mine : 1u; nx = cnt > 0u ? cnt : 1u;
}
__device__ __forceinline__ void xcd_barrier(const XcdBarrier& b) {
    asm volatile("s_waitcnt vmcnt(0)" ::: "memory");
    __syncthreads();
    if (threadIdx.x == 0) {
        unsigned* bar = b.bar;
        __builtin_amdgcn_s_waitcnt(0);
        unsigned nloc = b.st[0], nx = b.st[1];
        if (nloc == 0u) { xcd_barrier_complete(bar, b.x, nloc, nx); b.st[0] = nloc; b.st[1] = nx; }
        const unsigned old = xb_add(&bar[XB_XSUB(b.x)], 1u);
        const unsigned gen = old / nloc;
        if (old + 1u == (gen + 1u) * nloc) {
            __builtin_amdgcn_fence(__ATOMIC_RELEASE, "agent");
            asm volatile("s_waitcnt vmcnt(0)" ::: "memory");
            const unsigned og = xb_add(&bar[XB_TOP], 1u);
            const unsigned tg = og / nx;
            if (og + 1u == (tg + 1u) * nx) xb_add(&bar[XB_TOPGEN], 1u);
            else XB_SPIN(xb_ld(&bar[XB_TOPGEN]) == tg, bar);
            __builtin_amdgcn_fence(__ATOMIC_ACQUIRE, "agent");
            xb_add(&bar[XB_XGEN(b.x)], 1u);
            asm volatile("s_waitcnt vmcnt(0)" ::: "memory");
        } else {
            XB_SPIN(xb_ld(&bar[XB_XGEN(b.x)]) == gen, bar);
            __builtin_amdgcn_fence(__ATOMIC_ACQUIRE, "agent");
            asm volatile("s_waitcnt vmcnt(0)" ::: "memory");
        }
    }
    __syncthreads();
}

struct Args { const float* in[20]; float* out; unsigned char* ws; int ph_lo, ph_hi, li, pad; };
enum { I_X = 0, I_META, I_GMIX, I_WIN, I_GKV, I_WKVUP, I_GIDXK, I_BF, I_WBA, I_WBB, I_WOUT, I_GFFN, I_WGROUP, I_BGROUP, I_WEXPERT, I_BEXPERT, I_WGATE, I_WUP, I_WDOWN, I_GFINAL };

__device__ __forceinline__ float wave_sum(float v) {
#pragma unroll
    for (int o = 1; o < 64; o <<= 1) v += __shfl_xor(v, o);
    return v;
}
__device__ __forceinline__ int wave_isum(int v) {
#pragma unroll
    for (int o = 1; o < 64; o <<= 1) v += __shfl_xor(v, o);
    return __builtin_amdgcn_readfirstlane(v);
}
__device__ __forceinline__ float wave_max(float v) {
#pragma unroll
    for (int o = 1; o < 64; o <<= 1) v = fmaxf(v, __shfl_xor(v, o));
    return v;
}

__device__ __forceinline__ void transpose_item(const float* colp, size_t ldsrc, bf16* WT, int ldwt, int k0, int n0, LAS float* scr, int lane, const float* rowscale = nullptr) {
    float v[32];
#pragma unroll
    for (int i = 0; i < 32; ++i) { const int kk = 2 * i + (lane >> 5); v[i] = colp ? colp[(size_t)(k0 + kk) * ldsrc] : 0.f; }
#pragma unroll
    for (int i = 0; i < 32; i += 8) asm volatile("" : "+v"(v[i]), "+v"(v[i + 1]), "+v"(v[i + 2]), "+v"(v[i + 3]), "+v"(v[i + 4]), "+v"(v[i + 5]), "+v"(v[i + 6]), "+v"(v[i + 7]));
#pragma unroll
    for (int i = 0; i < 32; ++i) { const int kk = 2 * i + (lane >> 5); scr[kk * 33 + (lane & 31)] = rowscale ? v[i] * rowscale[k0 + kk] : v[i]; }
    LDS_WAIT(); asm volatile("" ::: "memory");
    const int c = lane & 7;
#pragma unroll
    for (int j = 0; j < 4; ++j) { const int n = (lane >> 3) + 8 * j; const LAS float* s = scr + (8 * c) * 33 + n;
        v4u o; o.x = pk2(s[0 * 33], s[1 * 33]); o.y = pk2(s[2 * 33], s[3 * 33]); o.z = pk2(s[4 * 33], s[5 * 33]); o.w = pk2(s[6 * 33], s[7 * 33]);
        *(GAS v4u*)(WT + (size_t)(n0 + n) * ldwt + k0 + 8 * c) = o; }
    LDS_WAIT(); asm volatile("" ::: "memory");
}
__device__ __forceinline__ void tr_load(float (&v)[32], const float* colp, size_t ldsrc, int k0, int lane) {
#pragma unroll
    for (int i = 0; i < 32; ++i) { const int kk = 2 * i + (lane >> 5); v[i] = colp ? colp[(size_t)(k0 + kk) * ldsrc] : 0.f; }
}
__device__ __forceinline__ void tr_fence(float (&v)[32]) {
#pragma unroll
    for (int i = 0; i < 32; i += 8) asm volatile("" : "+v"(v[i]), "+v"(v[i + 1]), "+v"(v[i + 2]), "+v"(v[i + 3]), "+v"(v[i + 4]), "+v"(v[i + 5]), "+v"(v[i + 6]), "+v"(v[i + 7]));
}
__device__ __forceinline__ void tr_store(const float (&v)[32], bf16* WT, int ldwt, int k0, int n0, LAS float* scr, int lane, const float* rowscale = nullptr) {
#pragma unroll
    for (int i = 0; i < 32; ++i) { const int kk = 2 * i + (lane >> 5); scr[kk * 33 + (lane & 31)] = rowscale ? v[i] * rowscale[k0 + kk] : v[i]; }
    LDS_WAIT(); asm volatile("" ::: "memory");
    const int c = lane & 7;
#pragma unroll
    for (int j = 0; j < 4; ++j) { const int n = (lane >> 3) + 8 * j; const LAS float* s = scr + (8 * c) * 33 + n;
        v4u o; o.x = pk2(s[0 * 33], s[1 * 33]); o.y = pk2(s[2 * 33], s[3 * 33]); o.z = pk2(s[4 * 33], s[5 * 33]); o.w = pk2(s[6 * 33], s[7 * 33]);
        *(GAS v4u*)(WT + (size_t)(n0 + n) * ldwt + k0 + 8 * c) = o; }
    LDS_WAIT(); asm volatile("" ::: "memory");
}
__device__ __forceinline__ int rope_dim(int c, int half) { return (c & 1) ? half + (c >> 1) : (c >> 1); }
__device__ __forceinline__ int win_src(int n) {
    if (n < 1024) return (n & ~127) + rope_dim(n & 127, 64);
    if (n < PC_QI) return n;
    if (n < PC_KI) return PC_QI + ((n - PC_QI) & ~63) + rope_dim((n - PC_QI) & 63, 32);
    if (n < PC_FB) return n;
    if (n < PC_FB + 8) return 5712 + (n - PC_FB);
    if (n < PC_QB) return -1;
    if (n < PC_GA) return 2640 + (n - PC_QB);
    if (n < PC_END) return 5720 + (n - PC_GA);
    return -1;
}

using pg8::Unit;
typedef pg8::f32x4 (AccT)[2][2][4][2];
#define EPI_FOREACH(...) \
    _Pragma("unroll") for (int ai = 0; ai < 2; ++ai) _Pragma("unroll") for (int m = 0; m < 4; ++m) _Pragma("unroll") for (int bj = 0; bj < 2; ++bj) { \
        const int row = u.pm * 256 + ai * 128 + wr * 64 + m * 16 + fr; const int col = u.pn * 256 + bj * 128 + wc * 32 + 8 * fq; \
        const f32x4 v0 = acc[ai][bj][m][0], v1 = acc[ai][bj][m][1]; __VA_ARGS__ }

#define PACK8(v0, v1) (v4u){pg8::cvt_pk_bf16((v0)[0], (v0)[1]), pg8::cvt_pk_bf16((v0)[2], (v0)[3]), pg8::cvt_pk_bf16((v1)[0], (v1)[1]), pg8::cvt_pk_bf16((v1)[2], (v1)[3])}
__device__ __forceinline__ void rope8(f32x4& v0, f32x4& v1, const f32x4 cs0, const f32x4 cs1) {
    const f32x4 a = v0, b = v1;
    v0[0] = a[0] * cs0[0] - a[1] * cs0[1]; v0[1] = a[1] * cs0[0] + a[0] * cs0[1]; v0[2] = a[2] * cs0[2] - a[3] * cs0[3]; v0[3] = a[3] * cs0[2] + a[2] * cs0[3];
    v1[0] = b[0] * cs1[0] - b[1] * cs1[1]; v1[1] = b[1] * cs1[0] + b[0] * cs1[1]; v1[2] = b[2] * cs1[2] - b[3] * cs1[3]; v1[3] = b[3] * cs1[2] + b[2] * cs1[3];
}
struct EpiProj { static constexpr bool HAS_MID = false;
    bf16* P; float* SM; const float* R128; const float* R64; float* SSQ;
    __device__ __forceinline__ void operator()(const AccT& acc, const Unit& u, int wr, int wc, int fr, int fq) const {
        const int kind = u.pn < 4 ? 1 : (u.pn < 6 ? 2 : (u.pn < 10 ? 3 : (u.pn == 10 ? 4 : 0)));
#pragma unroll
        for (int ai = 0; ai < 2; ++ai)
#pragma unroll
            for (int mp = 0; mp < 2; ++mp) {
                f32x4 cs[2][2];
                if (kind == 1 || kind == 3) {
#pragma unroll
                    for (int mm = 0; mm < 2; ++mm) { const int pos = NMETA + u.pm * 256 + ai * 128 + wr * 64 + (2 * mp + mm) * 16 + fr;
                        const float* t = kind == 1 ? R128 + ((size_t)pos * 64 + 16 * wc + 4 * fq) * 2 : R64 + ((size_t)pos * 32 + 16 * (wc & 1) + 4 * fq) * 2;
                        cs[mm][0] = *(const f32x4*)t; cs[mm][1] = *(const f32x4*)(t + 4); }
                    asm volatile("" : "+v"(cs[0][0]), "+v"(cs[0][1]), "+v"(cs[1][0]), "+v"(cs[1][1]));
                }
#pragma unroll
                for (int mm = 0; mm < 2; ++mm)
#pragma unroll
                    for (int bj = 0; bj < 2; ++bj) { const int m = 2 * mp + mm;
                        const int row = NMETA + u.pm * 256 + ai * 128 + wr * 64 + m * 16 + fr; const int col = u.pn * 256 + bj * 128 + wc * 32 + 8 * fq;
                        f32x4 v0 = acc[ai][bj][m][0], v1 = acc[ai][bj][m][1];
                        if (kind == 1 || kind == 3) rope8(v0, v1, cs[mm][0], cs[mm][1]);
                        if (kind == 2) { float q = (v0[0] * v0[0] + v0[1] * v0[1]) + (v0[2] * v0[2] + v0[3] * v0[3]) + (v1[0] * v1[0] + v1[1] * v1[1]) + (v1[2] * v1[2] + v1[3] * v1[3]);
                            q += __shfl_xor(q, 16); q += __shfl_xor(q, 32); if (fq == 0) SSQ[(size_t)row * 16 + (u.pn - 4) * 8 + bj * 4 + wc] = q; }
                        if (kind == 4 && bj == 0) { float* sm = SM + (size_t)row * 128 + (col - 2560); *(f32x4*)sm = v0; *(f32x4*)(sm + 4) = v1; }
                        *(v4u*)(P + (size_t)row * PW + col) = PACK8(v0, v1);
                    }
            }
    }
};
struct EpiKvUp { static constexpr bool HAS_MID = false;
    bf16* O; const float* R128; const float* SSQ;
    __device__ __forceinline__ void operator()(const AccT& acc, const Unit& u, int wr, int wc, int fr, int fq) const {
        const bool isk = u.pn < 4;
#pragma unroll
        for (int ai = 0; ai < 2; ++ai)
#pragma unroll
            for (int mp = 0; mp < 2; ++mp) {
                f32x4 cs[2][2], sq[2][4];
#pragma unroll
                for (int mm = 0; mm < 2; ++mm) { const int pos = NMETA + u.pm * 256 + ai * 128 + wr * 64 + (2 * mp + mm) * 16 + fr;
                    const f32x4* sp = (const f32x4*)(SSQ + (size_t)pos * 16); sq[mm][0] = sp[0]; sq[mm][1] = sp[1]; sq[mm][2] = sp[2]; sq[mm][3] = sp[3];
                    if (isk) { const float* t = R128 + ((size_t)pos * 64 + 16 * wc + 4 * fq) * 2; cs[mm][0] = *(const f32x4*)t; cs[mm][1] = *(const f32x4*)(t + 4); } }
                asm volatile("" : "+v"(sq[0][0]), "+v"(sq[0][1]), "+v"(sq[0][2]), "+v"(sq[0][3]), "+v"(sq[1][0]), "+v"(sq[1][1]), "+v"(sq[1][2]), "+v"(sq[1][3]));
                if (isk) asm volatile("" : "+v"(cs[0][0]), "+v"(cs[0][1]), "+v"(cs[1][0]), "+v"(cs[1][1]));
#pragma unroll
                for (int mm = 0; mm < 2; ++mm) { const int m = 2 * mp + mm;
                    const f32x4 s0 = sq[mm][0], s1 = sq[mm][1], s2 = sq[mm][2], s3 = sq[mm][3];
                    const float ss = (((s0[0] + s0[1]) + (s0[2] + s0[3])) + ((s1[0] + s1[1]) + (s1[2] + s1[3]))) + (((s2[0] + s2[1]) + (s2[2] + s2[3])) + ((s3[0] + s3[1]) + (s3[2] + s3[3])));
                    const float rstd = 1.f / sqrtf(ss * (1.f / 512.f) + EPS);
#pragma unroll
                    for (int bj = 0; bj < 2; ++bj) {
                        const int row = NMETA + u.pm * 256 + ai * 128 + wr * 64 + m * 16 + fr; const int col = u.pn * 256 + bj * 128 + wc * 32 + 8 * fq;
                        f32x4 v0 = acc[ai][bj][m][0] * rstd, v1 = acc[ai][bj][m][1] * rstd;
                        if (isk) rope8(v0, v1, cs[mm][0], cs[mm][1]);
                        *(v4u*)(O + (size_t)row * 2048 + col) = PACK8(v0, v1);
                    } }
            }
    }
};
template <int UNR>
__device__ __forceinline__ void gemm16(const bf16* A, int lda, const bf16* Bt, int ldb, int K, int lane, f32x4 (&out)[4]) {
    const int fr = lane & 15, fq = lane >> 4;
    const bf16* ap = A + (size_t)fr * lda + 8 * fq; const bf16* bp = Bt + (size_t)fr * ldb + 8 * fq;
#pragma unroll
    for (int t = 0; t < 4; ++t) out[t] = (f32x4){0.f, 0.f, 0.f, 0.f};
#pragma unroll UNR
    for (int k0 = 0; k0 < K; k0 += 32) {
        const bf16x8 av = *(const bf16x8*)(ap + k0);
#pragma unroll
        for (int t = 0; t < 4; ++t) { const bf16x8 bv = *(const bf16x8*)(bp + (size_t)(16 * t) * ldb + k0); out[t] = __builtin_amdgcn_mfma_f32_16x16x32_bf16(av, bv, out[t], 0, 0, 0); }
    }
}
struct EpiBf16Plain { static constexpr bool HAS_MID = false;
    bf16* O; int ldc;
    __device__ __forceinline__ void operator()(const AccT& acc, const Unit& u, int wr, int wc, int fr, int fq) const {
        EPI_FOREACH({ v4u w; w.x = pg8::cvt_pk_bf16(v0[0], v0[1]); w.y = pg8::cvt_pk_bf16(v0[2], v0[3]); w.z = pg8::cvt_pk_bf16(v1[0], v1[1]); w.w = pg8::cvt_pk_bf16(v1[2], v1[3]);
            *(v4u*)(O + (size_t)row * ldc + col) = w; })
    }
};
__device__ __forceinline__ float sigmoidf_(float x) { return 1.f / (1.f + __expf(-x)); }
#define EPI_ROWCOL(ai, m, bj) const int row = u.pm * 256 + (ai) * 128 + wr * 64 + (m) * 16 + fr; const int col = u.pn * 256 + (bj) * 128 + wc * 32 + 8 * fq
struct EpiBranchA { static constexpr bool HAS_MID = false;
    const bf16* P; float* M1;
    __device__ __forceinline__ void operator()(const AccT& acc, const Unit& u, int wr, int wc, int fr, int fq) const {
#pragma unroll
        for (int ai = 0; ai < 2; ++ai) {
            v4u gw[4][2];
#pragma unroll
            for (int m = 0; m < 4; ++m)
#pragma unroll
                for (int bj = 0; bj < 2; ++bj) { EPI_ROWCOL(ai, m, bj); gw[m][bj] = *(const v4u*)(P + (size_t)(row + NMETA) * PW + PC_GA + col); }
#pragma unroll
            for (int m = 0; m < 4; ++m) asm volatile("" : "+v"(gw[m][0]), "+v"(gw[m][1]));
#pragma unroll
            for (int m = 0; m < 4; ++m)
#pragma unroll
                for (int bj = 0; bj < 2; ++bj) { EPI_ROWCOL(ai, m, bj); const v4u g = gw[m][bj]; const f32x4 v0 = acc[ai][bj][m][0], v1 = acc[ai][bj][m][1];
                    f32x4 o0, o1;
                    o0[0] = sigmoidf_(bflo(g.x)) * v0[0]; o0[1] = sigmoidf_(bfhi(g.x)) * v0[1]; o0[2] = sigmoidf_(bflo(g.y)) * v0[2]; o0[3] = sigmoidf_(bfhi(g.y)) * v0[3];
                    o1[0] = sigmoidf_(bflo(g.z)) * v1[0]; o1[1] = sigmoidf_(bfhi(g.z)) * v1[1]; o1[2] = sigmoidf_(bflo(g.w)) * v1[2]; o1[3] = sigmoidf_(bfhi(g.w)) * v1[3];
                    float* d = M1 + (size_t)row * 2048 + col; *(f32x4*)d = o0; *(f32x4*)(d + 4) = o1; }
        }
    }
};
struct EpiBranchB { static constexpr bool HAS_MID = false;
    const bf16* P; const float* M1; bf16* MG;
    __device__ __forceinline__ void operator()(const AccT& acc, const Unit& u, int wr, int wc, int fr, int fq) const {
#pragma unroll
        for (int ai = 0; ai < 2; ++ai)
#pragma unroll
            for (int mp = 0; mp < 2; ++mp) {
                v4u gw[2][2]; f32x4 a0[2][2], a1[2][2];
#pragma unroll
                for (int mm = 0; mm < 2; ++mm)
#pragma unroll
                    for (int bj = 0; bj < 2; ++bj) { EPI_ROWCOL(ai, 2 * mp + mm, bj); gw[mm][bj] = *(const v4u*)(P + (size_t)(row + NMETA) * PW + PC_GB + col);
                        const float* d = M1 + (size_t)row * 2048 + col; a0[mm][bj] = *(const f32x4*)d; a1[mm][bj] = *(const f32x4*)(d + 4); }
#pragma unroll
                for (int mm = 0; mm < 2; ++mm) asm volatile("" : "+v"(gw[mm][0]), "+v"(gw[mm][1]), "+v"(a0[mm][0]), "+v"(a0[mm][1]), "+v"(a1[mm][0]), "+v"(a1[mm][1]));
#pragma unroll
                for (int mm = 0; mm < 2; ++mm)
#pragma unroll
                    for (int bj = 0; bj < 2; ++bj) { EPI_ROWCOL(ai, 2 * mp + mm, bj); const v4u g = gw[mm][bj]; const f32x4 v0 = acc[ai][bj][2 * mp + mm][0], v1 = acc[ai][bj][2 * mp + mm][1];
                        const f32x4 b0 = a0[mm][bj], b1 = a1[mm][bj]; f32x4 o0, o1;
                        o0[0] = b0[0] + sigmoidf_(bflo(g.x)) * v0[0]; o0[1] = b0[1] + sigmoidf_(bfhi(g.x)) * v0[1]; o0[2] = b0[2] + sigmoidf_(bflo(g.y)) * v0[2]; o0[3] = b0[3] + sigmoidf_(bfhi(g.y)) * v0[3];
                        o1[0] = b1[0] + sigmoidf_(bflo(g.z)) * v1[0]; o1[1] = b1[1] + sigmoidf_(bfhi(g.z)) * v1[1]; o1[2] = b1[2] + sigmoidf_(bflo(g.w)) * v1[2]; o1[3] = b1[3] + sigmoidf_(bfhi(g.w)) * v1[3];
                        v4u w; w.x = pg8::cvt_pk_bf16(o0[0], o0[1]); w.y = pg8::cvt_pk_bf16(o0[2], o0[3]); w.z = pg8::cvt_pk_bf16(o1[0], o1[1]); w.w = pg8::cvt_pk_bf16(o1[2], o1[3]);
                        *(v4u*)(MG + (size_t)row * 2048 + col) = w; }
            }
    }
};
__device__ __forceinline__ float sig_ratio(float ga, float gbc) { return (1.f + __expf(-gbc)) / (1.f + __expf(-ga)); }
struct EpiBranchFused { static constexpr bool HAS_MID = true;
    const bf16* P; bf16* MG;
    __device__ __forceinline__ void mid(AccT& acc, const Unit& u, int wr, int wc, int fr_in, int fq) const {
        int fr = fr_in; asm volatile("" : "+v"(fr));
#pragma unroll
        for (int ai = 0; ai < 2; ++ai)
#pragma unroll
            for (int mp = 0; mp < 2; ++mp) {
                v4u ga[2][2], gb[2][2];
#pragma unroll
                for (int mm = 0; mm < 2; ++mm)
#pragma unroll
                    for (int bj = 0; bj < 2; ++bj) { EPI_ROWCOL(ai, 2 * mp + mm, bj); const bf16* gp = P + (size_t)(row + NMETA) * PW + col; ga[mm][bj] = *(const v4u*)(gp + PC_GA); gb[mm][bj] = *(const v4u*)(gp + PC_GB); }
#pragma unroll
                for (int mm = 0; mm < 2; ++mm) asm volatile("" : "+v"(ga[mm][0]), "+v"(ga[mm][1]), "+v"(gb[mm][0]), "+v"(gb[mm][1]));
#pragma unroll
                for (int mm = 0; mm < 2; ++mm)
#pragma unroll
                    for (int bj = 0; bj < 2; ++bj) { const int m = 2 * mp + mm; const v4u a = ga[mm][bj], b = gb[mm][bj];
                        acc[ai][bj][m][0][0] *= sig_ratio(bflo(a.x), fmaxf(bflo(b.x), -80.f)); acc[ai][bj][m][0][1] *= sig_ratio(bfhi(a.x), fmaxf(bfhi(b.x), -80.f));
                        acc[ai][bj][m][0][2] *= sig_ratio(bflo(a.y), fmaxf(bflo(b.y), -80.f)); acc[ai][bj][m][0][3] *= sig_ratio(bfhi(a.y), fmaxf(bfhi(b.y), -80.f));
                        acc[ai][bj][m][1][0] *= sig_ratio(bflo(a.z), fmaxf(bflo(b.z), -80.f)); acc[ai][bj][m][1][1] *= sig_ratio(bfhi(a.z), fmaxf(bfhi(b.z), -80.f));
                        acc[ai][bj][m][1][2] *= sig_ratio(bflo(a.w), fmaxf(bflo(b.w), -80.f)); acc[ai][bj][m][1][3] *= sig_ratio(bfhi(a.w), fmaxf(bfhi(b.w), -80.f)); }
            }
    }
    __device__ __forceinline__ void operator()(const AccT& acc, const Unit& u, int wr, int wc, int fr, int fq) const {
#pragma unroll
        for (int ai = 0; ai < 2; ++ai) {
            v4u gb[4][2];
#pragma unroll
            for (int m = 0; m < 4; ++m)
#pragma unroll
                for (int bj = 0; bj < 2; ++bj) { EPI_ROWCOL(ai, m, bj); gb[m][bj] = *(const v4u*)(P + (size_t)(row + NMETA) * PW + PC_GB + col); }
#pragma unroll
            for (int m = 0; m < 4; ++m) asm volatile("" : "+v"(gb[m][0]), "+v"(gb[m][1]));
#pragma unroll
            for (int m = 0; m < 4; ++m)
#pragma unroll
                for (int bj = 0; bj < 2; ++bj) { EPI_ROWCOL(ai, m, bj); const v4u g = gb[m][bj]; const f32x4 v0 = acc[ai][bj][m][0], v1 = acc[ai][bj][m][1]; f32x4 o0, o1;
                    o0[0] = sigmoidf_(fmaxf(bflo(g.x), -80.f)) * v0[0]; o0[1] = sigmoidf_(fmaxf(bfhi(g.x), -80.f)) * v0[1]; o0[2] = sigmoidf_(fmaxf(bflo(g.y), -80.f)) * v0[2]; o0[3] = sigmoidf_(fmaxf(bfhi(g.y), -80.f)) * v0[3];
                    o1[0] = sigmoidf_(fmaxf(bflo(g.z), -80.f)) * v1[0]; o1[1] = sigmoidf_(fmaxf(bfhi(g.z), -80.f)) * v1[1]; o1[2] = sigmoidf_(fmaxf(bflo(g.w), -80.f)) * v1[2]; o1[3] = sigmoidf_(fmaxf(bfhi(g.w), -80.f)) * v1[3];
                    *(v4u*)(MG + (size_t)row * 2048 + col) = PACK8(o0, o1); }
        }
    }
};
struct EpiOut { static constexpr bool HAS_MID = false;
    const float* X; float* H2; float* SQ;
    __device__ __forceinline__ void operator()(const AccT& acc, const Unit& u, int wr, int wc, int fr, int fq) const {
#pragma unroll
        for (int ai = 0; ai < 2; ++ai)
#pragma unroll
            for (int mp = 0; mp < 2; ++mp) {
                f32x4 a0[2][2], a1[2][2];
#pragma unroll
                for (int mm = 0; mm < 2; ++mm)
#pragma unroll
                    for (int bj = 0; bj < 2; ++bj) { EPI_ROWCOL(ai, 2 * mp + mm, bj); const float* xs = X + (size_t)row * 2048 + col; a0[mm][bj] = *(const f32x4*)xs; a1[mm][bj] = *(const f32x4*)(xs + 4); }
#pragma unroll
                for (int mm = 0; mm < 2; ++mm) asm volatile("" : "+v"(a0[mm][0]), "+v"(a0[mm][1]), "+v"(a1[mm][0]), "+v"(a1[mm][1]));
#pragma unroll
                for (int mm = 0; mm < 2; ++mm)
#pragma unroll
                    for (int bj = 0; bj < 2; ++bj) { EPI_ROWCOL(ai, 2 * mp + mm, bj); float* d = H2 + (size_t)row * 2048 + col;
                        const f32x4 h0 = a0[mm][bj] + acc[ai][bj][2 * mp + mm][0], h1 = a1[mm][bj] + acc[ai][bj][2 * mp + mm][1];
                        *(f32x4*)d = h0; *(f32x4*)(d + 4) = h1;
                        float q = ((h0[0] * h0[0] + h0[1] * h0[1]) + (h0[2] * h0[2] + h0[3] * h0[3])) + ((h1[0] * h1[0] + h1[1] * h1[1]) + (h1[2] * h1[2] + h1[3] * h1[3]));
                        q += __shfl_xor(q, 16); q += __shfl_xor(q, 32); if (fq == 0) SQ[(size_t)row * 64 + u.pn * 8 + bj * 4 + wc] = q; }
            }
    }
};
struct EpiGateUp { static constexpr bool HAS_MID = false;
    bf16* ACT; const float* ROWW;
    __device__ __forceinline__ void operator()(const AccT& acc, const Unit& u, int wr, int wc, int fr, int fq) const {
        float rwv[2][4];
#pragma unroll
        for (int ai = 0; ai < 2; ++ai)
#pragma unroll
            for (int m = 0; m < 4; ++m) rwv[ai][m] = ROWW[u.rb + ai * 128 + wr * 64 + m * 16 + fr];
        asm volatile("" : "+v"(rwv[0][0]), "+v"(rwv[0][1]), "+v"(rwv[0][2]), "+v"(rwv[0][3]), "+v"(rwv[1][0]), "+v"(rwv[1][1]), "+v"(rwv[1][2]), "+v"(rwv[1][3]));
#pragma unroll
        for (int ai = 0; ai < 2; ++ai)
#pragma unroll
            for (int m = 0; m < 4; ++m) {
                const int row = u.pm * 256 + ai * 128 + wr * 64 + m * 16 + fr; const int col = u.pn * 128 + wc * 32 + 8 * fq;
                const float rw = rwv[ai][m];
                float o[8];
#pragma unroll
                for (int n = 0; n < 2; ++n)
#pragma unroll
                    for (int j = 0; j < 4; ++j) { const float gv = acc[ai][0][m][n][j], uv = acc[ai][1][m][n][j]; o[n * 4 + j] = gv * sigmoidf_(gv) * uv * rw; }
                v4u w; w.x = pg8::cvt_pk_bf16(o[0], o[1]); w.y = pg8::cvt_pk_bf16(o[2], o[3]); w.z = pg8::cvt_pk_bf16(o[4], o[5]); w.w = pg8::cvt_pk_bf16(o[6], o[7]);
                *(v4u*)(ACT + (size_t)row * 512 + col) = w;
            }
    }
};
struct EpiDown { static constexpr bool HAS_MID = false;
    bf16* Y; const int* ROWTOK;
    __device__ __forceinline__ void operator()(const AccT& acc, const Unit& u, int wr, int wc, int fr, int fq) const {
        int rtv[2][4];
#pragma unroll
        for (int ai = 0; ai < 2; ++ai)
#pragma unroll
            for (int m = 0; m < 4; ++m) rtv[ai][m] = ROWTOK[u.rb + ai * 128 + wr * 64 + m * 16 + fr];
        asm volatile("" : "+v"(rtv[0][0]), "+v"(rtv[0][1]), "+v"(rtv[0][2]), "+v"(rtv[0][3]), "+v"(rtv[1][0]), "+v"(rtv[1][1]), "+v"(rtv[1][2]), "+v"(rtv[1][3]));
#pragma unroll
        for (int ai = 0; ai < 2; ++ai)
#pragma unroll
            for (int m = 0; m < 4; ++m) {
                const int rt = rtv[ai][m];
                if (rt >= 0) { bf16* d = Y + ((size_t)(rt & 1) * SEQ + (rt >> 1)) * 2048 + u.pn * 256 + wc * 32 + 8 * fq;
#pragma unroll
                    for (int bj = 0; bj < 2; ++bj) { const f32x4 v0 = acc[ai][bj][m][0], v1 = acc[ai][bj][m][1];
                        v4u w; w.x = pg8::cvt_pk_bf16(v0[0], v0[1]); w.y = pg8::cvt_pk_bf16(v0[2], v0[3]); w.z = pg8::cvt_pk_bf16(v1[0], v1[1]); w.w = pg8::cvt_pk_bf16(v1[2], v1[3]);
                        *(v4u*)(d + bj * 128) = w; } }
            }
    }
};

__device__ __forceinline__ size_t s_row_off(int qr) { const int b = qr >> 8; const size_t pitch = 320 + 256 * b; return (size_t)256 * (320 * (size_t)b + 128 * (size_t)b * (b - 1)) + (size_t)(qr & 255) * pitch; }
__device__ __forceinline__ unsigned f2key(float f) { const unsigned u = __builtin_bit_cast(unsigned, f); return u ^ ((u >> 31) ? 0xFFFFFFFFu : 0x80000000u); }

constexpr int PC_I_IN = 32 * (PW / 32), PC_I_KV = 8 * 64, PC_I_A = 16 * 64, PC_I_O = 32 * 64, PC_NITEMS = PC_I_IN + PC_I_KV + 2 * PC_I_A + PC_I_O;
__device__ __forceinline__ void copy_items(const Args& a, LAS unsigned char* lds, int it_lo, int it_hi, int gw, int NGW, int wave, int lane) {
    unsigned char* ws = a.ws;
    LAS float* scr = (LAS float*)(lds + RING_OFF + wave * 16384);
    constexpr int I_IN = PC_I_IN, I_KV = PC_I_KV, I_A = PC_I_A;
    auto item = [&](int it, const float*& src, size_t& ldsrc, bf16*& dst, int& ldwt, int& k0, int& n0, const float*& rsc) {
        int r = it; rsc = nullptr;
        if (r < I_IN) { const int nblk = PW / 32, kb = r / nblk, nb = r % nblk; const int sc = win_src(nb * 32 + (lane & 31));
            src = sc >= 0 ? a.in[I_WIN] + sc : nullptr; ldsrc = INW; dst = (bf16*)(ws + WS_WINT); ldwt = 2048; k0 = 64 * kb; n0 = 32 * nb; return; } r -= I_IN;
        if (r < I_KV) { const int kb = r / 64, nb = r % 64; const int n = nb * 32 + (lane & 31); const int sc = n < 1024 ? (n & ~127) + rope_dim(n & 127, 64) : n;
            src = a.in[I_WKVUP] + sc; ldsrc = 2048; dst = (bf16*)(ws + WS_WKVT); ldwt = 512; k0 = 64 * kb; n0 = 32 * nb; rsc = a.in[I_GKV]; return; } r -= I_KV;
        if (r < I_A) { const int kb = r / 64, nb = r % 64; src = a.in[I_WBA] + nb * 32 + (lane & 31); ldsrc = 2048; dst = (bf16*)(ws + WS_WAT); ldwt = 2048; k0 = 64 * kb; n0 = 32 * nb; return; } r -= I_A;
        if (r < I_A) { const int kb = r / 64, nb = r % 64; src = a.in[I_WBB] + nb * 32 + (lane & 31); ldsrc = 2048; dst = (bf16*)(ws + WS_WAT) + 1024; ldwt = 2048; k0 = 64 * kb; n0 = 32 * nb; return; } r -= I_A;
        { const int kb = r / 64, nb = r % 64; src = a.in[I_WOUT] + nb * 32 + (lane & 31); ldsrc = 2048; dst = (bf16*)(ws + WS_WOT); ldwt = 2048; k0 = 64 * kb; n0 = 32 * nb; }
    };
#pragma unroll 1
    for (int it = it_lo + gw; it < it_hi; it += 2 * NGW) {
        const float* s0; size_t l0; bf16* d0; int w0, k0, n0; const float* r0; item(it, s0, l0, d0, w0, k0, n0, r0);
        const bool two = it + NGW < it_hi;
        const float* s1; size_t l1; bf16* d1; int w1, k1, n1; const float* r1; item(two ? it + NGW : it, s1, l1, d1, w1, k1, n1, r1);
        float va[32], vb[32];
        tr_load(va, s0, l0, k0, lane); tr_load(vb, s1, l1, k1, lane);
        tr_fence(va); tr_fence(vb);
        tr_store(va, d0, w0, k0, n0, scr, lane, r0);
        if (two) tr_store(vb, d1, w1, k1, n1, scr, lane, r1);
    }
}
__device__ __forceinline__ void phase_prologue(const Args& a, LAS unsigned char* lds, int gw, int NGW, int wave, int lane, int it_hi) {
    unsigned char* ws = a.ws;
    copy_items(a, lds, 0, it_hi, gw, NGW, wave, lane);
    const f32x4* gm = (const f32x4*)a.in[I_GMIX];
    for (int p = gw; p < LP; p += NGW) {
        bf16* orow = (bf16*)(ws + WS_HN) + (size_t)p * 2048;
        if (p >= LTOK) { for (int j = 0; j < 8; ++j) *(v2u*)(orow + 4 * (lane + 64 * j)) = (v2u){0u, 0u}; continue; }
        const float* xrow = p < NMETA ? a.in[I_META] + (size_t)p * 2048 : a.in[I_X] + (size_t)(p - NMETA) * 2048;
        f32x4 v[8]; float s = 0.f;
#pragma unroll
        for (int j = 0; j < 8; ++j) { v[j] = ((const f32x4*)xrow)[lane + 64 * j]; s += (v[j][0] * v[j][0] + v[j][1] * v[j][1]) + (v[j][2] * v[j][2] + v[j][3] * v[j][3]); }
        const float rstd = 1.f / sqrtf(wave_sum(s) * (1.f / 2048.f) + EPS);
#pragma unroll
        for (int j = 0; j < 8; ++j) { const f32x4 g = gm[lane + 64 * j]; v2u o; o.x = pk2(v[j][0] * rstd * g[0], v[j][1] * rstd * g[1]); o.y = pk2(v[j][2] * rstd * g[2], v[j][3] * rstd * g[3]);
            *(v2u*)(orow + 4 * (lane + 64 * j)) = o; }
    }
    const int gt = gw * 64 + lane, NGT = NGW * 64;
    for (int i = gt; i < LTOK * 64; i += NGT) { const int p = i >> 6, f = i & 63; const double inv = exp(-9.210340371976184 * (double)f / 64.0); const double ang = (double)p * inv;
        double sn, cs; sincos(ang, &sn, &cs); ((f32x2*)(ws + WS_ROPE128))[i] = (f32x2){(float)cs, (float)sn}; }
    for (int i = gt; i < LTOK * 32; i += NGT) { const int p = i >> 5, f = i & 31; const double inv = exp(-9.210340371976184 * (double)f / 32.0); const double ang = (double)p * inv;
        double sn, cs; sincos(ang, &sn, &cs); ((f32x2*)(ws + WS_ROPE64))[i] = (f32x2){(float)cs, (float)sn}; }
}

__device__ __forceinline__ void phase_minipost(const Args& a, volatile LAS unsigned* lmax  , int gw, int NGW, int lane) {
    unsigned char* ws = a.ws;
    const float* SM = (const float*)(ws + WS_SMALL); const f32x2* R64 = (const f32x2*)(ws + WS_ROPE64);
    if (threadIdx.x < 8) lmax[threadIdx.x] = 0u;
    __syncthreads();
    float kmx = 0.f;
    for (int p = gw; p < LP; p += NGW) {
        if (p < LTOK) { const v4u* kr = (const v4u*)((const bf16*)(ws + WS_PROJ) + (size_t)p * PW + PC_KB + 16 * lane); const v4u k0 = kr[0], k1 = kr[1];
            float q = bflo(k0.x) * bflo(k0.x) + bfhi(k0.x) * bfhi(k0.x) + bflo(k0.y) * bflo(k0.y) + bfhi(k0.y) * bfhi(k0.y) + bflo(k0.z) * bflo(k0.z) + bfhi(k0.z) * bfhi(k0.z) + bflo(k0.w) * bflo(k0.w) + bfhi(k0.w) * bfhi(k0.w)
                    + bflo(k1.x) * bflo(k1.x) + bfhi(k1.x) * bfhi(k1.x) + bflo(k1.y) * bflo(k1.y) + bfhi(k1.y) * bfhi(k1.y) + bflo(k1.z) * bflo(k1.z) + bfhi(k1.z) * bfhi(k1.z) + bflo(k1.w) * bflo(k1.w) + bfhi(k1.w) * bfhi(k1.w);
            q += __shfl_xor(q, 1); q += __shfl_xor(q, 2); q += __shfl_xor(q, 4); kmx = fmaxf(kmx, q); }
        bf16* ki = (bf16*)(ws + WS_KI) + (size_t)p * 64;
        if (p >= LTOK) { if (lane < 8) *(v4u*)(ki + 8 * lane) = (v4u){0u, 0u, 0u, 0u};
            if (lane < 16) ((float*)(ws + WS_WI))[(size_t)p * 16 + lane] = 0.f; if (lane < 8) ((float*)(ws + WS_LOGF))[(size_t)lane * LP + p] = 0.f;
            if (p < LTOK + 64) { v4u* kv = (v4u*)((bf16*)(ws + WS_PROJ) + (size_t)p * PW + PC_KB); v4u* ka = (v4u*)((bf16*)(ws + WS_KVA) + (size_t)p * 2048);
#pragma unroll
                for (int j = 0; j < 4; ++j) { kv[lane + 64 * j] = (v4u){0u, 0u, 0u, 0u}; ka[lane + 64 * j] = (v4u){0u, 0u, 0u, 0u}; } }
            continue; }
        { const float v = SM[(size_t)p * 128 + lane]; const float rstd = 1.f / sqrtf(wave_sum(v * v) * (1.f / 64.f) + EPS);
          const float n = v * rstd * a.in[I_GIDXK][lane]; const float pr = __shfl_xor(n, 32); const f32x2 c2 = R64[(size_t)p * 32 + (lane & 31)];
          const float y = lane < 32 ? n * c2[0] - pr * c2[1] : n * c2[0] + pr * c2[1];
          ki[lane < 32 ? 2 * lane : 2 * (lane - 32) + 1] = (bf16)f2bf(y); }
        if (lane < 16) ((float*)(ws + WS_WI))[(size_t)p * 16 + lane] = SM[(size_t)p * 128 + 64 + lane] * (0.25f * 0.125f);
        if (lane < 8) { const float z = SM[(size_t)p * 128 + 80 + lane] + a.in[I_BF][lane]; ((float*)(ws + WS_LOGF))[(size_t)lane * LP + p] = fminf(z, 0.f) - log1pf(expf(-fabsf(z))); }
    }
    if ((lane & 7) == 0) __hip_atomic_fetch_max((LAS unsigned*)lmax + (lane >> 3), __float_as_uint(kmx), __ATOMIC_RELAXED, __HIP_MEMORY_SCOPE_WORKGROUP);
    __syncthreads();
    if (threadIdx.x < 8) __hip_atomic_fetch_max((unsigned*)(ws + WS_CTL) + CW_KMAX + threadIdx.x, lmax[threadIdx.x], RLX_AGENT);
}
__device__ __forceinline__ void meta_inproj(const Args& a, int mw, int NGW, int lane) {
    unsigned char* ws = a.ws; const int fr = lane & 15, fq = lane >> 4;
    bf16* PROJ = (bf16*)(ws + WS_PROJ); float* SM = (float*)(ws + WS_SMALL); float* SSQ = (float*)(ws + WS_SSQ);
    for (int it = mw; it < 42; it += NGW) {
        const int n0 = it < 8 ? PC_CKV + 64 * it : (it < 10 ? PC_KI + 64 * (it - 8) : PC_KB + 64 * (it - 10));
        f32x4 o[4]; gemm16<8>((const bf16*)(ws + WS_HN), 2048, (const bf16*)(ws + WS_WINT) + (size_t)n0 * 2048, 2048, 2048, lane, o);
#pragma unroll
        for (int r = 0; r < 4; ++r) { const int m = 4 * fq + r; float q = 0.f;
#pragma unroll
            for (int t = 0; t < 4; ++t) { const int n = n0 + 16 * t + fr; const float v = o[t][r]; PROJ[(size_t)m * PW + n] = (bf16)f2bf(v); q += v * v;
                if (it >= 8 && it < 10) SM[(size_t)m * 128 + (n - PC_KI)] = v; }
            if (it < 8) { q += __shfl_xor(q, 1); q += __shfl_xor(q, 2); q += __shfl_xor(q, 4); q += __shfl_xor(q, 8); if (fr == 0) { SSQ[(size_t)m * 16 + 2 * it] = q; SSQ[(size_t)m * 16 + 2 * it + 1] = 0.f; } } }
    }
}
__device__ __forceinline__ void meta_kvup(const Args& a, int gw, int NGW, int lane) {
    unsigned char* ws = a.ws; const int fr = lane & 15, fq = lane >> 4;
    const float* SSQ = (const float*)(ws + WS_SSQ); const f32x2* R128 = (const f32x2*)(ws + WS_ROPE128); bf16* KVA = (bf16*)(ws + WS_KVA);
    for (int it = gw; it < 32; it += NGW) {
        const int n0 = 64 * it;
        f32x4 o[4]; gemm16<16>((const bf16*)(ws + WS_PROJ) + PC_CKV, PW, (const bf16*)(ws + WS_WKVT) + (size_t)n0 * 512, 512, 512, lane, o);
#pragma unroll
        for (int r = 0; r < 4; ++r) { const int m = 4 * fq + r; float sq = 0.f;
#pragma unroll
            for (int i = 0; i < 16; ++i) sq += SSQ[(size_t)m * 16 + i];
            const float rstd = 1.f / sqrtf(sq * (1.f / 512.f) + EPS);
#pragma unroll
            for (int t = 0; t < 4; ++t) { const int n = n0 + 16 * t + fr; float v = o[t][r] * rstd;
                if (n0 < 1024) { const float pr = __shfl_xor(v, 1); const int cl = n & 127; const f32x2 cs = R128[(size_t)m * 64 + (cl >> 1)]; v = (cl & 1) ? v * cs[0] + pr * cs[1] : v * cs[0] - pr * cs[1]; }
                KVA[(size_t)m * 2048 + n] = (bf16)f2bf(v); } }
    }
}
__device__ __forceinline__ void phase_cumsum(const Args& a, int wave, int lane) {
    unsigned char* ws = a.ws;
    const f32x4* LF = (const f32x4*)((const float*)(ws + WS_LOGF) + (size_t)wave * LP) + lane * 33;
    f32x4* CT = (f32x4*)((float*)(ws + WS_CCT) + (size_t)wave * LP) + lane * 33;
    f32x4 v[33]; float s = 0.f;
#pragma unroll
    for (int i = 0; i < 33; ++i) { v[i] = LF[i]; }
#pragma unroll
    for (int i = 0; i < 33; ++i) { s += (v[i][0] + v[i][1]) + (v[i][2] + v[i][3]); }
    float inc = s;
#pragma unroll
    for (int o = 1; o < 64; o <<= 1) { const float t = __shfl_up(inc, o); if (lane >= o) inc += t; }
    float run = inc - s;
#pragma unroll
    for (int i = 0; i < 33; ++i) { f32x4 o; run += v[i][0]; o[0] = run; run += v[i][1]; o[1] = run; run += v[i][2]; o[2] = run; run += v[i][3]; o[3] = run; CT[i] = o; }
}

__device__ __forceinline__ void phase_indexer(const Args& a, LAS unsigned char* lds, int gw, int NGW, int wave, int lane) {
    unsigned char* ws = a.ws;
    const bf16* PROJ = (const bf16*)(ws + WS_PROJ); const bf16* KI = (const bf16*)(ws + WS_KI); const float* WI = (const float*)(ws + WS_WI); float* S = (float*)(ws + WS_S);
    LAS float* qs = (LAS float*)(lds + wave * 8192);
    for (int qr = gw; qr < SEQ; qr += NGW) {
        const int pos = qr + NMETA;
        { const bf16* qrow = PROJ + (size_t)pos * PW + PC_QI + 16 * lane; const v4u w0 = *(const v4u*)qrow, w1 = *(const v4u*)(qrow + 8);
          LAS float* d = qs + 16 * lane;
          d[0] = bflo(w0.x); d[1] = bfhi(w0.x); d[2] = bflo(w0.y); d[3] = bfhi(w0.y); d[4] = bflo(w0.z); d[5] = bfhi(w0.z); d[6] = bflo(w0.w); d[7] = bfhi(w0.w);
          d[8] = bflo(w1.x); d[9] = bfhi(w1.x); d[10] = bflo(w1.y); d[11] = bfhi(w1.y); d[12] = bflo(w1.z); d[13] = bfhi(w1.z); d[14] = bflo(w1.w); d[15] = bfhi(w1.w);
          if (lane < 16) qs[1024 + lane] = WI[(size_t)pos * 16 + lane]; }
        LDS_WAIT(); asm volatile("" ::: "memory");
        float* Srow = S + s_row_off(qr);
        const int ntile = pos / 64 + 1;
        for (int j = 0; j < ntile; ++j) {
            const int key = j * 64 + lane;
            float kf[64];
            { const v4u* kp = (const v4u*)(KI + (size_t)key * 64);
#pragma unroll
              for (int c = 0; c < 8; ++c) { const v4u w = kp[c]; kf[8 * c] = bflo(w.x); kf[8 * c + 1] = bfhi(w.x); kf[8 * c + 2] = bflo(w.y); kf[8 * c + 3] = bfhi(w.y);
                  kf[8 * c + 4] = bflo(w.z); kf[8 * c + 5] = bfhi(w.z); kf[8 * c + 6] = bflo(w.w); kf[8 * c + 7] = bfhi(w.w); } }
            float score = 0.f;
#pragma unroll 1
            for (int h = 0; h < 16; ++h) { float d = 0.f;
#pragma unroll
                for (int c = 0; c < 16; ++c) { const f32x4 q = *(const LAS f32x4*)(qs + h * 64 + 4 * c); d += q[0] * kf[4 * c] + q[1] * kf[4 * c + 1] + q[2] * kf[4 * c + 2] + q[3] * kf[4 * c + 3]; }
                score += qs[1024 + h] * fmaxf(d, 0.f); }
            if (key <= pos) Srow[key] = score;
        }
        LDS_WAIT(); asm volatile("" ::: "memory");
    }
}


__device__ __forceinline__ void phase_indexer_mfma(const Args& a, LAS unsigned char* lds, int vcu, int G) {
    typedef float f32x16 __attribute__((ext_vector_type(16)));
    unsigned char* ws = a.ws;
    const bf16* PROJ = (const bf16*)(ws + WS_PROJ); const bf16* KI = (const bf16*)(ws + WS_KI); const float* WI = (const float*)(ws + WS_WI); float* S = (float*)(ws + WS_S);
    const int tid = threadIdx.x, wid = __builtin_amdgcn_readfirstlane(tid >> 6), lane = tid & 63, r32 = lane & 31, hi = lane >> 5;
    const int keyrow = 16 * ((r32 >> 2) & 1) + 4 * (r32 >> 3) + (r32 & 3);
    for (int sub = 0; sub < 2; ++sub)
    for (int it = vcu; it < 256; it += G) {
        const int qt = sub == 0 ? it : 255 - it;
        const int q0 = qt * 32, pos0 = q0 + NMETA, nkt = (pos0 + 31) / 32 + 1;
        const int klo = sub == 0 ? 0 : nkt / 2, khi = sub == 0 ? nkt / 2 : nkt;
        __syncthreads();
#pragma unroll
        for (int i = 0; i < 8; ++i) { const int c = tid + 512 * i, row = c >> 7, ch = c & 127;
            const v4u v = *(const v4u*)(PROJ + (size_t)(pos0 + row) * PW + PC_QI + ch * 8);
            *(LAS v4u*)(lds + (ch >> 1) * 1024 + (row + 32 * (ch & 1)) * 16) = v; }
        float w[16];
        { const f32x4* wp = (const f32x4*)(WI + (size_t)(pos0 + r32) * 16);
#pragma unroll
          for (int i = 0; i < 4; ++i) { const f32x4 t = wp[i]; w[4 * i] = t[0]; w[4 * i + 1] = t[1]; w[4 * i + 2] = t[2]; w[4 * i + 3] = t[3]; } }
        __syncthreads();
        float* Srow = S + s_row_off(q0 + r32) + 16 * hi;
        bf16x8 afn[4];
        { const int kt0 = klo + wid < khi ? klo + wid : 0;
#pragma unroll
          for (int ks = 0; ks < 4; ++ks) afn[ks] = *(const bf16x8*)(KI + (size_t)(kt0 * 32 + keyrow) * 64 + ks * 16 + 8 * hi); }
        for (int kt = klo + wid; kt < khi; kt += 8) {
            const int kb = kt * 32;
            bf16x8 af[4];
#pragma unroll
            for (int ks = 0; ks < 4; ++ks) af[ks] = afn[ks];
            { const int ktn = kt + 8 < khi ? kt + 8 : kt;
#pragma unroll
              for (int ks = 0; ks < 4; ++ks) afn[ks] = *(const bf16x8*)(KI + (size_t)(ktn * 32 + keyrow) * 64 + ks * 16 + 8 * hi); }
            f32x16 acc = {};
            bf16x8 bq[2][4]; f32x16 d[2];
            unsigned qoff = lane * 16; asm volatile("" : "+v"(qoff));
            const LAS unsigned char* qk = lds + qoff;
#pragma unroll
            for (int ks = 0; ks < 4; ++ks) bq[0][ks] = *(const LAS bf16x8*)(qk + ks * 1024);
#pragma unroll
            for (int h = 0; h < 17; ++h) {
                __builtin_amdgcn_sched_barrier(0);
                if (h < 16) { d[h & 1] = f32x16{};
#pragma unroll
                    for (int ks = 0; ks < 4; ++ks) d[h & 1] = __builtin_amdgcn_mfma_f32_32x32x16_bf16(af[ks], bq[h & 1][ks], d[h & 1], 0, 0, 0); }
                if (h < 15) {
#pragma unroll
                    for (int ks = 0; ks < 4; ++ks) bq[(h + 1) & 1][ks] = *(const LAS bf16x8*)(qk + ((h + 1) * 4 + ks) * 1024); }
                if (h > 0) {
#pragma unroll
                    for (int r = 0; r < 16; ++r) { const float dv = d[(h - 1) & 1][r]; const int xi = __float_as_int(dv); const float rl = __int_as_float(xi > 0 ? xi : 0);
                        float ar = acc[r]; asm("v_fmac_f32 %0, %1, %2" : "+v"(ar) : "v"(rl), "v"(w[h - 1])); acc[r] = ar; } }
            }
            __builtin_amdgcn_sched_barrier(0);
#pragma unroll
            for (int g = 0; g < 4; ++g) { const float x0 = acc[4 * g], x1 = acc[4 * g + 1], x2 = acc[4 * g + 2], x3 = acc[4 * g + 3]; *(v4u*)(Srow + kb + 4 * g) = (v4u){f2key(x0), f2key(x1), f2key(x2), f2key(x3)}; }
        }
    }
}

__device__ __forceinline__ int wave_incl_scan(int x) {
    x += __builtin_amdgcn_update_dpp(0, x, 0x111, 0xf, 0xf, false);
    x += __builtin_amdgcn_update_dpp(0, x, 0x112, 0xf, 0xf, false);
    x += __builtin_amdgcn_update_dpp(0, x, 0x114, 0xf, 0xf, false);
    x += __builtin_amdgcn_update_dpp(0, x, 0x118, 0xf, 0xf, false);
    x += __builtin_amdgcn_update_dpp(0, x, 0x142, 0xa, 0xf, false);
    x += __builtin_amdgcn_update_dpp(0, x, 0x143, 0xc, 0xf, false);
    return x;
}
#define SEL_CNT6(OP, c0, c1, c2, k0, k1, k2, k3, k4, k5, cand) do { unsigned long long m1_, m2_, m3_, m4_, m5_; \
    asm volatile(OP " vcc, %8, %9\n\t" OP " %3, %8, %10\n\t" OP " %4, %8, %11\n\t" OP " %5, %8, %12\n\t" OP " %6, %8, %13\n\t" OP " %7, %8, %14\n\t" \
                 "v_addc_co_u32 %0, vcc, 0, %0, vcc\n\tv_addc_co_u32 %1, %3, 0, %1, %3\n\tv_addc_co_u32 %2, %4, 0, %2, %4\n\t" \
                 "v_addc_co_u32 %0, %5, 0, %0, %5\n\tv_addc_co_u32 %1, %6, 0, %1, %6\n\tv_addc_co_u32 %2, %7, 0, %2, %7" \
                 : "+v"(c0), "+v"(c1), "+v"(c2), "=&s"(m1_), "=&s"(m2_), "=&s"(m3_), "=&s"(m4_), "=&s"(m5_) \
                 : "s"(cand), "v"(k0), "v"(k1), "v"(k2), "v"(k3), "v"(k4), "v"(k5) : "vcc"); } while (0)
__device__ __forceinline__ int sel_wave_total(int c) {
    int t = 0;
#pragma unroll
    for (int b = 0; b < 8; ++b) t += __popcll(__ballot((c >> b) & 1)) << b;
    return t;
}
__device__ __forceinline__ int sel_count_ge(const unsigned (&key)[NTILE64], unsigned cand, int nreg) {
    int c0 = 0, c1 = 0, c2 = 0;
#define SEL_G(g) SEL_CNT6("v_cmp_le_u32", c0, c1, c2, key[6 * (g)], key[6 * (g) + 1], key[6 * (g) + 2], key[6 * (g) + 3], key[6 * (g) + 4], key[6 * (g) + 5], cand)
#pragma unroll
    for (int g = 0; g < 6; ++g) SEL_G(g);
    if (nreg > 36) {
#pragma unroll
        for (int g = 6; g < 11; ++g) SEL_G(g);
        if (nreg > 66) {
#pragma unroll
            for (int g = 11; g < 16; ++g) SEL_G(g);
            if (nreg > 96) {
#pragma unroll
                for (int g = 16; g < 21; ++g) SEL_G(g);
                { unsigned z = 0u; SEL_CNT6("v_cmp_le_u32", c0, c1, c2, key[126], key[127], key[128], z, z, z, cand); }
            }
        }
    }
#undef SEL_G
    return sel_wave_total(c0 + c1 + c2);
}
__device__ __forceinline__ void sel_hist(const unsigned (&key)[NTILE64], int nreg, LAS unsigned* hist, unsigned prefix, int shift) {
#define SEL_H(j) do { const unsigned k = key[j]; const unsigned addr = (k >> shift) & 0xffu; \
        const unsigned inc = (((k ^ prefix) >> shift) >> 8) == 0u ? 1u : 0u; \
        __hip_atomic_fetch_add(hist + addr, inc, __ATOMIC_RELAXED, __HIP_MEMORY_SCOPE_WORKGROUP); } while (0)
#pragma unroll
    for (int j = 0; j < 36; ++j) SEL_H(j);
    if (nreg > 36) {
#pragma unroll
        for (int j = 36; j < 66; ++j) SEL_H(j);
        if (nreg > 66) {
#pragma unroll
            for (int j = 66; j < 96; ++j) SEL_H(j);
            if (nreg > 96) {
#pragma unroll
                for (int j = 96; j < NTILE64; ++j) SEL_H(j);
            }
        }
    }
#undef SEL_H
}
__device__ __forceinline__ void phase_select(const Args& a, LAS unsigned char* lds, int gw, int NGW, int wave, int lane) {
    unsigned char* ws = a.ws;
    const unsigned* S = (const unsigned*)(ws + WS_S); unsigned long long* MASK = (unsigned long long*)(ws + WS_MASK);
    LAS unsigned* hist = (LAS unsigned*)(lds + wave * 1024);
    for (int kq = 0; kq * NGW < SEQ; ++kq) {
        const int qr = kq * NGW + ((kq & 1) ? NGW - 1 - gw : gw);
        if (qr >= SEQ) continue;
        const int pos = qr + NMETA, n = pos + 1, nreg = __builtin_amdgcn_readfirstlane((n + 63) >> 6);
        const __amdgpu_buffer_rsrc_t rs = __builtin_amdgcn_make_buffer_rsrc((void*)(S + s_row_off(qr)), 0, n * 4, 0x00020000);
        unsigned key[NTILE64];
#define SEL_LD(j) key[j] = __builtin_amdgcn_raw_buffer_load_b32(rs, lane * 4, (j) * 256, 0)
#pragma unroll
        for (int j = 0; j < 36; ++j) SEL_LD(j);
        if (nreg > 36) {
#pragma unroll
            for (int j = 36; j < 66; ++j) SEL_LD(j);
            if (nreg > 66) {
#pragma unroll
                for (int j = 66; j < 96; ++j) SEL_LD(j);
                if (nreg > 96) {
#pragma unroll
                    for (int j = 96; j < NTILE64; ++j) SEL_LD(j);
                }
            }
        }
#undef SEL_LD
        unsigned T = 1u; int need = 0; bool ge_only = true;
        if (n > TOPK) {
            unsigned mx = 0u;
#pragma unroll
            for (int j = 0; j < 36; ++j) mx = key[j] > mx ? key[j] : mx;
            if (nreg > 36) {
#pragma unroll
                for (int j = 36; j < 66; ++j) mx = key[j] > mx ? key[j] : mx;
                if (nreg > 66) {
#pragma unroll
                    for (int j = 66; j < 96; ++j) mx = key[j] > mx ? key[j] : mx;
                    if (nreg > 96) {
#pragma unroll
                        for (int j = 96; j < NTILE64; ++j) mx = key[j] > mx ? key[j] : mx;
                    }
                }
            }
#pragma unroll
            for (int o = 1; o < 64; o <<= 1) { const unsigned t = (unsigned)__shfl_xor((int)mx, o); mx = t > mx ? t : mx; }
            int lo = (int)__builtin_amdgcn_readfirstlane((int)(mx >> 24)), hi = lo + 1, cge = 0, cabove = 0;
            for (int step = 1;; step *= 2) { const int c = sel_count_ge(key, (unsigned)lo << 24, nreg); if (c >= TOPK || lo == 0) { cge = c; break; } hi = lo; cabove = c; lo = lo - step > 0 ? lo - step : 0; }
            while (hi - lo > 1) { const int mid = (lo + hi) >> 1; const int c = sel_count_ge(key, (unsigned)mid << 24, nreg); if (c >= TOPK) { lo = mid; cge = c; } else { hi = mid; cabove = c; } }
            unsigned prefix = (unsigned)lo << 24;
            if (cge != TOPK) {
                for (int b = 23; b >= 0; --b) { const unsigned cand = prefix | (1u << b); const int c = sel_count_ge(key, cand, nreg); if (c >= TOPK) { prefix = cand; cge = c; if (c == TOPK) break; } }
            }
            T = prefix; ge_only = (cge == TOPK);
            if (!ge_only) need = TOPK - sel_count_ge(key, T + 1u, nreg);
        }
        unsigned w0l = 0u, w0h = 0u, w1l = 0u, w1h = 0u, w2l = 0u, w2h = 0u;
#define EM_WL2(dlo, dhi, vlo, vhi, l) asm volatile("s_nop 4\n\tv_writelane_b32 %0, %2, %4\n\tv_writelane_b32 %1, %3, %4" : "+v"(dlo), "+v"(dhi) : "s"(vlo), "s"(vhi), "n"(l))
#define EM_PUT(j, w) do { const unsigned lo_ = (unsigned)(w), hi_ = (unsigned)((w) >> 32); \
        if ((j) < 64) EM_WL2(w0l, w0h, lo_, hi_, (j)); else if ((j) < 128) EM_WL2(w1l, w1h, lo_, hi_, (j) - 64); else EM_WL2(w2l, w2h, lo_, hi_, (j) - 128); } while (0)
#define EM_GE(j) do { const unsigned long long w_ = __ballot(key[j] >= T); EM_PUT(j, w_); } while (0)
#define EM_TIE(j) do { unsigned long long w_ = __ballot(key[j] > T); \
        if (need > 0) { unsigned long long eq = __ballot(key[j] == T); int c = __popcll(eq); \
            while (c > need) { eq &= ~(1ull << (63 - __builtin_clzll(eq))); --c; } \
            w_ |= eq; need -= c; } \
        EM_PUT(j, w_); } while (0)
#define EM_TIERS(EM) do { _Pragma("unroll") for (int j = 0; j < 36; ++j) EM(j); \
        if (nreg > 36) { _Pragma("unroll") for (int j = 36; j < 66; ++j) EM(j); \
            if (nreg > 66) { _Pragma("unroll") for (int j = 66; j < 96; ++j) EM(j); \
                if (nreg > 96) { _Pragma("unroll") for (int j = 96; j < NTILE64; ++j) EM(j); } } } } while (0)
        if (ge_only) EM_TIERS(EM_GE); else EM_TIERS(EM_TIE);
#undef EM_TIERS
#undef EM_TIE
#undef EM_GE
#undef EM_PUT
#undef EM_WL2
        const unsigned long long w0 = ((unsigned long long)w0h << 32) | w0l, w1 = ((unsigned long long)w1h << 32) | w1l, w2 = ((unsigned long long)w2h << 32) | w2l;
        MASK[(size_t)lane * SEQ + qr] = w0; MASK[(size_t)(64 + lane) * SEQ + qr] = w1; if (lane == 0) MASK[(size_t)128 * SEQ + qr] = w2;
    }
}
#undef SEL_CNT6

template <bool DSAMODE>
__device__ __forceinline__ void attn_naive(const Args& a, LAS unsigned char* lds, int gw, int NGW, int wave, int lane) {
    unsigned char* ws = a.ws;
    const bf16* PROJ = (const bf16*)(ws + WS_PROJ); const bf16* KVA = (const bf16*)(ws + WS_KVA);
    const bf16* Q = DSAMODE ? PROJ + PC_QA : PROJ + PC_QB; const int ldq = PW;
    const bf16* Kp = DSAMODE ? KVA : PROJ + PC_KB; const int ldk = DSAMODE ? 2048 : PW;
    const bf16* Vp = DSAMODE ? KVA + 1024 : PROJ + PC_VB; const int ldv = DSAMODE ? 2048 : PW;
    bf16* O = (bf16*)(ws + (DSAMODE ? WS_YA : WS_YB));
    const unsigned long long* MASK = (const unsigned long long*)(ws + WS_MASK); const float* CC = (const float*)(ws + WS_CC);
    LAS float* qs = (LAS float*)(lds + wave * 1024);
    for (int item = gw; item < SEQ * NH; item += NGW) {
        const int qr = item >> 3, h = item & 7, pos = qr + NMETA;
        { const unsigned w = *(const unsigned*)(Q + (size_t)pos * ldq + h * 128 + 2 * lane); qs[2 * lane] = bflo(w) * (ATT_SCALE * LOG2E); qs[2 * lane + 1] = bfhi(w) * (ATT_SCALE * LOG2E); }
        LDS_WAIT(); asm volatile("" ::: "memory");
        const float cq = DSAMODE ? 0.f : CC[(size_t)pos * 8 + h];
        float m = -1e30f, l = 0.f, o0 = 0.f, o1 = 0.f;
        const int ntile = pos / 64 + 1;
        for (int j = 0; j < ntile; ++j) {
            const int key = j * 64 + lane; bool valid = key <= pos;
            if (DSAMODE) { const unsigned long long w = MASK[(size_t)j * SEQ + qr]; if (w == 0ull) continue; valid = valid && ((w >> lane) & 1ull); }
            float s = -__builtin_inff();
            if (valid) { const v4u* kp = (const v4u*)(Kp + (size_t)key * ldk + h * 128); float d = 0.f;
#pragma unroll
                for (int c = 0; c < 16; ++c) { const v4u w = kp[c]; const f32x4 q0 = *(const LAS f32x4*)(qs + 8 * c), q1 = *(const LAS f32x4*)(qs + 8 * c + 4);
                    d += q0[0] * bflo(w.x) + q0[1] * bfhi(w.x) + q0[2] * bflo(w.y) + q0[3] * bfhi(w.y) + q1[0] * bflo(w.z) + q1[1] * bfhi(w.z) + q1[2] * bflo(w.w) + q1[3] * bfhi(w.w); }
                s = d; if (!DSAMODE) s += (cq - CC[(size_t)key * 8 + h]) * LOG2E; }
            const float tmax = wave_max(s); const float mn = fmaxf(m, tmax); const float alpha = __builtin_amdgcn_exp2f(m - mn);
            const float p = valid ? __builtin_amdgcn_exp2f(s - mn) : 0.f;
            l = l * alpha + wave_sum(p); o0 *= alpha; o1 *= alpha; m = mn;
            unsigned long long pm = __ballot(p > 0.f);
            while (pm) { const int sl = __builtin_ctzll(pm); pm &= pm - 1; const float ps = __shfl(p, sl);
                const unsigned vv = *(const unsigned*)(Vp + (size_t)(j * 64 + sl) * ldv + h * 128 + 2 * lane); o0 += ps * bflo(vv); o1 += ps * bfhi(vv); }
        }
        const float rl = 1.f / l;
        *(unsigned*)(O + (size_t)qr * 1024 + h * 128 + 2 * lane) = pk2(o0 * rl, o1 * rl);
        LDS_WAIT(); asm volatile("" ::: "memory");
    }
}


constexpr int MOE_GU_ITEMS = NE * 32 * 32, MOE_D_ITEMS = NE * 8 * 64;
template <bool DOWN>
__device__ __forceinline__ void moe_item(const Args& a, int i, int lane, const float*& src, size_t& ldsrc, bf16*& dst, int& ldwt, int& k0, int& n0) {
    unsigned char* ws = a.ws;
    if (!DOWN) { const int e = i >> 10, r = i & 1023; const int kb = r / 32, nb = r % 32; const int n = nb * 32 + (lane & 31); const int pn = n >> 8, half = (n >> 7) & 1, j = n & 127;
        src = (half ? a.in[I_WUP] : a.in[I_WGATE]) + (size_t)e * 2048 * 512 + 128 * pn + j; ldsrc = 512; dst = (bf16*)(ws + WS_WGUT) + (size_t)e * 1024 * 2048; ldwt = 2048; k0 = 64 * kb; n0 = 32 * nb; }
    else { const int e = i >> 9, r = i & 511; const int kb = r / 64, nb = r % 64;
        src = a.in[I_WDOWN] + (size_t)e * 512 * 2048 + nb * 32 + (lane & 31); ldsrc = 2048; dst = (bf16*)(ws + WS_WDT) + (size_t)e * 2048 * 512; ldwt = 512; k0 = 64 * kb; n0 = 32 * nb; }
}
template <bool DOWN>
__device__ __forceinline__ void moe_copy_pair(const Args& a, LAS float* scr, int i0, int i1  , int lane) {
    const float* s0; size_t l0; bf16* d0; int w0, k0, n0; moe_item<DOWN>(a, i0, lane, s0, l0, d0, w0, k0, n0);
    const bool two = i1 >= 0;
    const float* s1; size_t l1; bf16* d1; int w1, k1, n1; moe_item<DOWN>(a, two ? i1 : i0, lane, s1, l1, d1, w1, k1, n1);
    float va[32], vb[32];
    tr_load(va, s0, l0, k0, lane); tr_load(vb, s1, l1, k1, lane);
    tr_fence(va); tr_fence(vb);
    tr_store(va, d0, w0, k0, n0, scr, lane);
    if (two) tr_store(vb, d1, w1, k1, n1, scr, lane);
}

constexpr size_t WS_PART = WS_R + 32 * MiB;
constexpr int CW_AQ = 2048;
constexpr int N_DSA_ENT = 48, N_ATT_ITEMS = N_DSA_ENT * 8 + 256;
constexpr int N_COPY_POPS = MOE_GU_ITEMS / 64;
__device__ const unsigned char DSA_ENT[N_DSA_ENT] = {125, 60, 126, 121, 122, 117, 56, 118, 113, 114, 109, 52, 110, 105, 106, 101, 48, 102, 97, 98, 93, 44, 94, 89, 90, 85, 40, 86, 81, 82, 77, 36, 78, 73, 74, 69, 32, 70, 65, 66, 28, 24, 20, 16, 12, 8, 4, 0};
template <int MODE>
__device__ __forceinline__ void attn_item(unsigned char* ws, char* lds, int h, int b, int kind) {
    constexpr int LDKV = MODE ? 2048 : PW;
    att::ItemRef r; r.P0 = NMETA + 256 * b;
    const bf16* PROJ = (const bf16*)(ws + WS_PROJ); const bf16* KVA = (const bf16*)(ws + WS_KVA);
    r.Q = PROJ + (size_t)r.P0 * PW + (MODE ? PC_QA : PC_QB) + h * 128;
    r.K = MODE ? KVA + h * 128 : PROJ + PC_KB + h * 128;
    r.V = MODE ? KVA + 1024 + h * 128 : PROJ + PC_VB + h * 128;
    r.O = (bf16*)(ws + WS_YA) + (size_t)(256 * b) * 2048 + (MODE ? 0 : 1024) + h * 128;
    r.cb = (const float*)(ws + WS_CCT) + (size_t)h * LP; r.cref = MODE ? 0.f : r.cb[r.P0];
    r.mk = (const unsigned long long*)(ws + WS_MASK) + 256 * b;
    const int NT = 4 * b + 5, half = (NT + 1) / 2;
    r.t_lo = kind == 2 ? half : 0; r.t_hi = kind == 1 ? half : NT;
    r.kn2 = MODE ? 0.f : __uint_as_float(((const unsigned*)(ws + WS_CTL))[CW_KMAX + h]);
    r.part = kind ? (float*)(ws + WS_PART) + (size_t)(((h * 16 + (b - 16)) * 2) + (kind - 1)) * att::PART_FLOATS : nullptr;
    att::run_item<MODE, PW, LDKV, 2048>(r, lds);
}
__device__ __forceinline__ void phase_attn(const Args& a, char* lds, volatile LAS int* qslot) {
    unsigned* qh = (unsigned*)(a.ws + WS_CTL) + CW_AQ;
    for (;;) {
        if (threadIdx.x == 0) qslot[0] = (int)__hip_atomic_fetch_add(qh, 1u, RLX_AGENT);
        __syncthreads();
        const int it = qslot[0];
        __syncthreads();
        if (it >= N_ATT_ITEMS + N_COPY_POPS) break;
        int ai = it - N_COPY_POPS;
        if (it < 3 * N_COPY_POPS) {
            if (it % 3 == 2) {
                int tid_ = threadIdx.x; asm volatile("" : "+v"(tid_)); const int lane = tid_ & 63, wave = __builtin_amdgcn_readfirstlane(tid_ >> 6);
                LAS float* scr = (LAS float*)((LAS char*)lds + wave * 16384);
                const int c = it / 3;
#pragma unroll 1
                for (int k = 0; k < 8; k += 2) moe_copy_pair<false>(a, scr, c * 64 + wave + 8 * k, c * 64 + wave + 8 * (k + 1), lane);
                continue;
            }
            ai = (it / 3) * 2 + it % 3;
        }
        if (ai < N_DSA_ENT * 8) { const int e = DSA_ENT[ai >> 3]; attn_item<1>(a.ws, lds, ai & 7, e >> 2, e & 3); }
        else { const int j = ai - N_DSA_ENT * 8; attn_item<0>(a.ws, lds, j & 7, 31 - (j >> 3), 0); }
    }
}
__device__ __forceinline__ void phase_attn_combine(const Args& a, char* lds, int vcu, int G) {
    for (int sl = vcu; sl < 128; sl += G) { const int h = sl >> 4, b = 16 + (sl & 15);
        const float* p1 = (const float*)(a.ws + WS_PART) + (size_t)(sl * 2) * att::PART_FLOATS;
        att::combine_item<2048>(p1, p1 + att::PART_FLOATS, (bf16*)(a.ws + WS_YA) + (size_t)(256 * b) * 2048 + h * 128, lds); }
}

__device__ __forceinline__ float wave_total_f(float v) {
    v += __builtin_bit_cast(float, __builtin_amdgcn_update_dpp(0, __builtin_bit_cast(int, v), 0x111, 0xf, 0xf, false));
    v += __builtin_bit_cast(float, __builtin_amdgcn_update_dpp(0, __builtin_bit_cast(int, v), 0x112, 0xf, 0xf, false));
    v += __builtin_bit_cast(float, __builtin_amdgcn_update_dpp(0, __builtin_bit_cast(int, v), 0x114, 0xf, 0xf, false));
    v += __builtin_bit_cast(float, __builtin_amdgcn_update_dpp(0, __builtin_bit_cast(int, v), 0x118, 0xf, 0xf, false));
    v += __builtin_bit_cast(float, __builtin_amdgcn_update_dpp(0, __builtin_bit_cast(int, v), 0x142, 0xa, 0xf, false));
    v += __builtin_bit_cast(float, __builtin_amdgcn_update_dpp(0, __builtin_bit_cast(int, v), 0x143, 0xc, 0xf, false));
    return __builtin_bit_cast(float, __builtin_amdgcn_readlane(__builtin_bit_cast(int, v), 63));
}
__device__ __forceinline__ void phase_route(const Args& a, volatile LAS int* lcnt  , int gw, int NGW, int lane) {
    unsigned char* ws = a.ws;
    const float* H2 = (const float*)(ws + WS_H2); bf16* T = (bf16*)(ws + WS_T); unsigned* cnt = (unsigned*)(ws + WS_CTL) + CW_CNT;
    const f32x4* gf = (const f32x4*)a.in[I_GFFN]; const __amdgpu_buffer_rsrc_t wrs = __builtin_amdgcn_make_buffer_rsrc((void*)(ws + WS_WRT), 0, 20 * 2048 * 4, 0x00020000);
    const int ngroups = (SEQ + 4 * NGW - 1) / (4 * NGW);
    for (int grp = 0; grp < ngroups; ++grp) {
        const int t0 = gw + grp * 4 * NGW;
        int tok[4]; float rstd[4]; bool live[4];
#pragma unroll
        for (int q = 0; q < 4; ++q) { tok[q] = t0 + q * NGW; live[q] = tok[q] < SEQ; if (!live[q]) tok[q] = 0; }
        if (threadIdx.x < 16) lcnt[threadIdx.x] = 0;
        __syncthreads();
        { float sv[4];
#pragma unroll
          for (int q = 0; q < 4; ++q) sv[q] = ((const float*)(ws + WS_SQ2))[(size_t)tok[q] * 64 + lane];
#pragma unroll
          for (int q = 0; q < 4; ++q) rstd[q] = 1.f / sqrtf(wave_total_f(sv[q]) * (1.f / 2048.f) + EPS); }
        float lg[4][20];
#pragma unroll
        for (int q = 0; q < 4; ++q)
#pragma unroll
            for (int i = 0; i < 20; ++i) lg[q][i] = 0.f;
#pragma unroll 1
        for (int j = 0; j < 8; ++j) {
            int ln = lane + 64 * j; asm volatile("" : "+v"(ln));
            f32x4 hv[4], wt[20]; const f32x4 g = gf[ln];
#pragma unroll
            for (int q = 0; q < 4; ++q) hv[q] = ((const f32x4*)(H2 + (size_t)tok[q] * 2048))[ln];
#pragma unroll
            for (int e = 0; e < 20; ++e) wt[e] = __builtin_bit_cast(f32x4, __builtin_amdgcn_raw_buffer_load_b128(wrs, ln * 16, e * 8192, 0));
            asm volatile("" : "+v"(hv[0]), "+v"(hv[1]), "+v"(hv[2]), "+v"(hv[3]));
#pragma unroll
            for (int e = 0; e < 20; e += 5) asm volatile("" : "+v"(wt[e]), "+v"(wt[e + 1]), "+v"(wt[e + 2]), "+v"(wt[e + 3]), "+v"(wt[e + 4]));
            f32x4 t[4];
#pragma unroll
            for (int q = 0; q < 4; ++q) {
                t[q][0] = hv[q][0] * rstd[q] * g[0]; t[q][1] = hv[q][1] * rstd[q] * g[1]; t[q][2] = hv[q][2] * rstd[q] * g[2]; t[q][3] = hv[q][3] * rstd[q] * g[3];
                v2u o; o.x = pk2(t[q][0], t[q][1]); o.y = pk2(t[q][2], t[q][3]); if (live[q]) *(v2u*)(T + (size_t)tok[q] * 2048 + 4 * ln) = o; }
#pragma unroll
            for (int c = 0; c < 4; ++c)
#pragma unroll
                for (int q = 0; q < 4; ++q)
#pragma unroll
                    for (int e = 0; e < 20; ++e) lg[q][e] += t[q][c] * wt[e][c]; }
        int e0v[4], e1v[4], s0v[4], s1v[4]; float w0v[4], w1v[4];
#pragma unroll
        for (int q = 0; q < 4; ++q) {
            float l20[20];
#pragma unroll
            for (int i = 0; i < 20; ++i) l20[i] = wave_total_f(lg[q][i]);
            float gl[4];
#pragma unroll
            for (int i = 0; i < 4; ++i) gl[i] = l20[i] + a.in[I_BGROUP][i];
            int gs = 0; float gmx = gl[0];
#pragma unroll
            for (int i = 1; i < 4; ++i) if (gl[i] > gmx) { gmx = gl[i]; gs = i; }
            float den = 0.f;
#pragma unroll
            for (int i = 0; i < 4; ++i) den += expf(gl[i] - gmx);
            const float pg = 1.f / den;
            float el[4];
#pragma unroll
            for (int i = 0; i < 4; ++i) { el[i] = 0.f;
#pragma unroll
                for (int g = 0; g < 4; ++g) if (gs == g) el[i] = l20[4 + 4 * g + i] + a.in[I_BEXPERT][4 * g + i]; }
            int i0 = 0; float m0 = el[0];
#pragma unroll
            for (int i = 1; i < 4; ++i) if (el[i] > m0) { m0 = el[i]; i0 = i; }
            int i1 = -1; float m1 = -__builtin_inff();
#pragma unroll
            for (int i = 0; i < 4; ++i) if (i != i0 && el[i] > m1) { m1 = el[i]; i1 = i; }
            const float ex = expf(m1 - m0); const float p0 = 1.f / (1.f + ex), p1 = ex / (1.f + ex);
            e0v[q] = gs * 4 + i0; e1v[q] = gs * 4 + i1; w0v[q] = pg * p0; w1v[q] = pg * p1; s0v[q] = 0; s1v[q] = 0;
            if (lane == 0 && live[q]) { s0v[q] = __hip_atomic_fetch_add((LAS int*)lcnt + e0v[q], 1, __ATOMIC_RELAXED, __HIP_MEMORY_SCOPE_WORKGROUP);
                                        s1v[q] = __hip_atomic_fetch_add((LAS int*)lcnt + e1v[q], 1, __ATOMIC_RELAXED, __HIP_MEMORY_SCOPE_WORKGROUP); }
        }
        __syncthreads();
        if (threadIdx.x < 16) { const int c = lcnt[threadIdx.x]; lcnt[16 + threadIdx.x] = c ? (int)__hip_atomic_fetch_add(cnt + 64 * threadIdx.x, (unsigned)c, RLX_AGENT) : 0; }
        __syncthreads();
        if (lane == 0) {
#pragma unroll
            for (int q = 0; q < 4; ++q) if (live[q]) { int* RT = (int*)(ws + WS_ROWTOK); float* RW = (float*)(ws + WS_ROWW);
                const int i0 = e0v[q] * 8192 + lcnt[16 + e0v[q]] + s0v[q], i1 = e1v[q] * 8192 + lcnt[16 + e1v[q]] + s1v[q];
                RT[i0] = tok[q] * 2; RW[i0] = w0v[q]; RT[i1] = tok[q] * 2 + 1; RW[i1] = w1v[q]; }
        }
        __syncthreads();
    }
}
__device__ __forceinline__ void moe_tile_bases(const Args& a, volatile LAS int* tb) {
    if (threadIdx.x == 0) { const unsigned* cnt = (const unsigned*)(a.ws + WS_CTL) + CW_CNT; int acc = 0;
        for (int e = 0; e < 16; ++e) { tb[e] = acc; acc += (int)((__hip_atomic_load(cnt + 64 * e, RLX_AGENT) + 255u) >> 8); } tb[16] = acc; }
    __syncthreads();
}
__device__ __forceinline__ void phase_final(const Args& a, int gw, int NGW, int lane) {
    unsigned char* ws = a.ws;
    const float* H2 = (const float*)(ws + WS_H2); const bf16* Y = (const bf16*)(ws + WS_Y); const f32x4* gf = (const f32x4*)a.in[I_GFINAL];
    for (int tok = gw; tok < SEQ; tok += NGW) {
        const f32x4* hr = (const f32x4*)(H2 + (size_t)tok * 2048); const v2u* y0 = (const v2u*)(Y + (size_t)tok * 2048); const v2u* y1 = (const v2u*)(Y + ((size_t)SEQ + tok) * 2048);
        f32x4 v[8]; float s = 0.f;
#pragma unroll
        for (int j = 0; j < 8; ++j) { const f32x4 hv = hr[lane + 64 * j]; const v2u a0 = y0[lane + 64 * j], a1 = y1[lane + 64 * j];
            v[j][0] = hv[0] + bflo(a0.x) + bflo(a1.x); v[j][1] = hv[1] + bfhi(a0.x) + bfhi(a1.x); v[j][2] = hv[2] + bflo(a0.y) + bflo(a1.y); v[j][3] = hv[3] + bfhi(a0.y) + bfhi(a1.y);
            s += (v[j][0] * v[j][0] + v[j][1] * v[j][1]) + (v[j][2] * v[j][2] + v[j][3] * v[j][3]); }
        const float rstd = 1.f / sqrtf(wave_sum(s) * (1.f / 2048.f) + EPS);
        f32x4* orow = (f32x4*)(a.out + (size_t)tok * 2048);
        float pscale = 1.f;
        if (PROBE_TS_A >= 0) { const unsigned long long* tsp = (const unsigned long long*)(a.ws + WS_CTL + 65536); const float tq = floorf((float)(tsp[PROBE_TS_B] - tsp[PROBE_TS_A]) * (0.01f / 16.f) + 0.5f) * 16.f; pscale = 1.f + tq / PROBE_TS_SCALE_US; }
        const float rs2 = rstd * pscale;
#pragma unroll
        for (int j = 0; j < 8; ++j) { const f32x4 g = gf[lane + 64 * j]; orow[lane + 64 * j] = (f32x4){v[j][0] * rs2 * g[0], v[j][1] * rs2 * g[1], v[j][2] * rs2 * g[2], v[j][3] * rs2 * g[3]}; }
    }
}

__global__ void __launch_bounds__(NWAVES * 64, 2) mk_fwd(Args args) {
    extern __shared__ __attribute__((aligned(16))) unsigned char lds_raw[];
    LAS unsigned char* lds = (LAS unsigned char*)lds_raw;
    volatile LAS unsigned* MISC = (volatile LAS unsigned*)(lds + MISC_OFF);
    volatile LAS int* TB = (volatile LAS int*)(lds + MISC_OFF + 64);
    const int tid = threadIdx.x;
    const int G = gridDim.x; const int bx = blockIdx.x; const int vcu = (G % 8 == 0) ? (bx % 8) * (G / 8) + bx / 8 : bx;
    const int NGW = G * NWAVES;
#define TIDS() int tid_ = threadIdx.x; asm volatile("" : "+v"(tid_)); const int lane = tid_ & 63, wave = __builtin_amdgcn_readfirstlane(tid_ >> 6), gw = vcu * NWAVES + wave; (void)lane; (void)gw;
    unsigned char* ws = args.ws;
    gu32* ctl = (gu32*)(ws + WS_CTL);
    for (int u = tid; u < (LDS_BYTES - LDSCTL_OFF) / 4; u += NWAVES * 64) ((LAS unsigned*)(lds + LDSCTL_OFF))[u] = 0u;
    __syncthreads();
    XcdBarrier bar; bar.bar = (unsigned*)(ctl + CW_BAR); bar.x = 0; bar.st = nullptr;
    if (MK_ONE_LAUNCH) bar = xcd_barrier_post((unsigned*)(ctl + CW_BAR), MISC + 8);
    const int lo = args.ph_lo, hi = args.ph_hi;
#ifndef PHASE_MASK
#define PHASE_MASK 0x3fff
#endif

#define REP(k) for (int rep_ = 0; rep_ < ((PROBE_DOUBLE == (k)) ? 2 : 1); ++rep_)
#define IN(k) (((PHASE_MASK >> (k)) & 1) && lo <= (k) && (k) < hi)
#define SEAM(k) do { if (IN(k) && IN((k) + 1)) xcd_barrier(bar); } while (0)

    const int nfull = ((SEQ / 256) * (PW / 256)) % G; const bool late_copies = nfull > 0 && G - nfull >= 16; const int cb0 = late_copies ? nfull + 6 : 0;
    TS(0); if (IN(0)) REP(0) { TIDS(); phase_prologue(args, lds, gw, NGW, wave, lane, late_copies ? PC_I_IN : PC_NITEMS); } SEAM(0);
    TS(1); if (IN(1)) REP(1) {
        pg8::Gemm g{(const bf16*)(ws + WS_HN) + (size_t)NMETA * 2048, (const bf16*)(ws + WS_WINT), 2048, 2048, 2048, nullptr}; pg8::StaticOrder S; S.init(SEQ / 256, PW / 256, G, bx);
        EpiProj E{(bf16*)(ws + WS_PROJ), (float*)(ws + WS_SMALL), (const float*)(ws + WS_ROPE128), (const float*)(ws + WS_ROPE64), (float*)(ws + WS_SSQ)};
        pg8::gemm_phase(lds + RING_OFF, g, S, E);
        { TIDS(); meta_inproj(args, ((bx + 32) % G) * NWAVES + wave, NGW, lane);
          if (late_copies && bx >= cb0) { __syncthreads(); copy_items(args, lds, PC_I_IN, PC_NITEMS, (bx - cb0) * NWAVES + wave, (G - cb0) * NWAVES, wave, lane); } }
    } SEAM(1);
    TS(2); if (IN(2)) REP(2) {
        { TIDS(); phase_minipost(args, (volatile LAS unsigned*)(lds + MISC_OFF + 640), gw, NGW, lane); }
        pg8::Gemm g{(const bf16*)(ws + WS_PROJ) + (size_t)NMETA * PW + PC_CKV, (const bf16*)(ws + WS_WKVT), PW, 512, 512, nullptr}; pg8::StaticOrder S; S.init(SEQ / 256, 8, G, bx);
        EpiKvUp E{(bf16*)(ws + WS_KVA), (const float*)(ws + WS_ROPE128), (const float*)(ws + WS_SSQ)};
        pg8::gemm_phase(lds + RING_OFF, g, S, E);
        { TIDS(); meta_kvup(args, gw, NGW, lane); }
    } SEAM(2);
    TS(3); if (IN(3)) REP(3) { if (vcu < 8) { TIDS(); if (wave == 0) phase_cumsum(args, vcu, lane); } phase_indexer_mfma(args, lds + RING_OFF, vcu, G); } SEAM(3);
    TS(4); if (IN(4)) REP(4) { TIDS(); phase_select(args, lds + RING_OFF, gw, NGW, wave, lane); } SEAM(4);
    TS(5); if (IN(5)) REP(5) { phase_attn(args, (char*)lds_raw + RING_OFF, (volatile LAS int*)(lds + MISC_OFF + 512)); } SEAM(5);
    TS(6); if (IN(6)) REP(6) { phase_attn_combine(args, (char*)lds_raw + RING_OFF, vcu, G);
        { const int c0 = G >= 256 ? 128 : 0;
          if (vcu >= c0) { TIDS(); __syncthreads(); LAS float* scr = (LAS float*)(lds + RING_OFF + wave * 16384); const int gwv = (vcu - c0) * NWAVES + wave, ngwv = (G - c0) * NWAVES;
#pragma unroll 1
              for (int i = gwv; i < MOE_D_ITEMS; i += 2 * ngwv) moe_copy_pair<true>(args, scr, i, i + ngwv < MOE_D_ITEMS ? i + ngwv : -1, lane); } }
    } SEAM(6);
    TS(7); if (IN(7)) REP(7) {
        pg8::Gemm g{(const bf16*)(ws + WS_YA), (const bf16*)(ws + WS_WAT), 2048, 2048, 2048, nullptr}; pg8::StaticOrder S; S.init(SEQ / 256, 8, G, bx);
        EpiBranchFused E{(const bf16*)(ws + WS_PROJ), (bf16*)(ws + WS_MERGED)};
        pg8::gemm_phase(lds + RING_OFF, g, S, E);
    } SEAM(7);
    TS(8); if (IN(8)) REP(8) {
        { TIDS(); for (int i = gw * 64 + lane; i < 20 * 2048; i += NGW * 64) { const int e = i >> 11, k = i & 2047;
              ((float*)(ws + WS_WRT))[i] = e < 4 ? args.in[I_WGROUP][k * 4 + e] : args.in[I_WEXPERT][k * 16 + (e - 4)]; }
          for (int i = gw * 64 + lane; i < 16 * 8192; i += NGW * 64) ((int*)(ws + WS_ROWTOK))[i] = -1; }
        pg8::Gemm g{(const bf16*)(ws + WS_MERGED), (const bf16*)(ws + WS_WOT), 2048, 2048, 2048, nullptr}; pg8::StaticOrder S; S.init(SEQ / 256, 8, G, bx);
        EpiOut E{args.in[I_X], (float*)(ws + WS_H2), (float*)(ws + WS_SQ2)};
        pg8::gemm_phase(lds + RING_OFF, g, S, E);
    } SEAM(8);
    TS(9); if (IN(9)) REP(9) { TIDS(); phase_route(args, (volatile LAS int*)(lds + MISC_OFF + 256), gw, NGW, lane); } SEAM(9);
    TS(10); if (IN(10)) REP(10) {
        moe_tile_bases(args, TB); const int nrt = TB[16];
        pg8::Gemm g{(const bf16*)(ws + WS_T), (const bf16*)(ws + WS_WGUT), 2048, 2048, 2048, (const int*)(ws + WS_ROWTOK)}; pg8::MoeOrder S; S.init(0, nrt < 64 ? nrt : 64, 4, G, bx, (const LAS int*)TB, (size_t)1024 * 2048 * 2);
        EpiGateUp E{(bf16*)(ws + WS_ACT), (const float*)(ws + WS_ROWW)};
        pg8::gemm_phase<EpiGateUp, pg8::MoeOrder, true>(lds + RING_OFF, g, S, E);
    } SEAM(10);
    TS(11); if (IN(11)) REP(11) {
        moe_tile_bases(args, TB); const int nrt = TB[16]; const int ngu = nrt > 64 ? (nrt - 64) * 4 : 0; const int ngb = ngu < G / 2 ? ngu : G / 2;
        { pg8::Gemm g{(const bf16*)(ws + WS_T), (const bf16*)(ws + WS_WGUT), 2048, 2048, 2048, (const int*)(ws + WS_ROWTOK)}; pg8::MoeOrder S; S.init(64, nrt - 64, 4, ngb, bx < ngb ? bx : -1, (const LAS int*)TB, (size_t)1024 * 2048 * 2);
          EpiGateUp E{(bf16*)(ws + WS_ACT), (const float*)(ws + WS_ROWW)};
          pg8::gemm_phase<EpiGateUp, pg8::MoeOrder, true>(lds + RING_OFF, g, S, E); }
        { pg8::Gemm g{(const bf16*)(ws + WS_ACT), (const bf16*)(ws + WS_WDT), 512, 512, 512, nullptr}; pg8::MoeOrder S; S.init(0, nrt < 64 ? nrt : 64, 8, G - ngb, bx - ngb, (const LAS int*)TB, (size_t)2048 * 512 * 2);
          EpiDown E{(bf16*)(ws + WS_Y), (const int*)(ws + WS_ROWTOK)};
          pg8::gemm_phase(lds + RING_OFF, g, S, E); }
    } SEAM(11);
    TS(12); if (IN(12)) REP(12) {
        moe_tile_bases(args, TB); const int nrt = TB[16];
        pg8::Gemm g{(const bf16*)(ws + WS_ACT), (const bf16*)(ws + WS_WDT), 512, 512, 512, nullptr}; pg8::MoeOrder S; S.init(64, nrt - 64, 8, G, bx, (const LAS int*)TB, (size_t)2048 * 512 * 2);
        EpiDown E{(bf16*)(ws + WS_Y), (const int*)(ws + WS_ROWTOK)};
        pg8::gemm_phase(lds + RING_OFF, g, S, E);
    } SEAM(12);
    TS(13); if (IN(13)) REP(13) { TIDS(); phase_final(args, gw, NGW, lane); }
    TS(14);
#undef IN
#undef SEAM
}

extern "C" void kernel_launch(void* const* d_in, const int* in_sizes, int n_in, void* d_out, int out_size, void* d_ws, size_t ws_size, hipStream_t stream) {
    static int grid = 0;
    if (grid == 0) {
        if (n_in != 20 || out_size != SEQ * DM || ws_size < WS_NEED) { fprintf(stderr, "kernel_launch: unexpected shapes (n_in %d, out %d, ws %zu need %zu)\n", n_in, out_size, ws_size, (size_t)WS_NEED); grid = -1; return; }
        int dev = 0, cus = 0;
        if (hipGetDevice(&dev) != hipSuccess || hipDeviceGetAttribute(&cus, hipDeviceAttributeMultiprocessorCount, dev) != hipSuccess) { grid = -1; return; }
        if (hipFuncSetAttribute((const void*)mk_fwd, hipFuncAttributeMaxDynamicSharedMemorySize, LDS_BYTES) != hipSuccess) { fprintf(stderr, "kernel_launch: hipFuncSetAttribute failed\n"); grid = -1; return; }
        int per_cu = 0;
        if (hipOccupancyMaxActiveBlocksPerMultiprocessor(&per_cu, (const void*)mk_fwd, NWAVES * 64, LDS_BYTES) != hipSuccess || per_cu < 1) fprintf(stderr, "kernel_launch: occupancy query says %d\n", per_cu);
        (void)hipGetLastError();
        grid = cus;
    }
    if (grid < 0) return;
    (void)hipMemsetAsync((char*)d_ws + WS_CTL, 0, CTL_ZERO_BYTES, stream);
    Args a{};
    for (int i = 0; i < 20; ++i) a.in[i] = (const float*)d_in[i];
    a.out = (float*)d_out; a.ws = (unsigned char*)d_ws;
    if (MK_ONE_LAUNCH) {
        a.ph_lo = 0; a.ph_hi = NPHASE; a.li = 0;
        hipLaunchKernelGGL(mk_fwd, dim3(grid), dim3(NWAVES * 64), LDS_BYTES, stream, a);
    } else {
        for (int p = 0; p < NPHASE; ++p) { a.ph_lo = p; a.ph_hi = p + 1; a.li = p; hipLaunchKernelGGL(mk_fwd, dim3(grid), dim3(NWAVES * 64), LDS_BYTES, stream, a); }
    }
}
```

```cpp
#include <hip/hip_runtime.h>
#include <hip/hip_bf16.h>
#include <cstdio>
#include <cstdint>

#ifndef MK_ONE_LAUNCH
#define MK_ONE_LAUNCH 1
#endif
#define PROBE_DOUBLE -1
#ifndef PROBE_TS_A
#define PROBE_TS_A -1
#define PROBE_TS_B -1
#endif
#define PROBE_TS_SCALE_US 3000.0f
#ifndef PROBE_TS_BLOCK
#define PROBE_TS_BLOCK 0
#endif
#define TSA(a_, i) do { if (PROBE_TS_A >= 0 && blockIdx.x == PROBE_TS_BLOCK && threadIdx.x == 0) ((unsigned long long*)((a_).ws + WS_CTL + 65536))[i] = __builtin_amdgcn_s_memrealtime(); } while (0)
#define TS(i) do { if (PROBE_TS_A >= 0 && blockIdx.x == PROBE_TS_BLOCK && threadIdx.x == 0) ((unsigned long long*)(args.ws + WS_CTL + 65536))[i] = __builtin_amdgcn_s_memrealtime(); } while (0)

namespace pg8 {
#define PG8_LAS __attribute__((address_space(3)))
typedef unsigned short bf16_t;
typedef short bf16x8 __attribute__((ext_vector_type(8)));
typedef float f32x4 __attribute__((ext_vector_type(4)));
typedef unsigned u32x4 __attribute__((ext_vector_type(4)));
constexpr int BM = 256, BK = 64, HALF = 128, HTB = HALF * BK * 2, STAGE_BYTES = 8 * HTB, NXCD = 8, WGM = 8;

__host__ __device__ __forceinline__ int lds_byte(int r, int c) { const int st = (r >> 4) * 2 + (c >> 5), rr = r & 15, cc = c & 31, ob = rr * 64 + cc * 2; return st * 1024 + (ob ^ (((ob >> 9) & 1) << 5)); }
__host__ __device__ __forceinline__ void stage_rc(int b, int& R, int& C) { const int st = b / 1024, sb = b % 1024, swz = sb ^ (((sb >> 9) & 1) << 5); R = (st >> 1) * 16 + swz / 64; C = (st & 1) * 32 + (swz % 64) / 2; }
__host__ __device__ __forceinline__ int perm32(int rho) { const int n = rho >> 4, i = rho & 15; return 8 * (i >> 2) + 4 * n + (i & 3); }

struct Unit { int pm, pn; size_t bofs; int rb; };
struct Gemm { const bf16_t* A; const bf16_t* Bt; int lda, ldb, K; const int* rowsrc; };

struct StaticOrder {
    int nM, nN, nwg, G, c;
    __device__ void init(int nM_, int nN_, int G_, int c_) { nM = nM_; nN = nN_; nwg = nM * nN; G = G_; c = c_; }
    __device__ bool next(int i, Unit& u) const {
        const long L = (long)i * G + c; if (L >= nwg) return false;
        int wgid = (int)L; { const int q = nwg / NXCD, r = nwg % NXCD, xcd = wgid % NXCD, off = wgid / NXCD; wgid = (xcd < r ? xcd * (q + 1) : r * (q + 1) + (xcd - r) * q) + off; }
        const int nig = WGM * nN, gid = wgid / nig, fm = gid * WGM, gsz = (nM - fm) < WGM ? (nM - fm) : WGM;
        u.pm = fm + ((wgid % nig) % gsz); u.pn = (wgid % nig) / gsz; u.bofs = 0; u.rb = u.pm * 256; return true;
    }
};
struct MoeOrder {
    int pm_lo, nN, nwg, G, c; const PG8_LAS int* tb; size_t bstride;
    __device__ void init(int pm_lo_, int npm, int nN_, int G_, int c_, const PG8_LAS int* tb_, size_t bs) { pm_lo = pm_lo_; nN = nN_; nwg = (npm > 0 && c_ >= 0 && c_ < G_) ? npm * nN_ : 0; G = G_; c = c_; tb = tb_; bstride = bs; }
    __device__ bool next(int i, Unit& u) const {
        const long L = (long)i * G + c; if (c < 0 || L >= nwg) return false;
        const int wgid = (int)L;
        u.pn = wgid % nN; u.pm = pm_lo + wgid / nN;
        int e = 0;
#pragma unroll
        for (int k = 1; k < 16; ++k) e += (tb[k] <= u.pm) ? 1 : 0;
        u.bofs = (size_t)e * bstride; u.rb = e * 8192 + (u.pm - tb[e]) * 256; return true;
    }
};

__device__ __forceinline__ unsigned cvt_pk_bf16(float lo, float hi) { unsigned r; asm volatile("v_cvt_pk_bf16_f32 %0, %1, %2" : "=v"(r) : "v"(lo), "v"(hi)); return r; }

template <class Epi, class Sched, bool GATHER = false>
__device__ __forceinline__ void gemm_phase(PG8_LAS unsigned char* lds, const Gemm g, const Sched& S, const Epi& E) {
    int tid = threadIdx.x; asm volatile("" : "+v"(tid));
    const int wid = __builtin_amdgcn_readfirstlane(tid >> 6), lane = tid & 63, wr = wid >> 2, wc = wid & 3, fr = lane & 15, fq = lane >> 4;
    const int K = g.K, nt = K / BK;
    unsigned voffA[2], voffB[2];
#pragma unroll
    for (int i = 0; i < 2; ++i) { int R, C; stage_rc(tid * 16 + i * 8192, R, C); const int Rb = ((R & ~31) + perm32(R & 31));
        voffA[i] = (unsigned)(R * g.lda + C) * 2u; voffB[i] = (unsigned)(Rb * g.ldb + C) * 2u; }
    int gR[2], gC[2];
#pragma unroll
    for (int i = 0; i < 2; ++i) stage_rc(tid * 16 + i * 8192, gR[i], gC[i]);
    unsigned cvA[2][2] = {{0u, 0u}, {0u, 0u}}, nvA[2][2] = {{0u, 0u}, {0u, 0u}};
#define PG8_GLOAD(dst, rb_) do { _Pragma("unroll") for (int h_ = 0; h_ < 2; ++h_) _Pragma("unroll") for (int i_ = 0; i_ < 2; ++i_) { \
        const int rt_ = g.rowsrc[(rb_) + h_ * HALF + gR[i_]]; dst[h_][i_] = (unsigned)((rt_ >= 0 ? rt_ >> 1 : 0) * g.lda + gC[i_]) * 2u; } } while (0)
    const size_t kstep = (size_t)(BK * 2);
    const size_t hstepA = (size_t)HALF * g.lda * 2, hstepB = (size_t)HALF * g.ldb * 2;
    const size_t tstepA = 2 * hstepA, tstepB = 2 * hstepB;
    const unsigned ldsw = (unsigned)wid * 1024u;
    const int aoff = lds_byte(wr * 64 + fr, fq * 8), boff = lds_byte(wc * 32 + fr, fq * 8);
#define PG8_SA(b, h) (((b) * 2 + (h)) * HTB)
#define PG8_SB(b, h) ((4 + (b) * 2 + (h)) * HTB)
#define PG8_STAGE(bufoff, gbase, voff) do { _Pragma("unroll") for (int _i = 0; _i < 2; ++_i) \
        __builtin_amdgcn_global_load_lds((const unsigned*)((const char*)(gbase) + (voff)[_i]), (PG8_LAS unsigned*)(lds + (bufoff) + ldsw + _i * 8192), 16, 0, 0); } while (0)
#define PG8_LDA(dst, b, h) do { _Pragma("unroll") for (int m = 0; m < 4; ++m) _Pragma("unroll") for (int k = 0; k < 2; ++k) dst[m][k] = *(const PG8_LAS bf16x8*)(lds + PG8_SA(b, h) + aoff + m * 2048 + k * 1024); } while (0)
#define PG8_LDB(dst, b, h) do { _Pragma("unroll") for (int n = 0; n < 2; ++n) _Pragma("unroll") for (int k = 0; k < 2; ++k) dst[n][k] = *(const PG8_LAS bf16x8*)(lds + PG8_SB(b, h) + boff + n * 2048 + k * 1024); } while (0)
#define PG8_MMA(ai, bj, At, Bt) do { __builtin_amdgcn_s_setprio(1); _Pragma("unroll") for (int m = 0; m < 4; ++m) _Pragma("unroll") for (int n = 0; n < 2; ++n) _Pragma("unroll") for (int k = 0; k < 2; ++k) \
        acc[ai][bj][m][n] = __builtin_amdgcn_mfma_f32_16x16x32_bf16(Bt[n][k], At[m][k], acc[ai][bj][m][n], 0, 0, 0); __builtin_amdgcn_s_setprio(0); } while (0)
#define PG8_WAIT_V(n) asm volatile("s_waitcnt vmcnt(" #n ")" ::: "memory")
#define PG8_WAIT_L(n) asm volatile("s_waitcnt lgkmcnt(" #n ")" ::: "memory")
#define PG8_BAR __builtin_amdgcn_s_barrier()
#define PG8_SCHED __builtin_amdgcn_sched_barrier(0)
    Unit cur, nxt; int ui = 0;
    if (!S.next(0, cur)) return;
    f32x4 acc[2][2][4][2];
#pragma unroll
    for (int a = 0; a < 2; ++a)
#pragma unroll
        for (int b = 0; b < 2; ++b)
#pragma unroll
            for (int m = 0; m < 4; ++m)
#pragma unroll
                for (int n = 0; n < 2; ++n) acc[a][b][m][n] = (f32x4){0.f, 0.f, 0.f, 0.f};
    bf16x8 At[4][2], B0[2][2], B1[2][2];
    const char* cA = (const char*)g.A + (size_t)cur.pm * tstepA; const char* cB = (const char*)g.Bt + cur.bofs + (size_t)cur.pn * tstepB;
    const char* gA = (const char*)g.A;
    if constexpr (GATHER) { PG8_GLOAD(cvA, cur.rb); }
    {
        PG8_STAGE(PG8_SB(0, 0), cB, voffB); PG8_STAGE(PG8_SB(0, 1), cB + hstepB, voffB);
        if constexpr (GATHER) { PG8_STAGE(PG8_SA(0, 0), gA, cvA[0]); PG8_STAGE(PG8_SA(0, 1), gA, cvA[1]); } else { PG8_STAGE(PG8_SA(0, 0), cA, voffA); PG8_STAGE(PG8_SA(0, 1), cA + hstepA, voffA); }
        if (wr == 1) PG8_BAR;
        PG8_WAIT_V(2); PG8_BAR;
        PG8_STAGE(PG8_SB(1, 0), cB + kstep, voffB);
        if constexpr (GATHER) { PG8_STAGE(PG8_SA(1, 0), gA + kstep, cvA[0]); } else { PG8_STAGE(PG8_SA(1, 0), cA + kstep, voffA); }
        PG8_STAGE(PG8_SB(1, 1), cB + hstepB + kstep, voffB);
        PG8_WAIT_V(6); PG8_BAR;
    }
    for (;;) {
        const bool has_next = S.next(ui + 1, nxt);
        const char* nA = has_next ? (const char*)g.A + (size_t)nxt.pm * tstepA : cA; const char* nB = has_next ? (const char*)g.Bt + nxt.bofs + (size_t)nxt.pn * tstepB : cB;
        if constexpr (GATHER) { if (has_next) { PG8_GLOAD(nvA, nxt.rb); } else {
#pragma unroll
            for (int h_ = 0; h_ < 2; ++h_) { nvA[h_][0] = cvA[h_][0]; nvA[h_][1] = cvA[h_][1]; } } }
        for (int t = 0; t < nt; t += 2) {
            if constexpr (Epi::HAS_MID) { if (t == nt / 2) E.mid(acc, cur, wr, wc, fr, fq); }
            const bool last = (t == nt - 2);
            const char* a1 = cA + (size_t)(t + 1) * kstep;
            const char* a2 = last ? nA : cA + (size_t)(t + 2) * kstep; const char* b2 = last ? nB : cB + (size_t)(t + 2) * kstep;
            const char* a3 = a2 + kstep; const char* b3 = b2 + kstep;
            unsigned sv[2][2]; const char* g2 = gA;
            if constexpr (GATHER) { g2 = last ? gA : gA + (size_t)(t + 2) * kstep;
#pragma unroll
                for (int h_ = 0; h_ < 2; ++h_) { sv[h_][0] = last ? nvA[h_][0] : cvA[h_][0]; sv[h_][1] = last ? nvA[h_][1] : cvA[h_][1]; } }
            PG8_LDB(B0, 0, 0); PG8_LDB(B1, 0, 1); PG8_SCHED; PG8_LDA(At, 0, 0);
            if constexpr (GATHER) { PG8_STAGE(PG8_SA(1, 1), gA + (size_t)(t + 1) * kstep, cvA[1]); } else { PG8_STAGE(PG8_SA(1, 1), a1 + hstepA, voffA); }
            PG8_WAIT_V(8); PG8_WAIT_L(0); PG8_BAR; PG8_MMA(0, 0, At, B0); PG8_MMA(0, 1, At, B1); PG8_BAR; PG8_SCHED;
            PG8_LDA(At, 0, 1); PG8_STAGE(PG8_SB(0, 0), b2, voffB); PG8_STAGE(PG8_SB(0, 1), b2 + hstepB, voffB);
            if constexpr (GATHER) { PG8_STAGE(PG8_SA(0, 0), g2, sv[0]); } else { PG8_STAGE(PG8_SA(0, 0), a2, voffA); }
            PG8_WAIT_V(8); PG8_WAIT_L(0); PG8_BAR; PG8_MMA(1, 0, At, B0); PG8_MMA(1, 1, At, B1); PG8_BAR; PG8_SCHED;
            PG8_LDB(B0, 1, 0); PG8_LDB(B1, 1, 1); PG8_SCHED; PG8_LDA(At, 1, 0);
            if constexpr (GATHER) { PG8_STAGE(PG8_SA(0, 1), g2, sv[1]); } else { PG8_STAGE(PG8_SA(0, 1), a2 + hstepA, voffA); }
            PG8_WAIT_V(8); PG8_WAIT_L(0); PG8_BAR; PG8_MMA(0, 0, At, B0); PG8_MMA(0, 1, At, B1); PG8_BAR; PG8_SCHED;
            PG8_LDA(At, 1, 1); PG8_STAGE(PG8_SB(1, 0), b3, voffB); PG8_STAGE(PG8_SB(1, 1), b3 + hstepB, voffB);
            if constexpr (GATHER) { PG8_STAGE(PG8_SA(1, 0), g2 + kstep, sv[0]); } else { PG8_STAGE(PG8_SA(1, 0), a3, voffA); }
            PG8_WAIT_V(8); PG8_WAIT_L(0); PG8_BAR; PG8_MMA(1, 0, At, B0); PG8_MMA(1, 1, At, B1); PG8_BAR; PG8_SCHED;
        }
        if (wr == 0) PG8_BAR;
        E(acc, cur, wr, wc, fr, fq);
        if (!has_next) break;
#pragma unroll
        for (int a = 0; a < 2; ++a)
#pragma unroll
            for (int b = 0; b < 2; ++b)
#pragma unroll
                for (int m = 0; m < 4; ++m)
#pragma unroll
                    for (int n = 0; n < 2; ++n) acc[a][b][m][n] = (f32x4){0.f, 0.f, 0.f, 0.f};
        cur = nxt; cA = nA; cB = nB; ++ui;
        if constexpr (GATHER) {
#pragma unroll
            for (int h_ = 0; h_ < 2; ++h_) { cvA[h_][0] = nvA[h_][0]; cvA[h_][1] = nvA[h_][1]; } }
        if (wr == 1) PG8_BAR;
    }
    PG8_WAIT_V(0);
    PG8_BAR;
#undef PG8_GLOAD
#undef PG8_SA
#undef PG8_SB
#undef PG8_STAGE
#undef PG8_LDA
#undef PG8_LDB
#undef PG8_MMA
#undef PG8_WAIT_V
#undef PG8_WAIT_L
#undef PG8_BAR
#undef PG8_SCHED
}
}

constexpr int NWAVES = 8;
constexpr int DM = 2048, SEQ = 8192, NMETA = 16, LTOK = SEQ + NMETA, LP = 8448;
constexpr int HD = 128, NH = 8, KVR = 512, IH = 16, IDD = 64, TOPK = 256;
constexpr int INW = 9816, PW = 9984;
constexpr int PC_QA = 0, PC_CKV = 1024, PC_QI = 1536, PC_KI = 2560, PC_WI = 2624, PC_FB = 2640, PC_QB = 2688, PC_KB = 3712, PC_VB = 4736, PC_GA = 5760, PC_GB = 7808, PC_END = 9856;
constexpr int NE = 16, DFF = 512, TSROWS = 20480;
constexpr float EPS = 1e-6f;
constexpr float LOG2E = 1.4426950408889634f;
constexpr float ATT_SCALE = 0.08838834764831845f;
constexpr int NTILE64 = 129;
constexpr int NPHASE = 14;


namespace att {
typedef short bf16x8 __attribute__((ext_vector_type(8)));
typedef short s16x4 __attribute__((ext_vector_type(4)));
typedef float f32x16 __attribute__((ext_vector_type(16)));
typedef float f32x4 __attribute__((ext_vector_type(4)));
typedef unsigned u32x4 __attribute__((ext_vector_type(4)));
typedef unsigned short bf16;
constexpr int NW = 8, QBLK = 32, KVBLK = 64, QB = NW * QBLK, D = 128;
constexpr int SHM_V = KVBLK * D * 2, SHM_K = KVBLK * D * 2;
constexpr int NVS = 3;
constexpr int OFF_WS = NVS * SHM_V + 2 * SHM_K, OFF_BIAS = OFF_WS + NW * 64 * 4, OFF_Q = OFF_BIAS + 2 * 64 * 4, LDS_TOTAL = OFF_Q + NW * 8192;
constexpr float SCALE = 0.08838834764831845f, THR = 8.f;
#define KSWZ(row, colB) ((row) * 256 + ((colB) ^ (((row) & 7) << 4)))
#define SBAR() __builtin_amdgcn_sched_barrier(0)
__device__ __forceinline__ int v_st(int k, int c) { const int kk = (k & ~0xC) | ((k & 4) << 1) | ((k & 8) >> 1); return ((kk >> 3) * 4 + (c >> 5)) * 512 + ((kk & 7) * 32 + (c & 31)) * 2; }
__device__ __forceinline__ int v_rd_base(int lane) { return ((lane & 3) << 3) | (((lane >> 2) & 3) << 6) | (((lane >> 4) & 1) << 5) | (((lane >> 5) & 1) << 8); }
constexpr int v_rd_off(int d0, int ks, int half) { return d0 * 512 + ks * 4096 + half * 2048; }
__device__ __forceinline__ int crow(int r, int hi) { return (r & 3) + 8 * (r >> 2) + 4 * hi; }
__device__ __forceinline__ unsigned cvtpk(float lo, float hi) { unsigned r; asm volatile("v_cvt_pk_bf16_f32 %0, %1, %2" : "=v"(r) : "v"(lo), "v"(hi)); return r; }
__device__ __forceinline__ void mask_causal(f32x16& p0, f32x16& p1, int dq) {
    const float NEG = -__builtin_inff();
#pragma unroll
    for (int r = 0; r < 16; ++r) { const int c = (r & 3) + 8 * (r >> 2); if (dq - c < 0) p0[r] = NEG; if (dq - c - 32 < 0) p1[r] = NEG; }
}
__device__ __forceinline__ void mask_bits(f32x16& p0, f32x16& p1, unsigned long long w, int hi) {
    const float NEG = -__builtin_inff();
    const unsigned wl = (unsigned)w >> (4 * hi), wh = (unsigned)(w >> 32) >> (4 * hi);
#pragma unroll
    for (int r = 0; r < 16; ++r) { const int c = (r & 3) + 8 * (r >> 2);
        const unsigned m0 = (unsigned)__builtin_amdgcn_sbfe((int)wl, c, 1), m1 = (unsigned)__builtin_amdgcn_sbfe((int)wh, c, 1);
        p0[r] = __uint_as_float((__float_as_uint(p0[r]) & m0) | (__float_as_uint(NEG) & ~m0)); p1[r] = __uint_as_float((__float_as_uint(p1[r]) & m1) | (__float_as_uint(NEG) & ~m1)); }
}
__device__ __forceinline__ void partialSM(f32x16& p0, f32x16& p1, float& m_reg, float& mn, float& alpha) {
    float pmax = p0[0];
#pragma unroll
    for (int r = 1; r < 16; ++r) pmax = fmaxf(pmax, p0[r]);
#pragma unroll
    for (int r = 0; r < 16; ++r) pmax = fmaxf(pmax, p1[r]);
    { auto rr = __builtin_amdgcn_permlane32_swap(__float_as_uint(pmax), __float_as_uint(pmax), false, false);
      pmax = fmaxf(__uint_as_float(rr[0]), __uint_as_float(rr[1])); }
    constexpr float C2 = 1.4426950408889634f * SCALE;
    if (__builtin_expect(__all((pmax - m_reg) * SCALE <= THR), 1)) { mn = m_reg; alpha = 1.f; }
    else { mn = fmaxf(m_reg, pmax); alpha = __builtin_amdgcn_exp2f((m_reg - mn) * C2); m_reg = mn; }
    const float mnL = -mn * C2;
#pragma unroll
    for (int r = 0; r < 16; ++r) p0[r] = fmaf(p0[r], C2, mnL);
#pragma unroll
    for (int r = 0; r < 16; ++r) p1[r] = fmaf(p1[r], C2, mnL);
#pragma unroll
    for (int r = 0; r < 16; ++r) p0[r] = __builtin_amdgcn_exp2f(p0[r]);
}
__device__ __forceinline__ void finishSM(f32x16& p0, f32x16& p1, float alpha, float& l_reg, bf16x8& pa0, bf16x8& pa1, bf16x8& pa2, bf16x8& pa3) {
#pragma unroll
    for (int r = 0; r < 16; ++r) p1[r] = __builtin_amdgcn_exp2f(p1[r]);
    float ps = 0;
#pragma unroll
    for (int r = 0; r < 16; ++r) ps += p0[r];
#pragma unroll
    for (int r = 0; r < 16; ++r) ps += p1[r];
    { auto rr = __builtin_amdgcn_permlane32_swap(__float_as_uint(ps), __float_as_uint(ps), false, false);
      ps = __uint_as_float(rr[0]) + __uint_as_float(rr[1]); }
    l_reg = l_reg * alpha + ps;
#define PK4(P, B_, OUT) do { unsigned a0 = cvtpk(P[B_+0], P[B_+1]), a1 = cvtpk(P[B_+2], P[B_+3]);                          \
        unsigned b0 = cvtpk(P[B_+4], P[B_+5]), b1 = cvtpk(P[B_+6], P[B_+7]);                                             \
        auto r0 = __builtin_amdgcn_permlane32_swap(a0, b0, false, false); auto r1 = __builtin_amdgcn_permlane32_swap(a1, b1, false, false); \
        u32x4 w = {r0[0], r1[0], r0[1], r1[1]}; OUT = *reinterpret_cast<bf16x8*>(&w); } while (0)
    PK4(p0, 0, pa0); PK4(p0, 8, pa1); PK4(p1, 0, pa2); PK4(p1, 8, pa3);
#undef PK4
}
template <int KB, int MODE>
__device__ __forceinline__ void qkt(f32x16& p0, f32x16& p1, const char* lds, int r32, int hi, const char* qsp) {
    const char* K_lds = lds + NVS * SHM_V;
    if (MODE == 0) { const float* bb = (const float*)(lds + OFF_BIAS + KB * 256) + 4 * hi;
#pragma unroll
        for (int g = 0; g < 4; ++g) { const f32x4 b0 = *(const f32x4*)(bb + 8 * g), b1 = *(const f32x4*)(bb + 32 + 8 * g);
            p0[4 * g] = b0[0]; p0[4 * g + 1] = b0[1]; p0[4 * g + 2] = b0[2]; p0[4 * g + 3] = b0[3];
            p1[4 * g] = b1[0]; p1[4 * g + 1] = b1[1]; p1[4 * g + 2] = b1[2]; p1[4 * g + 3] = b1[3]; } }
    else { p0 = f32x16{}; p1 = f32x16{}; }
    const char* kb[4];
#pragma unroll
    for (int dd = 0; dd < 4; ++dd) kb[dd] = K_lds + KB * SHM_K + KSWZ(r32, (dd * 16 + hi * 8) * 2);
#pragma unroll
    for (int d0 = 0; d0 < 8; ++d0) { const char* a = kb[d0 & 3] + (d0 >> 2) * 128;
        bf16x8 b0 = *reinterpret_cast<const bf16x8*>(a);
        bf16x8 b1 = *reinterpret_cast<const bf16x8*>(a + 32 * 256);
        const bf16x8 q = *reinterpret_cast<const bf16x8*>(qsp + d0 * 1024);
        p0 = __builtin_amdgcn_mfma_f32_32x32x16_bf16(b0, q, p0, 0, 0, 0);
        p1 = __builtin_amdgcn_mfma_f32_32x32x16_bf16(b1, q, p1, 0, 0, 0); }
}
__device__ __forceinline__ void pv_tile(f32x16* o, int vb0, bf16x8 pa0, bf16x8 pa1, bf16x8 pa2, bf16x8 pa3) {
#define TRRD(dst, off) asm volatile("ds_read_b64_tr_b16 %0, %1 offset:%2" : "=&v"(dst) : "v"(vb0), "i"(off) : "memory")
#define PV_D0(d0) do { s16x4 l0, l1, l2, l3, h0, h1, h2, h3; constexpr int b_ = v_rd_off(d0, 0, 0); \
        TRRD(l0, b_); TRRD(h0, b_ + 2048); TRRD(l1, b_ + 4096); TRRD(h1, b_ + 6144); TRRD(l2, b_ + 8192); TRRD(h2, b_ + 10240); TRRD(l3, b_ + 12288); TRRD(h3, b_ + 14336); \
        asm volatile("s_waitcnt lgkmcnt(0)" ::: "memory"); SBAR(); \
        o[d0] = __builtin_amdgcn_mfma_f32_32x32x16_bf16(pa0, (bf16x8){l0[0], l0[1], l0[2], l0[3], h0[0], h0[1], h0[2], h0[3]}, o[d0], 0, 0, 0);   \
        o[d0] = __builtin_amdgcn_mfma_f32_32x32x16_bf16(pa1, (bf16x8){l1[0], l1[1], l1[2], l1[3], h1[0], h1[1], h1[2], h1[3]}, o[d0], 0, 0, 0);   \
        o[d0] = __builtin_amdgcn_mfma_f32_32x32x16_bf16(pa2, (bf16x8){l2[0], l2[1], l2[2], l2[3], h2[0], h2[1], h2[2], h2[3]}, o[d0], 0, 0, 0);   \
        o[d0] = __builtin_amdgcn_mfma_f32_32x32x16_bf16(pa3, (bf16x8){l3[0], l3[1], l3[2], l3[3], h3[0], h3[1], h3[2], h3[3]}, o[d0], 0, 0, 0); } while (0)
    PV_D0(0); PV_D0(1); PV_D0(2); PV_D0(3);
#undef PV_D0
#undef TRRD
}
struct ItemRef { const bf16* Q; const bf16* K; const bf16* V; bf16* O; int P0, t_lo, t_hi; const float* cb; float cref; const unsigned long long* mk; float* part; float kn2; };
constexpr float FOX_TAU = 30.5f;
constexpr int PART_FLOATS = 256 * 128 + 512;
struct Seam { bf16x8 st_v0, st_v1, st_k0, st_k1; float st_b; };
#define ROWP(p, k0, rr) ((p) + (size_t)((k0) + (rr)) * LDKV + sc)
#define VMW() asm volatile("s_waitcnt vmcnt(0)" ::: "memory")
#define LD8(p) (*reinterpret_cast<const bf16x8*>(p))
#define SLOAD_H(R, k0) do { S.st_v0 = LD8(ROWP((R).V, k0, sr)); S.st_v1 = LD8(ROWP((R).V, k0, 32 + sr)); S.st_k0 = LD8(ROWP((R).K, k0, sr)); S.st_k1 = LD8(ROWP((R).K, k0, 32 + sr)); \
        if (MODE == 0 && wid == 0) S.st_b = ((R).cref - (R).cb[(k0) + lane]) * (1.0f / SCALE); } while (0)
#define SWRITE_HK(bf) do { *(bf16x8*)(K_lds + (bf) * SHM_K + kws) = S.st_k0; *(bf16x8*)(K_lds + (bf) * SHM_K + kws + 32 * 256) = S.st_k1; \
        if (MODE == 0 && wid == 0) ((float*)(lds + OFF_BIAS))[(bf) * 64 + lane] = S.st_b; } while (0)
#define SWRITE_HV(bf) do { *(bf16x8*)(V_lds + (bf) * SHM_V + vst0) = S.st_v0; *(bf16x8*)(V_lds + (bf) * SHM_V + vst1) = S.st_v1; } while (0)
#define SWRITE_H(bf) do { SWRITE_HV(bf); SWRITE_HK(bf); } while (0)
template <int MODE, int LDQ, int LDKV, int LDO>
__device__ __forceinline__ void run_item(const ItemRef& cur, char* lds) {
    int tid = threadIdx.x; asm volatile("" : "+v"(tid));
    const int wid = __builtin_amdgcn_readfirstlane(tid >> 6), lane = tid & 63, r32 = lane & 31, hi = lane >> 5;
    int t_lo = cur.t_lo;
    const int qlo = cur.P0 + wid * QBLK, qm = qlo + r32 - 4 * hi;
    char* V_lds = lds; char* K_lds = lds + NVS * SHM_V;
    float* wsf = (float*)(lds + OFF_WS) + wid * 64; float* li_l = wsf, * al_l = wsf + 32;
    char* qsp = lds + OFF_Q + wid * 8192 + lane * 16;
    float m_reg = -1e30f, l_reg = 0; f32x16 o[4] = {};
    const int sr = tid >> 4, sc = (tid & 15) * 8, vst0 = v_st(sr, sc), vst1 = v_st(32 + sr, sc), kws = KSWZ(sr, sc * 2);
    const int vb0 = (int)(uintptr_t)V_lds + v_rd_base(lane);
    const unsigned long long* mkl = cur.mk + wid * QBLK + r32;
    Seam S;
#define RESC(a) do { if (__any((a) < 1.f)) { if (hi == 0) al_l[r32] = (a); asm volatile("s_waitcnt lgkmcnt(0)" ::: "memory");              \
                     _Pragma("unroll") for (int d_ = 0; d_ < 4; ++d_) _Pragma("unroll") for (int r = 0; r < 16; ++r) o[d_][r] *= al_l[crow(r, hi)]; } } while (0)
#define KBASE(t) ((t_lo + (t)) * KVBLK)
#define MLOAD(t) (MODE == 1 ? mkl[(size_t)(t_lo + (t)) * SEQ] : 0ull)
#define MASKT(P0_, P1_, t, w_) do { if (MODE == 1) mask_bits(P0_, P1_, w_, hi); else { const int kb_ = KBASE(t); if (kb_ + KVBLK - 1 > qlo) mask_causal(P0_, P1_, qm - kb_); } } while (0)
    { bf16x8 tq[8];
#pragma unroll
      for (int d0 = 0; d0 < 8; ++d0) tq[d0] = LD8(cur.Q + (size_t)(wid * QBLK + r32) * LDQ + d0 * 16 + hi * 8);
      if (MODE == 0) {
          float q2 = 0.f;
#pragma unroll
          for (int d0 = 0; d0 < 8; ++d0)
#pragma unroll
              for (int j = 0; j < 8; ++j) { const float x = __uint_as_float((unsigned)(unsigned short)tq[d0][j] << 16); q2 = fmaf(x, x, q2); }
          q2 += __shfl_xor(q2, 32);
#pragma unroll
          for (int ofs = 1; ofs < 32; ofs <<= 1) q2 = fmaxf(q2, __shfl_xor(q2, ofs));
          if (lane == 0) al_l[0] = q2;
          __syncthreads();
          float Q2 = 0.f;
#pragma unroll
          for (int w = 0; w < NW; ++w) Q2 = fmaxf(Q2, ((const float*)(lds + OFF_WS))[w * 64 + 32]);
          const float D = FOX_TAU + 2.002f * SCALE * sqrtf(Q2 * cur.kn2);
          const float cthr = cur.cb[cur.P0] + D; int cntskip = 0;
#pragma unroll
          for (int i = 0; i < 3; ++i) { const int t = lane + 64 * i; const bool sk = t < cur.t_hi && cur.cb[t * KVBLK + KVBLK - 1] >= cthr; cntskip += __popcll(__ballot(sk)); }
          t_lo = cntskip < cur.t_hi - 1 ? cntskip : cur.t_hi - 1;
          __syncthreads();
      }
      SLOAD_H(cur, KBASE(0)); VMW();
#pragma unroll
      for (int d0 = 0; d0 < 8; ++d0) *(bf16x8*)(qsp + d0 * 1024) = tq[d0];
      SWRITE_HK(0); }
    const int NT = cur.t_hi - t_lo;
    __syncthreads();
    f32x16 pA0, pA1, pB0, pB1; float mnA, mnB, alA, alB; bf16x8 pa0, pa1, pa2, pa3;
    unsigned long long mw = MLOAD(0);
    SWRITE_HV(0); SBAR();
    if (NT > 1) { SLOAD_H(cur, KBASE(1)); }
    SBAR(); qkt<0, MODE>(pA0, pA1, lds, r32, hi, qsp);
    MASKT(pA0, pA1, 0, mw); partialSM(pA0, pA1, m_reg, mnA, alA);
    if (NT > 1) { VMW(); SWRITE_H(1); }
    __syncthreads();
    int vs = 0;
#define HALF_STEP(PX0, PX1, mnX, alX, PY0, PY1, alY, t, KB, SB) do {                                                          \
        SBAR(); mw = MLOAD(t); qkt<KB, MODE>(PX0, PX1, lds, r32, hi, qsp);                                                    \
        finishSM(PY0, PY1, alY, l_reg, pa0, pa1, pa2, pa3); SBAR();                                                           \
        if ((t) + 1 < NT) { SLOAD_H(cur, KBASE((t) + 1)); SBAR(); }                                                           \
        pv_tile(o, vb0 + vs * SHM_V, pa0, pa1, pa2, pa3); MASKT(PX0, PX1, (t), mw); partialSM(PX0, PX1, m_reg, mnX, alX);     \
        if ((t) + 1 < NT) { const int vn_ = vs >= 1 ? vs - 1 : 2; VMW(); SWRITE_HK(SB); SWRITE_HV(vn_); }                      \
        RESC(alX); vs = vs == 2 ? 0 : vs + 1; __syncthreads(); } while (0)
    for (int t = 1; t + 1 < NT; t += 2) {
        HALF_STEP(pB0, pB1, mnB, alB, pA0, pA1, alA, t, 1, 0);
        HALF_STEP(pA0, pA1, mnA, alA, pB0, pB1, alB, t + 1, 0, 1);
    }
    const bool even = (NT & 1) == 0;
    if (even) { SBAR(); mw = MLOAD(NT - 1); qkt<1, MODE>(pB0, pB1, lds, r32, hi, qsp); SBAR(); }
    finishSM(pA0, pA1, alA, l_reg, pa0, pa1, pa2, pa3); SBAR();
    pv_tile(o, vb0 + vs * SHM_V, pa0, pa1, pa2, pa3);
    if (even) { MASKT(pB0, pB1, NT - 1, mw); partialSM(pB0, pB1, m_reg, mnB, alB); __syncthreads(); RESC(alB);
        finishSM(pB0, pB1, alB, l_reg, pa0, pa1, pa2, pa3); SBAR(); pv_tile(o, vb0 + (vs == 2 ? 0 : vs + 1) * SHM_V, pa0, pa1, pa2, pa3); }
    SBAR();
    if (cur.part) {
        float* po = cur.part + (size_t)(wid * 64 + lane) * 64;
#pragma unroll
        for (int d0 = 0; d0 < 4; ++d0)
#pragma unroll
            for (int g = 0; g < 4; ++g) *(f32x4*)(po + d0 * 16 + 4 * g) = (f32x4){o[d0][4 * g], o[d0][4 * g + 1], o[d0][4 * g + 2], o[d0][4 * g + 3]};
        if (hi == 0) { cur.part[256 * 128 + wid * QBLK + r32] = m_reg; cur.part[256 * 128 + 256 + wid * QBLK + r32] = l_reg; }
    } else {
        if (hi == 0) li_l[r32] = l_reg; asm volatile("s_waitcnt lgkmcnt(0)" ::: "memory");
        float rli[16];
#pragma unroll
        for (int r = 0; r < 16; ++r) rli[r] = __builtin_amdgcn_rcpf(li_l[crow(r, hi)]);
        bf16* Ow = cur.O + (size_t)(wid * QBLK) * LDO;
#pragma unroll
        for (int r = 0; r < 16; ++r) { const int orow = crow(r, hi);
#pragma unroll
            for (int d0 = 0; d0 < 4; ++d0) { const float v = o[d0][r] * rli[r];
                const float vn = __shfl_xor(v, 1);
                if ((r32 & 1) == 0) *(unsigned*)(Ow + (size_t)orow * LDO + d0 * 32 + r32) = cvtpk(v, vn); } }
    }
    __syncthreads();
#undef RESC
#undef KBASE
#undef MLOAD
#undef MASKT
#undef HALF_STEP
}
template <int LDO>
__device__ __forceinline__ void combine_item(const float* p1, const float* p2, bf16* O, char* lds) {
    int tid = threadIdx.x; asm volatile("" : "+v"(tid));
    const int wid = __builtin_amdgcn_readfirstlane(tid >> 6), lane = tid & 63, r32 = lane & 31, hi = lane >> 5;
    float* wsf = (float*)(lds + OFF_WS) + wid * 64;
    constexpr float C2 = 1.4426950408889634f * SCALE;
    { const int row = wid * QBLK + r32; const float m1 = p1[256 * 128 + row], m2 = p2[256 * 128 + row], l1 = p1[256 * 128 + 256 + row], l2 = p2[256 * 128 + 256 + row];
      const float m = fmaxf(m1, m2), f1 = __builtin_amdgcn_exp2f((m1 - m) * C2), f2 = __builtin_amdgcn_exp2f((m2 - m) * C2); const float rl = 1.f / (l1 * f1 + l2 * f2);
      if (hi == 0) { wsf[r32] = f1 * rl; wsf[32 + r32] = f2 * rl; } }
    asm volatile("s_waitcnt lgkmcnt(0)" ::: "memory");
    const float* q1 = p1 + (size_t)(wid * 64 + lane) * 64; const float* q2 = p2 + (size_t)(wid * 64 + lane) * 64;
    bf16* Ow = O + (size_t)(wid * QBLK) * LDO;
#pragma unroll
    for (int d0 = 0; d0 < 4; ++d0)
#pragma unroll
        for (int g = 0; g < 4; ++g) { const f32x4 a = *(const f32x4*)(q1 + d0 * 16 + 4 * g), b = *(const f32x4*)(q2 + d0 * 16 + 4 * g);
#pragma unroll
            for (int j = 0; j < 4; ++j) { const int r = 4 * g + j, orow = crow(r, hi); const float v = a[j] * wsf[orow] + b[j] * wsf[32 + orow];
                const float vn = __shfl_xor(v, 1);
                if ((r32 & 1) == 0) *(unsigned*)(Ow + (size_t)orow * LDO + d0 * 32 + r32) = cvtpk(v, vn); } }
    __syncthreads();
}
#undef ROWP
#undef VMW
#undef LD8
#undef SLOAD_H
#undef SWRITE_HK
#undef SWRITE_HV
#undef SWRITE_H
#undef KSWZ
#undef SBAR
}

constexpr size_t MiB = 1u << 20;
constexpr size_t WS_CTL = 0, CTL_ZERO_BYTES = 1 * MiB;
constexpr size_t WS_ROPE128 = 1 * MiB;
constexpr size_t WS_ROPE64 = 5 * MiB + 256 * 1024;
constexpr size_t WS_WRT = 7 * MiB + 288 * 1024;
constexpr size_t WS_KI = 7 * MiB + 512 * 1024;
constexpr size_t WS_WI = 8 * MiB + 768 * 1024;
constexpr size_t WS_LOGF = 9 * MiB + 512 * 1024;
constexpr size_t WS_CC = 9 * MiB + 896 * 1024;
constexpr size_t WS_ROUTE = 10 * MiB + 256 * 1024;
constexpr size_t WS_ROWTOK = 7 * MiB + 512 * 1024;
constexpr size_t WS_ROWW = 8 * MiB;
constexpr size_t WS_CCT = 11 * MiB;
constexpr size_t WS_WAT = 12 * MiB, WS_WBT = 16 * MiB, WS_WOT = 20 * MiB, WS_WKVT = 28 * MiB;
constexpr size_t WS_PROJ = 30 * MiB;
constexpr size_t WS_KVA = 191 * MiB;
constexpr size_t WS_CKVN = 224 * MiB;
constexpr size_t WS_MASK = 224 * MiB;
constexpr size_t WS_R = 233 * MiB;
constexpr size_t WS_HN = WS_R, WS_WINT = WS_R + 33 * MiB, WS_SMALL = WS_R + 73 * MiB;
constexpr size_t WS_S = WS_R;
constexpr size_t WS_YA = WS_R, WS_YB = WS_R + 16 * MiB, WS_MERGED = WS_R + 32 * MiB, WS_M1 = WS_R + 64 * MiB;
constexpr size_t WS_H2 = 30 * MiB, WS_T = 94 * MiB, WS_ACT = 126 * MiB, WS_WDT = 190 * MiB;
constexpr size_t WS_WGUT = WS_R + 66 * MiB;
constexpr size_t WS_SQ2 = 222 * MiB;
constexpr size_t WS_TS = WS_R, WS_Y = WS_R;
constexpr size_t WS_NEED = WS_R + 134 * MiB;
static_assert(WS_PROJ + (size_t)LP * PW * 2 <= WS_KVA && WS_KVA + (size_t)LP * 2048 * 2 <= WS_CKVN && WS_CKVN + (size_t)LP * 512 * 2 <= WS_R, "ws map");
static_assert(WS_WDT + (size_t)NE * 2048 * 512 * 2 <= WS_MASK && WS_M1 + (size_t)SEQ * 2048 * 4 <= WS_NEED && WS_ACT + (size_t)TSROWS * 512 * 2 <= WS_WDT && WS_WGUT + (size_t)NE * 1024 * 2048 * 2 <= WS_NEED, "ws map 2");
constexpr size_t WS_SSQ = 11 * MiB + 288 * 1024;
constexpr int CW_CNT = 64;
constexpr int CW_KMAX = 2112;
constexpr int CW_BAR = 4096;

constexpr int RING_OFF = 0, RING_BYTES = 131072;
constexpr int LDSCTL_OFF = 155648, MISC_OFF = LDSCTL_OFF + 320;
constexpr int LDS_BYTES = 159744;

#define GAS __attribute__((address_space(1)))
#define LAS __attribute__((address_space(3)))
typedef unsigned short bf16;
typedef unsigned v4u __attribute__((ext_vector_type(4)));
typedef unsigned v2u __attribute__((ext_vector_type(2)));
typedef float f32x4 __attribute__((ext_vector_type(4)));
typedef float f32x2 __attribute__((ext_vector_type(2)));
typedef short bf16x8 __attribute__((ext_vector_type(8)));
typedef GAS unsigned gu32;
#define RLX_AGENT __ATOMIC_RELAXED, __HIP_MEMORY_SCOPE_AGENT
#define LDS_WAIT() asm volatile("s_waitcnt lgkmcnt(0)" ::: "memory")
#define VM_WAIT() asm volatile("s_waitcnt vmcnt(0)" ::: "memory")
__device__ __forceinline__ unsigned f2bf(float f) { unsigned u = __builtin_bit_cast(unsigned, f); return (u + 0x7fffu + ((u >> 16) & 1u)) >> 16; }
__device__ __forceinline__ unsigned pk2(float lo, float hi) { return f2bf(lo) | (f2bf(hi) << 16); }
__device__ __forceinline__ float bf2f(unsigned h) { return __builtin_bit_cast(float, h << 16); }
__device__ __forceinline__ float bflo(unsigned w) { return __builtin_bit_cast(float, w << 16); }
__device__ __forceinline__ float bfhi(unsigned w) { return __builtin_bit_cast(float, w & 0xffff0000u); }

#define XB_TMO      128
#define XB_XCNT(j)  (256  + 64 * (j))
#define XB_XSUB(j)  (1280 + 64 * (j))
#define XB_XGEN(j)  (2304 + 64 * (j))
#define XB_TOP      3328
#define XB_TOPGEN   3392
#define XCD_BAR_WORDS 3456
#define XB_SPIN_CAP (1u << 22)
__device__ __forceinline__ unsigned xb_ld(unsigned* p)              { return __hip_atomic_load(p, __ATOMIC_RELAXED, __HIP_MEMORY_SCOPE_AGENT); }
__device__ __forceinline__ unsigned xb_add(unsigned* p, unsigned v) { return __hip_atomic_fetch_add(p, v, __ATOMIC_RELAXED, __HIP_MEMORY_SCOPE_AGENT); }
__device__ __forceinline__ unsigned xb_xcc_id() { return (unsigned)__builtin_amdgcn_s_getreg((3 << 11) | 20) & 0xFu; }
#define XB_SPIN(cond, bar) do { unsigned _sp = 0; while (cond) { __builtin_amdgcn_s_sleep(1); \
    if ((++_sp & 255u) == 0u) { if (xb_ld(&(bar)[XB_TMO])) break; if (_sp > XB_SPIN_CAP) { atomicAdd(&(bar)[XB_TMO], 1u); break; } } } } while (0)
struct XcdBarrier { unsigned* bar; unsigned x; volatile LAS unsigned* st; };
__device__ __forceinline__ XcdBarrier xcd_barrier_post(unsigned* bar, volatile LAS unsigned* st) {
    XcdBarrier b; b.bar = bar; b.x = xb_xcc_id(); b.st = st;
    if (threadIdx.x == 0) (void)xb_add(&bar[XB_XCNT(b.x)], 1u);
    return b;
}
__device__ __forceinline__ void xcd_barrier_complete(unsigned* bar, unsigned x, unsigned& nloc, unsigned& nx) {
    const unsigned G = gridDim.x * gridDim.y * gridDim.z;
    unsigned sum, cnt, mine, sp = 0u;
    for (;;) {
        sum = 0u; cnt = 0u; mine = 0u;
#pragma unroll
        for (unsigned j = 0; j < 16; ++j) { const unsigned c = xb_ld(&bar[XB_XCNT(j)]); sum += c; cnt += (c > 0u) ? 1u : 0u; mine = (j == x) ? c : mine; }
        if (sum == G) break;
        __builtin_amdgcn_s_sleep(1);
        if ((++sp & 255u) == 0u) { if (xb_ld(&bar[XB_TMO])) break; if (sp > XB_SPIN_CAP) { atomicAdd(&bar[XB_TMO], 1u); break; } }
    }
    nloc = mine > 0u ? mine : 1u; nx = cnt > 0u ? cnt : 1u;
}
__device__ __forceinline__ void xcd_barrier(const XcdBarrier& b) {
    asm volatile("s_waitcnt vmcnt(0)" ::: "memory");
    __syncthreads();
    if (threadIdx.x == 0) {
        unsigned* bar = b.bar;
        __builtin_amdgcn_s_waitcnt(0);
        unsigned nloc = b.st[0], nx = b.st[1];
        if (nloc == 0u) { xcd_barrier_complete(bar, b.x, nloc, nx); b.st[0] = nloc; b.st[1] = nx; }
        const unsigned old = xb_add(&bar[XB_XSUB(b.x)], 1u);
        const unsigned gen = old / nloc;
        if (old + 1u == (gen + 1u) * nloc) {
            __builtin_amdgcn_fence(__ATOMIC_RELEASE, "agent");
            asm volatile("s_waitcnt vmcnt(0)" ::: "memory");
            const unsigned og = xb_add(&bar[XB_TOP], 1u);
            const unsigned tg = og / nx;
            if (og + 1u == (tg + 1u) * nx) xb_add(&bar[XB_TOPGEN], 1u);
            else XB_SPIN(xb_ld(&bar[XB_TOPGEN]) == tg, bar);
            __builtin_amdgcn_fence(__ATOMIC_ACQUIRE, "agent");
            xb_add(&bar[XB_XGEN(b.x)], 1u);
            asm volatile("s_waitcnt vmcnt(0)" ::: "memory");
        } else {
            XB_SPIN(xb_ld(&bar[XB_XGEN(b.x)]) == gen, bar);
            __builtin_amdgcn_fence(__ATOMIC_ACQUIRE, "agent");
            asm volatile("s_waitcnt vmcnt(0)" ::: "memory");
        }
    }
    __syncthreads();
}

struct Args { const float* in[20]; float* out; unsigned char* ws; int ph_lo, ph_hi, li, pad; };
enum { I_X = 0, I_META, I_GMIX, I_WIN, I_GKV, I_WKVUP, I_GIDXK, I_BF, I_WBA, I_WBB, I_WOUT, I_GFFN, I_WGROUP, I_BGROUP, I_WEXPERT, I_BEXPERT, I_WGATE, I_WUP, I_WDOWN, I_GFINAL };

__device__ __forceinline__ float wave_sum(float v) {
#pragma unroll
    for (int o = 1; o < 64; o <<= 1) v += __shfl_xor(v, o);
    return v;
}
__device__ __forceinline__ int wave_isum(int v) {
#pragma unroll
    for (int o = 1; o < 64; o <<= 1) v += __shfl_xor(v, o);
    return __builtin_amdgcn_readfirstlane(v);
}
__device__ __forceinline__ float wave_max(float v) {
#pragma unroll
    for (int o = 1; o < 64; o <<= 1) v = fmaxf(v, __shfl_xor(v, o));
    return v;
}

__device__ __forceinline__ void transpose_item(const float* colp, size_t ldsrc, bf16* WT, int ldwt, int k0, int n0, LAS float* scr, int lane, const float* rowscale = nullptr) {
    float v[32];
#pragma unroll
    for (int i = 0; i < 32; ++i) { const int kk = 2 * i + (lane >> 5); v[i] = colp ? colp[(size_t)(k0 + kk) * ldsrc] : 0.f; }
#pragma unroll
    for (int i = 0; i < 32; i += 8) asm volatile("" : "+v"(v[i]), "+v"(v[i + 1]), "+v"(v[i + 2]), "+v"(v[i + 3]), "+v"(v[i + 4]), "+v"(v[i + 5]), "+v"(v[i + 6]), "+v"(v[i + 7]));
#pragma unroll
    for (int i = 0; i < 32; ++i) { const int kk = 2 * i + (lane >> 5); scr[kk * 33 + (lane & 31)] = rowscale ? v[i] * rowscale[k0 + kk] : v[i]; }
    LDS_WAIT(); asm volatile("" ::: "memory");
    const int c = lane & 7;
#pragma unroll
    for (int j = 0; j < 4; ++j) { const int n = (lane >> 3) + 8 * j; const LAS float* s = scr + (8 * c) * 33 + n;
        v4u o; o.x = pk2(s[0 * 33], s[1 * 33]); o.y = pk2(s[2 * 33], s[3 * 33]); o.z = pk2(s[4 * 33], s[5 * 33]); o.w = pk2(s[6 * 33], s[7 * 33]);
        *(GAS v4u*)(WT + (size_t)(n0 + n) * ldwt + k0 + 8 * c) = o; }
    LDS_WAIT(); asm volatile("" ::: "memory");
}
__device__ __forceinline__ void tr_load(float (&v)[32], const float* colp, size_t ldsrc, int k0, int lane) {
#pragma unroll
    for (int i = 0; i < 32; ++i) { const int kk = 2 * i + (lane >> 5); v[i] = colp ? colp[(size_t)(k0 + kk) * ldsrc] : 0.f; }
}
__device__ __forceinline__ void tr_fence(float (&v)[32]) {
#pragma unroll
    for (int i = 0; i < 32; i += 8) asm volatile("" : "+v"(v[i]), "+v"(v[i + 1]), "+v"(v[i + 2]), "+v"(v[i + 3]), "+v"(v[i + 4]), "+v"(v[i + 5]), "+v"(v[i + 6]), "+v"(v[i + 7]));
}
__device__ __forceinline__ void tr_store(const float (&v)[32], bf16* WT, int ldwt, int k0, int n0, LAS float* scr, int lane, const float* rowscale = nullptr) {
#pragma unroll
    for (int i = 0; i < 32; ++i) { const int kk = 2 * i + (lane >> 5); scr[kk * 33 + (lane & 31)] = rowscale ? v[i] * rowscale[k0 + kk] : v[i]; }
    LDS_WAIT(); asm volatile("" ::: "memory");
    const int c = lane & 7;
#pragma unroll
    for (int j = 0; j < 4; ++j) { const int n = (lane >> 3) + 8 * j; const LAS float* s = scr + (8 * c) * 33 + n;
        v4u o; o.x = pk2(s[0 * 33], s[1 * 33]); o.y = pk2(s[2 * 33], s[3 * 33]); o.z = pk2(s[4 * 33], s[5 * 33]); o.w = pk2(s[6 * 33], s[7 * 33]);
        *(GAS v4u*)(WT + (size_t)(n0 + n) * ldwt + k0 + 8 * c) = o; }
    LDS_WAIT(); asm volatile("" ::: "memory");
}
__device__ __forceinline__ int rope_dim(int c, int half) { return (c & 1) ? half + (c >> 1) : (c >> 1); }
__device__ __forceinline__ int win_src(int n) {
    if (n < 1024) return (n & ~127) + rope_dim(n & 127, 64);
    if (n < PC_QI) return n;
    if (n < PC_KI) return PC_QI + ((n - PC_QI) & ~63) + rope_dim((n - PC_QI) & 63, 32);
    if (n < PC_FB) return n;
    if (n < PC_FB + 8) return 5712 + (n - PC_FB);
    if (n < PC_QB) return -1;
    if (n < PC_GA) return 2640 + (n - PC_QB);
    if (n < PC_END) return 5720 + (n - PC_GA);
    return -1;
}

using pg8::Unit;
typedef pg8::f32x4 (AccT)[2][2][4][2];
#define EPI_FOREACH(...) \
    _Pragma("unroll") for (int ai = 0; ai < 2; ++ai) _Pragma("unroll") for (int m = 0; m < 4; ++m) _Pragma("unroll") for (int bj = 0; bj < 2; ++bj) { \
        const int row = u.pm * 256 + ai * 128 + wr * 64 + m * 16 + fr; const int col = u.pn * 256 + bj * 128 + wc * 32 + 8 * fq; \
        const f32x4 v0 = acc[ai][bj][m][0], v1 = acc[ai][bj][m][1]; __VA_ARGS__ }

#define PACK8(v0, v1) (v4u){pg8::cvt_pk_bf16((v0)[0], (v0)[1]), pg8::cvt_pk_bf16((v0)[2], (v0)[3]), pg8::cvt_pk_bf16((v1)[0], (v1)[1]), pg8::cvt_pk_bf16((v1)[2], (v1)[3])}
__device__ __forceinline__ void rope8(f32x4& v0, f32x4& v1, const f32x4 cs0, const f32x4 cs1) {
    const f32x4 a = v0, b = v1;
    v0[0] = a[0] * cs0[0] - a[1] * cs0[1]; v0[1] = a[1] * cs0[0] + a[0] * cs0[1]; v0[2] = a[2] * cs0[2] - a[3] * cs0[3]; v0[3] = a[3] * cs0[2] + a[2] * cs0[3];
    v1[0] = b[0] * cs1[0] - b[1] * cs1[1]; v1[1] = b[1] * cs1[0] + b[0] * cs1[1]; v1[2] = b[2] * cs1[2] - b[3] * cs1[3]; v1[3] = b[3] * cs1[2] + b[2] * cs1[3];
}
struct EpiProj { static constexpr bool HAS_MID = false;
    bf16* P; float* SM; const float* R128; const float* R64; float* SSQ;
    __device__ __forceinline__ void operator()(const AccT& acc, const Unit& u, int wr, int wc, int fr, int fq) const {
        const int kind = u.pn < 4 ? 1 : (u.pn < 6 ? 2 : (u.pn < 10 ? 3 : (u.pn == 10 ? 4 : 0)));
#pragma unroll
        for (int ai = 0; ai < 2; ++ai)
#pragma unroll
            for (int mp = 0; mp < 2; ++mp) {
                f32x4 cs[2][2];
                if (kind == 1 || kind == 3) {
#pragma unroll
                    for (int mm = 0; mm < 2; ++mm) { const int pos = NMETA + u.pm * 256 + ai * 128 + wr * 64 + (2 * mp + mm) * 16 + fr;
                        const float* t = kind == 1 ? R128 + ((size_t)pos * 64 + 16 * wc + 4 * fq) * 2 : R64 + ((size_t)pos * 32 + 16 * (wc & 1) + 4 * fq) * 2;
                        cs[mm][0] = *(const f32x4*)t; cs[mm][1] = *(const f32x4*)(t + 4); }
                    asm volatile("" : "+v"(cs[0][0]), "+v"(cs[0][1]), "+v"(cs[1][0]), "+v"(cs[1][1]));
                }
#pragma unroll
                for (int mm = 0; mm < 2; ++mm)
#pragma unroll
                    for (int bj = 0; bj < 2; ++bj) { const int m = 2 * mp + mm;
                        const int row = NMETA + u.pm * 256 + ai * 128 + wr * 64 + m * 16 + fr; const int col = u.pn * 256 + bj * 128 + wc * 32 + 8 * fq;
                        f32x4 v0 = acc[ai][bj][m][0], v1 = acc[ai][bj][m][1];
                        if (kind == 1 || kind == 3) rope8(v0, v1, cs[mm][0], cs[mm][1]);
                        if (kind == 2) { float q = (v0[0] * v0[0] + v0[1] * v0[1]) + (v0[2] * v0[2] + v0[3] * v0[3]) + (v1[0] * v1[0] + v1[1] * v1[1]) + (v1[2] * v1[2] + v1[3] * v1[3]);
                            q += __shfl_xor(q, 16); q += __shfl_xor(q, 32); if (fq == 0) SSQ[(size_t)row * 16 + (u.pn - 4) * 8 + bj * 4 + wc] = q; }
                        if (kind == 4 && bj == 0) { float* sm = SM + (size_t)row * 128 + (col - 2560); *(f32x4*)sm = v0; *(f32x4*)(sm + 4) = v1; }
                        *(v4u*)(P + (size_t)row * PW + col) = PACK8(v0, v1);
                    }
            }
    }
};
struct EpiKvUp { static constexpr bool HAS_MID = false;
    bf16* O; const float* R128; const float* SSQ;
    __device__ __forceinline__ void operator()(const AccT& acc, const Unit& u, int wr, int wc, int fr, int fq) const {
        const bool isk = u.pn < 4;
#pragma unroll
        for (int ai = 0; ai < 2; ++ai)
#pragma unroll
            for (int mp = 0; mp < 2; ++mp) {
                f32x4 cs[2][2], sq[2][4];
#pragma unroll
                for (int mm = 0; mm < 2; ++mm) { const int pos = NMETA + u.pm * 256 + ai * 128 + wr * 64 + (2 * mp + mm) * 16 + fr;
                    const f32x4* sp = (const f32x4*)(SSQ + (size_t)pos * 16); sq[mm][0] = sp[0]; sq[mm][1] = sp[1]; sq[mm][2] = sp[2]; sq[mm][3] = sp[3];
                    if (isk) { const float* t = R128 + ((size_t)pos * 64 + 16 * wc + 4 * fq) * 2; cs[mm][0] = *(const f32x4*)t; cs[mm][1] = *(const f32x4*)(t + 4); } }
                asm volatile("" : "+v"(sq[0][0]), "+v"(sq[0][1]), "+v"(sq[0][2]), "+v"(sq[0][3]), "+v"(sq[1][0]), "+v"(sq[1][1]), "+v"(sq[1][2]), "+v"(sq[1][3]));
                if (isk) asm volatile("" : "+v"(cs[0][0]), "+v"(cs[0][1]), "+v"(cs[1][0]), "+v"(cs[1][1]));
#pragma unroll
                for (int mm = 0; mm < 2; ++mm) { const int m = 2 * mp + mm;
                    const f32x4 s0 = sq[mm][0], s1 = sq[mm][1], s2 = sq[mm][2], s3 = sq[mm][3];
                    const float ss = (((s0[0] + s0[1]) + (s0[2] + s0[3])) + ((s1[0] + s1[1]) + (s1[2] + s1[3]))) + (((s2[0] + s2[1]) + (s2[2] + s2[3])) + ((s3[0] + s3[1]) + (s3[2] + s3[3])));
                    const float rstd = 1.f / sqrtf(ss * (1.f / 512.f) + EPS);
#pragma unroll
                    for (int bj = 0; bj < 2; ++bj) {
                        const int row = NMETA + u.pm * 256 + ai * 128 + wr * 64 + m * 16 + fr; const int col = u.pn * 256 + bj * 128 + wc * 32 + 8 * fq;
                        f32x4 v0 = acc[ai][bj][m][0] * rstd, v1 = acc[ai][bj][m][1] * rstd;
                        if (isk) rope8(v0, v1, cs[mm][0], cs[mm][1]);
                        *(v4u*)(O + (size_t)row * 2048 + col) = PACK8(v0, v1);
                    } }
            }
    }
};
template <int UNR>
__device__ __forceinline__ void gemm16(const bf16* A, int lda, const bf16* Bt, int ldb, int K, int lane, f32x4 (&out)[4]) {
    const int fr = lane & 15, fq = lane >> 4;
    const bf16* ap = A + (size_t)fr * lda + 8 * fq; const bf16* bp = Bt + (size_t)fr * ldb + 8 * fq;
#pragma unroll
    for (int t = 0; t < 4; ++t) out[t] = (f32x4){0.f, 0.f, 0.f, 0.f};
#pragma unroll UNR
    for (int k0 = 0; k0 < K; k0 += 32) {
        const bf16x8 av = *(const bf16x8*)(ap + k0);
#pragma unroll
        for (int t = 0; t < 4; ++t) { const bf16x8 bv = *(const bf16x8*)(bp + (size_t)(16 * t) * ldb + k0); out[t] = __builtin_amdgcn_mfma_f32_16x16x32_bf16(av, bv, out[t], 0, 0, 0); }
    }
}
struct EpiBf16Plain { static constexpr bool HAS_MID = false;
    bf16* O; int ldc;
    __device__ __forceinline__ void operator()(const AccT& acc, const Unit& u, int wr, int wc, int fr, int fq) const {
        EPI_FOREACH({ v4u w; w.x = pg8::cvt_pk_bf16(v0[0], v0[1]); w.y = pg8::cvt_pk_bf16(v0[2], v0[3]); w.z = pg8::cvt_pk_bf16(v1[0], v1[1]); w.w = pg8::cvt_pk_bf16(v1[2], v1[3]);
            *(v4u*)(O + (size_t)row * ldc + col) = w; })
    }
};
__device__ __forceinline__ float sigmoidf_(float x) { return 1.f / (1.f + __expf(-x)); }
#define EPI_ROWCOL(ai, m, bj) const int row = u.pm * 256 + (ai) * 128 + wr * 64 + (m) * 16 + fr; const int col = u.pn * 256 + (bj) * 128 + wc * 32 + 8 * fq
struct EpiBranchA { static constexpr bool HAS_MID = false;
    const bf16* P; float* M1;
    __device__ __forceinline__ void operator()(const AccT& acc, const Unit& u, int wr, int wc, int fr, int fq) const {
#pragma unroll
        for (int ai = 0; ai < 2; ++ai) {
            v4u gw[4][2];
#pragma unroll
            for (int m = 0; m < 4; ++m)
#pragma unroll
                for (int bj = 0; bj < 2; ++bj) { EPI_ROWCOL(ai, m, bj); gw[m][bj] = *(const v4u*)(P + (size_t)(row + NMETA) * PW + PC_GA + col); }
#pragma unroll
            for (int m = 0; m < 4; ++m) asm volatile("" : "+v"(gw[m][0]), "+v"(gw[m][1]));
#pragma unroll
            for (int m = 0; m < 4; ++m)
#pragma unroll
                for (int bj = 0; bj < 2; ++bj) { EPI_ROWCOL(ai, m, bj); const v4u g = gw[m][bj]; const f32x4 v0 = acc[ai][bj][m][0], v1 = acc[ai][bj][m][1];
                    f32x4 o0, o1;
                    o0[0] = sigmoidf_(bflo(g.x)) * v0[0]; o0[1] = sigmoidf_(bfhi(g.x)) * v0[1]; o0[2] = sigmoidf_(bflo(g.y)) * v0[2]; o0[3] = sigmoidf_(bfhi(g.y)) * v0[3];
                    o1[0] = sigmoidf_(bflo(g.z)) * v1[0]; o1[1] = sigmoidf_(bfhi(g.z)) * v1[1]; o1[2] = sigmoidf_(bflo(g.w)) * v1[2]; o1[3] = sigmoidf_(bfhi(g.w)) * v1[3];
                    float* d = M1 + (size_t)row * 2048 + col; *(f32x4*)d = o0; *(f32x4*)(d + 4) = o1; }
        }
    }
};
struct EpiBranchB { static constexpr bool HAS_MID = false;
    const bf16* P; const float* M1; bf16* MG;
    __device__ __forceinline__ void operator()(const AccT& acc, const Unit& u, int wr, int wc, int fr, int fq) const {
#pragma unroll
        for (int ai = 0; ai < 2; ++ai)
#pragma unroll
            for (int mp = 0; mp < 2; ++mp) {
                v4u gw[2][2]; f32x4 a0[2][2], a1[2][2];
#pragma unroll
                for (int mm = 0; mm < 2; ++mm)
#pragma unroll
                    for (int bj = 0; bj < 2; ++bj) { EPI_ROWCOL(ai, 2 * mp + mm, bj); gw[mm][bj] = *(const v4u*)(P + (size_t)(row + NMETA) * PW + PC_GB + col);
                        const float* d = M1 + (size_t)row * 2048 + col; a0[mm][bj] = *(const f32x4*)d; a1[mm][bj] = *(const f32x4*)(d + 4); }
#pragma unroll
                for (int mm = 0; mm < 2; ++mm) asm volatile("" : "+v"(gw[mm][0]), "+v"(gw[mm][1]), "+v"(a0[mm][0]), "+v"(a0[mm][1]), "+v"(a1[mm][0]), "+v"(a1[mm][1]));
#pragma unroll
                for (int mm = 0; mm < 2; ++mm)
#pragma unroll
                    for (int bj = 0; bj < 2; ++bj) { EPI_ROWCOL(ai, 2 * mp + mm, bj); const v4u g = gw[mm][bj]; const f32x4 v0 = acc[ai][bj][2 * mp + mm][0], v1 = acc[ai][bj][2 * mp + mm][1];
                        const f32x4 b0 = a0[mm][bj], b1 = a1[mm][bj]; f32x4 o0, o1;
                        o0[0] = b0[0] + sigmoidf_(bflo(g.x)) * v0[0]; o0[1] = b0[1] + sigmoidf_(bfhi(g.x)) * v0[1]; o0[2] = b0[2] + sigmoidf_(bflo(g.y)) * v0[2]; o0[3] = b0[3] + sigmoidf_(bfhi(g.y)) * v0[3];
                        o1[0] = b1[0] + sigmoidf_(bflo(g.z)) * v1[0]; o1[1] = b1[1] + sigmoidf_(bfhi(g.z)) * v1[1]; o1[2] = b1[2] + sigmoidf_(bflo(g.w)) * v1[2]; o1[3] = b1[3] + sigmoidf_(bfhi(g.w)) * v1[3];
                        v4u w; w.x = pg8::cvt_pk_bf16(o0[0], o0[1]); w.y = pg8::cvt_pk_bf16(o0[2], o0[3]); w.z = pg8::cvt_pk_bf16(o1[0], o1[1]); w.w = pg8::cvt_pk_bf16(o1[2], o1[3]);
                        *(v4u*)(MG + (size_t)row * 2048 + col) = w; }
            }
    }
};
__device__ __forceinline__ float sig_ratio(float ga, float gbc) { return (1.f + __expf(-gbc)) / (1.f + __expf(-ga)); }
struct EpiBranchFused { static constexpr bool HAS_MID = true;
    const bf16* P; bf16* MG;
    __device__ __forceinline__ void mid(AccT& acc, const Unit& u, int wr, int wc, int fr_in, int fq) const {
        int fr = fr_in; asm volatile("" : "+v"(fr));
#pragma unroll
        for (int ai = 0; ai < 2; ++ai)
#pragma unroll
            for (int mp = 0; mp < 2; ++mp) {
                v4u ga[2][2], gb[2][2];
#pragma unroll
                for (int mm = 0; mm < 2; ++mm)
#pragma unroll
                    for (int bj = 0; bj < 2; ++bj) { EPI_ROWCOL(ai, 2 * mp + mm, bj); const bf16* gp = P + (size_t)(row + NMETA) * PW + col; ga[mm][bj] = *(const v4u*)(gp + PC_GA); gb[mm][bj] = *(const v4u*)(gp + PC_GB); }
#pragma unroll
                for (int mm = 0; mm < 2; ++mm) asm volatile("" : "+v"(ga[mm][0]), "+v"(ga[mm][1]), "+v"(gb[mm][0]), "+v"(gb[mm][1]));
#pragma unroll
                for (int mm = 0; mm < 2; ++mm)
#pragma unroll
                    for (int bj = 0; bj < 2; ++bj) { const int m = 2 * mp + mm; const v4u a = ga[mm][bj], b = gb[mm][bj];
                        acc[ai][bj][m][0][0] *= sig_ratio(bflo(a.x), fmaxf(bflo(b.x), -80.f)); acc[ai][bj][m][0][1] *= sig_ratio(bfhi(a.x), fmaxf(bfhi(b.x), -80.f));
                        acc[ai][bj][m][0][2] *= sig_ratio(bflo(a.y), fmaxf(bflo(b.y), -80.f)); acc[ai][bj][m][0][3] *= sig_ratio(bfhi(a.y), fmaxf(bfhi(b.y), -80.f));
                        acc[ai][bj][m][1][0] *= sig_ratio(bflo(a.z), fmaxf(bflo(b.z), -80.f)); acc[ai][bj][m][1][1] *= sig_ratio(bfhi(a.z), fmaxf(bfhi(b.z), -80.f));
                        acc[ai][bj][m][1][2] *= sig_ratio(bflo(a.w), fmaxf(bflo(b.w), -80.f)); acc[ai][bj][m][1][3] *= sig_ratio(bfhi(a.w), fmaxf(bfhi(b.w), -80.f)); }
            }
    }
    __device__ __forceinline__ void operator()(const AccT& acc, const Unit& u, int wr, int wc, int fr, int fq) const {
#pragma unroll
        for (int ai = 0; ai < 2; ++ai) {
            v4u gb[4][2];
#pragma unroll
            for (int m = 0; m < 4; ++m)
#pragma unroll
                for (int bj = 0; bj < 2; ++bj) { EPI_ROWCOL(ai, m, bj); gb[m][bj] = *(const v4u*)(P + (size_t)(row + NMETA) * PW + PC_GB + col); }
#pragma unroll
            for (int m = 0; m < 4; ++m) asm volatile("" : "+v"(gb[m][0]), "+v"(gb[m][1]));
#pragma unroll
            for (int m = 0; m < 4; ++m)
#pragma unroll
                for (int bj = 0; bj < 2; ++bj) { EPI_ROWCOL(ai, m, bj); const v4u g = gb[m][bj]; const f32x4 v0 = acc[ai][bj][m][0], v1 = acc[ai][bj][m][1]; f32x4 o0, o1;
                    o0[0] = sigmoidf_(fmaxf(bflo(g.x), -80.f)) * v0[0]; o0[1] = sigmoidf_(fmaxf(bfhi(g.x), -80.f)) * v0[1]; o0[2] = sigmoidf_(fmaxf(bflo(g.y), -80.f)) * v0[2]; o0[3] = sigmoidf_(fmaxf(bfhi(g.y), -80.f)) * v0[3];
                    o1[0] = sigmoidf_(fmaxf(bflo(g.z), -80.f)) * v1[0]; o1[1] = sigmoidf_(fmaxf(bfhi(g.z), -80.f)) * v1[1]; o1[2] = sigmoidf_(fmaxf(bflo(g.w), -80.f)) * v1[2]; o1[3] = sigmoidf_(fmaxf(bfhi(g.w), -80.f)) * v1[3];
                    *(v4u*)(MG + (size_t)row * 2048 + col) = PACK8(o0, o1); }
        }
    }
};
struct EpiOut { static constexpr bool HAS_MID = false;
    const float* X; float* H2; float* SQ;
    __device__ __forceinline__ void operator()(const AccT& acc, const Unit& u, int wr, int wc, int fr, int fq) const {
#pragma unroll
        for (int ai = 0; ai < 2; ++ai)
#pragma unroll
            for (int mp = 0; mp < 2; ++mp) {
                f32x4 a0[2][2], a1[2][2];
#pragma unroll
                for (int mm = 0; mm < 2; ++mm)
#pragma unroll
                    for (int bj = 0; bj < 2; ++bj) { EPI_ROWCOL(ai, 2 * mp + mm, bj); const float* xs = X + (size_t)row * 2048 + col; a0[mm][bj] = *(const f32x4*)xs; a1[mm][bj] = *(const f32x4*)(xs + 4); }
#pragma unroll
                for (int mm = 0; mm < 2; ++mm) asm volatile("" : "+v"(a0[mm][0]), "+v"(a0[mm][1]), "+v"(a1[mm][0]), "+v"(a1[mm][1]));
#pragma unroll
                for (int mm = 0; mm < 2; ++mm)
#pragma unroll
                    for (int bj = 0; bj < 2; ++bj) { EPI_ROWCOL(ai, 2 * mp + mm, bj); float* d = H2 + (size_t)row * 2048 + col;
                        const f32x4 h0 = a0[mm][bj] + acc[ai][bj][2 * mp + mm][0], h1 = a1[mm][bj] + acc[ai][bj][2 * mp + mm][1];
                        *(f32x4*)d = h0; *(f32x4*)(d + 4) = h1;
                        float q = ((h0[0] * h0[0] + h0[1] * h0[1]) + (h0[2] * h0[2] + h0[3] * h0[3])) + ((h1[0] * h1[0] + h1[1] * h1[1]) + (h1[2] * h1[2] + h1[3] * h1[3]));
                        q += __shfl_xor(q, 16); q += __shfl_xor(q, 32); if (fq == 0) SQ[(size_t)row * 64 + u.pn * 8 + bj * 4 + wc] = q; }
            }
    }
};
struct EpiGateUp { static constexpr bool HAS_MID = false;
    bf16* ACT; const float* ROWW;
    __device__ __forceinline__ void operator()(const AccT& acc, const Unit& u, int wr, int wc, int fr, int fq) const {
        float rwv[2][4];
#pragma unroll
        for (int ai = 0; ai < 2; ++ai)
#pragma unroll
            for (int m = 0; m < 4; ++m) rwv[ai][m] = ROWW[u.rb + ai * 128 + wr * 64 + m * 16 + fr];
        asm volatile("" : "+v"(rwv[0][0]), "+v"(rwv[0][1]), "+v"(rwv[0][2]), "+v"(rwv[0][3]), "+v"(rwv[1][0]), "+v"(rwv[1][1]), "+v"(rwv[1][2]), "+v"(rwv[1][3]));
#pragma unroll
        for (int ai = 0; ai < 2; ++ai)
#pragma unroll
            for (int m = 0; m < 4; ++m) {
                const int row = u.pm * 256 + ai * 128 + wr * 64 + m * 16 + fr; const int col = u.pn * 128 + wc * 32 + 8 * fq;
                const float rw = rwv[ai][m];
                float o[8];
#pragma unroll
                for (int n = 0; n < 2; ++n)
#pragma unroll
                    for (int j = 0; j < 4; ++j) { const float gv = acc[ai][0][m][n][j], uv = acc[ai][1][m][n][j]; o[n * 4 + j] = gv * sigmoidf_(gv) * uv * rw; }
                v4u w; w.x = pg8::cvt_pk_bf16(o[0], o[1]); w.y = pg8::cvt_pk_bf16(o[2], o[3]); w.z = pg8::cvt_pk_bf16(o[4], o[5]); w.w = pg8::cvt_pk_bf16(o[6], o[7]);
                *(v4u*)(ACT + (size_t)row * 512 + col) = w;
            }
    }
};
struct EpiDown { static constexpr bool HAS_MID = false;
    bf16* Y; const int* ROWTOK;
    __device__ __forceinline__ void operator()(const AccT& acc, const Unit& u, int wr, int wc, int fr, int fq) const {
        int rtv[2][4];
#pragma unroll
        for (int ai = 0; ai < 2; ++ai)
#pragma unroll
            for (int m = 0; m < 4; ++m) rtv[ai][m] = ROWTOK[u.rb + ai * 128 + wr * 64 + m * 16 + fr];
        asm volatile("" : "+v"(rtv[0][0]), "+v"(rtv[0][1]), "+v"(rtv[0][2]), "+v"(rtv[0][3]), "+v"(rtv[1][0]), "+v"(rtv[1][1]), "+v"(rtv[1][2]), "+v"(rtv[1][3]));
#pragma unroll
        for (int ai = 0; ai < 2; ++ai)
#pragma unroll
            for (int m = 0; m < 4; ++m) {
                const int rt = rtv[ai][m];
                if (rt >= 0) { bf16* d = Y + ((size_t)(rt & 1) * SEQ + (rt >> 1)) * 2048 + u.pn * 256 + wc * 32 + 8 * fq;
#pragma unroll
                    for (int bj = 0; bj < 2; ++bj) { const f32x4 v0 = acc[ai][bj][m][0], v1 = acc[ai][bj][m][1];
                        v4u w; w.x = pg8::cvt_pk_bf16(v0[0], v0[1]); w.y = pg8::cvt_pk_bf16(v0[2], v0[3]); w.z = pg8::cvt_pk_bf16(v1[0], v1[1]); w.w = pg8::cvt_pk_bf16(v1[2], v1[3]);
                        *(v4u*)(d + bj * 128) = w; } }
            }
    }
};

__device__ __forceinline__ size_t s_row_off(int qr) { const int b = qr >> 8; const size_t pitch = 320 + 256 * b; return (size_t)256 * (320 * (size_t)b + 128 * (size_t)b * (b - 1)) + (size_t)(qr & 255) * pitch; }
__device__ __forceinline__ unsigned f2key(float f) { const unsigned u = __builtin_bit_cast(unsigned, f); return u ^ ((u >> 31) ? 0xFFFFFFFFu : 0x80000000u); }

constexpr int PC_I_IN = 32 * (PW / 32), PC_I_KV = 8 * 64, PC_I_A = 16 * 64, PC_I_O = 32 * 64, PC_NITEMS = PC_I_IN + PC_I_KV + 2 * PC_I_A + PC_I_O;
__device__ __forceinline__ void copy_items(const Args& a, LAS unsigned char* lds, int it_lo, int it_hi, int gw, int NGW, int wave, int lane) {
    unsigned char* ws = a.ws;
    LAS float* scr = (LAS float*)(lds + RING_OFF + wave * 16384);
    constexpr int I_IN = PC_I_IN, I_KV = PC_I_KV, I_A = PC_I_A;
    auto item = [&](int it, const float*& src, size_t& ldsrc, bf16*& dst, int& ldwt, int& k0, int& n0, const float*& rsc) {
        int r = it; rsc = nullptr;
        if (r < I_IN) { const int nblk = PW / 32, kb = r / nblk, nb = r % nblk; const int sc = win_src(nb * 32 + (lane & 31));
            src = sc >= 0 ? a.in[I_WIN] + sc : nullptr; ldsrc = INW; dst = (bf16*)(ws + WS_WINT); ldwt = 2048; k0 = 64 * kb; n0 = 32 * nb; return; } r -= I_IN;
        if (r < I_KV) { const int kb = r / 64, nb = r % 64; const int n = nb * 32 + (lane & 31); const int sc = n < 1024 ? (n & ~127) + rope_dim(n & 127, 64) : n;
            src = a.in[I_WKVUP] + sc; ldsrc = 2048; dst = (bf16*)(ws + WS_WKVT); ldwt = 512; k0 = 64 * kb; n0 = 32 * nb; rsc = a.in[I_GKV]; return; } r -= I_KV;
        if (r < I_A) { const int kb = r / 64, nb = r % 64; src = a.in[I_WBA] + nb * 32 + (lane & 31); ldsrc = 2048; dst = (bf16*)(ws + WS_WAT); ldwt = 2048; k0 = 64 * kb; n0 = 32 * nb; return; } r -= I_A;
        if (r < I_A) { const int kb = r / 64, nb = r % 64; src = a.in[I_WBB] + nb * 32 + (lane & 31); ldsrc = 2048; dst = (bf16*)(ws + WS_WAT) + 1024; ldwt = 2048; k0 = 64 * kb; n0 = 32 * nb; return; } r -= I_A;
        { const int kb = r / 64, nb = r % 64; src = a.in[I_WOUT] + nb * 32 + (lane & 31); ldsrc = 2048; dst = (bf16*)(ws + WS_WOT); ldwt = 2048; k0 = 64 * kb; n0 = 32 * nb; }
    };
#pragma unroll 1
    for (int it = it_lo + gw; it < it_hi; it += 2 * NGW) {
        const float* s0; size_t l0; bf16* d0; int w0, k0, n0; const float* r0; item(it, s0, l0, d0, w0, k0, n0, r0);
        const bool two = it + NGW < it_hi;
        const float* s1; size_t l1; bf16* d1; int w1, k1, n1; const float* r1; item(two ? it + NGW : it, s1, l1, d1, w1, k1, n1, r1);
        float va[32], vb[32];
        tr_load(va, s0, l0, k0, lane); tr_load(vb, s1, l1, k1, lane);
        tr_fence(va); tr_fence(vb);
        tr_store(va, d0, w0, k0, n0, scr, lane, r0);
        if (two) tr_store(vb, d1, w1, k1, n1, scr, lane, r1);
    }
}
__device__ __forceinline__ void phase_prologue(const Args& a, LAS unsigned char* lds, int gw, int NGW, int wave, int lane, int it_hi) {
    unsigned char* ws = a.ws;
    copy_items(a, lds, 0, it_hi, gw, NGW, wave, lane);
    const f32x4* gm = (const f32x4*)a.in[I_GMIX];
    for (int p = gw; p < LP; p += NGW) {
        bf16* orow = (bf16*)(ws + WS_HN) + (size_t)p * 2048;
        if (p >= LTOK) { for (int j = 0; j < 8; ++j) *(v2u*)(orow + 4 * (lane + 64 * j)) = (v2u){0u, 0u}; continue; }
        const float* xrow = p < NMETA ? a.in[I_META] + (size_t)p * 2048 : a.in[I_X] + (size_t)(p - NMETA) * 2048;
        f32x4 v[8]; float s = 0.f;
#pragma unroll
        for (int j = 0; j < 8; ++j) { v[j] = ((const f32x4*)xrow)[lane + 64 * j]; s += (v[j][0] * v[j][0] + v[j][1] * v[j][1]) + (v[j][2] * v[j][2] + v[j][3] * v[j][3]); }
        const float rstd = 1.f / sqrtf(wave_sum(s) * (1.f / 2048.f) + EPS);
#pragma unroll
        for (int j = 0; j < 8; ++j) { const f32x4 g = gm[lane + 64 * j]; v2u o; o.x = pk2(v[j][0] * rstd * g[0], v[j][1] * rstd * g[1]); o.y = pk2(v[j][2] * rstd * g[2], v[j][3] * rstd * g[3]);
            *(v2u*)(orow + 4 * (lane + 64 * j)) = o; }
    }
    const int gt = gw * 64 + lane, NGT = NGW * 64;
    for (int i = gt; i < LTOK * 64; i += NGT) { const int p = i >> 6, f = i & 63; const double inv = exp(-9.210340371976184 * (double)f / 64.0); const double ang = (double)p * inv;
        double sn, cs; sincos(ang, &sn, &cs); ((f32x2*)(ws + WS_ROPE128))[i] = (f32x2){(float)cs, (float)sn}; }
    for (int i = gt; i < LTOK * 32; i += NGT) { const int p = i >> 5, f = i & 31; const double inv = exp(-9.210340371976184 * (double)f / 32.0); const double ang = (double)p * inv;
        double sn, cs; sincos(ang, &sn, &cs); ((f32x2*)(ws + WS_ROPE64))[i] = (f32x2){(float)cs, (float)sn}; }
}

__device__ __forceinline__ void phase_minipost(const Args& a, volatile LAS unsigned* lmax  , int gw, int NGW, int lane) {
    unsigned char* ws = a.ws;
    const float* SM = (const float*)(ws + WS_SMALL); const f32x2* R64 = (const f32x2*)(ws + WS_ROPE64);
    if (threadIdx.x < 8) lmax[threadIdx.x] = 0u;
    __syncthreads();
    float kmx = 0.f;
    for (int p = gw; p < LP; p += NGW) {
        if (p < LTOK) { const v4u* kr = (const v4u*)((const bf16*)(ws + WS_PROJ) + (size_t)p * PW + PC_KB + 16 * lane); const v4u k0 = kr[0], k1 = kr[1];
            float q = bflo(k0.x) * bflo(k0.x) + bfhi(k0.x) * bfhi(k0.x) + bflo(k0.y) * bflo(k0.y) + bfhi(k0.y) * bfhi(k0.y) + bflo(k0.z) * bflo(k0.z) + bfhi(k0.z) * bfhi(k0.z) + bflo(k0.w) * bflo(k0.w) + bfhi(k0.w) * bfhi(k0.w)
                    + bflo(k1.x) * bflo(k1.x) + bfhi(k1.x) * bfhi(k1.x) + bflo(k1.y) * bflo(k1.y) + bfhi(k1.y) * bfhi(k1.y) + bflo(k1.z) * bflo(k1.z) + bfhi(k1.z) * bfhi(k1.z) + bflo(k1.w) * bflo(k1.w) + bfhi(k1.w) * bfhi(k1.w);
            q += __shfl_xor(q, 1); q += __shfl_xor(q, 2); q += __shfl_xor(q, 4); kmx = fmaxf(kmx, q); }
        bf16* ki = (bf16*)(ws + WS_KI) + (size_t)p * 64;
        if (p >= LTOK) { if (lane < 8) *(v4u*)(ki + 8 * lane) = (v4u){0u, 0u, 0u, 0u};
            if (lane < 16) ((float*)(ws + WS_WI))[(size_t)p * 16 + lane] = 0.f; if (lane < 8) ((float*)(ws + WS_LOGF))[(size_t)lane * LP + p] = 0.f;
            if (p < LTOK + 64) { v4u* kv = (v4u*)((bf16*)(ws + WS_PROJ) + (size_t)p * PW + PC_KB); v4u* ka = (v4u*)((bf16*)(ws + WS_KVA) + (size_t)p * 2048);
#pragma unroll
                for (int j = 0; j < 4; ++j) { kv[lane + 64 * j] = (v4u){0u, 0u, 0u, 0u}; ka[lane + 64 * j] = (v4u){0u, 0u, 0u, 0u}; } }
            continue; }
        { const float v = SM[(size_t)p * 128 + lane]; const float rstd = 1.f / sqrtf(wave_sum(v * v) * (1.f / 64.f) + EPS);
          const float n = v * rstd * a.in[I_GIDXK][lane]; const float pr = __shfl_xor(n, 32); const f32x2 c2 = R64[(size_t)p * 32 + (lane & 31)];
          const float y = lane < 32 ? n * c2[0] - pr * c2[1] : n * c2[0] + pr * c2[1];
          ki[lane < 32 ? 2 * lane : 2 * (lane - 32) + 1] = (bf16)f2bf(y); }
        if (lane < 16) ((float*)(ws + WS_WI))[(size_t)p * 16 + lane] = SM[(size_t)p * 128 + 64 + lane] * (0.25f * 0.125f);
        if (lane < 8) { const float z = SM[(size_t)p * 128 + 80 + lane] + a.in[I_BF][lane]; ((float*)(ws + WS_LOGF))[(size_t)lane * LP + p] = fminf(z, 0.f) - log1pf(expf(-fabsf(z))); }
    }
    if ((lane & 7) == 0) __hip_atomic_fetch_max((LAS unsigned*)lmax + (lane >> 3), __float_as_uint(kmx), __ATOMIC_RELAXED, __HIP_MEMORY_SCOPE_WORKGROUP);
    __syncthreads();
    if (threadIdx.x < 8) __hip_atomic_fetch_max((unsigned*)(ws + WS_CTL) + CW_KMAX + threadIdx.x, lmax[threadIdx.x], RLX_AGENT);
}
__device__ __forceinline__ void meta_inproj(const Args& a, int mw, int NGW, int lane) {
    unsigned char* ws = a.ws; const int fr = lane & 15, fq = lane >> 4;
    bf16* PROJ = (bf16*)(ws + WS_PROJ); float* SM = (float*)(ws + WS_SMALL); float* SSQ = (float*)(ws + WS_SSQ);
    for (int it = mw; it < 42; it += NGW) {
        const int n0 = it < 8 ? PC_CKV + 64 * it : (it < 10 ? PC_KI + 64 * (it - 8) : PC_KB + 64 * (it - 10));
        f32x4 o[4]; gemm16<8>((const bf16*)(ws + WS_HN), 2048, (const bf16*)(ws + WS_WINT) + (size_t)n0 * 2048, 2048, 2048, lane, o);
#pragma unroll
        for (int r = 0; r < 4; ++r) { const int m = 4 * fq + r; float q = 0.f;
#pragma unroll
            for (int t = 0; t < 4; ++t) { const int n = n0 + 16 * t + fr; const float v = o[t][r]; PROJ[(size_t)m * PW + n] = (bf16)f2bf(v); q += v * v;
                if (it >= 8 && it < 10) SM[(size_t)m * 128 + (n - PC_KI)] = v; }
            if (it < 8) { q += __shfl_xor(q, 1); q += __shfl_xor(q, 2); q += __shfl_xor(q, 4); q += __shfl_xor(q, 8); if (fr == 0) { SSQ[(size_t)m * 16 + 2 * it] = q; SSQ[(size_t)m * 16 + 2 * it + 1] = 0.f; } } }
    }
}
__device__ __forceinline__ void meta_kvup(const Args& a, int gw, int NGW, int lane) {
    unsigned char* ws = a.ws; const int fr = lane & 15, fq = lane >> 4;
    const float* SSQ = (const float*)(ws + WS_SSQ); const f32x2* R128 = (const f32x2*)(ws + WS_ROPE128); bf16* KVA = (bf16*)(ws + WS_KVA);
    for (int it = gw; it < 32; it += NGW) {
        const int n0 = 64 * it;
        f32x4 o[4]; gemm16<16>((const bf16*)(ws + WS_PROJ) + PC_CKV, PW, (const bf16*)(ws + WS_WKVT) + (size_t)n0 * 512, 512, 512, lane, o);
#pragma unroll
        for (int r = 0; r < 4; ++r) { const int m = 4 * fq + r; float sq = 0.f;
#pragma unroll
            for (int i = 0; i < 16; ++i) sq += SSQ[(size_t)m * 16 + i];
            const float rstd = 1.f / sqrtf(sq * (1.f / 512.f) + EPS);
#pragma unroll
            for (int t = 0; t < 4; ++t) { const int n = n0 + 16 * t + fr; float v = o[t][r] * rstd;
                if (n0 < 1024) { const float pr = __shfl_xor(v, 1); const int cl = n & 127; const f32x2 cs = R128[(size_t)m * 64 + (cl >> 1)]; v = (cl & 1) ? v * cs[0] + pr * cs[1] : v * cs[0] - pr * cs[1]; }
                KVA[(size_t)m * 2048 + n] = (bf16)f2bf(v); } }
    }
}
__device__ __forceinline__ void phase_cumsum(const Args& a, int wave, int lane) {
    unsigned char* ws = a.ws;
    const f32x4* LF = (const f32x4*)((const float*)(ws + WS_LOGF) + (size_t)wave * LP) + lane * 33;
    f32x4* CT = (f32x4*)((float*)(ws + WS_CCT) + (size_t)wave * LP) + lane * 33;
    f32x4 v[33]; float s = 0.f;
#pragma unroll
    for (int i = 0; i < 33; ++i) { v[i] = LF[i]; }
#pragma unroll
    for (int i = 0; i < 33; ++i) { s += (v[i][0] + v[i][1]) + (v[i][2] + v[i][3]); }
    float inc = s;
#pragma unroll
    for (int o = 1; o < 64; o <<= 1) { const float t = __shfl_up(inc, o); if (lane >= o) inc += t; }
    float run = inc - s;
#pragma unroll
    for (int i = 0; i < 33; ++i) { f32x4 o; run += v[i][0]; o[0] = run; run += v[i][1]; o[1] = run; run += v[i][2]; o[2] = run; run += v[i][3]; o[3] = run; CT[i] = o; }
}

__device__ __forceinline__ void phase_indexer(const Args& a, LAS unsigned char* lds, int gw, int NGW, int wave, int lane) {
    unsigned char* ws = a.ws;
    const bf16* PROJ = (const bf16*)(ws + WS_PROJ); const bf16* KI = (const bf16*)(ws + WS_KI); const float* WI = (const float*)(ws + WS_WI); float* S = (float*)(ws + WS_S);
    LAS float* qs = (LAS float*)(lds + wave * 8192);
    for (int qr = gw; qr < SEQ; qr += NGW) {
        const int pos = qr + NMETA;
        { const bf16* qrow = PROJ + (size_t)pos * PW + PC_QI + 16 * lane; const v4u w0 = *(const v4u*)qrow, w1 = *(const v4u*)(qrow + 8);
          LAS float* d = qs + 16 * lane;
          d[0] = bflo(w0.x); d[1] = bfhi(w0.x); d[2] = bflo(w0.y); d[3] = bfhi(w0.y); d[4] = bflo(w0.z); d[5] = bfhi(w0.z); d[6] = bflo(w0.w); d[7] = bfhi(w0.w);
          d[8] = bflo(w1.x); d[9] = bfhi(w1.x); d[10] = bflo(w1.y); d[11] = bfhi(w1.y); d[12] = bflo(w1.z); d[13] = bfhi(w1.z); d[14] = bflo(w1.w); d[15] = bfhi(w1.w);
          if (lane < 16) qs[1024 + lane] = WI[(size_t)pos * 16 + lane]; }
        LDS_WAIT(); asm volatile("" ::: "memory");
        float* Srow = S + s_row_off(qr);
        const int ntile = pos / 64 + 1;
        for (int j = 0; j < ntile; ++j) {
            const int key = j * 64 + lane;
            float kf[64];
            { const v4u* kp = (const v4u*)(KI + (size_t)key * 64);
#pragma unroll
              for (int c = 0; c < 8; ++c) { const v4u w = kp[c]; kf[8 * c] = bflo(w.x); kf[8 * c + 1] = bfhi(w.x); kf[8 * c + 2] = bflo(w.y); kf[8 * c + 3] = bfhi(w.y);
                  kf[8 * c + 4] = bflo(w.z); kf[8 * c + 5] = bfhi(w.z); kf[8 * c + 6] = bflo(w.w); kf[8 * c + 7] = bfhi(w.w); } }
            float score = 0.f;
#pragma unroll 1
            for (int h = 0; h < 16; ++h) { float d = 0.f;
#pragma unroll
                for (int c = 0; c < 16; ++c) { const f32x4 q = *(const LAS f32x4*)(qs + h * 64 + 4 * c); d += q[0] * kf[4 * c] + q[1] * kf[4 * c + 1] + q[2] * kf[4 * c + 2] + q[3] * kf[4 * c + 3]; }
                score += qs[1024 + h] * fmaxf(d, 0.f); }
            if (key <= pos) Srow[key] = score;
        }
        LDS_WAIT(); asm volatile("" ::: "memory");
    }
}


__device__ __forceinline__ void phase_indexer_mfma(const Args& a, LAS unsigned char* lds, int vcu, int G) {
    typedef float f32x16 __attribute__((ext_vector_type(16)));
    unsigned char* ws = a.ws;
    const bf16* PROJ = (const bf16*)(ws + WS_PROJ); const bf16* KI = (const bf16*)(ws + WS_KI); const float* WI = (const float*)(ws + WS_WI); float* S = (float*)(ws + WS_S);
    const int tid = threadIdx.x, wid = __builtin_amdgcn_readfirstlane(tid >> 6), lane = tid & 63, r32 = lane & 31, hi = lane >> 5;
    const int keyrow = 16 * ((r32 >> 2) & 1) + 4 * (r32 >> 3) + (r32 & 3);
    for (int sub = 0; sub < 2; ++sub)
    for (int it = vcu; it < 256; it += G) {
        const int qt = sub == 0 ? it : 255 - it;
        const int q0 = qt * 32, pos0 = q0 + NMETA, nkt = (pos0 + 31) / 32 + 1;
        const int klo = sub == 0 ? 0 : nkt / 2, khi = sub == 0 ? nkt / 2 : nkt;
        __syncthreads();
#pragma unroll
        for (int i = 0; i < 8; ++i) { const int c = tid + 512 * i, row = c >> 7, ch = c & 127;
            const v4u v = *(const v4u*)(PROJ + (size_t)(pos0 + row) * PW + PC_QI + ch * 8);
            *(LAS v4u*)(lds + (ch >> 1) * 1024 + (row + 32 * (ch & 1)) * 16) = v; }
        float w[16];
        { const f32x4* wp = (const f32x4*)(WI + (size_t)(pos0 + r32) * 16);
#pragma unroll
          for (int i = 0; i < 4; ++i) { const f32x4 t = wp[i]; w[4 * i] = t[0]; w[4 * i + 1] = t[1]; w[4 * i + 2] = t[2]; w[4 * i + 3] = t[3]; } }
        __syncthreads();
        float* Srow = S + s_row_off(q0 + r32) + 16 * hi;
        bf16x8 afn[4];
        { const int kt0 = klo + wid < khi ? klo + wid : 0;
#pragma unroll
          for (int ks = 0; ks < 4; ++ks) afn[ks] = *(const bf16x8*)(KI + (size_t)(kt0 * 32 + keyrow) * 64 + ks * 16 + 8 * hi); }
        for (int kt = klo + wid; kt < khi; kt += 8) {
            const int kb = kt * 32;
            bf16x8 af[4];
#pragma unroll
            for (int ks = 0; ks < 4; ++ks) af[ks] = afn[ks];
            { const int ktn = kt + 8 < khi ? kt + 8 : kt;
#pragma unroll
              for (int ks = 0; ks < 4; ++ks) afn[ks] = *(const bf16x8*)(KI + (size_t)(ktn * 32 + keyrow) * 64 + ks * 16 + 8 * hi); }
            f32x16 acc = {};
            bf16x8 bq[2][4]; f32x16 d[2];
            unsigned qoff = lane * 16; asm volatile("" : "+v"(qoff));
            const LAS unsigned char* qk = lds + qoff;
#pragma unroll
            for (int ks = 0; ks < 4; ++ks) bq[0][ks] = *(const LAS bf16x8*)(qk + ks * 1024);
#pragma unroll
            for (int h = 0; h < 17; ++h) {
                __builtin_amdgcn_sched_barrier(0);
                if (h < 16) { d[h & 1] = f32x16{};
#pragma unroll
                    for (int ks = 0; ks < 4; ++ks) d[h & 1] = __builtin_amdgcn_mfma_f32_32x32x16_bf16(af[ks], bq[h & 1][ks], d[h & 1], 0, 0, 0); }
                if (h < 15) {
#pragma unroll
                    for (int ks = 0; ks < 4; ++ks) bq[(h + 1) & 1][ks] = *(const LAS bf16x8*)(qk + ((h + 1) * 4 + ks) * 1024); }
                if (h > 0) {
#pragma unroll
                    for (int r = 0; r < 16; ++r) { const float dv = d[(h - 1) & 1][r]; const int xi = __float_as_int(dv); const float rl = __int_as_float(xi > 0 ? xi : 0);
                        float ar = acc[r]; asm("v_fmac_f32 %0, %1, %2" : "+v"(ar) : "v"(rl), "v"(w[h - 1])); acc[r] = ar; } }
            }
            __builtin_amdgcn_sched_barrier(0);
#pragma unroll
            for (int g = 0; g < 4; ++g) { const float x0 = acc[4 * g], x1 = acc[4 * g + 1], x2 = acc[4 * g + 2], x3 = acc[4 * g + 3]; *(v4u*)(Srow + kb + 4 * g) = (v4u){f2key(x0), f2key(x1), f2key(x2), f2key(x3)}; }
        }
    }
}

__device__ __forceinline__ int wave_incl_scan(int x) {
    x += __builtin_amdgcn_update_dpp(0, x, 0x111, 0xf, 0xf, false);
    x += __builtin_amdgcn_update_dpp(0, x, 0x112, 0xf, 0xf, false);
    x += __builtin_amdgcn_update_dpp(0, x, 0x114, 0xf, 0xf, false);
    x += __builtin_amdgcn_update_dpp(0, x, 0x118, 0xf, 0xf, false);
    x += __builtin_amdgcn_update_dpp(0, x, 0x142, 0xa, 0xf, false);
    x += __builtin_amdgcn_update_dpp(0, x, 0x143, 0xc, 0xf, false);
    return x;
}
#define SEL_CNT6(OP, c0, c1, c2, k0, k1, k2, k3, k4, k5, cand) do { unsigned long long m1_, m2_, m3_, m4_, m5_; \
    asm volatile(OP " vcc, %8, %9\n\t" OP " %3, %8, %10\n\t" OP " %4, %8, %11\n\t" OP " %5, %8, %12\n\t" OP " %6, %8, %13\n\t" OP " %7, %8, %14\n\t" \
                 "v_addc_co_u32 %0, vcc, 0, %0, vcc\n\tv_addc_co_u32 %1, %3, 0, %1, %3\n\tv_addc_co_u32 %2, %4, 0, %2, %4\n\t" \
                 "v_addc_co_u32 %0, %5, 0, %0, %5\n\tv_addc_co_u32 %1, %6, 0, %1, %6\n\tv_addc_co_u32 %2, %7, 0, %2, %7" \
                 : "+v"(c0), "+v"(c1), "+v"(c2), "=&s"(m1_), "=&s"(m2_), "=&s"(m3_), "=&s"(m4_), "=&s"(m5_) \
                 : "s"(cand), "v"(k0), "v"(k1), "v"(k2), "v"(k3), "v"(k4), "v"(k5) : "vcc"); } while (0)
__device__ __forceinline__ int sel_wave_total(int c) {
    int t = 0;
#pragma unroll
    for (int b = 0; b < 8; ++b) t += __popcll(__ballot((c >> b) & 1)) << b;
    return t;
}
__device__ __forceinline__ int sel_count_ge(const unsigned (&key)[NTILE64], unsigned cand, int nreg) {
    int c0 = 0, c1 = 0, c2 = 0;
#define SEL_G(g) SEL_CNT6("v_cmp_le_u32", c0, c1, c2, key[6 * (g)], key[6 * (g) + 1], key[6 * (g) + 2], key[6 * (g) + 3], key[6 * (g) + 4], key[6 * (g) + 5], cand)
#pragma unroll
    for (int g = 0; g < 6; ++g) SEL_G(g);
    if (nreg > 36) {
#pragma unroll
        for (int g = 6; g < 11; ++g) SEL_G(g);
        if (nreg > 66) {
#pragma unroll
            for (int g = 11; g < 16; ++g) SEL_G(g);
            if (nreg > 96) {
#pragma unroll
                for (int g = 16; g < 21; ++g) SEL_G(g);
                { unsigned z = 0u; SEL_CNT6("v_cmp_le_u32", c0, c1, c2, key[126], key[127], key[128], z, z, z, cand); }
            }
        }
    }
#undef SEL_G
    return sel_wave_total(c0 + c1 + c2);
}
__device__ __forceinline__ void sel_hist(const unsigned (&key)[NTILE64], int nreg, LAS unsigned* hist, unsigned prefix, int shift) {
#define SEL_H(j) do { const unsigned k = key[j]; const unsigned addr = (k >> shift) & 0xffu; \
        const unsigned inc = (((k ^ prefix) >> shift) >> 8) == 0u ? 1u : 0u; \
        __hip_atomic_fetch_add(hist + addr, inc, __ATOMIC_RELAXED, __HIP_MEMORY_SCOPE_WORKGROUP); } while (0)
#pragma unroll
    for (int j = 0; j < 36; ++j) SEL_H(j);
    if (nreg > 36) {
#pragma unroll
        for (int j = 36; j < 66; ++j) SEL_H(j);
        if (nreg > 66) {
#pragma unroll
            for (int j = 66; j < 96; ++j) SEL_H(j);
            if (nreg > 96) {
#pragma unroll
                for (int j = 96; j < NTILE64; ++j) SEL_H(j);
            }
        }
    }
#undef SEL_H
}
__device__ __forceinline__ void phase_select(const Args& a, LAS unsigned char* lds, int gw, int NGW, int wave, int lane) {
    unsigned char* ws = a.ws;
    const unsigned* S = (const unsigned*)(ws + WS_S); unsigned long long* MASK = (unsigned long long*)(ws + WS_MASK);
    LAS unsigned* hist = (LAS unsigned*)(lds + wave * 1024);
    for (int kq = 0; kq * NGW < SEQ; ++kq) {
        const int qr = kq * NGW + ((kq & 1) ? NGW - 1 - gw : gw);
        if (qr >= SEQ) continue;
        const int pos = qr + NMETA, n = pos + 1, nreg = __builtin_amdgcn_readfirstlane((n + 63) >> 6);
        const __amdgpu_buffer_rsrc_t rs = __builtin_amdgcn_make_buffer_rsrc((void*)(S + s_row_off(qr)), 0, n * 4, 0x00020000);
        unsigned key[NTILE64];
#define SEL_LD(j) key[j] = __builtin_amdgcn_raw_buffer_load_b32(rs, lane * 4, (j) * 256, 0)
#pragma unroll
        for (int j = 0; j < 36; ++j) SEL_LD(j);
        if (nreg > 36) {
#pragma unroll
            for (int j = 36; j < 66; ++j) SEL_LD(j);
            if (nreg > 66) {
#pragma unroll
                for (int j = 66; j < 96; ++j) SEL_LD(j);
                if (nreg > 96) {
#pragma unroll
                    for (int j = 96; j < NTILE64; ++j) SEL_LD(j);
                }
            }
        }
#undef SEL_LD
        unsigned T = 1u; int need = 0; bool ge_only = true;
        if (n > TOPK) {
            unsigned mx = 0u;
#pragma unroll
            for (int j = 0; j < 36; ++j) mx = key[j] > mx ? key[j] : mx;
            if (nreg > 36) {
#pragma unroll
                for (int j = 36; j < 66; ++j) mx = key[j] > mx ? key[j] : mx;
                if (nreg > 66) {
#pragma unroll
                    for (int j = 66; j < 96; ++j) mx = key[j] > mx ? key[j] : mx;
                    if (nreg > 96) {
#pragma unroll
                        for (int j = 96; j < NTILE64; ++j) mx = key[j] > mx ? key[j] : mx;
                    }
                }
            }
#pragma unroll
            for (int o = 1; o < 64; o <<= 1) { const unsigned t = (unsigned)__shfl_xor((int)mx, o); mx = t > mx ? t : mx; }
            int lo = (int)__builtin_amdgcn_readfirstlane((int)(mx >> 24)), hi = lo + 1, cge = 0, cabove = 0;
            for (int step = 1;; step *= 2) { const int c = sel_count_ge(key, (unsigned)lo << 24, nreg); if (c >= TOPK || lo == 0) { cge = c; break; } hi = lo; cabove = c; lo = lo - step > 0 ? lo - step : 0; }
            while (hi - lo > 1) { const int mid = (lo + hi) >> 1; const int c = sel_count_ge(key, (unsigned)mid << 24, nreg); if (c >= TOPK) { lo = mid; cge = c; } else { hi = mid; cabove = c; } }
            unsigned prefix = (unsigned)lo << 24;
            if (cge != TOPK) {
                for (int b = 23; b >= 0; --b) { const unsigned cand = prefix | (1u << b); const int c = sel_count_ge(key, cand, nreg); if (c >= TOPK) { prefix = cand; cge = c; if (c == TOPK) break; } }
            }
            T = prefix; ge_only = (cge == TOPK);
            if (!ge_only) need = TOPK - sel_count_ge(key, T + 1u, nreg);
        }
        unsigned w0l = 0u, w0h = 0u, w1l = 0u, w1h = 0u, w2l = 0u, w2h = 0u;
#define EM_WL2(dlo, dhi, vlo, vhi, l) asm volatile("s_nop 4\n\tv_writelane_b32 %0, %2, %4\n\tv_writelane_b32 %1, %3, %4" : "+v"(dlo), "+v"(dhi) : "s"(vlo), "s"(vhi), "n"(l))
#define EM_PUT(j, w) do { const unsigned lo_ = (unsigned)(w), hi_ = (unsigned)((w) >> 32); \
        if ((j) < 64) EM_WL2(w0l, w0h, lo_, hi_, (j)); else if ((j) < 128) EM_WL2(w1l, w1h, lo_, hi_, (j) - 64); else EM_WL2(w2l, w2h, lo_, hi_, (j) - 128); } while (0)
#define EM_GE(j) do { const unsigned long long w_ = __ballot(key[j] >= T); EM_PUT(j, w_); } while (0)
#define EM_TIE(j) do { unsigned long long w_ = __ballot(key[j] > T); \
        if (need > 0) { unsigned long long eq = __ballot(key[j] == T); int c = __popcll(eq); \
            while (c > need) { eq &= ~(1ull << (63 - __builtin_clzll(eq))); --c; } \
            w_ |= eq; need -= c; } \
        EM_PUT(j, w_); } while (0)
#define EM_TIERS(EM) do { _Pragma("unroll") for (int j = 0; j < 36; ++j) EM(j); \
        if (nreg > 36) { _Pragma("unroll") for (int j = 36; j < 66; ++j) EM(j); \
            if (nreg > 66) { _Pragma("unroll") for (int j = 66; j < 96; ++j) EM(j); \
                if (nreg > 96) { _Pragma("unroll") for (int j = 96; j < NTILE64; ++j) EM(j); } } } } while (0)
        if (ge_only) EM_TIERS(EM_GE); else EM_TIERS(EM_TIE);
#undef EM_TIERS
#undef EM_TIE
#undef EM_GE
#undef EM_PUT
#undef EM_WL2
        const unsigned long long w0 = ((unsigned long long)w0h << 32) | w0l, w1 = ((unsigned long long)w1h << 32) | w1l, w2 = ((unsigned long long)w2h << 32) | w2l;
        MASK[(size_t)lane * SEQ + qr] = w0; MASK[(size_t)(64 + lane) * SEQ + qr] = w1; if (lane == 0) MASK[(size_t)128 * SEQ + qr] = w2;
    }
}
#undef SEL_CNT6

template <bool DSAMODE>
__device__ __forceinline__ void attn_naive(const Args& a, LAS unsigned char* lds, int gw, int NGW, int wave, int lane) {
    unsigned char* ws = a.ws;
    const bf16* PROJ = (const bf16*)(ws + WS_PROJ); const bf16* KVA = (const bf16*)(ws + WS_KVA);
    const bf16* Q = DSAMODE ? PROJ + PC_QA : PROJ + PC_QB; const int ldq = PW;
    const bf16* Kp = DSAMODE ? KVA : PROJ + PC_KB; const int ldk = DSAMODE ? 2048 : PW;
    const bf16* Vp = DSAMODE ? KVA + 1024 : PROJ + PC_VB; const int ldv = DSAMODE ? 2048 : PW;
    bf16* O = (bf16*)(ws + (DSAMODE ? WS_YA : WS_YB));
    const unsigned long long* MASK = (const unsigned long long*)(ws + WS_MASK); const float* CC = (const float*)(ws + WS_CC);
    LAS float* qs = (LAS float*)(lds + wave * 1024);
    for (int item = gw; item < SEQ * NH; item += NGW) {
        const int qr = item >> 3, h = item & 7, pos = qr + NMETA;
        { const unsigned w = *(const unsigned*)(Q + (size_t)pos * ldq + h * 128 + 2 * lane); qs[2 * lane] = bflo(w) * (ATT_SCALE * LOG2E); qs[2 * lane + 1] = bfhi(w) * (ATT_SCALE * LOG2E); }
        LDS_WAIT(); asm volatile("" ::: "memory");
        const float cq = DSAMODE ? 0.f : CC[(size_t)pos * 8 + h];
        float m = -1e30f, l = 0.f, o0 = 0.f, o1 = 0.f;
        const int ntile = pos / 64 + 1;
        for (int j = 0; j < ntile; ++j) {
            const int key = j * 64 + lane; bool valid = key <= pos;
            if (DSAMODE) { const unsigned long long w = MASK[(size_t)j * SEQ + qr]; if (w == 0ull) continue; valid = valid && ((w >> lane) & 1ull); }
            float s = -__builtin_inff();
            if (valid) { const v4u* kp = (const v4u*)(Kp + (size_t)key * ldk + h * 128); float d = 0.f;
#pragma unroll
                for (int c = 0; c < 16; ++c) { const v4u w = kp[c]; const f32x4 q0 = *(const LAS f32x4*)(qs + 8 * c), q1 = *(const LAS f32x4*)(qs + 8 * c + 4);
                    d += q0[0] * bflo(w.x) + q0[1] * bfhi(w.x) + q0[2] * bflo(w.y) + q0[3] * bfhi(w.y) + q1[0] * bflo(w.z) + q1[1] * bfhi(w.z) + q1[2] * bflo(w.w) + q1[3] * bfhi(w.w); }
                s = d; if (!DSAMODE) s += (cq - CC[(size_t)key * 8 + h]) * LOG2E; }
            const float tmax = wave_max(s); const float mn = fmaxf(m, tmax); const float alpha = __builtin_amdgcn_exp2f(m - mn);
            const float p = valid ? __builtin_amdgcn_exp2f(s - mn) : 0.f;
            l = l * alpha + wave_sum(p); o0 *= alpha; o1 *= alpha; m = mn;
            unsigned long long pm = __ballot(p > 0.f);
            while (pm) { const int sl = __builtin_ctzll(pm); pm &= pm - 1; const float ps = __shfl(p, sl);
                const unsigned vv = *(const unsigned*)(Vp + (size_t)(j * 64 + sl) * ldv + h * 128 + 2 * lane); o0 += ps * bflo(vv); o1 += ps * bfhi(vv); }
        }
        const float rl = 1.f / l;
        *(unsigned*)(O + (size_t)qr * 1024 + h * 128 + 2 * lane) = pk2(o0 * rl, o1 * rl);
        LDS_WAIT(); asm volatile("" ::: "memory");
    }
}


constexpr int MOE_GU_ITEMS = NE * 32 * 32, MOE_D_ITEMS = NE * 8 * 64;
template <bool DOWN>
__device__ __forceinline__ void moe_item(const Args& a, int i, int lane, const float*& src, size_t& ldsrc, bf16*& dst, int& ldwt, int& k0, int& n0) {
    unsigned char* ws = a.ws;
    if (!DOWN) { const int e = i >> 10, r = i & 1023; const int kb = r / 32, nb = r % 32; const int n = nb * 32 + (lane & 31); const int pn = n >> 8, half = (n >> 7) & 1, j = n & 127;
        src = (half ? a.in[I_WUP] : a.in[I_WGATE]) + (size_t)e * 2048 * 512 + 128 * pn + j; ldsrc = 512; dst = (bf16*)(ws + WS_WGUT) + (size_t)e * 1024 * 2048; ldwt = 2048; k0 = 64 * kb; n0 = 32 * nb; }
    else { const int e = i >> 9, r = i & 511; const int kb = r / 64, nb = r % 64;
        src = a.in[I_WDOWN] + (size_t)e * 512 * 2048 + nb * 32 + (lane & 31); ldsrc = 2048; dst = (bf16*)(ws + WS_WDT) + (size_t)e * 2048 * 512; ldwt = 512; k0 = 64 * kb; n0 = 32 * nb; }
}
template <bool DOWN>
__device__ __forceinline__ void moe_copy_pair(const Args& a, LAS float* scr, int i0, int i1  , int lane) {
    const float* s0; size_t l0; bf16* d0; int w0, k0, n0; moe_item<DOWN>(a, i0, lane, s0, l0, d0, w0, k0, n0);
    const bool two = i1 >= 0;
    const float* s1; size_t l1; bf16* d1; int w1, k1, n1; moe_item<DOWN>(a, two ? i1 : i0, lane, s1, l1, d1, w1, k1, n1);
    float va[32], vb[32];
    tr_load(va, s0, l0, k0, lane); tr_load(vb, s1, l1, k1, lane);
    tr_fence(va); tr_fence(vb);
    tr_store(va, d0, w0, k0, n0, scr, lane);
    if (two) tr_store(vb, d1, w1, k1, n1, scr, lane);
}

constexpr size_t WS_PART = WS_R + 32 * MiB;
constexpr int CW_AQ = 2048;
constexpr int N_DSA_ENT = 48, N_ATT_ITEMS = N_DSA_ENT * 8 + 256;
constexpr int N_COPY_POPS = MOE_GU_ITEMS / 64;
__device__ const unsigned char DSA_ENT[N_DSA_ENT] = {125, 60, 126, 121, 122, 117, 56, 118, 113, 114, 109, 52, 110, 105, 106, 101, 48, 102, 97, 98, 93, 44, 94, 89, 90, 85, 40, 86, 81, 82, 77, 36, 78, 73, 74, 69, 32, 70, 65, 66, 28, 24, 20, 16, 12, 8, 4, 0};
template <int MODE>
__device__ __forceinline__ void attn_item(unsigned char* ws, char* lds, int h, int b, int kind) {
    constexpr int LDKV = MODE ? 2048 : PW;
    att::ItemRef r; r.P0 = NMETA + 256 * b;
    const bf16* PROJ = (const bf16*)(ws + WS_PROJ); const bf16* KVA = (const bf16*)(ws + WS_KVA);
    r.Q = PROJ + (size_t)r.P0 * PW + (MODE ? PC_QA : PC_QB) + h * 128;
    r.K = MODE ? KVA + h * 128 : PROJ + PC_KB + h * 128;
    r.V = MODE ? KVA + 1024 + h * 128 : PROJ + PC_VB + h * 128;
    r.O = (bf16*)(ws + WS_YA) + (size_t)(256 * b) * 2048 + (MODE ? 0 : 1024) + h * 128;
    r.cb = (const float*)(ws + WS_CCT) + (size_t)h * LP; r.cref = MODE ? 0.f : r.cb[r.P0];
    r.mk = (const unsigned long long*)(ws + WS_MASK) + 256 * b;
    const int NT = 4 * b + 5, half = (NT + 1) / 2;
    r.t_lo = kind == 2 ? half : 0; r.t_hi = kind == 1 ? half : NT;
    r.kn2 = MODE ? 0.f : __uint_as_float(((const unsigned*)(ws + WS_CTL))[CW_KMAX + h]);
    r.part = kind ? (float*)(ws + WS_PART) + (size_t)(((h * 16 + (b - 16)) * 2) + (kind - 1)) * att::PART_FLOATS : nullptr;
    att::run_item<MODE, PW, LDKV, 2048>(r, lds);
}
__device__ __forceinline__ void phase_attn(const Args& a, char* lds, volatile LAS int* qslot) {
    unsigned* qh = (unsigned*)(a.ws + WS_CTL) + CW_AQ;
    for (;;) {
        if (threadIdx.x == 0) qslot[0] = (int)__hip_atomic_fetch_add(qh, 1u, RLX_AGENT);
        __syncthreads();
        const int it = qslot[0];
        __syncthreads();
        if (it >= N_ATT_ITEMS + N_COPY_POPS) break;
        int ai = it - N_COPY_POPS;
        if (it < 3 * N_COPY_POPS) {
            if (it % 3 == 2) {
                int tid_ = threadIdx.x; asm volatile("" : "+v"(tid_)); const int lane = tid_ & 63, wave = __builtin_amdgcn_readfirstlane(tid_ >> 6);
                LAS float* scr = (LAS float*)((LAS char*)lds + wave * 16384);
                const int c = it / 3;
#pragma unroll 1
                for (int k = 0; k < 8; k += 2) moe_copy_pair<false>(a, scr, c * 64 + wave + 8 * k, c * 64 + wave + 8 * (k + 1), lane);
                continue;
            }
            ai = (it / 3) * 2 + it % 3;
        }
        if (ai < N_DSA_ENT * 8) { const int e = DSA_ENT[ai >> 3]; attn_item<1>(a.ws, lds, ai & 7, e >> 2, e & 3); }
        else { const int j = ai - N_DSA_ENT * 8; attn_item<0>(a.ws, lds, j & 7, 31 - (j >> 3), 0); }
    }
}
__device__ __forceinline__ void phase_attn_combine(const Args& a, char* lds, int vcu, int G) {
    for (int sl = vcu; sl < 128; sl += G) { const int h = sl >> 4, b = 16 + (sl & 15);
        const float* p1 = (const float*)(a.ws + WS_PART) + (size_t)(sl * 2) * att::PART_FLOATS;
        att::combine_item<2048>(p1, p1 + att::PART_FLOATS, (bf16*)(a.ws + WS_YA) + (size_t)(256 * b) * 2048 + h * 128, lds); }
}

__device__ __forceinline__ float wave_total_f(float v) {
    v += __builtin_bit_cast(float, __builtin_amdgcn_update_dpp(0, __builtin_bit_cast(int, v), 0x111, 0xf, 0xf, false));
    v += __builtin_bit_cast(float, __builtin_amdgcn_update_dpp(0, __builtin_bit_cast(int, v), 0x112, 0xf, 0xf, false));
    v += __builtin_bit_cast(float, __builtin_amdgcn_update_dpp(0, __builtin_bit_cast(int, v), 0x114, 0xf, 0xf, false));
    v += __builtin_bit_cast(float, __builtin_amdgcn_update_dpp(0, __builtin_bit_cast(int, v), 0x118, 0xf, 0xf, false));
    v += __builtin_bit_cast(float, __builtin_amdgcn_update_dpp(0, __builtin_bit_cast(int, v), 0x142, 0xa, 0xf, false));
    v += __builtin_bit_cast(float, __builtin_amdgcn_update_dpp(0, __builtin_bit_cast(int, v), 0x143, 0xc, 0xf, false));
    return __builtin_bit_cast(float, __builtin_amdgcn_readlane(__builtin_bit_cast(int, v), 63));
}
__device__ __forceinline__ void phase_route(const Args& a, volatile LAS int* lcnt  , int gw, int NGW, int lane) {
    unsigned char* ws = a.ws;
    const float* H2 = (const float*)(ws + WS_H2); bf16* T = (bf16*)(ws + WS_T); unsigned* cnt = (unsigned*)(ws + WS_CTL) + CW_CNT;
    const f32x4* gf = (const f32x4*)a.in[I_GFFN]; const __amdgpu_buffer_rsrc_t wrs = __builtin_amdgcn_make_buffer_rsrc((void*)(ws + WS_WRT), 0, 20 * 2048 * 4, 0x00020000);
    const int ngroups = (SEQ + 4 * NGW - 1) / (4 * NGW);
    for (int grp = 0; grp < ngroups; ++grp) {
        const int t0 = gw + grp * 4 * NGW;
        int tok[4]; float rstd[4]; bool live[4];
#pragma unroll
        for (int q = 0; q < 4; ++q) { tok[q] = t0 + q * NGW; live[q] = tok[q] < SEQ; if (!live[q]) tok[q] = 0; }
        if (threadIdx.x < 16) lcnt[threadIdx.x] = 0;
        __syncthreads();
        { float sv[4];
#pragma unroll
          for (int q = 0; q < 4; ++q) sv[q] = ((const float*)(ws + WS_SQ2))[(size_t)tok[q] * 64 + lane];
#pragma unroll
          for (int q = 0; q < 4; ++q) rstd[q] = 1.f / sqrtf(wave_total_f(sv[q]) * (1.f / 2048.f) + EPS); }
        float lg[4][20];
#pragma unroll
        for (int q = 0; q < 4; ++q)
#pragma unroll
            for (int i = 0; i < 20; ++i) lg[q][i] = 0.f;
#pragma unroll 1
        for (int j = 0; j < 8; ++j) {
            int ln = lane + 64 * j; asm volatile("" : "+v"(ln));
            f32x4 hv[4], wt[20]; const f32x4 g = gf[ln];
#pragma unroll
            for (int q = 0; q < 4; ++q) hv[q] = ((const f32x4*)(H2 + (size_t)tok[q] * 2048))[ln];
#pragma unroll
            for (int e = 0; e < 20; ++e) wt[e] = __builtin_bit_cast(f32x4, __builtin_amdgcn_raw_buffer_load_b128(wrs, ln * 16, e * 8192, 0));
            asm volatile("" : "+v"(hv[0]), "+v"(hv[1]), "+v"(hv[2]), "+v"(hv[3]));
#pragma unroll
            for (int e = 0; e < 20; e += 5) asm volatile("" : "+v"(wt[e]), "+v"(wt[e + 1]), "+v"(wt[e + 2]), "+v"(wt[e + 3]), "+v"(wt[e + 4]));
            f32x4 t[4];
#pragma unroll
            for (int q = 0; q < 4; ++q) {
                t[q][0] = hv[q][0] * rstd[q] * g[0]; t[q][1] = hv[q][1] * rstd[q] * g[1]; t[q][2] = hv[q][2] * rstd[q] * g[2]; t[q][3] = hv[q][3] * rstd[q] * g[3];
                v2u o; o.x = pk2(t[q][0], t[q][1]); o.y = pk2(t[q][2], t[q][3]); if (live[q]) *(v2u*)(T + (size_t)tok[q] * 2048 + 4 * ln) = o; }
#pragma unroll
            for (int c = 0; c < 4; ++c)
#pragma unroll
                for (int q = 0; q < 4; ++q)
#pragma unroll
                    for (int e = 0; e < 20; ++e) lg[q][e] += t[q][c] * wt[e][c]; }
        int e0v[4], e1v[4], s0v[4], s1v[4]; float w0v[4], w1v[4];
#pragma unroll
        for (int q = 0; q < 4; ++q) {
            float l20[20];
#pragma unroll
            for (int i = 0; i < 20; ++i) l20[i] = wave_total_f(lg[q][i]);
            float gl[4];
#pragma unroll
            for (int i = 0; i < 4; ++i) gl[i] = l20[i] + a.in[I_BGROUP][i];
            int gs = 0; float gmx = gl[0];
#pragma unroll
            for (int i = 1; i < 4; ++i) if (gl[i] > gmx) { gmx = gl[i]; gs = i; }
            float den = 0.f;
#pragma unroll
            for (int i = 0; i < 4; ++i) den += expf(gl[i] - gmx);
            const float pg = 1.f / den;
            float el[4];
#pragma unroll
            for (int i = 0; i < 4; ++i) { el[i] = 0.f;
#pragma unroll
                for (int g = 0; g < 4; ++g) if (gs == g) el[i] = l20[4 + 4 * g + i] + a.in[I_BEXPERT][4 * g + i]; }
            int i0 = 0; float m0 = el[0];
#pragma unroll
            for (int i = 1; i < 4; ++i) if (el[i] > m0) { m0 = el[i]; i0 = i; }
            int i1 = -1; float m1 = -__builtin_inff();
#pragma unroll
            for (int i = 0; i < 4; ++i) if (i != i0 && el[i] > m1) { m1 = el[i]; i1 = i; }
            const float ex = expf(m1 - m0); const float p0 = 1.f / (1.f + ex), p1 = ex / (1.f + ex);
            e0v[q] = gs * 4 + i0; e1v[q] = gs * 4 + i1; w0v[q] = pg * p0; w1v[q] = pg * p1; s0v[q] = 0; s1v[q] = 0;
            if (lane == 0 && live[q]) { s0v[q] = __hip_atomic_fetch_add((LAS int*)lcnt + e0v[q], 1, __ATOMIC_RELAXED, __HIP_MEMORY_SCOPE_WORKGROUP);
                                        s1v[q] = __hip_atomic_fetch_add((LAS int*)lcnt + e1v[q], 1, __ATOMIC_RELAXED, __HIP_MEMORY_SCOPE_WORKGROUP); }
        }
        __syncthreads();
        if (threadIdx.x < 16) { const int c = lcnt[threadIdx.x]; lcnt[16 + threadIdx.x] = c ? (int)__hip_atomic_fetch_add(cnt + 64 * threadIdx.x, (unsigned)c, RLX_AGENT) : 0; }
        __syncthreads();
        if (lane == 0) {
#pragma unroll
            for (int q = 0; q < 4; ++q) if (live[q]) { int* RT = (int*)(ws + WS_ROWTOK); float* RW = (float*)(ws + WS_ROWW);
                const int i0 = e0v[q] * 8192 + lcnt[16 + e0v[q]] + s0v[q], i1 = e1v[q] * 8192 + lcnt[16 + e1v[q]] + s1v[q];
                RT[i0] = tok[q] * 2; RW[i0] = w0v[q]; RT[i1] = tok[q] * 2 + 1; RW[i1] = w1v[q]; }
        }
        __syncthreads();
    }
}
__device__ __forceinline__ void moe_tile_bases(const Args& a, volatile LAS int* tb) {
    if (threadIdx.x == 0) { const unsigned* cnt = (const unsigned*)(a.ws + WS_CTL) + CW_CNT; int acc = 0;
        for (int e = 0; e < 16; ++e) { tb[e] = acc; acc += (int)((__hip_atomic_load(cnt + 64 * e, RLX_AGENT) + 255u) >> 8); } tb[16] = acc; }
    __syncthreads();
}
__device__ __forceinline__ void phase_final(const Args& a, int gw, int NGW, int lane) {
    unsigned char* ws = a.ws;
    const float* H2 = (const float*)(ws + WS_H2); const bf16* Y = (const bf16*)(ws + WS_Y); const f32x4* gf = (const f32x4*)a.in[I_GFINAL];
    for (int tok = gw; tok < SEQ; tok += NGW) {
        const f32x4* hr = (const f32x4*)(H2 + (size_t)tok * 2048); const v2u* y0 = (const v2u*)(Y + (size_t)tok * 2048); const v2u* y1 = (const v2u*)(Y + ((size_t)SEQ + tok) * 2048);
        f32x4 v[8]; float s = 0.f;
#pragma unroll
        for (int j = 0; j < 8; ++j) { const f32x4 hv = hr[lane + 64 * j]; const v2u a0 = y0[lane + 64 * j], a1 = y1[lane + 64 * j];
            v[j][0] = hv[0] + bflo(a0.x) + bflo(a1.x); v[j][1] = hv[1] + bfhi(a0.x) + bfhi(a1.x); v[j][2] = hv[2] + bflo(a0.y) + bflo(a1.y); v[j][3] = hv[3] + bfhi(a0.y) + bfhi(a1.y);
            s += (v[j][0] * v[j][0] + v[j][1] * v[j][1]) + (v[j][2] * v[j][2] + v[j][3] * v[j][3]); }
        const float rstd = 1.f / sqrtf(wave_sum(s) * (1.f / 2048.f) + EPS);
        f32x4* orow = (f32x4*)(a.out + (size_t)tok * 2048);
        float pscale = 1.f;
        if (PROBE_TS_A >= 0) { const unsigned long long* tsp = (const unsigned long long*)(a.ws + WS_CTL + 65536); const float tq = floorf((float)(tsp[PROBE_TS_B] - tsp[PROBE_TS_A]) * (0.01f / 16.f) + 0.5f) * 16.f; pscale = 1.f + tq / PROBE_TS_SCALE_US; }
        const float rs2 = rstd * pscale;
#pragma unroll
        for (int j = 0; j < 8; ++j) { const f32x4 g = gf[lane + 64 * j]; orow[lane + 64 * j] = (f32x4){v[j][0] * rs2 * g[0], v[j][1] * rs2 * g[1], v[j][2] * rs2 * g[2], v[j][3] * rs2 * g[3]}; }
    }
}

__global__ void __launch_bounds__(NWAVES * 64, 2) mk_fwd(Args args) {
    extern __shared__ __attribute__((aligned(16))) unsigned char lds_raw[];
    LAS unsigned char* lds = (LAS unsigned char*)lds_raw;
    volatile LAS unsigned* MISC = (volatile LAS unsigned*)(lds + MISC_OFF);
    volatile LAS int* TB = (volatile LAS int*)(lds + MISC_OFF + 64);
    const int tid = threadIdx.x;
    const int G = gridDim.x; const int bx = blockIdx.x; const int vcu = (G % 8 == 0) ? (bx % 8) * (G / 8) + bx / 8 : bx;
    const int NGW = G * NWAVES;
#define TIDS() int tid_ = threadIdx.x; asm volatile("" : "+v"(tid_)); const int lane = tid_ & 63, wave = __builtin_amdgcn_readfirstlane(tid_ >> 6), gw = vcu * NWAVES + wave; (void)lane; (void)gw;
    unsigned char* ws = args.ws;
    gu32* ctl = (gu32*)(ws + WS_CTL);
    for (int u = tid; u < (LDS_BYTES - LDSCTL_OFF) / 4; u += NWAVES * 64) ((LAS unsigned*)(lds + LDSCTL_OFF))[u] = 0u;
    __syncthreads();
    XcdBarrier bar; bar.bar = (unsigned*)(ctl + CW_BAR); bar.x = 0; bar.st = nullptr;
    if (MK_ONE_LAUNCH) bar = xcd_barrier_post((unsigned*)(ctl + CW_BAR), MISC + 8);
    const int lo = args.ph_lo, hi = args.ph_hi;
#ifndef PHASE_MASK
#define PHASE_MASK 0x3fff
#endif

#define REP(k) for (int rep_ = 0; rep_ < ((PROBE_DOUBLE == (k)) ? 2 : 1); ++rep_)
#define IN(k) (((PHASE_MASK >> (k)) & 1) && lo <= (k) && (k) < hi)
#define SEAM(k) do { if (IN(k) && IN((k) + 1)) xcd_barrier(bar); } while (0)

    const int nfull = ((SEQ / 256) * (PW / 256)) % G; const bool late_copies = nfull > 0 && G - nfull >= 16; const int cb0 = late_copies ? nfull + 6 : 0;
    TS(0); if (IN(0)) REP(0) { TIDS(); phase_prologue(args, lds, gw, NGW, wave, lane, late_copies ? PC_I_IN : PC_NITEMS); } SEAM(0);
    TS(1); if (IN(1)) REP(1) {
        pg8::Gemm g{(const bf16*)(ws + WS_HN) + (size_t)NMETA * 2048, (const bf16*)(ws + WS_WINT), 2048, 2048, 2048, nullptr}; pg8::StaticOrder S; S.init(SEQ / 256, PW / 256, G, bx);
        EpiProj E{(bf16*)(ws + WS_PROJ), (float*)(ws + WS_SMALL), (const float*)(ws + WS_ROPE128), (const float*)(ws + WS_ROPE64), (float*)(ws + WS_SSQ)};
        pg8::gemm_phase(lds + RING_OFF, g, S, E);
        { TIDS(); meta_inproj(args, ((bx + 32) % G) * NWAVES + wave, NGW, lane);
          if (late_copies && bx >= cb0) { __syncthreads(); copy_items(args, lds, PC_I_IN, PC_NITEMS, (bx - cb0) * NWAVES + wave, (G - cb0) * NWAVES, wave, lane); } }
    } SEAM(1);
    TS(2); if (IN(2)) REP(2) {
        { TIDS(); phase_minipost(args, (volatile LAS unsigned*)(lds + MISC_OFF + 640), gw, NGW, lane); }
        pg8::Gemm g{(const bf16*)(ws + WS_PROJ) + (size_t)NMETA * PW + PC_CKV, (const bf16*)(ws + WS_WKVT), PW, 512, 512, nullptr}; pg8::StaticOrder S; S.init(SEQ / 256, 8, G, bx);
        EpiKvUp E{(bf16*)(ws + WS_KVA), (const float*)(ws + WS_ROPE128), (const float*)(ws + WS_SSQ)};
        pg8::gemm_phase(lds + RING_OFF, g, S, E);
    } SEAM(2);
    TS(3); if (IN(3)) REP(3) { if (vcu < 8) { TIDS(); if (wave == 0) phase_cumsum(args, vcu, lane); else if (wave <= 4) meta_kvup(args, vcu * 4 + (wave - 1), 32, lane); } phase_indexer_mfma(args, lds + RING_OFF, vcu, G); } SEAM(3);
    TS(4); if (IN(4)) REP(4) { TIDS(); phase_select(args, lds + RING_OFF, gw, NGW, wave, lane); } SEAM(4);
    TS(5); if (IN(5)) REP(5) { phase_attn(args, (char*)lds_raw + RING_OFF, (volatile LAS int*)(lds + MISC_OFF + 512)); } SEAM(5);
    TS(6); if (IN(6)) REP(6) { phase_attn_combine(args, (char*)lds_raw + RING_OFF, vcu, G);
        { const int c0 = G >= 256 ? 128 : 0;
          if (vcu >= c0) { TIDS(); __syncthreads(); LAS float* scr = (LAS float*)(lds + RING_OFF + wave * 16384); const int gwv = (vcu - c0) * NWAVES + wave, ngwv = (G - c0) * NWAVES;
#pragma unroll 1
              for (int i = gwv; i < MOE_D_ITEMS; i += 2 * ngwv) moe_copy_pair<true>(args, scr, i, i + ngwv < MOE_D_ITEMS ? i + ngwv : -1, lane); } }
    } SEAM(6);
    TS(7); if (IN(7)) REP(7) {
        pg8::Gemm g{(const bf16*)(ws + WS_YA), (const bf16*)(ws + WS_WAT), 2048, 2048, 2048, nullptr}; pg8::StaticOrder S; S.init(SEQ / 256, 8, G, bx);
        EpiBranchFused E{(const bf16*)(ws + WS_PROJ), (bf16*)(ws + WS_MERGED)};
        pg8::gemm_phase(lds + RING_OFF, g, S, E);
    } SEAM(7);
    TS(8); if (IN(8)) REP(8) {
        { TIDS(); for (int i = gw * 64 + lane; i < 20 * 2048; i += NGW * 64) { const int e = i >> 11, k = i & 2047;
              ((float*)(ws + WS_WRT))[i] = e < 4 ? args.in[I_WGROUP][k * 4 + e] : args.in[I_WEXPERT][k * 16 + (e - 4)]; }
          for (int i = gw * 64 + lane; i < 16 * 8192; i += NGW * 64) ((int*)(ws + WS_ROWTOK))[i] = -1; }
        pg8::Gemm g{(const bf16*)(ws + WS_MERGED), (const bf16*)(ws + WS_WOT), 2048, 2048, 2048, nullptr}; pg8::StaticOrder S; S.init(SEQ / 256, 8, G, bx);
        EpiOut E{args.in[I_X], (float*)(ws + WS_H2), (float*)(ws + WS_SQ2)};
        pg8::gemm_phase(lds + RING_OFF, g, S, E);
    } SEAM(8);
    TS(9); if (IN(9)) REP(9) { TIDS(); phase_route(args, (volatile LAS int*)(lds + MISC_OFF + 256), gw, NGW, lane); } SEAM(9);
    TS(10); if (IN(10)) REP(10) {
        moe_tile_bases(args, TB); const int nrt = TB[16];
        pg8::Gemm g{(const bf16*)(ws + WS_T), (const bf16*)(ws + WS_WGUT), 2048, 2048, 2048, (const int*)(ws + WS_ROWTOK)}; pg8::MoeOrder S; S.init(0, nrt < 64 ? nrt : 64, 4, G, bx, (const LAS int*)TB, (size_t)1024 * 2048 * 2);
        EpiGateUp E{(bf16*)(ws + WS_ACT), (const float*)(ws + WS_ROWW)};
        pg8::gemm_phase<EpiGateUp, pg8::MoeOrder, true>(lds + RING_OFF, g, S, E);
    } SEAM(10);
    TS(11); if (IN(11)) REP(11) {
        moe_tile_bases(args, TB); const int nrt = TB[16]; const int ngu = nrt > 64 ? (nrt - 64) * 4 : 0; const int ngb = ngu < G / 2 ? ngu : G / 2;
        { pg8::Gemm g{(const bf16*)(ws + WS_T), (const bf16*)(ws + WS_WGUT), 2048, 2048, 2048, (const int*)(ws + WS_ROWTOK)}; pg8::MoeOrder S; S.init(64, nrt - 64, 4, ngb, bx < ngb ? bx : -1, (const LAS int*)TB, (size_t)1024 * 2048 * 2);
          EpiGateUp E{(bf16*)(ws + WS_ACT), (const float*)(ws + WS_ROWW)};
          pg8::gemm_phase<EpiGateUp, pg8::MoeOrder, true>(lds + RING_OFF, g, S, E); }
        { pg8::Gemm g{(const bf16*)(ws + WS_ACT), (const bf16*)(ws + WS_WDT), 512, 512, 512, nullptr}; pg8::MoeOrder S; S.init(0, nrt < 64 ? nrt : 64, 8, G - ngb, bx - ngb, (const LAS int*)TB, (size_t)2048 * 512 * 2);
          EpiDown E{(bf16*)(ws + WS_Y), (const int*)(ws + WS_ROWTOK)};
          pg8::gemm_phase(lds + RING_OFF, g, S, E); }
    } SEAM(11);
    TS(12); if (IN(12)) REP(12) {
        moe_tile_bases(args, TB); const int nrt = TB[16];
        pg8::Gemm g{(const bf16*)(ws + WS_ACT), (const bf16*)(ws + WS_WDT), 512, 512, 512, nullptr}; pg8::MoeOrder S; S.init(64, nrt - 64, 8, G, bx, (const LAS int*)TB, (size_t)2048 * 512 * 2);
        EpiDown E{(bf16*)(ws + WS_Y), (const int*)(ws + WS_ROWTOK)};
        pg8::gemm_phase(lds + RING_OFF, g, S, E);
    } SEAM(12);
    TS(13); if (IN(13)) REP(13) { TIDS(); phase_final(args, gw, NGW, lane); }
    TS(14);
#undef IN
#undef SEAM
}

extern "C" void kernel_launch(void* const* d_in, const int* in_sizes, int n_in, void* d_out, int out_size, void* d_ws, size_t ws_size, hipStream_t stream) {
    static int grid = 0;
    if (grid == 0) {
        if (n_in != 20 || out_size != SEQ * DM || ws_size < WS_NEED) { fprintf(stderr, "kernel_launch: unexpected shapes (n_in %d, out %d, ws %zu need %zu)\n", n_in, out_size, ws_size, (size_t)WS_NEED); grid = -1; return; }
        int dev = 0, cus = 0;
        if (hipGetDevice(&dev) != hipSuccess || hipDeviceGetAttribute(&cus, hipDeviceAttributeMultiprocessorCount, dev) != hipSuccess) { grid = -1; return; }
        if (hipFuncSetAttribute((const void*)mk_fwd, hipFuncAttributeMaxDynamicSharedMemorySize, LDS_BYTES) != hipSuccess) { fprintf(stderr, "kernel_launch: hipFuncSetAttribute failed\n"); grid = -1; return; }
        int per_cu = 0;
        if (hipOccupancyMaxActiveBlocksPerMultiprocessor(&per_cu, (const void*)mk_fwd, NWAVES * 64, LDS_BYTES) != hipSuccess || per_cu < 1) fprintf(stderr, "kernel_launch: occupancy query says %d\n", per_cu);
        (void)hipGetLastError();
        grid = cus;
    }
    if (grid < 0) return;
    (void)hipMemsetAsync((char*)d_ws + WS_CTL, 0, CTL_ZERO_BYTES, stream);
    Args a{};
    for (int i = 0; i < 20; ++i) a.in[i] = (const float*)d_in[i];
    a.out = (float*)d_out; a.ws = (unsigned char*)d_ws;
    if (MK_ONE_LAUNCH) {
        a.ph_lo = 0; a.ph_hi = NPHASE; a.li = 0;
        hipLaunchKernelGGL(mk_fwd, dim3(grid), dim3(NWAVES * 64), LDS_BYTES, stream, a);
    } else {
        for (int p = 0; p < NPHASE; ++p) { a.ph_lo = p; a.ph_hi = p + 1; a.li = p; hipLaunchKernelGGL(mk_fwd, dim3(grid), dim3(NWAVES * 64), LDS_BYTES, stream, a); }
    }
}
```

```cpp
#include <hip/hip_runtime.h>
#include <hip/hip_bf16.h>
#include <cstdio>
#include <cstdint>

#ifndef MK_ONE_LAUNCH
#define MK_ONE_LAUNCH 1
#endif
#define PROBE_DOUBLE -1
#ifndef PROBE_TS_A
#define PROBE_TS_A -1
#define PROBE_TS_B -1
#endif
#define PROBE_TS_SCALE_US 3000.0f
#ifndef PROBE_TS_BLOCK
#define PROBE_TS_BLOCK 0
#endif
#define TSA(a_, i) do { if (PROBE_TS_A >= 0 && blockIdx.x == PROBE_TS_BLOCK && threadIdx.x == 0) ((unsigned long long*)((a_).ws + WS_CTL + 65536))[i] = __builtin_amdgcn_s_memrealtime(); } while (0)
#define TS(i) do { if (PROBE_TS_A >= 0 && blockIdx.x == PROBE_TS_BLOCK && threadIdx.x == 0) ((unsigned long long*)(args.ws + WS_CTL + 65536))[i] = __builtin_amdgcn_s_memrealtime(); } while (0)

namespace pg8 {
#define PG8_LAS __attribute__((address_space(3)))
typedef unsigned short bf16_t;
typedef short bf16x8 __attribute__((ext_vector_type(8)));
typedef float f32x4 __attribute__((ext_vector_type(4)));
typedef unsigned u32x4 __attribute__((ext_vector_type(4)));
constexpr int BM = 256, BK = 64, HALF = 128, HTB = HALF * BK * 2, STAGE_BYTES = 8 * HTB, NXCD = 8, WGM = 8;

__host__ __device__ __forceinline__ int lds_byte(int r, int c) { const int st = (r >> 4) * 2 + (c >> 5), rr = r & 15, cc = c & 31, ob = rr * 64 + cc * 2; return st * 1024 + (ob ^ (((ob >> 9) & 1) << 5)); }
__host__ __device__ __forceinline__ void stage_rc(int b, int& R, int& C) { const int st = b / 1024, sb = b % 1024, swz = sb ^ (((sb >> 9) & 1) << 5); R = (st >> 1) * 16 + swz / 64; C = (st & 1) * 32 + (swz % 64) / 2; }
__host__ __device__ __forceinline__ int perm32(int rho) { const int n = rho >> 4, i = rho & 15; return 8 * (i >> 2) + 4 * n + (i & 3); }

struct Unit { int pm, pn; size_t bofs; int rb; };
struct Gemm { const bf16_t* A; const bf16_t* Bt; int lda, ldb, K; const int* rowsrc; };

struct StaticOrder {
    int nM, nN, nwg, G, c;
    __device__ void init(int nM_, int nN_, int G_, int c_) { nM = nM_; nN = nN_; nwg = nM * nN; G = G_; c = c_; }
    __device__ bool next(int i, Unit& u) const {
        const long L = (long)i * G + c; if (L >= nwg) return false;
        int wgid = (int)L; { const int q = nwg / NXCD, r = nwg % NXCD, xcd = wgid % NXCD, off = wgid / NXCD; wgid = (xcd < r ? xcd * (q + 1) : r * (q + 1) + (xcd - r) * q) + off; }
        const int nig = WGM * nN, gid = wgid / nig, fm = gid * WGM, gsz = (nM - fm) < WGM ? (nM - fm) : WGM;
        u.pm = fm + ((wgid % nig) % gsz); u.pn = (wgid % nig) / gsz; u.bofs = 0; u.rb = u.pm * 256; return true;
    }
};
struct MoeOrder {
    int pm_lo, nN, nwg, G, c; const PG8_LAS int* tb; size_t bstride;
    __device__ void init(int pm_lo_, int npm, int nN_, int G_, int c_, const PG8_LAS int* tb_, size_t bs) { pm_lo = pm_lo_; nN = nN_; nwg = (npm > 0 && c_ >= 0 && c_ < G_) ? npm * nN_ : 0; G = G_; c = c_; tb = tb_; bstride = bs; }
    __device__ bool next(int i, Unit& u) const {
        const long L = (long)i * G + c; if (c < 0 || L >= nwg) return false;
        const int wgid = (int)L;
        u.pn = wgid % nN; u.pm = pm_lo + wgid / nN;
        int e = 0;
#pragma unroll
        for (int k = 1; k < 16; ++k) e += (tb[k] <= u.pm) ? 1 : 0;
        u.bofs = (size_t)e * bstride; u.rb = e * 8192 + (u.pm - tb[e]) * 256; return true;
    }
};

__device__ __forceinline__ unsigned cvt_pk_bf16(float lo, float hi) { unsigned r; asm volatile("v_cvt_pk_bf16_f32 %0, %1, %2" : "=v"(r) : "v"(lo), "v"(hi)); return r; }

template <class Epi, class Sched, bool GATHER = false>
__device__ __forceinline__ void gemm_phase(PG8_LAS unsigned char* lds, const Gemm g, const Sched& S, const Epi& E) {
    int tid = threadIdx.x; asm volatile("" : "+v"(tid));
    const int wid = __builtin_amdgcn_readfirstlane(tid >> 6), lane = tid & 63, wr = wid >> 2, wc = wid & 3, fr = lane & 15, fq = lane >> 4;
    const int K = g.K, nt = K / BK;
    unsigned voffA[2], voffB[2];
#pragma unroll
    for (int i = 0; i < 2; ++i) { int R, C; stage_rc(tid * 16 + i * 8192, R, C); const int Rb = ((R & ~31) + perm32(R & 31));
        voffA[i] = (unsigned)(R * g.lda + C) * 2u; voffB[i] = (unsigned)(Rb * g.ldb + C) * 2u; }
    int gR[2], gC[2];
#pragma unroll
    for (int i = 0; i < 2; ++i) stage_rc(tid * 16 + i * 8192, gR[i], gC[i]);
    unsigned cvA[2][2] = {{0u, 0u}, {0u, 0u}}, nvA[2][2] = {{0u, 0u}, {0u, 0u}};
#define PG8_GLOAD(dst, rb_) do { _Pragma("unroll") for (int h_ = 0; h_ < 2; ++h_) _Pragma("unroll") for (int i_ = 0; i_ < 2; ++i_) { \
        const int rt_ = g.rowsrc[(rb_) + h_ * HALF + gR[i_]]; dst[h_][i_] = (unsigned)((rt_ >= 0 ? rt_ >> 1 : 0) * g.lda + gC[i_]) * 2u; } } while (0)
    const size_t kstep = (size_t)(BK * 2);
    const size_t hstepA = (size_t)HALF * g.lda * 2, hstepB = (size_t)HALF * g.ldb * 2;
    const size_t tstepA = 2 * hstepA, tstepB = 2 * hstepB;
    const unsigned ldsw = (unsigned)wid * 1024u;
    const int aoff = lds_byte(wr * 64 + fr, fq * 8), boff = lds_byte(wc * 32 + fr, fq * 8);
#define PG8_SA(b, h) (((b) * 2 + (h)) * HTB)
#define PG8_SB(b, h) ((4 + (b) * 2 + (h)) * HTB)
#define PG8_STAGE(bufoff, gbase, voff) do { _Pragma("unroll") for (int _i = 0; _i < 2; ++_i) \
        __builtin_amdgcn_global_load_lds((const unsigned*)((const char*)(gbase) + (voff)[_i]), (PG8_LAS unsigned*)(lds + (bufoff) + ldsw + _i * 8192), 16, 0, 0); } while (0)
#define PG8_LDA(dst, b, h) do { _Pragma("unroll") for (int m = 0; m < 4; ++m) _Pragma("unroll") for (int k = 0; k < 2; ++k) dst[m][k] = *(const PG8_LAS bf16x8*)(lds + PG8_SA(b, h) + aoff + m * 2048 + k * 1024); } while (0)
#define PG8_LDB(dst, b, h) do { _Pragma("unroll") for (int n = 0; n < 2; ++n) _Pragma("unroll") for (int k = 0; k < 2; ++k) dst[n][k] = *(const PG8_LAS bf16x8*)(lds + PG8_SB(b, h) + boff + n * 2048 + k * 1024); } while (0)
#define PG8_MMA(ai, bj, At, Bt) do { __builtin_amdgcn_s_setprio(1); _Pragma("unroll") for (int m = 0; m < 4; ++m) _Pragma("unroll") for (int n = 0; n < 2; ++n) _Pragma("unroll") for (int k = 0; k < 2; ++k) \
        acc[ai][bj][m][n] = __builtin_amdgcn_mfma_f32_16x16x32_bf16(Bt[n][k], At[m][k], acc[ai][bj][m][n], 0, 0, 0); __builtin_amdgcn_s_setprio(0); } while (0)
#define PG8_WAIT_V(n) asm volatile("s_waitcnt vmcnt(" #n ")" ::: "memory")
#define PG8_WAIT_L(n) asm volatile("s_waitcnt lgkmcnt(" #n ")" ::: "memory")
#define PG8_BAR __builtin_amdgcn_s_barrier()
#define PG8_SCHED __builtin_amdgcn_sched_barrier(0)
    Unit cur, nxt; int ui = 0;
    if (!S.next(0, cur)) return;
    f32x4 acc[2][2][4][2];
#pragma unroll
    for (int a = 0; a < 2; ++a)
#pragma unroll
        for (int b = 0; b < 2; ++b)
#pragma unroll
            for (int m = 0; m < 4; ++m)
#pragma unroll
                for (int n = 0; n < 2; ++n) acc[a][b][m][n] = (f32x4){0.f, 0.f, 0.f, 0.f};
    bf16x8 At[4][2], B0[2][2], B1[2][2];
    const char* cA = (const char*)g.A + (size_t)cur.pm * tstepA; const char* cB = (const char*)g.Bt + cur.bofs + (size_t)cur.pn * tstepB;
    const char* gA = (const char*)g.A;
    if constexpr (GATHER) { PG8_GLOAD(cvA, cur.rb); }
    {
        PG8_STAGE(PG8_SB(0, 0), cB, voffB); PG8_STAGE(PG8_SB(0, 1), cB + hstepB, voffB);
        if constexpr (GATHER) { PG8_STAGE(PG8_SA(0, 0), gA, cvA[0]); PG8_STAGE(PG8_SA(0, 1), gA, cvA[1]); } else { PG8_STAGE(PG8_SA(0, 0), cA, voffA); PG8_STAGE(PG8_SA(0, 1), cA + hstepA, voffA); }
        if (wr == 1) PG8_BAR;
        PG8_WAIT_V(2); PG8_BAR;
        PG8_STAGE(PG8_SB(1, 0), cB + kstep, voffB);
        if constexpr (GATHER) { PG8_STAGE(PG8_SA(1, 0), gA + kstep, cvA[0]); } else { PG8_STAGE(PG8_SA(1, 0), cA + kstep, voffA); }
        PG8_STAGE(PG8_SB(1, 1), cB + hstepB + kstep, voffB);
        PG8_WAIT_V(6); PG8_BAR;
    }
    for (;;) {
        const bool has_next = S.next(ui + 1, nxt);
        const char* nA = has_next ? (const char*)g.A + (size_t)nxt.pm * tstepA : cA; const char* nB = has_next ? (const char*)g.Bt + nxt.bofs + (size_t)nxt.pn * tstepB : cB;
        if constexpr (GATHER) { if (has_next) { PG8_GLOAD(nvA, nxt.rb); } else {
#pragma unroll
            for (int h_ = 0; h_ < 2; ++h_) { nvA[h_][0] = cvA[h_][0]; nvA[h_][1] = cvA[h_][1]; } } }
        for (int t = 0; t < nt; t += 2) {
            if constexpr (Epi::HAS_MID) { if (t == nt / 2) E.mid(acc, cur, wr, wc, fr, fq); }
            const bool last = (t == nt - 2);
            const char* a1 = cA + (size_t)(t + 1) * kstep;
            const char* a2 = last ? nA : cA + (size_t)(t + 2) * kstep; const char* b2 = last ? nB : cB + (size_t)(t + 2) * kstep;
            const char* a3 = a2 + kstep; const char* b3 = b2 + kstep;
            unsigned sv[2][2]; const char* g2 = gA;
            if constexpr (GATHER) { g2 = last ? gA : gA + (size_t)(t + 2) * kstep;
#pragma unroll
                for (int h_ = 0; h_ < 2; ++h_) { sv[h_][0] = last ? nvA[h_][0] : cvA[h_][0]; sv[h_][1] = last ? nvA[h_][1] : cvA[h_][1]; } }
            PG8_LDB(B0, 0, 0); PG8_LDB(B1, 0, 1); PG8_SCHED; PG8_LDA(At, 0, 0);
            if constexpr (GATHER) { PG8_STAGE(PG8_SA(1, 1), gA + (size_t)(t + 1) * kstep, cvA[1]); } else { PG8_STAGE(PG8_SA(1, 1), a1 + hstepA, voffA); }
            PG8_WAIT_V(8); PG8_WAIT_L(0); PG8_BAR; PG8_MMA(0, 0, At, B0); PG8_MMA(0, 1, At, B1); PG8_BAR; PG8_SCHED;
            PG8_LDA(At, 0, 1); PG8_STAGE(PG8_SB(0, 0), b2, voffB); PG8_STAGE(PG8_SB(0, 1), b2 + hstepB, voffB);
            if constexpr (GATHER) { PG8_STAGE(PG8_SA(0, 0), g2, sv[0]); } else { PG8_STAGE(PG8_SA(0, 0), a2, voffA); }
            PG8_WAIT_V(8); PG8_WAIT_L(0); PG8_BAR; PG8_MMA(1, 0, At, B0); PG8_MMA(1, 1, At, B1); PG8_BAR; PG8_SCHED;
            PG8_LDB(B0, 1, 0); PG8_LDB(B1, 1, 1); PG8_SCHED; PG8_LDA(At, 1, 0);
            if constexpr (GATHER) { PG8_STAGE(PG8_SA(0, 1), g2, sv[1]); } else { PG8_STAGE(PG8_SA(0, 1), a2 + hstepA, voffA); }
            PG8_WAIT_V(8); PG8_WAIT_L(0); PG8_BAR; PG8_MMA(0, 0, At, B0); PG8_MMA(0, 1, At, B1); PG8_BAR; PG8_SCHED;
            PG8_LDA(At, 1, 1); PG8_STAGE(PG8_SB(1, 0), b3, voffB); PG8_STAGE(PG8_SB(1, 1), b3 + hstepB, voffB);
            if constexpr (GATHER) { PG8_STAGE(PG8_SA(1, 0), g2 + kstep, sv[0]); } else { PG8_STAGE(PG8_SA(1, 0), a3, voffA); }
            PG8_WAIT_V(8); PG8_WAIT_L(0); PG8_BAR; PG8_MMA(1, 0, At, B0); PG8_MMA(1, 1, At, B1); PG8_BAR; PG8_SCHED;
        }
        if (wr == 0) PG8_BAR;
        E(acc, cur, wr, wc, fr, fq);
        if (!has_next) break;
#pragma unroll
        for (int a = 0; a < 2; ++a)
#pragma unroll
            for (int b = 0; b < 2; ++b)
#pragma unroll
                for (int m = 0; m < 4; ++m)
#pragma unroll
                    for (int n = 0; n < 2; ++n) acc[a][b][m][n] = (f32x4){0.f, 0.f, 0.f, 0.f};
        cur = nxt; cA = nA; cB = nB; ++ui;
        if constexpr (GATHER) {
#pragma unroll
            for (int h_ = 0; h_ < 2; ++h_) { cvA[h_][0] = nvA[h_][0]; cvA[h_][1] = nvA[h_][1]; } }
        if (wr == 1) PG8_BAR;
    }
    PG8_WAIT_V(0);
    PG8_BAR;
#undef PG8_GLOAD
#undef PG8_SA
#undef PG8_SB
#undef PG8_STAGE
#undef PG8_LDA
#undef PG8_LDB
#undef PG8_MMA
#undef PG8_WAIT_V
#undef PG8_WAIT_L
#undef PG8_BAR
#undef PG8_SCHED
}
}

constexpr int NWAVES = 8;
constexpr int DM = 2048, SEQ = 8192, NMETA = 16, LTOK = SEQ + NMETA, LP = 8448;
constexpr int HD = 128, NH = 8, KVR = 512, IH = 16, IDD = 64, TOPK = 256;
constexpr int INW = 9816, PW = 9984;
constexpr int PC_QA = 0, PC_CKV = 1024, PC_QI = 1536, PC_KI = 2560, PC_WI = 2624, PC_FB = 2640, PC_QB = 2688, PC_KB = 3712, PC_VB = 4736, PC_GA = 5760, PC_GB = 7808, PC_END = 9856;
constexpr int NE = 16, DFF = 512, TSROWS = 20480;
constexpr float EPS = 1e-6f;
constexpr float LOG2E = 1.4426950408889634f;
constexpr float ATT_SCALE = 0.08838834764831845f;
constexpr int NTILE64 = 129;
constexpr int NPHASE = 14;


namespace att {
typedef short bf16x8 __attribute__((ext_vector_type(8)));
typedef short s16x4 __attribute__((ext_vector_type(4)));
typedef float f32x16 __attribute__((ext_vector_type(16)));
typedef float f32x4 __attribute__((ext_vector_type(4)));
typedef unsigned u32x4 __attribute__((ext_vector_type(4)));
typedef unsigned short bf16;
constexpr int NW = 8, QBLK = 32, KVBLK = 64, QB = NW * QBLK, D = 128;
constexpr int SHM_V = KVBLK * D * 2, SHM_K = KVBLK * D * 2;
constexpr int NVS = 3;
constexpr int OFF_WS = NVS * SHM_V + 2 * SHM_K, OFF_BIAS = OFF_WS + NW * 64 * 4, OFF_Q = OFF_BIAS + 2 * 64 * 4, LDS_TOTAL = OFF_Q + NW * 8192;
constexpr float SCALE = 0.08838834764831845f, THR = 8.f;
#define KSWZ(row, colB) ((row) * 256 + ((colB) ^ (((row) & 7) << 4)))
#define SBAR() __builtin_amdgcn_sched_barrier(0)
__device__ __forceinline__ int v_st(int k, int c) { const int kk = (k & ~0xC) | ((k & 4) << 1) | ((k & 8) >> 1); return ((kk >> 3) * 4 + (c >> 5)) * 512 + ((kk & 7) * 32 + (c & 31)) * 2; }
__device__ __forceinline__ int v_rd_base(int lane) { return ((lane & 3) << 3) | (((lane >> 2) & 3) << 6) | (((lane >> 4) & 1) << 5) | (((lane >> 5) & 1) << 8); }
constexpr int v_rd_off(int d0, int ks, int half) { return d0 * 512 + ks * 4096 + half * 2048; }
__device__ __forceinline__ int crow(int r, int hi) { return (r & 3) + 8 * (r >> 2) + 4 * hi; }
__device__ __forceinline__ unsigned cvtpk(float lo, float hi) { unsigned r; asm volatile("v_cvt_pk_bf16_f32 %0, %1, %2" : "=v"(r) : "v"(lo), "v"(hi)); return r; }
__device__ __forceinline__ void mask_causal(f32x16& p0, f32x16& p1, int dq) {
    const float NEG = -__builtin_inff();
#pragma unroll
    for (int r = 0; r < 16; ++r) { const int c = (r & 3) + 8 * (r >> 2); if (dq - c < 0) p0[r] = NEG; if (dq - c - 32 < 0) p1[r] = NEG; }
}
__device__ __forceinline__ void mask_bits(f32x16& p0, f32x16& p1, unsigned long long w, int hi) {
    const float NEG = -__builtin_inff();
    const unsigned wl = (unsigned)w >> (4 * hi), wh = (unsigned)(w >> 32) >> (4 * hi);
#pragma unroll
    for (int r = 0; r < 16; ++r) { const int c = (r & 3) + 8 * (r >> 2);
        const unsigned m0 = (unsigned)__builtin_amdgcn_sbfe((int)wl, c, 1), m1 = (unsigned)__builtin_amdgcn_sbfe((int)wh, c, 1);
        p0[r] = __uint_as_float((__float_as_uint(p0[r]) & m0) | (__float_as_uint(NEG) & ~m0)); p1[r] = __uint_as_float((__float_as_uint(p1[r]) & m1) | (__float_as_uint(NEG) & ~m1)); }
}
__device__ __forceinline__ void partialSM(f32x16& p0, f32x16& p1, float& m_reg, float& mn, float& alpha) {
    float pmax = p0[0];
#pragma unroll
    for (int r = 1; r < 16; ++r) pmax = fmaxf(pmax, p0[r]);
#pragma unroll
    for (int r = 0; r < 16; ++r) pmax = fmaxf(pmax, p1[r]);
    { auto rr = __builtin_amdgcn_permlane32_swap(__float_as_uint(pmax), __float_as_uint(pmax), false, false);
      pmax = fmaxf(__uint_as_float(rr[0]), __uint_as_float(rr[1])); }
    constexpr float C2 = 1.4426950408889634f * SCALE;
    if (__builtin_expect(__all((pmax - m_reg) * SCALE <= THR), 1)) { mn = m_reg; alpha = 1.f; }
    else { mn = fmaxf(m_reg, pmax); alpha = __builtin_amdgcn_exp2f((m_reg - mn) * C2); m_reg = mn; }
    const float mnL = -mn * C2;
#pragma unroll
    for (int r = 0; r < 16; ++r) p0[r] = fmaf(p0[r], C2, mnL);
#pragma unroll
    for (int r = 0; r < 16; ++r) p1[r] = fmaf(p1[r], C2, mnL);
#pragma unroll
    for (int r = 0; r < 16; ++r) p0[r] = __builtin_amdgcn_exp2f(p0[r]);
}
__device__ __forceinline__ void finishSM(f32x16& p0, f32x16& p1, float alpha, float& l_reg, bf16x8& pa0, bf16x8& pa1, bf16x8& pa2, bf16x8& pa3) {
#pragma unroll
    for (int r = 0; r < 16; ++r) p1[r] = __builtin_amdgcn_exp2f(p1[r]);
    float ps = 0;
#pragma unroll
    for (int r = 0; r < 16; ++r) ps += p0[r];
#pragma unroll
    for (int r = 0; r < 16; ++r) ps += p1[r];
    { auto rr = __builtin_amdgcn_permlane32_swap(__float_as_uint(ps), __float_as_uint(ps), false, false);
      ps = __uint_as_float(rr[0]) + __uint_as_float(rr[1]); }
    l_reg = l_reg * alpha + ps;
#define PK4(P, B_, OUT) do { unsigned a0 = cvtpk(P[B_+0], P[B_+1]), a1 = cvtpk(P[B_+2], P[B_+3]);                          \
        unsigned b0 = cvtpk(P[B_+4], P[B_+5]), b1 = cvtpk(P[B_+6], P[B_+7]);                                             \
        auto r0 = __builtin_amdgcn_permlane32_swap(a0, b0, false, false); auto r1 = __builtin_amdgcn_permlane32_swap(a1, b1, false, false); \
        u32x4 w = {r0[0], r1[0], r0[1], r1[1]}; OUT = *reinterpret_cast<bf16x8*>(&w); } while (0)
    PK4(p0, 0, pa0); PK4(p0, 8, pa1); PK4(p1, 0, pa2); PK4(p1, 8, pa3);
#undef PK4
}
template <int KB, int MODE>
__device__ __forceinline__ void qkt(f32x16& p0, f32x16& p1, const char* lds, int r32, int hi, const char* qsp) {
    const char* K_lds = lds + NVS * SHM_V;
    if (MODE == 0) { const float* bb = (const float*)(lds + OFF_BIAS + KB * 256) + 4 * hi;
#pragma unroll
        for (int g = 0; g < 4; ++g) { const f32x4 b0 = *(const f32x4*)(bb + 8 * g), b1 = *(const f32x4*)(bb + 32 + 8 * g);
            p0[4 * g] = b0[0]; p0[4 * g + 1] = b0[1]; p0[4 * g + 2] = b0[2]; p0[4 * g + 3] = b0[3];
            p1[4 * g] = b1[0]; p1[4 * g + 1] = b1[1]; p1[4 * g + 2] = b1[2]; p1[4 * g + 3] = b1[3]; } }
    else { p0 = f32x16{}; p1 = f32x16{}; }
    const char* kb[4];
#pragma unroll
    for (int dd = 0; dd < 4; ++dd) kb[dd] = K_lds + KB * SHM_K + KSWZ(r32, (dd * 16 + hi * 8) * 2);
#pragma unroll
    for (int d0 = 0; d0 < 8; ++d0) { const char* a = kb[d0 & 3] + (d0 >> 2) * 128;
        bf16x8 b0 = *reinterpret_cast<const bf16x8*>(a);
        bf16x8 b1 = *reinterpret_cast<const bf16x8*>(a + 32 * 256);
        const bf16x8 q = *reinterpret_cast<const bf16x8*>(qsp + d0 * 1024);
        p0 = __builtin_amdgcn_mfma_f32_32x32x16_bf16(b0, q, p0, 0, 0, 0);
        p1 = __builtin_amdgcn_mfma_f32_32x32x16_bf16(b1, q, p1, 0, 0, 0); }
}
__device__ __forceinline__ void pv_tile(f32x16* o, int vb0, bf16x8 pa0, bf16x8 pa1, bf16x8 pa2, bf16x8 pa3) {
#define TRRD(dst, off) asm volatile("ds_read_b64_tr_b16 %0, %1 offset:%2" : "=&v"(dst) : "v"(vb0), "i"(off) : "memory")
#define PV_D0(d0) do { s16x4 l0, l1, l2, l3, h0, h1, h2, h3; constexpr int b_ = v_rd_off(d0, 0, 0); \
        TRRD(l0, b_); TRRD(h0, b_ + 2048); TRRD(l1, b_ + 4096); TRRD(h1, b_ + 6144); TRRD(l2, b_ + 8192); TRRD(h2, b_ + 10240); TRRD(l3, b_ + 12288); TRRD(h3, b_ + 14336); \
        asm volatile("s_waitcnt lgkmcnt(0)" ::: "memory"); SBAR(); \
        o[d0] = __builtin_amdgcn_mfma_f32_32x32x16_bf16(pa0, (bf16x8){l0[0], l0[1], l0[2], l0[3], h0[0], h0[1], h0[2], h0[3]}, o[d0], 0, 0, 0);   \
        o[d0] = __builtin_amdgcn_mfma_f32_32x32x16_bf16(pa1, (bf16x8){l1[0], l1[1], l1[2], l1[3], h1[0], h1[1], h1[2], h1[3]}, o[d0], 0, 0, 0);   \
        o[d0] = __builtin_amdgcn_mfma_f32_32x32x16_bf16(pa2, (bf16x8){l2[0], l2[1], l2[2], l2[3], h2[0], h2[1], h2[2], h2[3]}, o[d0], 0, 0, 0);   \
        o[d0] = __builtin_amdgcn_mfma_f32_32x32x16_bf16(pa3, (bf16x8){l3[0], l3[1], l3[2], l3[3], h3[0], h3[1], h3[2], h3[3]}, o[d0], 0, 0, 0); } while (0)
    PV_D0(0); PV_D0(1); PV_D0(2); PV_D0(3);
#undef PV_D0
#undef TRRD
}
struct ItemRef { const bf16* Q; const bf16* K; const bf16* V; bf16* O; int P0, t_lo, t_hi; const float* cb; float cref; const unsigned long long* mk; float* part; float kn2; };
constexpr float FOX_TAU = 30.5f;
constexpr int PART_FLOATS = 256 * 128 + 512;
struct Seam { bf16x8 st_v0, st_v1, st_k0, st_k1; float st_b; };
#define ROWP(p, k0, rr) ((p) + (size_t)((k0) + (rr)) * LDKV + sc)
#define VMW() asm volatile("s_waitcnt vmcnt(0)" ::: "memory")
#define LD8(p) (*reinterpret_cast<const bf16x8*>(p))
#define SLOAD_H(R, k0) do { S.st_v0 = LD8(ROWP((R).V, k0, sr)); S.st_v1 = LD8(ROWP((R).V, k0, 32 + sr)); S.st_k0 = LD8(ROWP((R).K, k0, sr)); S.st_k1 = LD8(ROWP((R).K, k0, 32 + sr)); \
        if (MODE == 0 && wid == 0) S.st_b = ((R).cref - (R).cb[(k0) + lane]) * (1.0f / SCALE); } while (0)
#define SWRITE_HK(bf) do { *(bf16x8*)(K_lds + (bf) * SHM_K + kws) = S.st_k0; *(bf16x8*)(K_lds + (bf) * SHM_K + kws + 32 * 256) = S.st_k1; \
        if (MODE == 0 && wid == 0) ((float*)(lds + OFF_BIAS))[(bf) * 64 + lane] = S.st_b; } while (0)
#define SWRITE_HV(bf) do { *(bf16x8*)(V_lds + (bf) * SHM_V + vst0) = S.st_v0; *(bf16x8*)(V_lds + (bf) * SHM_V + vst1) = S.st_v1; } while (0)
#define SWRITE_H(bf) do { SWRITE_HV(bf); SWRITE_HK(bf); } while (0)
template <int MODE, int LDQ, int LDKV, int LDO>
__device__ __forceinline__ void run_item(const ItemRef& cur, char* lds) {
    int tid = threadIdx.x; asm volatile("" : "+v"(tid));
    const int wid = __builtin_amdgcn_readfirstlane(tid >> 6), lane = tid & 63, r32 = lane & 31, hi = lane >> 5;
    int t_lo = cur.t_lo;
    const int qlo = cur.P0 + wid * QBLK, qm = qlo + r32 - 4 * hi;
    char* V_lds = lds; char* K_lds = lds + NVS * SHM_V;
    float* wsf = (float*)(lds + OFF_WS) + wid * 64; float* li_l = wsf, * al_l = wsf + 32;
    char* qsp = lds + OFF_Q + wid * 8192 + lane * 16;
    float m_reg = -1e30f, l_reg = 0; f32x16 o[4] = {};
    const int sr = tid >> 4, sc = (tid & 15) * 8, vst0 = v_st(sr, sc), vst1 = v_st(32 + sr, sc), kws = KSWZ(sr, sc * 2);
    const int vb0 = (int)(uintptr_t)V_lds + v_rd_base(lane);
    const unsigned long long* mkl = cur.mk + wid * QBLK + r32;
    Seam S;
#define RESC(a) do { if (__any((a) < 1.f)) { if (hi == 0) al_l[r32] = (a); asm volatile("s_waitcnt lgkmcnt(0)" ::: "memory");              \
                     _Pragma("unroll") for (int d_ = 0; d_ < 4; ++d_) _Pragma("unroll") for (int r = 0; r < 16; ++r) o[d_][r] *= al_l[crow(r, hi)]; } } while (0)
#define KBASE(t) ((t_lo + (t)) * KVBLK)
#define MLOAD(t) (MODE == 1 ? mkl[(size_t)(t_lo + (t)) * SEQ] : 0ull)
#define MASKT(P0_, P1_, t, w_) do { if (MODE == 1) mask_bits(P0_, P1_, w_, hi); else { const int kb_ = KBASE(t); if (kb_ + KVBLK - 1 > qlo) mask_causal(P0_, P1_, qm - kb_); } } while (0)
    { bf16x8 tq[8];
#pragma unroll
      for (int d0 = 0; d0 < 8; ++d0) tq[d0] = LD8(cur.Q + (size_t)(wid * QBLK + r32) * LDQ + d0 * 16 + hi * 8);
      if (MODE == 0) {
          float q2 = 0.f;
#pragma unroll
          for (int d0 = 0; d0 < 8; ++d0)
#pragma unroll
              for (int j = 0; j < 8; ++j) { const float x = __uint_as_float((unsigned)(unsigned short)tq[d0][j] << 16); q2 = fmaf(x, x, q2); }
          q2 += __shfl_xor(q2, 32);
#pragma unroll
          for (int ofs = 1; ofs < 32; ofs <<= 1) q2 = fmaxf(q2, __shfl_xor(q2, ofs));
          if (lane == 0) al_l[0] = q2;
          __syncthreads();
          float Q2 = 0.f;
#pragma unroll
          for (int w = 0; w < NW; ++w) Q2 = fmaxf(Q2, ((const float*)(lds + OFF_WS))[w * 64 + 32]);
          const float D = FOX_TAU + 2.002f * SCALE * sqrtf(Q2 * cur.kn2);
          const float cthr = cur.cb[cur.P0] + D; int cntskip = 0;
#pragma unroll
          for (int i = 0; i < 3; ++i) { const int t = lane + 64 * i; const bool sk = t < cur.t_hi && cur.cb[t * KVBLK + KVBLK - 1] >= cthr; cntskip += __popcll(__ballot(sk)); }
          t_lo = cntskip < cur.t_hi - 1 ? cntskip : cur.t_hi - 1;
          __syncthreads();
      }
      SLOAD_H(cur, KBASE(0)); VMW();
#pragma unroll
      for (int d0 = 0; d0 < 8; ++d0) *(bf16x8*)(qsp + d0 * 1024) = tq[d0];
      SWRITE_HK(0); }
    const int NT = cur.t_hi - t_lo;
    __syncthreads();
    f32x16 pA0, pA1, pB0, pB1; float mnA, mnB, alA, alB; bf16x8 pa0, pa1, pa2, pa3;
    unsigned long long mw = MLOAD(0);
    SWRITE_HV(0); SBAR();
    if (NT > 1) { SLOAD_H(cur, KBASE(1)); }
    SBAR(); qkt<0, MODE>(pA0, pA1, lds, r32, hi, qsp);
    MASKT(pA0, pA1, 0, mw); partialSM(pA0, pA1, m_reg, mnA, alA);
    if (NT > 1) { VMW(); SWRITE_H(1); }
    __syncthreads();
    int vs = 0;
#define HALF_STEP(PX0, PX1, mnX, alX, PY0, PY1, alY, t, KB, SB) do {                                                          \
        SBAR(); mw = MLOAD(t); qkt<KB, MODE>(PX0, PX1, lds, r32, hi, qsp);                                                    \
        finishSM(PY0, PY1, alY, l_reg, pa0, pa1, pa2, pa3); SBAR();                                                           \
        if ((t) + 1 < NT) { SLOAD_H(cur, KBASE((t) + 1)); SBAR(); }                                                           \
        pv_tile(o, vb0 + vs * SHM_V, pa0, pa1, pa2, pa3); MASKT(PX0, PX1, (t), mw); partialSM(PX0, PX1, m_reg, mnX, alX);     \
        if ((t) + 1 < NT) { const int vn_ = vs >= 1 ? vs - 1 : 2; VMW(); SWRITE_HK(SB); SWRITE_HV(vn_); }                      \
        RESC(alX); vs = vs == 2 ? 0 : vs + 1; __syncthreads(); } while (0)
    for (int t = 1; t + 1 < NT; t += 2) {
        HALF_STEP(pB0, pB1, mnB, alB, pA0, pA1, alA, t, 1, 0);
        HALF_STEP(pA0, pA1, mnA, alA, pB0, pB1, alB, t + 1, 0, 1);
    }
    const bool even = (NT & 1) == 0;
    if (even) { SBAR(); mw = MLOAD(NT - 1); qkt<1, MODE>(pB0, pB1, lds, r32, hi, qsp); SBAR(); }
    finishSM(pA0, pA1, alA, l_reg, pa0, pa1, pa2, pa3); SBAR();
    pv_tile(o, vb0 + vs * SHM_V, pa0, pa1, pa2, pa3);
    if (even) { MASKT(pB0, pB1, NT - 1, mw); partialSM(pB0, pB1, m_reg, mnB, alB); __syncthreads(); RESC(alB);
        finishSM(pB0, pB1, alB, l_reg, pa0, pa1, pa2, pa3); SBAR(); pv_tile(o, vb0 + (vs == 2 ? 0 : vs + 1) * SHM_V, pa0, pa1, pa2, pa3); }
    SBAR();
    if (cur.part) {
        float* po = cur.part + (size_t)(wid * 64 + lane) * 64;
#pragma unroll
        for (int d0 = 0; d0 < 4; ++d0)
#pragma unroll
            for (int g = 0; g < 4; ++g) *(f32x4*)(po + d0 * 16 + 4 * g) = (f32x4){o[d0][4 * g], o[d0][4 * g + 1], o[d0][4 * g + 2], o[d0][4 * g + 3]};
        if (hi == 0) { cur.part[256 * 128 + wid * QBLK + r32] = m_reg; cur.part[256 * 128 + 256 + wid * QBLK + r32] = l_reg; }
    } else {
        if (hi == 0) li_l[r32] = l_reg; asm volatile("s_waitcnt lgkmcnt(0)" ::: "memory");
        float rli[16];
#pragma unroll
        for (int r = 0; r < 16; ++r) rli[r] = __builtin_amdgcn_rcpf(li_l[crow(r, hi)]);
        bf16* Ow = cur.O + (size_t)(wid * QBLK) * LDO;
#pragma unroll
        for (int r = 0; r < 16; ++r) { const int orow = crow(r, hi);
#pragma unroll
            for (int d0 = 0; d0 < 4; ++d0) { const float v = o[d0][r] * rli[r];
                const float vn = __shfl_xor(v, 1);
                if ((r32 & 1) == 0) *(unsigned*)(Ow + (size_t)orow * LDO + d0 * 32 + r32) = cvtpk(v, vn); } }
    }
    __syncthreads();
#undef RESC
#undef KBASE
#undef MLOAD
#undef MASKT
#undef HALF_STEP
}
template <int LDO>
__device__ __forceinline__ void combine_item(const float* p1, const float* p2, bf16* O, char* lds) {
    int tid = threadIdx.x; asm volatile("" : "+v"(tid));
    const int wid = __builtin_amdgcn_readfirstlane(tid >> 6), lane = tid & 63, r32 = lane & 31, hi = lane >> 5;
    float* wsf = (float*)(lds + OFF_WS) + wid * 64;
    constexpr float C2 = 1.4426950408889634f * SCALE;
    { const int row = wid * QBLK + r32; const float m1 = p1[256 * 128 + row], m2 = p2[256 * 128 + row], l1 = p1[256 * 128 + 256 + row], l2 = p2[256 * 128 + 256 + row];
      const float m = fmaxf(m1, m2), f1 = __builtin_amdgcn_exp2f((m1 - m) * C2), f2 = __builtin_amdgcn_exp2f((m2 - m) * C2); const float rl = 1.f / (l1 * f1 + l2 * f2);
      if (hi == 0) { wsf[r32] = f1 * rl; wsf[32 + r32] = f2 * rl; } }
    asm volatile("s_waitcnt lgkmcnt(0)" ::: "memory");
    const float* q1 = p1 + (size_t)(wid * 64 + lane) * 64; const float* q2 = p2 + (size_t)(wid * 64 + lane) * 64;
    bf16* Ow = O + (size_t)(wid * QBLK) * LDO;
#pragma unroll
    for (int d0 = 0; d0 < 4; ++d0)
#pragma unroll
        for (int g = 0; g < 4; ++g) { const f32x4 a = *(const f32x4*)(q1 + d0 * 16 + 4 * g), b = *(const f32x4*)(q2 + d0 * 16 + 4 * g);
#pragma unroll
            for (int j = 0; j < 4; ++j) { const int r = 4 * g + j, orow = crow(r, hi); const float v = a[j] * wsf[orow] + b[j] * wsf[32 + orow];
                const float vn = __shfl_xor(v, 1);
                if ((r32 & 1) == 0) *(unsigned*)(Ow + (size_t)orow * LDO + d0 * 32 + r32) = cvtpk(v, vn); } }
    __syncthreads();
}
#undef ROWP
#undef VMW
#undef LD8
#undef SLOAD_H
#undef SWRITE_HK
#undef SWRITE_HV
#undef SWRITE_H
#undef KSWZ
#undef SBAR
}

constexpr size_t MiB = 1u << 20;
constexpr size_t WS_CTL = 0, CTL_ZERO_BYTES = 1 * MiB;
constexpr size_t WS_ROPE128 = 1 * MiB;
constexpr size_t WS_ROPE64 = 5 * MiB + 256 * 1024;
constexpr size_t WS_WRT = 7 * MiB + 288 * 1024;
constexpr size_t WS_KI = 7 * MiB + 512 * 1024;
constexpr size_t WS_WI = 8 * MiB + 768 * 1024;
constexpr size_t WS_LOGF = 9 * MiB + 512 * 1024;
constexpr size_t WS_CC = 9 * MiB + 896 * 1024;
constexpr size_t WS_ROUTE = 10 * MiB + 256 * 1024;
constexpr size_t WS_ROWTOK = 7 * MiB + 512 * 1024;
constexpr size_t WS_ROWW = 8 * MiB;
constexpr size_t WS_CCT = 11 * MiB;
constexpr size_t WS_WAT = 12 * MiB, WS_WBT = 16 * MiB, WS_WOT = 20 * MiB, WS_WKVT = 28 * MiB;
constexpr size_t WS_PROJ = 30 * MiB;
constexpr size_t WS_KVA = 191 * MiB;
constexpr size_t WS_CKVN = 224 * MiB;
constexpr size_t WS_MASK = 224 * MiB;
constexpr size_t WS_R = 233 * MiB;
constexpr size_t WS_HN = WS_R, WS_WINT = WS_R + 33 * MiB, WS_SMALL = WS_R + 73 * MiB;
constexpr size_t WS_S = WS_R;
constexpr size_t WS_YA = WS_R, WS_YB = WS_R + 16 * MiB, WS_MERGED = WS_R + 32 * MiB, WS_M1 = WS_R + 64 * MiB;
constexpr size_t WS_H2 = 30 * MiB, WS_T = 94 * MiB, WS_ACT = 126 * MiB, WS_WDT = 190 * MiB;
constexpr size_t WS_WGUT = WS_R + 66 * MiB;
constexpr size_t WS_SQ2 = 222 * MiB;
constexpr size_t WS_TS = WS_R, WS_Y = WS_R;
constexpr size_t WS_NEED = WS_R + 134 * MiB;
static_assert(WS_PROJ + (size_t)LP * PW * 2 <= WS_KVA && WS_KVA + (size_t)LP * 2048 * 2 <= WS_CKVN && WS_CKVN + (size_t)LP * 512 * 2 <= WS_R, "ws map");
static_assert(WS_WDT + (size_t)NE * 2048 * 512 * 2 <= WS_MASK && WS_M1 + (size_t)SEQ * 2048 * 4 <= WS_NEED && WS_ACT + (size_t)TSROWS * 512 * 2 <= WS_WDT && WS_WGUT + (size_t)NE * 1024 * 2048 * 2 <= WS_NEED, "ws map 2");
constexpr size_t WS_SSQ = 11 * MiB + 288 * 1024;
constexpr int CW_CNT = 64;
constexpr int CW_KMAX = 2112;
constexpr int CW_BAR = 4096;

constexpr int RING_OFF = 0, RING_BYTES = 131072;
constexpr int LDSCTL_OFF = 155648, MISC_OFF = LDSCTL_OFF + 320;
constexpr int LDS_BYTES = 159744;

#define GAS __attribute__((address_space(1)))
#define LAS __attribute__((address_space(3)))
typedef unsigned short bf16;
typedef unsigned v4u __attribute__((ext_vector_type(4)));
typedef unsigned v2u __attribute__((ext_vector_type(2)));
typedef float f32x4 __attribute__((ext_vector_type(4)));
typedef float f32x2 __attribute__((ext_vector_type(2)));
typedef short bf16x8 __attribute__((ext_vector_type(8)));
typedef GAS unsigned gu32;
#define RLX_AGENT __ATOMIC_RELAXED, __HIP_MEMORY_SCOPE_AGENT
#define LDS_WAIT() asm volatile("s_waitcnt lgkmcnt(0)" ::: "memory")
#define VM_WAIT() asm volatile("s_waitcnt vmcnt(0)" ::: "memory")
__device__ __forceinline__ unsigned f2bf(float f) { unsigned u = __builtin_bit_cast(unsigned, f); return (u + 0x7fffu + ((u >> 16) & 1u)) >> 16; }
__device__ __forceinline__ unsigned pk2(float lo, float hi) { return f2bf(lo) | (f2bf(hi) << 16); }
__device__ __forceinline__ float bf2f(unsigned h) { return __builtin_bit_cast(float, h << 16); }
__device__ __forceinline__ float bflo(unsigned w) { return __builtin_bit_cast(float, w << 16); }
__device__ __forceinline__ float bfhi(unsigned w) { return __builtin_bit_cast(float, w & 0xffff0000u); }

#define XB_TMO      128
#define XB_XCNT(j)  (256  + 64 * (j))
#define XB_XSUB(j)  (1280 + 64 * (j))
#define XB_XGEN(j)  (2304 + 64 * (j))
#define XB_TOP      3328
#define XB_TOPGEN   3392
#define XCD_BAR_WORDS 3456
#define XB_SPIN_CAP (1u << 22)
__device__ __forceinline__ unsigned xb_ld(unsigned* p)              { return __hip_atomic_load(p, __ATOMIC_RELAXED, __HIP_MEMORY_SCOPE_AGENT); }
__device__ __forceinline__ unsigned xb_add(unsigned* p, unsigned v) { return __hip_atomic_fetch_add(p, v, __ATOMIC_RELAXED, __HIP_MEMORY_SCOPE_AGENT); }
__device__ __forceinline__ unsigned xb_xcc_id() { return (unsigned)__builtin_amdgcn_s_getreg((3 << 11) | 20) & 0xFu; }
#define XB_SPIN(cond, bar) do { unsigned _sp = 0; while (cond) { __builtin_amdgcn_s_sleep(1); \
    if ((++_sp & 255u) == 0u) { if (xb_ld(&(bar)[XB_TMO])) break; if (_sp > XB_SPIN_CAP) { atomicAdd(&(bar)[XB_TMO], 1u); break; } } } } while (0)
struct XcdBarrier { unsigned* bar; unsigned x; volatile LAS unsigned* st; };
__device__ __forceinline__ XcdBarrier xcd_barrier_post(unsigned* bar, volatile LAS unsigned* st) {
    XcdBarrier b; b.bar = bar; b.x = xb_xcc_id(); b.st = st;
    if (threadIdx.x == 0) (void)xb_add(&bar[XB_XCNT(b.x)], 1u);
    return b;
}
__device__ __forceinline__ void xcd_barrier_complete(unsigned* bar, unsigned x, unsigned& nloc, unsigned& nx) {
    const unsigned G = gridDim.x * gridDim.y * gridDim.z;
    unsigned sum, cnt, mine, sp = 0u;
    for (;;) {
        sum = 0u; cnt = 0u; mine = 0u;
#pragma unroll
        for (unsigned j = 0; j < 16; ++j) { const unsigned c = xb_ld(&bar[XB_XCNT(j)]); sum += c; cnt += (c > 0u) ? 1u : 0u; mine = (j == x) ? c : mine; }
        if (sum == G) break;
        __builtin_amdgcn_s_sleep(1);
        if ((++sp & 255u) == 0u) { if (xb_ld(&bar[XB_TMO])) break; if (sp > XB_SPIN_CAP) { atomicAdd(&bar[XB_TMO], 1u); break; } }
    }
    nloc = mine > 0u ? mine : 1u; nx = cnt > 0u ? cnt : 1u;
}
__device__ __forceinline__ void xcd_barrier(const XcdBarrier& b) {
    asm volatile("s_waitcnt vmcnt(0)" ::: "memory");
    __syncthreads();
    if (threadIdx.x == 0) {
        unsigned* bar = b.bar;
        __builtin_amdgcn_s_waitcnt(0);
        unsigned nloc = b.st[0], nx = b.st[1];
        if (nloc == 0u) { xcd_barrier_complete(bar, b.x, nloc, nx); b.st[0] = nloc; b.st[1] = nx; }
        const unsigned old = xb_add(&bar[XB_XSUB(b.x)], 1u);
        const unsigned gen = old / nloc;
        if (old + 1u == (gen + 1u) * nloc) {
            __builtin_amdgcn_fence(__ATOMIC_RELEASE, "agent");
            asm volatile("s_waitcnt vmcnt(0)" ::: "memory");
            const unsigned og = xb_add(&bar[XB_TOP], 1u);
            const unsigned tg = og / nx;
            if (og + 1u == (tg + 1u) * nx) xb_add(&bar[XB_TOPGEN], 1u);
            else XB_SPIN(xb_ld(&bar[XB_TOPGEN]) == tg, bar);
            __builtin_amdgcn_fence(__ATOMIC_ACQUIRE, "agent");
            xb_add(&bar[XB_XGEN(b.x)], 1u);
            asm volatile("s_waitcnt vmcnt(0)" ::: "memory");
        } else {
            XB_SPIN(xb_ld(&bar[XB_XGEN(b.x)]) == gen, bar);
            __builtin_amdgcn_fence(__ATOMIC_ACQUIRE, "agent");
            asm volatile("s_waitcnt vmcnt(0)" ::: "memory");
        }
    }
    __syncthreads();
}

struct Args { const float* in[20]; float* out; unsigned char* ws; int ph_lo, ph_hi, li, pad; };
enum { I_X = 0, I_META, I_GMIX, I_WIN, I_GKV, I_WKVUP, I_GIDXK, I_BF, I_WBA, I_WBB, I_WOUT, I_GFFN, I_WGROUP, I_BGROUP, I_WEXPERT, I_BEXPERT, I_WGATE, I_WUP, I_WDOWN, I_GFINAL };

__device__ __forceinline__ float wave_sum(float v) {
#pragma unroll
    for (int o = 1; o < 64; o <<= 1) v += __shfl_xor(v, o);
    return v;
}
__device__ __forceinline__ int wave_isum(int v) {
#pragma unroll
    for (int o = 1; o < 64; o <<= 1) v += __shfl_xor(v, o);
    return __builtin_amdgcn_readfirstlane(v);
}
__device__ __forceinline__ float wave_max(float v) {
#pragma unroll
    for (int o = 1; o < 64; o <<= 1) v = fmaxf(v, __shfl_xor(v, o));
    return v;
}

__device__ __forceinline__ void transpose_item(const float* colp, size_t ldsrc, bf16* WT, int ldwt, int k0, int n0, LAS float* scr, int lane, const float* rowscale = nullptr) {
    float v[32];
#pragma unroll
    for (int i = 0; i < 32; ++i) { const int kk = 2 * i + (lane >> 5); v[i] = colp ? colp[(size_t)(k0 + kk) * ldsrc] : 0.f; }
#pragma unroll
    for (int i = 0; i < 32; i += 8) asm volatile("" : "+v"(v[i]), "+v"(v[i + 1]), "+v"(v[i + 2]), "+v"(v[i + 3]), "+v"(v[i + 4]), "+v"(v[i + 5]), "+v"(v[i + 6]), "+v"(v[i + 7]));
#pragma unroll
    for (int i = 0; i < 32; ++i) { const int kk = 2 * i + (lane >> 5); scr[kk * 33 + (lane & 31)] = rowscale ? v[i] * rowscale[k0 + kk] : v[i]; }
    LDS_WAIT(); asm volatile("" ::: "memory");
    const int c = lane & 7;
#pragma unroll
    for (int j = 0; j < 4; ++j) { const int n = (lane >> 3) + 8 * j; const LAS float* s = scr + (8 * c) * 33 + n;
        v4u o; o.x = pk2(s[0 * 33], s[1 * 33]); o.y = pk2(s[2 * 33], s[3 * 33]); o.z = pk2(s[4 * 33], s[5 * 33]); o.w = pk2(s[6 * 33], s[7 * 33]);
        *(GAS v4u*)(WT + (size_t)(n0 + n) * ldwt + k0 + 8 * c) = o; }
    LDS_WAIT(); asm volatile("" ::: "memory");
}
__device__ __forceinline__ void tr_load(float (&v)[32], const float* colp, size_t ldsrc, int k0, int lane) {
#pragma unroll
    for (int i = 0; i < 32; ++i) { const int kk = 2 * i + (lane >> 5); v[i] = colp ? colp[(size_t)(k0 + kk) * ldsrc] : 0.f; }
}
__device__ __forceinline__ void tr_fence(float (&v)[32]) {
#pragma unroll
    for (int i = 0; i < 32; i += 8) asm volatile("" : "+v"(v[i]), "+v"(v[i + 1]), "+v"(v[i + 2]), "+v"(v[i + 3]), "+v"(v[i + 4]), "+v"(v[i + 5]), "+v"(v[i + 6]), "+v"(v[i + 7]));
}
__device__ __forceinline__ void tr_store(const float (&v)[32], bf16* WT, int ldwt, int k0, int n0, LAS float* scr, int lane, const float* rowscale = nullptr) {
#pragma unroll
    for (int i = 0; i < 32; ++i) { const int kk = 2 * i + (lane >> 5); scr[kk * 33 + (lane & 31)] = rowscale ? v[i] * rowscale[k0 + kk] : v[i]; }
    LDS_WAIT(); asm volatile("" ::: "memory");
    const int c = lane & 7;
#pragma unroll
    for (int j = 0; j < 4; ++j) { const int n = (lane >> 3) + 8 * j; const LAS float* s = scr + (8 * c) * 33 + n;
        v4u o; o.x = pk2(s[0 * 33], s[1 * 33]); o.y = pk2(s[2 * 33], s[3 * 33]); o.z = pk2(s[4 * 33], s[5 * 33]); o.w = pk2(s[6 * 33], s[7 * 33]);
        *(GAS v4u*)(WT + (size_t)(n0 + n) * ldwt + k0 + 8 * c) = o; }
    LDS_WAIT(); asm volatile("" ::: "memory");
}
__device__ __forceinline__ int rope_dim(int c, int half) { return (c & 1) ? half + (c >> 1) : (c >> 1); }
__device__ __forceinline__ int win_src(int n) {
    if (n < 1024) return (n & ~127) + rope_dim(n & 127, 64);
    if (n < PC_QI) return n;
    if (n < PC_KI) return PC_QI + ((n - PC_QI) & ~63) + rope_dim((n - PC_QI) & 63, 32);
    if (n < PC_FB) return n;
    if (n < PC_FB + 8) return 5712 + (n - PC_FB);
    if (n < PC_QB) return -1;
    if (n < PC_GA) return 2640 + (n - PC_QB);
    if (n < PC_END) return 5720 + (n - PC_GA);
    return -1;
}

using pg8::Unit;
typedef pg8::f32x4 (AccT)[2][2][4][2];
#define EPI_FOREACH(...) \
    _Pragma("unroll") for (int ai = 0; ai < 2; ++ai) _Pragma("unroll") for (int m = 0; m < 4; ++m) _Pragma("unroll") for (int bj = 0; bj < 2; ++bj) { \
        const int row = u.pm * 256 + ai * 128 + wr * 64 + m * 16 + fr; const int col = u.pn * 256 + bj * 128 + wc * 32 + 8 * fq; \
        const f32x4 v0 = acc[ai][bj][m][0], v1 = acc[ai][bj][m][1]; __VA_ARGS__ }

#define PACK8(v0, v1) (v4u){pg8::cvt_pk_bf16((v0)[0], (v0)[1]), pg8::cvt_pk_bf16((v0)[2], (v0)[3]), pg8::cvt_pk_bf16((v1)[0], (v1)[1]), pg8::cvt_pk_bf16((v1)[2], (v1)[3])}
__device__ __forceinline__ void rope8(f32x4& v0, f32x4& v1, const f32x4 cs0, const f32x4 cs1) {
    const f32x4 a = v0, b = v1;
    v0[0] = a[0] * cs0[0] - a[1] * cs0[1]; v0[1] = a[1] * cs0[0] + a[0] * cs0[1]; v0[2] = a[2] * cs0[2] - a[3] * cs0[3]; v0[3] = a[3] * cs0[2] + a[2] * cs0[3];
    v1[0] = b[0] * cs1[0] - b[1] * cs1[1]; v1[1] = b[1] * cs1[0] + b[0] * cs1[1]; v1[2] = b[2] * cs1[2] - b[3] * cs1[3]; v1[3] = b[3] * cs1[2] + b[2] * cs1[3];
}
struct EpiProj { static constexpr bool HAS_MID = false;
    bf16* P; float* SM; const float* R128; const float* R64; float* SSQ;
    __device__ __forceinline__ void operator()(const AccT& acc, const Unit& u, int wr, int wc, int fr, int fq) const {
        const int kind = u.pn < 4 ? 1 : (u.pn < 6 ? 2 : (u.pn < 10 ? 3 : (u.pn == 10 ? 4 : 0)));
#pragma unroll
        for (int ai = 0; ai < 2; ++ai)
#pragma unroll
            for (int mp = 0; mp < 2; ++mp) {
                f32x4 cs[2][2];
                if (kind == 1 || kind == 3) {
#pragma unroll
                    for (int mm = 0; mm < 2; ++mm) { const int pos = NMETA + u.pm * 256 + ai * 128 + wr * 64 + (2 * mp + mm) * 16 + fr;
                        const float* t = kind == 1 ? R128 + ((size_t)pos * 64 + 16 * wc + 4 * fq) * 2 : R64 + ((size_t)pos * 32 + 16 * (wc & 1) + 4 * fq) * 2;
                        cs[mm][0] = *(const f32x4*)t; cs[mm][1] = *(const f32x4*)(t + 4); }
                    asm volatile("" : "+v"(cs[0][0]), "+v"(cs[0][1]), "+v"(cs[1][0]), "+v"(cs[1][1]));
                }
#pragma unroll
                for (int mm = 0; mm < 2; ++mm)
#pragma unroll
                    for (int bj = 0; bj < 2; ++bj) { const int m = 2 * mp + mm;
                        const int row = NMETA + u.pm * 256 + ai * 128 + wr * 64 + m * 16 + fr; const int col = u.pn * 256 + bj * 128 + wc * 32 + 8 * fq;
                        f32x4 v0 = acc[ai][bj][m][0], v1 = acc[ai][bj][m][1];
                        if (kind == 1 || kind == 3) rope8(v0, v1, cs[mm][0], cs[mm][1]);
                        if (kind == 2) { float q = (v0[0] * v0[0] + v0[1] * v0[1]) + (v0[2] * v0[2] + v0[3] * v0[3]) + (v1[0] * v1[0] + v1[1] * v1[1]) + (v1[2] * v1[2] + v1[3] * v1[3]);
                            q += __shfl_xor(q, 16); q += __shfl_xor(q, 32); if (fq == 0) SSQ[(size_t)row * 16 + (u.pn - 4) * 8 + bj * 4 + wc] = q; }
                        if (kind == 4 && bj == 0) { float* sm = SM + (size_t)row * 128 + (col - 2560); *(f32x4*)sm = v0; *(f32x4*)(sm + 4) = v1; }
                        *(v4u*)(P + (size_t)row * PW + col) = PACK8(v0, v1);
                    }
            }
    }
};
struct EpiKvUp { static constexpr bool HAS_MID = false;
    bf16* O; const float* R128; const float* SSQ;
    __device__ __forceinline__ void operator()(const AccT& acc, const Unit& u, int wr, int wc, int fr, int fq) const {
        const bool isk = u.pn < 4;
#pragma unroll
        for (int ai = 0; ai < 2; ++ai)
#pragma unroll
            for (int mp = 0; mp < 2; ++mp) {
                f32x4 cs[2][2], sq[2][4];
#pragma unroll
                for (int mm = 0; mm < 2; ++mm) { const int pos = NMETA + u.pm * 256 + ai * 128 + wr * 64 + (2 * mp + mm) * 16 + fr;
                    const f32x4* sp = (const f32x4*)(SSQ + (size_t)pos * 16); sq[mm][0] = sp[0]; sq[mm][1] = sp[1]; sq[mm][2] = sp[2]; sq[mm][3] = sp[3];
                    if (isk) { const float* t = R128 + ((size_t)pos * 64 + 16 * wc + 4 * fq) * 2; cs[mm][0] = *(const f32x4*)t; cs[mm][1] = *(const f32x4*)(t + 4); } }
                asm volatile("" : "+v"(sq[0][0]), "+v"(sq[0][1]), "+v"(sq[0][2]), "+v"(sq[0][3]), "+v"(sq[1][0]), "+v"(sq[1][1]), "+v"(sq[1][2]), "+v"(sq[1][3]));
                if (isk) asm volatile("" : "+v"(cs[0][0]), "+v"(cs[0][1]), "+v"(cs[1][0]), "+v"(cs[1][1]));
#pragma unroll
                for (int mm = 0; mm < 2; ++mm) { const int m = 2 * mp + mm;
                    const f32x4 s0 = sq[mm][0], s1 = sq[mm][1], s2 = sq[mm][2], s3 = sq[mm][3];
                    const float ss = (((s0[0] + s0[1]) + (s0[2] + s0[3])) + ((s1[0] + s1[1]) + (s1[2] + s1[3]))) + (((s2[0] + s2[1]) + (s2[2] + s2[3])) + ((s3[0] + s3[1]) + (s3[2] + s3[3])));
                    const float rstd = 1.f / sqrtf(ss * (1.f / 512.f) + EPS);
#pragma unroll
                    for (int bj = 0; bj < 2; ++bj) {
                        const int row = NMETA + u.pm * 256 + ai * 128 + wr * 64 + m * 16 + fr; const int col = u.pn * 256 + bj * 128 + wc * 32 + 8 * fq;
                        f32x4 v0 = acc[ai][bj][m][0] * rstd, v1 = acc[ai][bj][m][1] * rstd;
                        if (isk) rope8(v0, v1, cs[mm][0], cs[mm][1]);
                        *(v4u*)(O + (size_t)row * 2048 + col) = PACK8(v0, v1);
                    } }
            }
    }
};
template <int UNR>
__device__ __forceinline__ void gemm16(const bf16* A, int lda, const bf16* Bt, int ldb, int K, int lane, f32x4 (&out)[4]) {
    const int fr = lane & 15, fq = lane >> 4;
    const bf16* ap = A + (size_t)fr * lda + 8 * fq; const bf16* bp = Bt + (size_t)fr * ldb + 8 * fq;
#pragma unroll
    for (int t = 0; t < 4; ++t) out[t] = (f32x4){0.f, 0.f, 0.f, 0.f};
#pragma unroll UNR
    for (int k0 = 0; k0 < K; k0 += 32) {
        const bf16x8 av = *(const bf16x8*)(ap + k0);
#pragma unroll
        for (int t = 0; t < 4; ++t) { const bf16x8 bv = *(const bf16x8*)(bp + (size_t)(16 * t) * ldb + k0); out[t] = __builtin_amdgcn_mfma_f32_16x16x32_bf16(av, bv, out[t], 0, 0, 0); }
    }
}
struct EpiBf16Plain { static constexpr bool HAS_MID = false;
    bf16* O; int ldc;
    __device__ __forceinline__ void operator()(const AccT& acc, const Unit& u, int wr, int wc, int fr, int fq) const {
        EPI_FOREACH({ v4u w; w.x = pg8::cvt_pk_bf16(v0[0], v0[1]); w.y = pg8::cvt_pk_bf16(v0[2], v0[3]); w.z = pg8::cvt_pk_bf16(v1[0], v1[1]); w.w = pg8::cvt_pk_bf16(v1[2], v1[3]);
            *(v4u*)(O + (size_t)row * ldc + col) = w; })
    }
};
__device__ __forceinline__ float sigmoidf_(float x) { return 1.f / (1.f + __expf(-x)); }
#define EPI_ROWCOL(ai, m, bj) const int row = u.pm * 256 + (ai) * 128 + wr * 64 + (m) * 16 + fr; const int col = u.pn * 256 + (bj) * 128 + wc * 32 + 8 * fq
struct EpiBranchA { static constexpr bool HAS_MID = false;
    const bf16* P; float* M1;
    __device__ __forceinline__ void operator()(const AccT& acc, const Unit& u, int wr, int wc, int fr, int fq) const {
#pragma unroll
        for (int ai = 0; ai < 2; ++ai) {
            v4u gw[4][2];
#pragma unroll
            for (int m = 0; m < 4; ++m)
#pragma unroll
                for (int bj = 0; bj < 2; ++bj) { EPI_ROWCOL(ai, m, bj); gw[m][bj] = *(const v4u*)(P + (size_t)(row + NMETA) * PW + PC_GA + col); }
#pragma unroll
            for (int m = 0; m < 4; ++m) asm volatile("" : "+v"(gw[m][0]), "+v"(gw[m][1]));
#pragma unroll
            for (int m = 0; m < 4; ++m)
#pragma unroll
                for (int bj = 0; bj < 2; ++bj) { EPI_ROWCOL(ai, m, bj); const v4u g = gw[m][bj]; const f32x4 v0 = acc[ai][bj][m][0], v1 = acc[ai][bj][m][1];
                    f32x4 o0, o1;
                    o0[0] = sigmoidf_(bflo(g.x)) * v0[0]; o0[1] = sigmoidf_(bfhi(g.x)) * v0[1]; o0[2] = sigmoidf_(bflo(g.y)) * v0[2]; o0[3] = sigmoidf_(bfhi(g.y)) * v0[3];
                    o1[0] = sigmoidf_(bflo(g.z)) * v1[0]; o1[1] = sigmoidf_(bfhi(g.z)) * v1[1]; o1[2] = sigmoidf_(bflo(g.w)) * v1[2]; o1[3] = sigmoidf_(bfhi(g.w)) * v1[3];
                    float* d = M1 + (size_t)row * 2048 + col; *(f32x4*)d = o0; *(f32x4*)(d + 4) = o1; }
        }
    }
};
struct EpiBranchB { static constexpr bool HAS_MID = false;
    const bf16* P; const float* M1; bf16* MG;
    __device__ __forceinline__ void operator()(const AccT& acc, const Unit& u, int wr, int wc, int fr, int fq) const {
#pragma unroll
        for (int ai = 0; ai < 2; ++ai)
#pragma unroll
            for (int mp = 0; mp < 2; ++mp) {
                v4u gw[2][2]; f32x4 a0[2][2], a1[2][2];
#pragma unroll
                for (int mm = 0; mm < 2; ++mm)
#pragma unroll
                    for (int bj = 0; bj < 2; ++bj) { EPI_ROWCOL(ai, 2 * mp + mm, bj); gw[mm][bj] = *(const v4u*)(P + (size_t)(row + NMETA) * PW + PC_GB + col);
                        const float* d = M1 + (size_t)row * 2048 + col; a0[mm][bj] = *(const f32x4*)d; a1[mm][bj] = *(const f32x4*)(d + 4); }
#pragma unroll
                for (int mm = 0; mm < 2; ++mm) asm volatile("" : "+v"(gw[mm][0]), "+v"(gw[mm][1]), "+v"(a0[mm][0]), "+v"(a0[mm][1]), "+v"(a1[mm][0]), "+v"(a1[mm][1]));
#pragma unroll
                for (int mm = 0; mm < 2; ++mm)
#pragma unroll
                    for (int bj = 0; bj < 2; ++bj) { EPI_ROWCOL(ai, 2 * mp + mm, bj); const v4u g = gw[mm][bj]; const f32x4 v0 = acc[ai][bj][2 * mp + mm][0], v1 = acc[ai][bj][2 * mp + mm][1];
                        const f32x4 b0 = a0[mm][bj], b1 = a1[mm][bj]; f32x4 o0, o1;
                        o0[0] = b0[0] + sigmoidf_(bflo(g.x)) * v0[0]; o0[1] = b0[1] + sigmoidf_(bfhi(g.x)) * v0[1]; o0[2] = b0[2] + sigmoidf_(bflo(g.y)) * v0[2]; o0[3] = b0[3] + sigmoidf_(bfhi(g.y)) * v0[3];
                        o1[0] = b1[0] + sigmoidf_(bflo(g.z)) * v1[0]; o1[1] = b1[1] + sigmoidf_(bfhi(g.z)) * v1[1]; o1[2] = b1[2] + sigmoidf_(bflo(g.w)) * v1[2]; o1[3] = b1[3] + sigmoidf_(bfhi(g.w)) * v1[3];
                        v4u w; w.x = pg8::cvt_pk_bf16(o0[0], o0[1]); w.y = pg8::cvt_pk_bf16(o0[2], o0[3]); w.z = pg8::cvt_pk_bf16(o1[0], o1[1]); w.w = pg8::cvt_pk_bf16(o1[2], o1[3]);
                        *(v4u*)(MG + (size_t)row * 2048 + col) = w; }
            }
    }
};
__device__ __forceinline__ float sig_ratio(float ga, float gbc) { return (1.f + __expf(-gbc)) / (1.f + __expf(-ga)); }
struct EpiBranchFused { static constexpr bool HAS_MID = true;
    const bf16* P; bf16* MG;
    __device__ __forceinline__ void mid(AccT& acc, const Unit& u, int wr, int wc, int fr_in, int fq) const {
        int fr = fr_in; asm volatile("" : "+v"(fr));
#pragma unroll
        for (int ai = 0; ai < 2; ++ai)
#pragma unroll
            for (int mp = 0; mp < 2; ++mp) {
                v4u ga[2][2], gb[2][2];
#pragma unroll
                for (int mm = 0; mm < 2; ++mm)
#pragma unroll
                    for (int bj = 0; bj < 2; ++bj) { EPI_ROWCOL(ai, 2 * mp + mm, bj); const bf16* gp = P + (size_t)(row + NMETA) * PW + col; ga[mm][bj] = *(const v4u*)(gp + PC_GA); gb[mm][bj] = *(const v4u*)(gp + PC_GB); }
#pragma unroll
                for (int mm = 0; mm < 2; ++mm) asm volatile("" : "+v"(ga[mm][0]), "+v"(ga[mm][1]), "+v"(gb[mm][0]), "+v"(gb[mm][1]));
#pragma unroll
                for (int mm = 0; mm < 2; ++mm)
#pragma unroll
                    for (int bj = 0; bj < 2; ++bj) { const int m = 2 * mp + mm; const v4u a = ga[mm][bj], b = gb[mm][bj];
                        acc[ai][bj][m][0][0] *= sig_ratio(bflo(a.x), fmaxf(bflo(b.x), -80.f)); acc[ai][bj][m][0][1] *= sig_ratio(bfhi(a.x), fmaxf(bfhi(b.x), -80.f));
                        acc[ai][bj][m][0][2] *= sig_ratio(bflo(a.y), fmaxf(bflo(b.y), -80.f)); acc[ai][bj][m][0][3] *= sig_ratio(bfhi(a.y), fmaxf(bfhi(b.y), -80.f));
                        acc[ai][bj][m][1][0] *= sig_ratio(bflo(a.z), fmaxf(bflo(b.z), -80.f)); acc[ai][bj][m][1][1] *= sig_ratio(bfhi(a.z), fmaxf(bfhi(b.z), -80.f));
                        acc[ai][bj][m][1][2] *= sig_ratio(bflo(a.w), fmaxf(bflo(b.w), -80.f)); acc[ai][bj][m][1][3] *= sig_ratio(bfhi(a.w), fmaxf(bfhi(b.w), -80.f)); }
            }
    }
    __device__ __forceinline__ void operator()(const AccT& acc, const Unit& u, int wr, int wc, int fr, int fq) const {
#pragma unroll
        for (int ai = 0; ai < 2; ++ai) {
            v4u gb[4][2];
#pragma unroll
            for (int m = 0; m < 4; ++m)
#pragma unroll
                for (int bj = 0; bj < 2; ++bj) { EPI_ROWCOL(ai, m, bj); gb[m][bj] = *(const v4u*)(P + (size_t)(row + NMETA) * PW + PC_GB + col); }
#pragma unroll
            for (int m = 0; m < 4; ++m) asm volatile("" : "+v"(gb[m][0]), "+v"(gb[m][1]));
#pragma unroll
            for (int m = 0; m < 4; ++m)
#pragma unroll
                for (int bj = 0; bj < 2; ++bj) { EPI_ROWCOL(ai, m, bj); const v4u g = gb[m][bj]; const f32x4 v0 = acc[ai][bj][m][0], v1 = acc[ai][bj][m][1]; f32x4 o0, o1;
                    o0[0] = sigmoidf_(fmaxf(bflo(g.x), -80.f)) * v0[0]; o0[1] = sigmoidf_(fmaxf(bfhi(g.x), -80.f)) * v0[1]; o0[2] = sigmoidf_(fmaxf(bflo(g.y), -80.f)) * v0[2]; o0[3] = sigmoidf_(fmaxf(bfhi(g.y), -80.f)) * v0[3];
                    o1[0] = sigmoidf_(fmaxf(bflo(g.z), -80.f)) * v1[0]; o1[1] = sigmoidf_(fmaxf(bfhi(g.z), -80.f)) * v1[1]; o1[2] = sigmoidf_(fmaxf(bflo(g.w), -80.f)) * v1[2]; o1[3] = sigmoidf_(fmaxf(bfhi(g.w), -80.f)) * v1[3];
                    *(v4u*)(MG + (size_t)row * 2048 + col) = PACK8(o0, o1); }
        }
    }
};
struct EpiOut { static constexpr bool HAS_MID = false;
    const float* X; float* H2; float* SQ;
    __device__ __forceinline__ void operator()(const AccT& acc, const Unit& u, int wr, int wc, int fr, int fq) const {
#pragma unroll
        for (int ai = 0; ai < 2; ++ai)
#pragma unroll
            for (int mp = 0; mp < 2; ++mp) {
                f32x4 a0[2][2], a1[2][2];
#pragma unroll
                for (int mm = 0; mm < 2; ++mm)
#pragma unroll
                    for (int bj = 0; bj < 2; ++bj) { EPI_ROWCOL(ai, 2 * mp + mm, bj); const float* xs = X + (size_t)row * 2048 + col; a0[mm][bj] = *(const f32x4*)xs; a1[mm][bj] = *(const f32x4*)(xs + 4); }
#pragma unroll
                for (int mm = 0; mm < 2; ++mm) asm volatile("" : "+v"(a0[mm][0]), "+v"(a0[mm][1]), "+v"(a1[mm][0]), "+v"(a1[mm][1]));
#pragma unroll
                for (int mm = 0; mm < 2; ++mm)
#pragma unroll
                    for (int bj = 0; bj < 2; ++bj) { EPI_ROWCOL(ai, 2 * mp + mm, bj); float* d = H2 + (size_t)row * 2048 + col;
                        const f32x4 h0 = a0[mm][bj] + acc[ai][bj][2 * mp + mm][0], h1 = a1[mm][bj] + acc[ai][bj][2 * mp + mm][1];
                        *(f32x4*)d = h0; *(f32x4*)(d + 4) = h1;
                        float q = ((h0[0] * h0[0] + h0[1] * h0[1]) + (h0[2] * h0[2] + h0[3] * h0[3])) + ((h1[0] * h1[0] + h1[1] * h1[1]) + (h1[2] * h1[2] + h1[3] * h1[3]));
                        q += __shfl_xor(q, 16); q += __shfl_xor(q, 32); if (fq == 0) SQ[(size_t)row * 64 + u.pn * 8 + bj * 4 + wc] = q; }
            }
    }
};
struct EpiGateUp { static constexpr bool HAS_MID = false;
    bf16* ACT; const float* ROWW;
    __device__ __forceinline__ void operator()(const AccT& acc, const Unit& u, int wr, int wc, int fr, int fq) const {
        float rwv[2][4];
#pragma unroll
        for (int ai = 0; ai < 2; ++ai)
#pragma unroll
            for (int m = 0; m < 4; ++m) rwv[ai][m] = ROWW[u.rb + ai * 128 + wr * 64 + m * 16 + fr];
        asm volatile("" : "+v"(rwv[0][0]), "+v"(rwv[0][1]), "+v"(rwv[0][2]), "+v"(rwv[0][3]), "+v"(rwv[1][0]), "+v"(rwv[1][1]), "+v"(rwv[1][2]), "+v"(rwv[1][3]));
#pragma unroll
        for (int ai = 0; ai < 2; ++ai)
#pragma unroll
            for (int m = 0; m < 4; ++m) {
                const int row = u.pm * 256 + ai * 128 + wr * 64 + m * 16 + fr; const int col = u.pn * 128 + wc * 32 + 8 * fq;
                const float rw = rwv[ai][m];
                float o[8];
#pragma unroll
                for (int n = 0; n < 2; ++n)
#pragma unroll
                    for (int j = 0; j < 4; ++j) { const float gv = acc[ai][0][m][n][j], uv = acc[ai][1][m][n][j]; o[n * 4 + j] = gv * sigmoidf_(gv) * uv * rw; }
                v4u w; w.x = pg8::cvt_pk_bf16(o[0], o[1]); w.y = pg8::cvt_pk_bf16(o[2], o[3]); w.z = pg8::cvt_pk_bf16(o[4], o[5]); w.w = pg8::cvt_pk_bf16(o[6], o[7]);
                *(v4u*)(ACT + (size_t)row * 512 + col) = w;
            }
    }
};
struct EpiDown { static constexpr bool HAS_MID = false;
    bf16* Y; const int* ROWTOK;
    __device__ __forceinline__ void operator()(const AccT& acc, const Unit& u, int wr, int wc, int fr, int fq) const {
        int rtv[2][4];
#pragma unroll
        for (int ai = 0; ai < 2; ++ai)
#pragma unroll
            for (int m = 0; m < 4; ++m) rtv[ai][m] = ROWTOK[u.rb + ai * 128 + wr * 64 + m * 16 + fr];
        asm volatile("" : "+v"(rtv[0][0]), "+v"(rtv[0][1]), "+v"(rtv[0][2]), "+v"(rtv[0][3]), "+v"(rtv[1][0]), "+v"(rtv[1][1]), "+v"(rtv[1][2]), "+v"(rtv[1][3]));
#pragma unroll
        for (int ai = 0; ai < 2; ++ai)
#pragma unroll
            for (int m = 0; m < 4; ++m) {
                const int rt = rtv[ai][m];
                if (rt >= 0) { bf16* d = Y + ((size_t)(rt & 1) * SEQ + (rt >> 1)) * 2048 + u.pn * 256 + wc * 32 + 8 * fq;
#pragma unroll
                    for (int bj = 0; bj < 2; ++bj) { const f32x4 v0 = acc[ai][bj][m][0], v1 = acc[ai][bj][m][1];
                        v4u w; w.x = pg8::cvt_pk_bf16(v0[0], v0[1]); w.y = pg8::cvt_pk_bf16(v0[2], v0[3]); w.z = pg8::cvt_pk_bf16(v1[0], v1[1]); w.w = pg8::cvt_pk_bf16(v1[2], v1[3]);
                        *(v4u*)(d + bj * 128) = w; } }
            }
    }
};

__device__ __forceinline__ size_t s_row_off(int qr) { const int b = qr >> 8; const size_t pitch = 320 + 256 * b; return (size_t)256 * (320 * (size_t)b + 128 * (size_t)b * (b - 1)) + (size_t)(qr & 255) * pitch; }
__device__ __forceinline__ unsigned f2key(float f) { const unsigned u = __builtin_bit_cast(unsigned, f); return u ^ ((u >> 31) ? 0xFFFFFFFFu : 0x80000000u); }

constexpr int PC_I_IN = 32 * (PW / 32), PC_I_KV = 8 * 64, PC_I_A = 16 * 64, PC_I_O = 32 * 64, PC_NITEMS = PC_I_IN + PC_I_KV + 2 * PC_I_A + PC_I_O;
__device__ __forceinline__ void copy_items(const Args& a, LAS unsigned char* lds, int it_lo, int it_hi, int gw, int NGW, int wave, int lane) {
    unsigned char* ws = a.ws;
    LAS float* scr = (LAS float*)(lds + RING_OFF + wave * 16384);
    constexpr int I_IN = PC_I_IN, I_KV = PC_I_KV, I_A = PC_I_A;
    auto item = [&](int it, const float*& src, size_t& ldsrc, bf16*& dst, int& ldwt, int& k0, int& n0, const float*& rsc) {
        int r = it; rsc = nullptr;
        if (r < I_IN) { const int nblk = PW / 32, kb = r / nblk, nb = r % nblk; const int sc = win_src(nb * 32 + (lane & 31));
            src = sc >= 0 ? a.in[I_WIN] + sc : nullptr; ldsrc = INW; dst = (bf16*)(ws + WS_WINT); ldwt = 2048; k0 = 64 * kb; n0 = 32 * nb; return; } r -= I_IN;
        if (r < I_KV) { const int kb = r / 64, nb = r % 64; const int n = nb * 32 + (lane & 31); const int sc = n < 1024 ? (n & ~127) + rope_dim(n & 127, 64) : n;
            src = a.in[I_WKVUP] + sc; ldsrc = 2048; dst = (bf16*)(ws + WS_WKVT); ldwt = 512; k0 = 64 * kb; n0 = 32 * nb; rsc = a.in[I_GKV]; return; } r -= I_KV;
        if (r < I_A) { const int kb = r / 64, nb = r % 64; src = a.in[I_WBA] + nb * 32 + (lane & 31); ldsrc = 2048; dst = (bf16*)(ws + WS_WAT); ldwt = 2048; k0 = 64 * kb; n0 = 32 * nb; return; } r -= I_A;
        if (r < I_A) { const int kb = r / 64, nb = r % 64; src = a.in[I_WBB] + nb * 32 + (lane & 31); ldsrc = 2048; dst = (bf16*)(ws + WS_WAT) + 1024; ldwt = 2048; k0 = 64 * kb; n0 = 32 * nb; return; } r -= I_A;
        { const int kb = r / 64, nb = r % 64; src = a.in[I_WOUT] + nb * 32 + (lane & 31); ldsrc = 2048; dst = (bf16*)(ws + WS_WOT); ldwt = 2048; k0 = 64 * kb; n0 = 32 * nb; }
    };
#pragma unroll 1
    for (int it = it_lo + gw; it < it_hi; it += 2 * NGW) {
        const float* s0; size_t l0; bf16* d0; int w0, k0, n0; const float* r0; item(it, s0, l0, d0, w0, k0, n0, r0);
        const bool two = it + NGW < it_hi;
        const float* s1; size_t l1; bf16* d1; int w1, k1, n1; const float* r1; item(two ? it + NGW : it, s1, l1, d1, w1, k1, n1, r1);
        float va[32], vb[32];
        tr_load(va, s0, l0, k0, lane); tr_load(vb, s1, l1, k1, lane);
        tr_fence(va); tr_fence(vb);
        tr_store(va, d0, w0, k0, n0, scr, lane, r0);
        if (two) tr_store(vb, d1, w1, k1, n1, scr, lane, r1);
    }
}
__device__ __forceinline__ void phase_prologue(const Args& a, LAS unsigned char* lds, int gw, int NGW, int wave, int lane, int it_hi) {
    unsigned char* ws = a.ws;
    copy_items(a, lds, 0, it_hi, gw, NGW, wave, lane);
    const f32x4* gm = (const f32x4*)a.in[I_GMIX];
    for (int p = gw; p < LP; p += NGW) {
        bf16* orow = (bf16*)(ws + WS_HN) + (size_t)p * 2048;
        if (p >= LTOK) { for (int j = 0; j < 8; ++j) *(v2u*)(orow + 4 * (lane + 64 * j)) = (v2u){0u, 0u}; continue; }
        const float* xrow = p < NMETA ? a.in[I_META] + (size_t)p * 2048 : a.in[I_X] + (size_t)(p - NMETA) * 2048;
        f32x4 v[8]; float s = 0.f;
#pragma unroll
        for (int j = 0; j < 8; ++j) { v[j] = ((const f32x4*)xrow)[lane + 64 * j]; s += (v[j][0] * v[j][0] + v[j][1] * v[j][1]) + (v[j][2] * v[j][2] + v[j][3] * v[j][3]); }
        const float rstd = 1.f / sqrtf(wave_sum(s) * (1.f / 2048.f) + EPS);
#pragma unroll
        for (int j = 0; j < 8; ++j) { const f32x4 g = gm[lane + 64 * j]; v2u o; o.x = pk2(v[j][0] * rstd * g[0], v[j][1] * rstd * g[1]); o.y = pk2(v[j][2] * rstd * g[2], v[j][3] * rstd * g[3]);
            *(v2u*)(orow + 4 * (lane + 64 * j)) = o; }
    }
    const int gt = gw * 64 + lane, NGT = NGW * 64;
    for (int i = gt; i < LTOK * 64; i += NGT) { const int p = i >> 6, f = i & 63; const double inv = exp(-9.210340371976184 * (double)f / 64.0); const double ang = (double)p * inv;
        double sn, cs; sincos(ang, &sn, &cs); ((f32x2*)(ws + WS_ROPE128))[i] = (f32x2){(float)cs, (float)sn}; }
    for (int i = gt; i < LTOK * 32; i += NGT) { const int p = i >> 5, f = i & 31; const double inv = exp(-9.210340371976184 * (double)f / 32.0); const double ang = (double)p * inv;
        double sn, cs; sincos(ang, &sn, &cs); ((f32x2*)(ws + WS_ROPE64))[i] = (f32x2){(float)cs, (float)sn}; }
}

__device__ __forceinline__ void phase_minipost(const Args& a, volatile LAS unsigned* lmax  , int gw, int NGW, int lane) {
    unsigned char* ws = a.ws;
    const float* SM = (const float*)(ws + WS_SMALL); const f32x2* R64 = (const f32x2*)(ws + WS_ROPE64);
    if (threadIdx.x < 8) lmax[threadIdx.x] = 0u;
    __syncthreads();
    float kmx = 0.f;
    for (int p = gw; p < LP; p += NGW) {
        if (p < LTOK) { const v4u* kr = (const v4u*)((const bf16*)(ws + WS_PROJ) + (size_t)p * PW + PC_KB + 16 * lane); const v4u k0 = kr[0], k1 = kr[1];
            float q = bflo(k0.x) * bflo(k0.x) + bfhi(k0.x) * bfhi(k0.x) + bflo(k0.y) * bflo(k0.y) + bfhi(k0.y) * bfhi(k0.y) + bflo(k0.z) * bflo(k0.z) + bfhi(k0.z) * bfhi(k0.z) + bflo(k0.w) * bflo(k0.w) + bfhi(k0.w) * bfhi(k0.w)
                    + bflo(k1.x) * bflo(k1.x) + bfhi(k1.x) * bfhi(k1.x) + bflo(k1.y) * bflo(k1.y) + bfhi(k1.y) * bfhi(k1.y) + bflo(k1.z) * bflo(k1.z) + bfhi(k1.z) * bfhi(k1.z) + bflo(k1.w) * bflo(k1.w) + bfhi(k1.w) * bfhi(k1.w);
            q += __shfl_xor(q, 1); q += __shfl_xor(q, 2); q += __shfl_xor(q, 4); kmx = fmaxf(kmx, q); }
        bf16* ki = (bf16*)(ws + WS_KI) + (size_t)p * 64;
        if (p >= LTOK) { if (lane < 8) *(v4u*)(ki + 8 * lane) = (v4u){0u, 0u, 0u, 0u};
            if (lane < 16) ((float*)(ws + WS_WI))[(size_t)p * 16 + lane] = 0.f; if (lane < 8) ((float*)(ws + WS_LOGF))[(size_t)lane * LP + p] = 0.f;
            if (p < LTOK + 64) { v4u* kv = (v4u*)((bf16*)(ws + WS_PROJ) + (size_t)p * PW + PC_KB); v4u* ka = (v4u*)((bf16*)(ws + WS_KVA) + (size_t)p * 2048);
#pragma unroll
                for (int j = 0; j < 4; ++j) { kv[lane + 64 * j] = (v4u){0u, 0u, 0u, 0u}; ka[lane + 64 * j] = (v4u){0u, 0u, 0u, 0u}; } }
            continue; }
        { const float v = SM[(size_t)p * 128 + lane]; const float rstd = 1.f / sqrtf(wave_sum(v * v) * (1.f / 64.f) + EPS);
          const float n = v * rstd * a.in[I_GIDXK][lane]; const float pr = __shfl_xor(n, 32); const f32x2 c2 = R64[(size_t)p * 32 + (lane & 31)];
          const float y = lane < 32 ? n * c2[0] - pr * c2[1] : n * c2[0] + pr * c2[1];
          ki[lane < 32 ? 2 * lane : 2 * (lane - 32) + 1] = (bf16)f2bf(y); }
        if (lane < 16) ((float*)(ws + WS_WI))[(size_t)p * 16 + lane] = SM[(size_t)p * 128 + 64 + lane] * (0.25f * 0.125f);
        if (lane < 8) { const float z = SM[(size_t)p * 128 + 80 + lane] + a.in[I_BF][lane]; ((float*)(ws + WS_LOGF))[(size_t)lane * LP + p] = fminf(z, 0.f) - log1pf(expf(-fabsf(z))); }
    }
    if ((lane & 7) == 0) __hip_atomic_fetch_max((LAS unsigned*)lmax + (lane >> 3), __float_as_uint(kmx), __ATOMIC_RELAXED, __HIP_MEMORY_SCOPE_WORKGROUP);
    __syncthreads();
    if (threadIdx.x < 8) __hip_atomic_fetch_max((unsigned*)(ws + WS_CTL) + CW_KMAX + threadIdx.x, lmax[threadIdx.x], RLX_AGENT);
}
__device__ __forceinline__ void meta_inproj(const Args& a, int mw, int NGW, int lane) {
    unsigned char* ws = a.ws; const int fr = lane & 15, fq = lane >> 4;
    bf16* PROJ = (bf16*)(ws + WS_PROJ); float* SM = (float*)(ws + WS_SMALL); float* SSQ = (float*)(ws + WS_SSQ);
    for (int it = mw; it < 42; it += NGW) {
        const int n0 = it < 8 ? PC_CKV + 64 * it : (it < 10 ? PC_KI + 64 * (it - 8) : PC_KB + 64 * (it - 10));
        f32x4 o[4]; gemm16<8>((const bf16*)(ws + WS_HN), 2048, (const bf16*)(ws + WS_WINT) + (size_t)n0 * 2048, 2048, 2048, lane, o);
#pragma unroll
        for (int r = 0; r < 4; ++r) { const int m = 4 * fq + r; float q = 0.f;
#pragma unroll
            for (int t = 0; t < 4; ++t) { const int n = n0 + 16 * t + fr; const float v = o[t][r]; PROJ[(size_t)m * PW + n] = (bf16)f2bf(v); q += v * v;
                if (it >= 8 && it < 10) SM[(size_t)m * 128 + (n - PC_KI)] = v; }
            if (it < 8) { q += __shfl_xor(q, 1); q += __shfl_xor(q, 2); q += __shfl_xor(q, 4); q += __shfl_xor(q, 8); if (fr == 0) { SSQ[(size_t)m * 16 + 2 * it] = q; SSQ[(size_t)m * 16 + 2 * it + 1] = 0.f; } } }
    }
}
__device__ __forceinline__ void meta_kvup(const Args& a, int gw, int NGW, int lane) {
    unsigned char* ws = a.ws; const int fr = lane & 15, fq = lane >> 4;
    const float* SSQ = (const float*)(ws + WS_SSQ); const f32x2* R128 = (const f32x2*)(ws + WS_ROPE128); bf16* KVA = (bf16*)(ws + WS_KVA);
    for (int it = gw; it < 32; it += NGW) {
        const int n0 = 64 * it;
        f32x4 o[4]; gemm16<16>((const bf16*)(ws + WS_PROJ) + PC_CKV, PW, (const bf16*)(ws + WS_WKVT) + (size_t)n0 * 512, 512, 512, lane, o);
#pragma unroll
        for (int r = 0; r < 4; ++r) { const int m = 4 * fq + r; float sq = 0.f;
#pragma unroll
            for (int i = 0; i < 16; ++i) sq += SSQ[(size_t)m * 16 + i];
            const float rstd = 1.f / sqrtf(sq * (1.f / 512.f) + EPS);
#pragma unroll
            for (int t = 0; t < 4; ++t) { const int n = n0 + 16 * t + fr; float v = o[t][r] * rstd;
                if (n0 < 1024) { const float pr = __shfl_xor(v, 1); const int cl = n & 127; const f32x2 cs = R128[(size_t)m * 64 + (cl >> 1)]; v = (cl & 1) ? v * cs[0] + pr * cs[1] : v * cs[0] - pr * cs[1]; }
                KVA[(size_t)m * 2048 + n] = (bf16)f2bf(v); } }
    }
}
__device__ __forceinline__ void phase_cumsum(const Args& a, int wave, int lane) {
    unsigned char* ws = a.ws;
    const f32x4* LF = (const f32x4*)((const float*)(ws + WS_LOGF) + (size_t)wave * LP) + lane * 33;
    f32x4* CT = (f32x4*)((float*)(ws + WS_CCT) + (size_t)wave * LP) + lane * 33;
    f32x4 v[33]; float s = 0.f;
#pragma unroll
    for (int i = 0; i < 33; ++i) { v[i] = LF[i]; }
#pragma unroll
    for (int i = 0; i < 33; ++i) { s += (v[i][0] + v[i][1]) + (v[i][2] + v[i][3]); }
    float inc = s;
#pragma unroll
    for (int o = 1; o < 64; o <<= 1) { const float t = __shfl_up(inc, o); if (lane >= o) inc += t; }
    float run = inc - s;
#pragma unroll
    for (int i = 0; i < 33; ++i) { f32x4 o; run += v[i][0]; o[0] = run; run += v[i][1]; o[1] = run; run += v[i][2]; o[2] = run; run += v[i][3]; o[3] = run; CT[i] = o; }
}

__device__ __forceinline__ void phase_indexer(const Args& a, LAS unsigned char* lds, int gw, int NGW, int wave, int lane) {
    unsigned char* ws = a.ws;
    const bf16* PROJ = (const bf16*)(ws + WS_PROJ); const bf16* KI = (const bf16*)(ws + WS_KI); const float* WI = (const float*)(ws + WS_WI); float* S = (float*)(ws + WS_S);
    LAS float* qs = (LAS float*)(lds + wave * 8192);
    for (int qr = gw; qr < SEQ; qr += NGW) {
        const int pos = qr + NMETA;
        { const bf16* qrow = PROJ + (size_t)pos * PW + PC_QI + 16 * lane; const v4u w0 = *(const v4u*)qrow, w1 = *(const v4u*)(qrow + 8);
          LAS float* d = qs + 16 * lane;
          d[0] = bflo(w0.x); d[1] = bfhi(w0.x); d[2] = bflo(w0.y); d[3] = bfhi(w0.y); d[4] = bflo(w0.z); d[5] = bfhi(w0.z); d[6] = bflo(w0.w); d[7] = bfhi(w0.w);
          d[8] = bflo(w1.x); d[9] = bfhi(w1.x); d[10] = bflo(w1.y); d[11] = bfhi(w1.y); d[12] = bflo(w1.z); d[13] = bfhi(w1.z); d[14] = bflo(w1.w); d[15] = bfhi(w1.w);
          if (lane < 16) qs[1024 + lane] = WI[(size_t)pos * 16 + lane]; }
        LDS_WAIT(); asm volatile("" ::: "memory");
        float* Srow = S + s_row_off(qr);
        const int ntile = pos / 64 + 1;
        for (int j = 0; j < ntile; ++j) {
            const int key = j * 64 + lane;
            float kf[64];
            { const v4u* kp = (const v4u*)(KI + (size_t)key * 64);
#pragma unroll
              for (int c = 0; c < 8; ++c) { const v4u w = kp[c]; kf[8 * c] = bflo(w.x); kf[8 * c + 1] = bfhi(w.x); kf[8 * c + 2] = bflo(w.y); kf[8 * c + 3] = bfhi(w.y);
                  kf[8 * c + 4] = bflo(w.z); kf[8 * c + 5] = bfhi(w.z); kf[8 * c + 6] = bflo(w.w); kf[8 * c + 7] = bfhi(w.w); } }
            float score = 0.f;
#pragma unroll 1
            for (int h = 0; h < 16; ++h) { float d = 0.f;
#pragma unroll
                for (int c = 0; c < 16; ++c) { const f32x4 q = *(const LAS f32x4*)(qs + h * 64 + 4 * c); d += q[0] * kf[4 * c] + q[1] * kf[4 * c + 1] + q[2] * kf[4 * c + 2] + q[3] * kf[4 * c + 3]; }
                score += qs[1024 + h] * fmaxf(d, 0.f); }
            if (key <= pos) Srow[key] = score;
        }
        LDS_WAIT(); asm volatile("" ::: "memory");
    }
}


__device__ __forceinline__ void phase_indexer_mfma(const Args& a, LAS unsigned char* lds, int vcu, int G) {
    typedef float f32x16 __attribute__((ext_vector_type(16)));
    unsigned char* ws = a.ws;
    const bf16* PROJ = (const bf16*)(ws + WS_PROJ); const bf16* KI = (const bf16*)(ws + WS_KI); const float* WI = (const float*)(ws + WS_WI); float* S = (float*)(ws + WS_S);
    const int tid = threadIdx.x, wid = __builtin_amdgcn_readfirstlane(tid >> 6), lane = tid & 63, r32 = lane & 31, hi = lane >> 5;
    const int keyrow = 16 * ((r32 >> 2) & 1) + 4 * (r32 >> 3) + (r32 & 3);
    for (int sub = 0; sub < 2; ++sub)
    for (int it = vcu; it < 256; it += G) {
        const int qt = sub == 0 ? it : 255 - it;
        const int q0 = qt * 32, pos0 = q0 + NMETA, nkt = (pos0 + 31) / 32 + 1;
        const int klo = sub == 0 ? 0 : nkt / 2, khi = sub == 0 ? nkt / 2 : nkt;
        __syncthreads();
#pragma unroll
        for (int i = 0; i < 8; ++i) { const int c = tid + 512 * i, row = c >> 7, ch = c & 127;
            const v4u v = *(const v4u*)(PROJ + (size_t)(pos0 + row) * PW + PC_QI + ch * 8);
            *(LAS v4u*)(lds + (ch >> 1) * 1024 + (row + 32 * (ch & 1)) * 16) = v; }
        float w[16];
        { const f32x4* wp = (const f32x4*)(WI + (size_t)(pos0 + r32) * 16);
#pragma unroll
          for (int i = 0; i < 4; ++i) { const f32x4 t = wp[i]; w[4 * i] = t[0]; w[4 * i + 1] = t[1]; w[4 * i + 2] = t[2]; w[4 * i + 3] = t[3]; } }
        __syncthreads();
        float* Srow = S + s_row_off(q0 + r32) + 16 * hi;
        bf16x8 afn[4];
        { const int kt0 = klo + wid < khi ? klo + wid : 0;
#pragma unroll
          for (int ks = 0; ks < 4; ++ks) afn[ks] = *(const bf16x8*)(KI + (size_t)(kt0 * 32 + keyrow) * 64 + ks * 16 + 8 * hi); }
        for (int kt = klo + wid; kt < khi; kt += 8) {
            const int kb = kt * 32;
            bf16x8 af[4];
#pragma unroll
            for (int ks = 0; ks < 4; ++ks) af[ks] = afn[ks];
            { const int ktn = kt + 8 < khi ? kt + 8 : kt;
#pragma unroll
              for (int ks = 0; ks < 4; ++ks) afn[ks] = *(const bf16x8*)(KI + (size_t)(ktn * 32 + keyrow) * 64 + ks * 16 + 8 * hi); }
            f32x16 acc = {};
            bf16x8 bq[2][4]; f32x16 d[2];
            unsigned qoff = lane * 16; asm volatile("" : "+v"(qoff));
            const LAS unsigned char* qk = lds + qoff;
#pragma unroll
            for (int ks = 0; ks < 4; ++ks) bq[0][ks] = *(const LAS bf16x8*)(qk + ks * 1024);
#pragma unroll
            for (int h = 0; h < 17; ++h) {
                __builtin_amdgcn_sched_barrier(0);
                if (h < 16) { d[h & 1] = f32x16{};
#pragma unroll
                    for (int ks = 0; ks < 4; ++ks) d[h & 1] = __builtin_amdgcn_mfma_f32_32x32x16_bf16(af[ks], bq[h & 1][ks], d[h & 1], 0, 0, 0); }
                if (h < 15) {
#pragma unroll
                    for (int ks = 0; ks < 4; ++ks) bq[(h + 1) & 1][ks] = *(const LAS bf16x8*)(qk + ((h + 1) * 4 + ks) * 1024); }
                if (h > 0) {
#pragma unroll
                    for (int r = 0; r < 16; ++r) { const float dv = d[(h - 1) & 1][r]; const int xi = __float_as_int(dv); const float rl = __int_as_float(xi > 0 ? xi : 0);
                        float ar = acc[r]; asm("v_fmac_f32 %0, %1, %2" : "+v"(ar) : "v"(rl), "v"(w[h - 1])); acc[r] = ar; } }
            }
            __builtin_amdgcn_sched_barrier(0);
#pragma unroll
            for (int g = 0; g < 4; ++g) { const float x0 = acc[4 * g], x1 = acc[4 * g + 1], x2 = acc[4 * g + 2], x3 = acc[4 * g + 3]; *(v4u*)(Srow + kb + 4 * g) = (v4u){f2key(x0), f2key(x1), f2key(x2), f2key(x3)}; }
        }
    }
}

__device__ __forceinline__ int wave_incl_scan(int x) {
    x += __builtin_amdgcn_update_dpp(0, x, 0x111, 0xf, 0xf, false);
    x += __builtin_amdgcn_update_dpp(0, x, 0x112, 0xf, 0xf, false);
    x += __builtin_amdgcn_update_dpp(0, x, 0x114, 0xf, 0xf, false);
    x += __builtin_amdgcn_update_dpp(0, x, 0x118, 0xf, 0xf, false);
    x += __builtin_amdgcn_update_dpp(0, x, 0x142, 0xa, 0xf, false);
    x += __builtin_amdgcn_update_dpp(0, x, 0x143, 0xc, 0xf, false);
    return x;
}
#define SEL_CNT6(OP, c0, c1, c2, k0, k1, k2, k3, k4, k5, cand) do { unsigned long long m1_, m2_, m3_, m4_, m5_; \
    asm volatile(OP " vcc, %8, %9\n\t" OP " %3, %8, %10\n\t" OP " %4, %8, %11\n\t" OP " %5, %8, %12\n\t" OP " %6, %8, %13\n\t" OP " %7, %8, %14\n\t" \
                 "v_addc_co_u32 %0, vcc, 0, %0, vcc\n\tv_addc_co_u32 %1, %3, 0, %1, %3\n\tv_addc_co_u32 %2, %4, 0, %2, %4\n\t" \
                 "v_addc_co_u32 %0, %5, 0, %0, %5\n\tv_addc_co_u32 %1, %6, 0, %1, %6\n\tv_addc_co_u32 %2, %7, 0, %2, %7" \
                 : "+v"(c0), "+v"(c1), "+v"(c2), "=&s"(m1_), "=&s"(m2_), "=&s"(m3_), "=&s"(m4_), "=&s"(m5_) \
                 : "s"(cand), "v"(k0), "v"(k1), "v"(k2), "v"(k3), "v"(k4), "v"(k5) : "vcc"); } while (0)
__device__ __forceinline__ int sel_wave_total(int c) {
    int t = 0;
#pragma unroll
    for (int b = 0; b < 8; ++b) t += __popcll(__ballot((c >> b) & 1)) << b;
    return t;
}
__device__ __forceinline__ int sel_count_ge(const unsigned (&key)[NTILE64], unsigned cand, int nreg) {
    int c0 = 0, c1 = 0, c2 = 0;
#define SEL_G(g) SEL_CNT6("v_cmp_le_u32", c0, c1, c2, key[6 * (g)], key[6 * (g) + 1], key[6 * (g) + 2], key[6 * (g) + 3], key[6 * (g) + 4], key[6 * (g) + 5], cand)
#pragma unroll
    for (int g = 0; g < 6; ++g) SEL_G(g);
    if (nreg > 36) {
#pragma unroll
        for (int g = 6; g < 11; ++g) SEL_G(g);
        if (nreg > 66) {
#pragma unroll
            for (int g = 11; g < 16; ++g) SEL_G(g);
            if (nreg > 96) {
#pragma unroll
                for (int g = 16; g < 21; ++g) SEL_G(g);
                { unsigned z = 0u; SEL_CNT6("v_cmp_le_u32", c0, c1, c2, key[126], key[127], key[128], z, z, z, cand); }
            }
        }
    }
#undef SEL_G
    return sel_wave_total(c0 + c1 + c2);
}
__device__ __forceinline__ void sel_hist(const unsigned (&key)[NTILE64], int nreg, LAS unsigned* hist, unsigned prefix, int shift) {
#define SEL_H(j) do { const unsigned k = key[j]; const unsigned addr = (k >> shift) & 0xffu; \
        const unsigned inc = (((k ^ prefix) >> shift) >> 8) == 0u ? 1u : 0u; \
        __hip_atomic_fetch_add(hist + addr, inc, __ATOMIC_RELAXED, __HIP_MEMORY_SCOPE_WORKGROUP); } while (0)
#pragma unroll
    for (int j = 0; j < 36; ++j) SEL_H(j);
    if (nreg > 36) {
#pragma unroll
        for (int j = 36; j < 66; ++j) SEL_H(j);
        if (nreg > 66) {
#pragma unroll
            for (int j = 66; j < 96; ++j) SEL_H(j);
            if (nreg > 96) {
#pragma unroll
                for (int j = 96; j < NTILE64; ++j) SEL_H(j);
            }
        }
    }
#undef SEL_H
}
__device__ __forceinline__ void phase_select(const Args& a, LAS unsigned char* lds, int gw, int NGW, int wave, int lane) {
    unsigned char* ws = a.ws;
    const unsigned* S = (const unsigned*)(ws + WS_S); unsigned long long* MASK = (unsigned long long*)(ws + WS_MASK);
    LAS unsigned* hist = (LAS unsigned*)(lds + wave * 1024);
    for (int kq = 0; kq * NGW < SEQ; ++kq) {
        const int qr = kq * NGW + ((kq & 1) ? NGW - 1 - gw : gw);
        if (qr >= SEQ) continue;
        const int pos = qr + NMETA, n = pos + 1, nreg = __builtin_amdgcn_readfirstlane((n + 63) >> 6);
        const __amdgpu_buffer_rsrc_t rs = __builtin_amdgcn_make_buffer_rsrc((void*)(S + s_row_off(qr)), 0, n * 4, 0x00020000);
        unsigned key[NTILE64];
#define SEL_LD(j) key[j] = __builtin_amdgcn_raw_buffer_load_b32(rs, lane * 4, (j) * 256, 0)
#pragma unroll
        for (int j = 0; j < 36; ++j) SEL_LD(j);
        if (nreg > 36) {
#pragma unroll
            for (int j = 36; j < 66; ++j) SEL_LD(j);
            if (nreg > 66) {
#pragma unroll
                for (int j = 66; j < 96; ++j) SEL_LD(j);
                if (nreg > 96) {
#pragma unroll
                    for (int j = 96; j < NTILE64; ++j) SEL_LD(j);
                }
            }
        }
#undef SEL_LD
        unsigned T = 1u; int need = 0; bool ge_only = true;
        if (n > TOPK) {
            unsigned mx = 0u;
#pragma unroll
            for (int j = 0; j < 36; ++j) mx = key[j] > mx ? key[j] : mx;
            if (nreg > 36) {
#pragma unroll
                for (int j = 36; j < 66; ++j) mx = key[j] > mx ? key[j] : mx;
                if (nreg > 66) {
#pragma unroll
                    for (int j = 66; j < 96; ++j) mx = key[j] > mx ? key[j] : mx;
                    if (nreg > 96) {
#pragma unroll
                        for (int j = 96; j < NTILE64; ++j) mx = key[j] > mx ? key[j] : mx;
                    }
                }
            }
#pragma unroll
            for (int o = 1; o < 64; o <<= 1) { const unsigned t = (unsigned)__shfl_xor((int)mx, o); mx = t > mx ? t : mx; }
            int lo = (int)__builtin_amdgcn_readfirstlane((int)(mx >> 24)), hi = lo + 1, cge = 0, cabove = 0;
            for (int step = 1;; step *= 2) { const int c = sel_count_ge(key, (unsigned)lo << 24, nreg); if (c >= TOPK || lo == 0) { cge = c; break; } hi = lo; cabove = c; lo = lo - step > 0 ? lo - step : 0; }
            while (hi - lo > 1) { const int mid = (lo + hi) >> 1; const int c = sel_count_ge(key, (unsigned)mid << 24, nreg); if (c >= TOPK) { lo = mid; cge = c; } else { hi = mid; cabove = c; } }
            unsigned prefix = (unsigned)lo << 24;
            if (cge != TOPK) {
                for (int b = 23; b >= 0; --b) { const unsigned cand = prefix | (1u << b); const int c = sel_count_ge(key, cand, nreg); if (c >= TOPK) { prefix = cand; cge = c; if (c == TOPK) break; } }
            }
            T = prefix; ge_only = (cge == TOPK);
            if (!ge_only) need = TOPK - sel_count_ge(key, T + 1u, nreg);
        }
        unsigned w0l = 0u, w0h = 0u, w1l = 0u, w1h = 0u, w2l = 0u, w2h = 0u;
#define EM_WL2(dlo, dhi, vlo, vhi, l) asm volatile("s_nop 4\n\tv_writelane_b32 %0, %2, %4\n\tv_writelane_b32 %1, %3, %4" : "+v"(dlo), "+v"(dhi) : "s"(vlo), "s"(vhi), "n"(l))
#define EM_PUT(j, w) do { const unsigned lo_ = (unsigned)(w), hi_ = (unsigned)((w) >> 32); \
        if ((j) < 64) EM_WL2(w0l, w0h, lo_, hi_, (j)); else if ((j) < 128) EM_WL2(w1l, w1h, lo_, hi_, (j) - 64); else EM_WL2(w2l, w2h, lo_, hi_, (j) - 128); } while (0)
#define EM_GE(j) do { const unsigned long long w_ = __ballot(key[j] >= T); EM_PUT(j, w_); } while (0)
#define EM_TIE(j) do { unsigned long long w_ = __ballot(key[j] > T); \
        if (need > 0) { unsigned long long eq = __ballot(key[j] == T); int c = __popcll(eq); \
            while (c > need) { eq &= ~(1ull << (63 - __builtin_clzll(eq))); --c; } \
            w_ |= eq; need -= c; } \
        EM_PUT(j, w_); } while (0)
#define EM_TIERS(EM) do { _Pragma("unroll") for (int j = 0; j < 36; ++j) EM(j); \
        if (nreg > 36) { _Pragma("unroll") for (int j = 36; j < 66; ++j) EM(j); \
            if (nreg > 66) { _Pragma("unroll") for (int j = 66; j < 96; ++j) EM(j); \
                if (nreg > 96) { _Pragma("unroll") for (int j = 96; j < NTILE64; ++j) EM(j); } } } } while (0)
        if (ge_only) EM_TIERS(EM_GE); else EM_TIERS(EM_TIE);
#undef EM_TIERS
#undef EM_TIE
#undef EM_GE
#undef EM_PUT
#undef EM_WL2
        const unsigned long long w0 = ((unsigned long long)w0h << 32) | w0l, w1 = ((unsigned long long)w1h << 32) | w1l, w2 = ((unsigned long long)w2h << 32) | w2l;
        MASK[(size_t)lane * SEQ + qr] = w0; MASK[(size_t)(64 + lane) * SEQ + qr] = w1; if (lane == 0) MASK[(size_t)128 * SEQ + qr] = w2;
    }
}
#undef SEL_CNT6

template <bool DSAMODE>
__device__ __forceinline__ void attn_naive(const Args& a, LAS unsigned char* lds, int gw, int NGW, int wave, int lane) {
    unsigned char* ws = a.ws;
    const bf16* PROJ = (const bf16*)(ws + WS_PROJ); const bf16* KVA = (const bf16*)(ws + WS_KVA);
    const bf16* Q = DSAMODE ? PROJ + PC_QA : PROJ + PC_QB; const int ldq = PW;
    const bf16* Kp = DSAMODE ? KVA : PROJ + PC_KB; const int ldk = DSAMODE ? 2048 : PW;
    const bf16* Vp = DSAMODE ? KVA + 1024 : PROJ + PC_VB; const int ldv = DSAMODE ? 2048 : PW;
    bf16* O = (bf16*)(ws + (DSAMODE ? WS_YA : WS_YB));
    const unsigned long long* MASK = (const unsigned long long*)(ws + WS_MASK); const float* CC = (const float*)(ws + WS_CC);
    LAS float* qs = (LAS float*)(lds + wave * 1024);
    for (int item = gw; item < SEQ * NH; item += NGW) {
        const int qr = item >> 3, h = item & 7, pos = qr + NMETA;
        { const unsigned w = *(const unsigned*)(Q + (size_t)pos * ldq + h * 128 + 2 * lane); qs[2 * lane] = bflo(w) * (ATT_SCALE * LOG2E); qs[2 * lane + 1] = bfhi(w) * (ATT_SCALE * LOG2E); }
        LDS_WAIT(); asm volatile("" ::: "memory");
        const float cq = DSAMODE ? 0.f : CC[(size_t)pos * 8 + h];
        float m = -1e30f, l = 0.f, o0 = 0.f, o1 = 0.f;
        const int ntile = pos / 64 + 1;
        for (int j = 0; j < ntile; ++j) {
            const int key = j * 64 + lane; bool valid = key <= pos;
            if (DSAMODE) { const unsigned long long w = MASK[(size_t)j * SEQ + qr]; if (w == 0ull) continue; valid = valid && ((w >> lane) & 1ull); }
            float s = -__builtin_inff();
            if (valid) { const v4u* kp = (const v4u*)(Kp + (size_t)key * ldk + h * 128); float d = 0.f;
#pragma unroll
                for (int c = 0; c < 16; ++c) { const v4u w = kp[c]; const f32x4 q0 = *(const LAS f32x4*)(qs + 8 * c), q1 = *(const LAS f32x4*)(qs + 8 * c + 4);
                    d += q0[0] * bflo(w.x) + q0[1] * bfhi(w.x) + q0[2] * bflo(w.y) + q0[3] * bfhi(w.y) + q1[0] * bflo(w.z) + q1[1] * bfhi(w.z) + q1[2] * bflo(w.w) + q1[3] * bfhi(w.w); }
                s = d; if (!DSAMODE) s += (cq - CC[(size_t)key * 8 + h]) * LOG2E; }
            const float tmax = wave_max(s); const float mn = fmaxf(m, tmax); const float alpha = __builtin_amdgcn_exp2f(m - mn);
            const float p = valid ? __builtin_amdgcn_exp2f(s - mn) : 0.f;
            l = l * alpha + wave_sum(p); o0 *= alpha; o1 *= alpha; m = mn;
            unsigned long long pm = __ballot(p > 0.f);
            while (pm) { const int sl = __builtin_ctzll(pm); pm &= pm - 1; const float ps = __shfl(p, sl);
                const unsigned vv = *(const unsigned*)(Vp + (size_t)(j * 64 + sl) * ldv + h * 128 + 2 * lane); o0 += ps * bflo(vv); o1 += ps * bfhi(vv); }
        }
        const float rl = 1.f / l;
        *(unsigned*)(O + (size_t)qr * 1024 + h * 128 + 2 * lane) = pk2(o0 * rl, o1 * rl);
        LDS_WAIT(); asm volatile("" ::: "memory");
    }
}


constexpr int MOE_GU_ITEMS = NE * 32 * 32, MOE_D_ITEMS = NE * 8 * 64;
template <bool DOWN>
__device__ __forceinline__ void moe_item(const Args& a, int i, int lane, const float*& src, size_t& ldsrc, bf16*& dst, int& ldwt, int& k0, int& n0) {
    unsigned char* ws = a.ws;
    if (!DOWN) { const int e = i >> 10, r = i & 1023; const int kb = r / 32, nb = r % 32; const int n = nb * 32 + (lane & 31); const int pn = n >> 8, half = (n >> 7) & 1, j = n & 127;
        src = (half ? a.in[I_WUP] : a.in[I_WGATE]) + (size_t)e * 2048 * 512 + 128 * pn + j; ldsrc = 512; dst = (bf16*)(ws + WS_WGUT) + (size_t)e * 1024 * 2048; ldwt = 2048; k0 = 64 * kb; n0 = 32 * nb; }
    else { const int e = i >> 9, r = i & 511; const int kb = r / 64, nb = r % 64;
        src = a.in[I_WDOWN] + (size_t)e * 512 * 2048 + nb * 32 + (lane & 31); ldsrc = 2048; dst = (bf16*)(ws + WS_WDT) + (size_t)e * 2048 * 512; ldwt = 512; k0 = 64 * kb; n0 = 32 * nb; }
}
template <bool DOWN>
__device__ __forceinline__ void moe_copy_pair(const Args& a, LAS float* scr, int i0, int i1  , int lane) {
    const float* s0; size_t l0; bf16* d0; int w0, k0, n0; moe_item<DOWN>(a, i0, lane, s0, l0, d0, w0, k0, n0);
    const bool two = i1 >= 0;
    const float* s1; size_t l1; bf16* d1; int w1, k1, n1; moe_item<DOWN>(a, two ? i1 : i0, lane, s1, l1, d1, w1, k1, n1);
    float va[32], vb[32];
    tr_load(va, s0, l0, k0, lane); tr_load(vb, s1, l1, k1, lane);
    tr_fence(va); tr_fence(vb);
    tr_store(va, d0, w0, k0, n0, scr, lane);
    if (two) tr_store(vb, d1, w1, k1, n1, scr, lane);
}

constexpr size_t WS_PART = WS_R + 32 * MiB;
constexpr int CW_AQ = 2048;
constexpr int N_DSA_ENT = 48, N_ATT_ITEMS = N_DSA_ENT * 8 + 256;
constexpr int N_COPY_POPS = MOE_GU_ITEMS / 64;
__device__ const unsigned char DSA_ENT[N_DSA_ENT] = {125, 60, 126, 121, 122, 117, 56, 118, 113, 114, 109, 52, 110, 105, 106, 101, 48, 102, 97, 98, 93, 44, 94, 89, 90, 85, 40, 86, 81, 82, 77, 36, 78, 73, 74, 69, 32, 70, 65, 66, 28, 24, 20, 16, 12, 8, 4, 0};
template <int MODE>
__device__ __forceinline__ void attn_item(unsigned char* ws, char* lds, int h, int b, int kind) {
    constexpr int LDKV = MODE ? 2048 : PW;
    att::ItemRef r; r.P0 = NMETA + 256 * b;
    const bf16* PROJ = (const bf16*)(ws + WS_PROJ); const bf16* KVA = (const bf16*)(ws + WS_KVA);
    r.Q = PROJ + (size_t)r.P0 * PW + (MODE ? PC_QA : PC_QB) + h * 128;
    r.K = MODE ? KVA + h * 128 : PROJ + PC_KB + h * 128;
    r.V = MODE ? KVA + 1024 + h * 128 : PROJ + PC_VB + h * 128;
    r.O = (bf16*)(ws + WS_YA) + (size_t)(256 * b) * 2048 + (MODE ? 0 : 1024) + h * 128;
    r.cb = (const float*)(ws + WS_CCT) + (size_t)h * LP; r.cref = MODE ? 0.f : r.cb[r.P0];
    r.mk = (const unsigned long long*)(ws + WS_MASK) + 256 * b;
    const int NT = 4 * b + 5, half = (NT + 1) / 2;
    r.t_lo = kind == 2 ? half : 0; r.t_hi = kind == 1 ? half : NT;
    r.kn2 = MODE ? 0.f : __uint_as_float(((const unsigned*)(ws + WS_CTL))[CW_KMAX + h]);
    r.part = kind ? (float*)(ws + WS_PART) + (size_t)(((h * 16 + (b - 16)) * 2) + (kind - 1)) * att::PART_FLOATS : nullptr;
    att::run_item<MODE, PW, LDKV, 2048>(r, lds);
}
__device__ __forceinline__ void phase_attn(const Args& a, char* lds, volatile LAS int* qslot) {
    unsigned* qh = (unsigned*)(a.ws + WS_CTL) + CW_AQ;
    for (;;) {
        if (threadIdx.x == 0) qslot[0] = (int)__hip_atomic_fetch_add(qh, 1u, RLX_AGENT);
        __syncthreads();
        const int it = qslot[0];
        __syncthreads();
        if (it >= N_ATT_ITEMS + N_COPY_POPS) break;
        int ai = it - N_COPY_POPS;
        if (it < 3 * N_COPY_POPS) {
            if (it % 3 == 2) {
                int tid_ = threadIdx.x; asm volatile("" : "+v"(tid_)); const int lane = tid_ & 63, wave = __builtin_amdgcn_readfirstlane(tid_ >> 6);
                LAS float* scr = (LAS float*)((LAS char*)lds + wave * 16384);
                const int c = it / 3;
#pragma unroll 1
                for (int k = 0; k < 8; k += 2) moe_copy_pair<false>(a, scr, c * 64 + wave + 8 * k, c * 64 + wave + 8 * (k + 1), lane);
                continue;
            }
            ai = (it / 3) * 2 + it % 3;
        }
        if (ai < N_DSA_ENT * 8) { const int e = DSA_ENT[ai >> 3]; attn_item<1>(a.ws, lds, ai & 7, e >> 2, e & 3); }
        else { const int j = ai - N_DSA_ENT * 8; attn_item<0>(a.ws, lds, j & 7, 31 - (j >> 3), 0); }
    }
}
__device__ __forceinline__ void phase_attn_combine(const Args& a, char* lds, int vcu, int G) {
    for (int sl = vcu; sl < 128; sl += G) { const int h = sl >> 4, b = 16 + (sl & 15);
        const float* p1 = (const float*)(a.ws + WS_PART) + (size_t)(sl * 2) * att::PART_FLOATS;
        att::combine_item<2048>(p1, p1 + att::PART_FLOATS, (bf16*)(a.ws + WS_YA) + (size_t)(256 * b) * 2048 + h * 128, lds); }
}

__device__ __forceinline__ float wave_total_f(float v) {
    v += __builtin_bit_cast(float, __builtin_amdgcn_update_dpp(0, __builtin_bit_cast(int, v), 0x111, 0xf, 0xf, false));
    v += __builtin_bit_cast(float, __builtin_amdgcn_update_dpp(0, __builtin_bit_cast(int, v), 0x112, 0xf, 0xf, false));
    v += __builtin_bit_cast(float, __builtin_amdgcn_update_dpp(0, __builtin_bit_cast(int, v), 0x114, 0xf, 0xf, false));
    v += __builtin_bit_cast(float, __builtin_amdgcn_update_dpp(0, __builtin_bit_cast(int, v), 0x118, 0xf, 0xf, false));
    v += __builtin_bit_cast(float, __builtin_amdgcn_update_dpp(0, __builtin_bit_cast(int, v), 0x142, 0xa, 0xf, false));
    v += __builtin_bit_cast(float, __builtin_amdgcn_update_dpp(0, __builtin_bit_cast(int, v), 0x143, 0xc, 0xf, false));
    return __builtin_bit_cast(float, __builtin_amdgcn_readlane(__builtin_bit_cast(int, v), 63));
}
__device__ __forceinline__ void phase_route(const Args& a, volatile LAS int* lcnt  , int gw, int NGW, int lane) {
    unsigned char* ws = a.ws;
    const float* H2 = (const float*)(ws + WS_H2); bf16* T = (bf16*)(ws + WS_T); unsigned* cnt = (unsigned*)(ws + WS_CTL) + CW_CNT;
    const f32x4* gf = (const f32x4*)a.in[I_GFFN]; const __amdgpu_buffer_rsrc_t wrs = __builtin_amdgcn_make_buffer_rsrc((void*)(ws + WS_WRT), 0, 20 * 2048 * 4, 0x00020000);
    const int ngroups = (SEQ + 4 * NGW - 1) / (4 * NGW);
    for (int grp = 0; grp < ngroups; ++grp) {
        const int t0 = gw + grp * 4 * NGW;
        int tok[4]; float rstd[4]; bool live[4];
#pragma unroll
        for (int q = 0; q < 4; ++q) { tok[q] = t0 + q * NGW; live[q] = tok[q] < SEQ; if (!live[q]) tok[q] = 0; }
        if (threadIdx.x < 16) lcnt[threadIdx.x] = 0;
        __syncthreads();
        { float sv[4];
#pragma unroll
          for (int q = 0; q < 4; ++q) sv[q] = ((const float*)(ws + WS_SQ2))[(size_t)tok[q] * 64 + lane];
#pragma unroll
          for (int q = 0; q < 4; ++q) rstd[q] = 1.f / sqrtf(wave_total_f(sv[q]) * (1.f / 2048.f) + EPS); }
        float lg[4][20];
#pragma unroll
        for (int q = 0; q < 4; ++q)
#pragma unroll
            for (int i = 0; i < 20; ++i) lg[q][i] = 0.f;
#pragma unroll 1
        for (int j = 0; j < 8; ++j) {
            int ln = lane + 64 * j; asm volatile("" : "+v"(ln));
            f32x4 hv[4], wt[20]; const f32x4 g = gf[ln];
#pragma unroll
            for (int q = 0; q < 4; ++q) hv[q] = ((const f32x4*)(H2 + (size_t)tok[q] * 2048))[ln];
#pragma unroll
            for (int e = 0; e < 20; ++e) wt[e] = __builtin_bit_cast(f32x4, __builtin_amdgcn_raw_buffer_load_b128(wrs, ln * 16, e * 8192, 0));
            asm volatile("" : "+v"(hv[0]), "+v"(hv[1]), "+v"(hv[2]), "+v"(hv[3]));
#pragma unroll
            for (int e = 0; e < 20; e += 5) asm volatile("" : "+v"(wt[e]), "+v"(wt[e + 1]), "+v"(wt[e + 2]), "+v"(wt[e + 3]), "+v"(wt[e + 4]));
            f32x4 t[4];
#pragma unroll
            for (int q = 0; q < 4; ++q) {
                t[q][0] = hv[q][0] * rstd[q] * g[0]; t[q][1] = hv[q][1] * rstd[q] * g[1]; t[q][2] = hv[q][2] * rstd[q] * g[2]; t[q][3] = hv[q][3] * rstd[q] * g[3];
                v2u o; o.x = pk2(t[q][0], t[q][1]); o.y = pk2(t[q][2], t[q][3]); if (live[q]) *(v2u*)(T + (size_t)tok[q] * 2048 + 4 * ln) = o; }
#pragma unroll
            for (int c = 0; c < 4; ++c)
#pragma unroll
                for (int q = 0; q < 4; ++q)
#pragma unroll
                    for (int e = 0; e < 20; ++e) lg[q][e] += t[q][c] * wt[e][c]; }
        int e0v[4], e1v[4], s0v[4], s1v[4]; float w0v[4], w1v[4];
#pragma unroll
        for (int q = 0; q < 4; ++q) {
            float l20[20];
#pragma unroll
            for (int i = 0; i < 20; ++i) l20[i] = wave_total_f(lg[q][i]);
            float gl[4];
#pragma unroll
            for (int i = 0; i < 4; ++i) gl[i] = l20[i] + a.in[I_BGROUP][i];
            int gs = 0; float gmx = gl[0];
#pragma unroll
            for (int i = 1; i < 4; ++i) if (gl[i] > gmx) { gmx = gl[i]; gs = i; }
            float den = 0.f;
#pragma unroll
            for (int i = 0; i < 4; ++i) den += expf(gl[i] - gmx);
            const float pg = 1.f / den;
            float el[4];
#pragma unroll
            for (int i = 0; i < 4; ++i) { el[i] = 0.f;
#pragma unroll
                for (int g = 0; g < 4; ++g) if (gs == g) el[i] = l20[4 + 4 * g + i] + a.in[I_BEXPERT][4 * g + i]; }
            int i0 = 0; float m0 = el[0];
#pragma unroll
            for (int i = 1; i < 4; ++i) if (el[i] > m0) { m0 = el[i]; i0 = i; }
            int i1 = -1; float m1 = -__builtin_inff();
#pragma unroll
            for (int i = 0; i < 4; ++i) if (i != i0 && el[i] > m1) { m1 = el[i]; i1 = i; }
            const float ex = expf(m1 - m0); const float p0 = 1.f / (1.f + ex), p1 = ex / (1.f + ex);
            e0v[q] = gs * 4 + i0; e1v[q] = gs * 4 + i1; w0v[q] = pg * p0; w1v[q] = pg * p1; s0v[q] = 0; s1v[q] = 0;
            if (lane == 0 && live[q]) { s0v[q] = __hip_atomic_fetch_add((LAS int*)lcnt + e0v[q], 1, __ATOMIC_RELAXED, __HIP_MEMORY_SCOPE_WORKGROUP);
                                        s1v[q] = __hip_atomic_fetch_add((LAS int*)lcnt + e1v[q], 1, __ATOMIC_RELAXED, __HIP_MEMORY_SCOPE_WORKGROUP); }
        }
        __syncthreads();
        if (threadIdx.x < 16) { const int c = lcnt[threadIdx.x]; lcnt[16 + threadIdx.x] = c ? (int)__hip_atomic_fetch_add(cnt + 64 * threadIdx.x, (unsigned)c, RLX_AGENT) : 0; }
        __syncthreads();
        if (lane == 0) {
#pragma unroll
            for (int q = 0; q < 4; ++q) if (live[q]) { int* RT = (int*)(ws + WS_ROWTOK); float* RW = (float*)(ws + WS_ROWW);
                const int i0 = e0v[q] * 8192 + lcnt[16 + e0v[q]] + s0v[q], i1 = e1v[q] * 8192 + lcnt[16 + e1v[q]] + s1v[q];
                RT[i0] = tok[q] * 2; RW[i0] = w0v[q]; RT[i1] = tok[q] * 2 + 1; RW[i1] = w1v[q]; }
        }
        __syncthreads();
    }
}
__device__ __forceinline__ void moe_tile_bases(const Args& a, volatile LAS int* tb) {
    if (threadIdx.x < 64) { const int l = threadIdx.x; const unsigned* cnt = (const unsigned*)(a.ws + WS_CTL) + CW_CNT;
        const int t = l < 16 ? (int)((__hip_atomic_load(cnt + 64 * (l & 15), RLX_AGENT) + 255u) >> 8) : 0;
        int inc = t;
#pragma unroll
        for (int o = 1; o < 16; o <<= 1) { const int u = __shfl_up(inc, o); if (l >= o) inc += u; }
        if (l < 16) tb[l] = inc - t;
        if (l == 15) tb[16] = inc; }
    __syncthreads();
}
__device__ __forceinline__ void phase_final(const Args& a, int gw, int NGW, int lane) {
    unsigned char* ws = a.ws;
    const float* H2 = (const float*)(ws + WS_H2); const bf16* Y = (const bf16*)(ws + WS_Y); const f32x4* gf = (const f32x4*)a.in[I_GFINAL];
    for (int tok = gw; tok < SEQ; tok += NGW) {
        const f32x4* hr = (const f32x4*)(H2 + (size_t)tok * 2048); const v2u* y0 = (const v2u*)(Y + (size_t)tok * 2048); const v2u* y1 = (const v2u*)(Y + ((size_t)SEQ + tok) * 2048);
        f32x4 v[8]; float s = 0.f;
#pragma unroll
        for (int j = 0; j < 8; ++j) { const f32x4 hv = hr[lane + 64 * j]; const v2u a0 = y0[lane + 64 * j], a1 = y1[lane + 64 * j];
            v[j][0] = hv[0] + bflo(a0.x) + bflo(a1.x); v[j][1] = hv[1] + bfhi(a0.x) + bfhi(a1.x); v[j][2] = hv[2] + bflo(a0.y) + bflo(a1.y); v[j][3] = hv[3] + bfhi(a0.y) + bfhi(a1.y);
            s += (v[j][0] * v[j][0] + v[j][1] * v[j][1]) + (v[j][2] * v[j][2] + v[j][3] * v[j][3]); }
        const float rstd = 1.f / sqrtf(wave_sum(s) * (1.f / 2048.f) + EPS);
        f32x4* orow = (f32x4*)(a.out + (size_t)tok * 2048);
        float pscale = 1.f;
        if (PROBE_TS_A >= 0) { const unsigned long long* tsp = (const unsigned long long*)(a.ws + WS_CTL + 65536); const float tq = floorf((float)(tsp[PROBE_TS_B] - tsp[PROBE_TS_A]) * (0.01f / 16.f) + 0.5f) * 16.f; pscale = 1.f + tq / PROBE_TS_SCALE_US; }
        const float rs2 = rstd * pscale;
#pragma unroll
        for (int j = 0; j < 8; ++j) { const f32x4 g = gf[lane + 64 * j]; orow[lane + 64 * j] = (f32x4){v[j][0] * rs2 * g[0], v[j][1] * rs2 * g[1], v[j][2] * rs2 * g[2], v[j][3] * rs2 * g[3]}; }
    }
}

__global__ void __launch_bounds__(NWAVES * 64, 2) mk_fwd(Args args) {
    extern __shared__ __attribute__((aligned(16))) unsigned char lds_raw[];
    LAS unsigned char* lds = (LAS unsigned char*)lds_raw;
    volatile LAS unsigned* MISC = (volatile LAS unsigned*)(lds + MISC_OFF);
    volatile LAS int* TB = (volatile LAS int*)(lds + MISC_OFF + 64);
    const int tid = threadIdx.x;
    const int G = gridDim.x; const int bx = blockIdx.x; const int vcu = (G % 8 == 0) ? (bx % 8) * (G / 8) + bx / 8 : bx;
    const int NGW = G * NWAVES;
#define TIDS() int tid_ = threadIdx.x; asm volatile("" : "+v"(tid_)); const int lane = tid_ & 63, wave = __builtin_amdgcn_readfirstlane(tid_ >> 6), gw = vcu * NWAVES + wave; (void)lane; (void)gw;
    unsigned char* ws = args.ws;
    gu32* ctl = (gu32*)(ws + WS_CTL);
    for (int u = tid; u < (LDS_BYTES - LDSCTL_OFF) / 4; u += NWAVES * 64) ((LAS unsigned*)(lds + LDSCTL_OFF))[u] = 0u;
    __syncthreads();
    XcdBarrier bar; bar.bar = (unsigned*)(ctl + CW_BAR); bar.x = 0; bar.st = nullptr;
    if (MK_ONE_LAUNCH) bar = xcd_barrier_post((unsigned*)(ctl + CW_BAR), MISC + 8);
    const int lo = args.ph_lo, hi = args.ph_hi;
#ifndef PHASE_MASK
#define PHASE_MASK 0x3fff
#endif

#define REP(k) for (int rep_ = 0; rep_ < ((PROBE_DOUBLE == (k)) ? 2 : 1); ++rep_)
#define IN(k) (((PHASE_MASK >> (k)) & 1) && lo <= (k) && (k) < hi)
#define SEAM(k) do { if (IN(k) && IN((k) + 1)) xcd_barrier(bar); } while (0)

    const int nfull = ((SEQ / 256) * (PW / 256)) % G; const bool late_copies = nfull > 0 && G - nfull >= 16; const int cb0 = late_copies ? nfull + 6 : 0;
    TS(0); if (IN(0)) REP(0) { TIDS(); phase_prologue(args, lds, gw, NGW, wave, lane, late_copies ? PC_I_IN : PC_NITEMS); } SEAM(0);
    TS(1); if (IN(1)) REP(1) {
        pg8::Gemm g{(const bf16*)(ws + WS_HN) + (size_t)NMETA * 2048, (const bf16*)(ws + WS_WINT), 2048, 2048, 2048, nullptr}; pg8::StaticOrder S; S.init(SEQ / 256, PW / 256, G, bx);
        EpiProj E{(bf16*)(ws + WS_PROJ), (float*)(ws + WS_SMALL), (const float*)(ws + WS_ROPE128), (const float*)(ws + WS_ROPE64), (float*)(ws + WS_SSQ)};
        pg8::gemm_phase(lds + RING_OFF, g, S, E);
        { TIDS(); meta_inproj(args, ((bx + 32) % G) * NWAVES + wave, NGW, lane);
          if (late_copies && bx >= cb0) { __syncthreads(); copy_items(args, lds, PC_I_IN, PC_NITEMS, (bx - cb0) * NWAVES + wave, (G - cb0) * NWAVES, wave, lane); } }
    } SEAM(1);
    TS(2); if (IN(2)) REP(2) {
        { TIDS(); phase_minipost(args, (volatile LAS unsigned*)(lds + MISC_OFF + 640), gw, NGW, lane); }
        pg8::Gemm g{(const bf16*)(ws + WS_PROJ) + (size_t)NMETA * PW + PC_CKV, (const bf16*)(ws + WS_WKVT), PW, 512, 512, nullptr}; pg8::StaticOrder S; S.init(SEQ / 256, 8, G, bx);
        EpiKvUp E{(bf16*)(ws + WS_KVA), (const float*)(ws + WS_ROPE128), (const float*)(ws + WS_SSQ)};
        pg8::gemm_phase(lds + RING_OFF, g, S, E);
    } SEAM(2);
    TS(3); if (IN(3)) REP(3) { if (vcu < 8) { TIDS(); if (wave == 0) phase_cumsum(args, vcu, lane); else if (wave <= 4) meta_kvup(args, vcu * 4 + (wave - 1), 32, lane); } phase_indexer_mfma(args, lds + RING_OFF, vcu, G); } SEAM(3);
    TS(4); if (IN(4)) REP(4) { TIDS(); phase_select(args, lds + RING_OFF, gw, NGW, wave, lane); } SEAM(4);
    TS(5); if (IN(5)) REP(5) { phase_attn(args, (char*)lds_raw + RING_OFF, (volatile LAS int*)(lds + MISC_OFF + 512)); } SEAM(5);
    TS(6); if (IN(6)) REP(6) { phase_attn_combine(args, (char*)lds_raw + RING_OFF, vcu, G);
        { const int c0 = G >= 256 ? 128 : 0;
          if (vcu >= c0) { TIDS(); __syncthreads(); LAS float* scr = (LAS float*)(lds + RING_OFF + wave * 16384); const int gwv = (vcu - c0) * NWAVES + wave, ngwv = (G - c0) * NWAVES;
#pragma unroll 1
              for (int i = gwv; i < MOE_D_ITEMS; i += 2 * ngwv) moe_copy_pair<true>(args, scr, i, i + ngwv < MOE_D_ITEMS ? i + ngwv : -1, lane); } }
    } SEAM(6);
    TS(7); if (IN(7)) REP(7) {
        pg8::Gemm g{(const bf16*)(ws + WS_YA), (const bf16*)(ws + WS_WAT), 2048, 2048, 2048, nullptr}; pg8::StaticOrder S; S.init(SEQ / 256, 8, G, bx);
        EpiBranchFused E{(const bf16*)(ws + WS_PROJ), (bf16*)(ws + WS_MERGED)};
        pg8::gemm_phase(lds + RING_OFF, g, S, E);
    } SEAM(7);
    TS(8); if (IN(8)) REP(8) {
        { TIDS(); for (int i = gw * 64 + lane; i < 20 * 2048; i += NGW * 64) { const int e = i >> 11, k = i & 2047;
              ((float*)(ws + WS_WRT))[i] = e < 4 ? args.in[I_WGROUP][k * 4 + e] : args.in[I_WEXPERT][k * 16 + (e - 4)]; }
          for (int i = gw * 64 + lane; i < 16 * 8192; i += NGW * 64) ((int*)(ws + WS_ROWTOK))[i] = -1; }
        pg8::Gemm g{(const bf16*)(ws + WS_MERGED), (const bf16*)(ws + WS_WOT), 2048, 2048, 2048, nullptr}; pg8::StaticOrder S; S.init(SEQ / 256, 8, G, bx);
        EpiOut E{args.in[I_X], (float*)(ws + WS_H2), (float*)(ws + WS_SQ2)};
        pg8::gemm_phase(lds + RING_OFF, g, S, E);
    } SEAM(8);
    TS(9); if (IN(9)) REP(9) { TIDS(); phase_route(args, (volatile LAS int*)(lds + MISC_OFF + 256), gw, NGW, lane); } SEAM(9);
    TS(10); if (IN(10)) REP(10) {
        moe_tile_bases(args, TB); const int nrt = TB[16];
        pg8::Gemm g{(const bf16*)(ws + WS_T), (const bf16*)(ws + WS_WGUT), 2048, 2048, 2048, (const int*)(ws + WS_ROWTOK)}; pg8::MoeOrder S; S.init(0, nrt < 64 ? nrt : 64, 4, G, bx, (const LAS int*)TB, (size_t)1024 * 2048 * 2);
        EpiGateUp E{(bf16*)(ws + WS_ACT), (const float*)(ws + WS_ROWW)};
        pg8::gemm_phase<EpiGateUp, pg8::MoeOrder, true>(lds + RING_OFF, g, S, E);
    } SEAM(10);
    TS(11); if (IN(11)) REP(11) {
        moe_tile_bases(args, TB); const int nrt = TB[16]; const int ngu = nrt > 64 ? (nrt - 64) * 4 : 0; const int ngb = ngu < G / 2 ? ngu : G / 2;
        { pg8::Gemm g{(const bf16*)(ws + WS_T), (const bf16*)(ws + WS_WGUT), 2048, 2048, 2048, (const int*)(ws + WS_ROWTOK)}; pg8::MoeOrder S; S.init(64, nrt - 64, 4, ngb, bx < ngb ? bx : -1, (const LAS int*)TB, (size_t)1024 * 2048 * 2);
          EpiGateUp E{(bf16*)(ws + WS_ACT), (const float*)(ws + WS_ROWW)};
          pg8::gemm_phase<EpiGateUp, pg8::MoeOrder, true>(lds + RING_OFF, g, S, E); }
        { pg8::Gemm g{(const bf16*)(ws + WS_ACT), (const bf16*)(ws + WS_WDT), 512, 512, 512, nullptr}; pg8::MoeOrder S; S.init(0, nrt < 64 ? nrt : 64, 8, G - ngb, bx - ngb, (const LAS int*)TB, (size_t)2048 * 512 * 2);
          EpiDown E{(bf16*)(ws + WS_Y), (const int*)(ws + WS_ROWTOK)};
          pg8::gemm_phase(lds + RING_OFF, g, S, E); }
    } SEAM(11);
    TS(12); if (IN(12)) REP(12) {
        moe_tile_bases(args, TB); const int nrt = TB[16];
        pg8::Gemm g{(const bf16*)(ws + WS_ACT), (const bf16*)(ws + WS_WDT), 512, 512, 512, nullptr}; pg8::MoeOrder S; S.init(64, nrt - 64, 8, G, bx, (const LAS int*)TB, (size_t)2048 * 512 * 2);
        EpiDown E{(bf16*)(ws + WS_Y), (const int*)(ws + WS_ROWTOK)};
        pg8::gemm_phase(lds + RING_OFF, g, S, E);
    } SEAM(12);
    TS(13); if (IN(13)) REP(13) { TIDS(); phase_final(args, gw, NGW, lane); }
    TS(14);
#undef IN
#undef SEAM
}

extern "C" void kernel_launch(void* const* d_in, const int* in_sizes, int n_in, void* d_out, int out_size, void* d_ws, size_t ws_size, hipStream_t stream) {
    static int grid = 0;
    if (grid == 0) {
        if (n_in != 20 || out_size != SEQ * DM || ws_size < WS_NEED) { fprintf(stderr, "kernel_launch: unexpected shapes (n_in %d, out %d, ws %zu need %zu)\n", n_in, out_size, ws_size, (size_t)WS_NEED); grid = -1; return; }
        int dev = 0, cus = 0;
        if (hipGetDevice(&dev) != hipSuccess || hipDeviceGetAttribute(&cus, hipDeviceAttributeMultiprocessorCount, dev) != hipSuccess) { grid = -1; return; }
        if (hipFuncSetAttribute((const void*)mk_fwd, hipFuncAttributeMaxDynamicSharedMemorySize, LDS_BYTES) != hipSuccess) { fprintf(stderr, "kernel_launch: hipFuncSetAttribute failed\n"); grid = -1; return; }
        int per_cu = 0;
        if (hipOccupancyMaxActiveBlocksPerMultiprocessor(&per_cu, (const void*)mk_fwd, NWAVES * 64, LDS_BYTES) != hipSuccess || per_cu < 1) fprintf(stderr, "kernel_launch: occupancy query says %d\n", per_cu);
        (void)hipGetLastError();
        grid = cus;
    }
    if (grid < 0) return;
    (void)hipMemsetAsync((char*)d_ws + WS_CTL, 0, CTL_ZERO_BYTES, stream);
    Args a{};
    for (int i = 0; i < 20; ++i) a.in[i] = (const float*)d_in[i];
    a.out = (float*)d_out; a.ws = (unsigned char*)d_ws;
    if (MK_ONE_LAUNCH) {
        a.ph_lo = 0; a.ph_hi = NPHASE; a.li = 0;
        hipLaunchKernelGGL(mk_fwd, dim3(grid), dim3(NWAVES * 64), LDS_BYTES, stream, a);
    } else {
        for (int p = 0; p < NPHASE; ++p) { a.ph_lo = p; a.ph_hi = p + 1; a.li = p; hipLaunchKernelGGL(mk_fwd, dim3(grid), dim3(NWAVES * 64), LDS_BYTES, stream, a); }
    }
}
```

```cpp
#include <hip/hip_runtime.h>
#include <hip/hip_bf16.h>
#include <cstdio>
#include <cstdint>

#ifndef MK_ONE_LAUNCH
#define MK_ONE_LAUNCH 1
#endif
#define PROBE_DOUBLE -1
#ifndef PROBE_TS_A
#define PROBE_TS_A -1
#define PROBE_TS_B -1
#endif
#define PROBE_TS_SCALE_US 3000.0f
#ifndef PROBE_TS_BLOCK
#define PROBE_TS_BLOCK 0
#endif
#define TSA(a_, i) do { if (PROBE_TS_A >= 0 && blockIdx.x == PROBE_TS_BLOCK && threadIdx.x == 0) ((unsigned long long*)((a_).ws + WS_CTL + 65536))[i] = __builtin_amdgcn_s_memrealtime(); } while (0)
#define TS(i) do { if (PROBE_TS_A >= 0 && blockIdx.x == PROBE_TS_BLOCK && threadIdx.x == 0) ((unsigned long long*)(args.ws + WS_CTL + 65536))[i] = __builtin_amdgcn_s_memrealtime(); } while (0)

namespace pg8 {
#define PG8_LAS __attribute__((address_space(3)))
typedef unsigned short bf16_t;
typedef short bf16x8 __attribute__((ext_vector_type(8)));
typedef float f32x4 __attribute__((ext_vector_type(4)));
typedef unsigned u32x4 __attribute__((ext_vector_type(4)));
constexpr int BM = 256, BK = 64, HALF = 128, HTB = HALF * BK * 2, STAGE_BYTES = 8 * HTB, NXCD = 8, WGM = 8;

__host__ __device__ __forceinline__ int lds_byte(int r, int c) { const int st = (r >> 4) * 2 + (c >> 5), rr = r & 15, cc = c & 31, ob = rr * 64 + cc * 2; return st * 1024 + (ob ^ (((ob >> 9) & 1) << 5)); }
__host__ __device__ __forceinline__ void stage_rc(int b, int& R, int& C) { const int st = b / 1024, sb = b % 1024, swz = sb ^ (((sb >> 9) & 1) << 5); R = (st >> 1) * 16 + swz / 64; C = (st & 1) * 32 + (swz % 64) / 2; }
__host__ __device__ __forceinline__ int perm32(int rho) { const int n = rho >> 4, i = rho & 15; return 8 * (i >> 2) + 4 * n + (i & 3); }

struct Unit { int pm, pn; size_t bofs; int rb; };
struct Gemm { const bf16_t* A; const bf16_t* Bt; int lda, ldb, K; const int* rowsrc; };

struct StaticOrder {
    int nM, nN, nwg, G, c;
    __device__ void init(int nM_, int nN_, int G_, int c_) { nM = nM_; nN = nN_; nwg = nM * nN; G = G_; c = c_; }
    __device__ bool next(int i, Unit& u) const {
        const long L = (long)i * G + c; if (L >= nwg) return false;
        int wgid = (int)L; { const int q = nwg / NXCD, r = nwg % NXCD, xcd = wgid % NXCD, off = wgid / NXCD; wgid = (xcd < r ? xcd * (q + 1) : r * (q + 1) + (xcd - r) * q) + off; }
        const int nig = WGM * nN, gid = wgid / nig, fm = gid * WGM, gsz = (nM - fm) < WGM ? (nM - fm) : WGM;
        u.pm = fm + ((wgid % nig) % gsz); u.pn = (wgid % nig) / gsz; u.bofs = 0; u.rb = u.pm * 256; return true;
    }
};
struct MoeOrder {
    int pm_lo, nN, nwg, G, c; const PG8_LAS int* tb; size_t bstride;
    __device__ void init(int pm_lo_, int npm, int nN_, int G_, int c_, const PG8_LAS int* tb_, size_t bs) { pm_lo = pm_lo_; nN = nN_; nwg = (npm > 0 && c_ >= 0 && c_ < G_) ? npm * nN_ : 0; G = G_; c = c_; tb = tb_; bstride = bs; }
    __device__ bool next(int i, Unit& u) const {
        const long L = (long)i * G + c; if (c < 0 || L >= nwg) return false;
        int wgid = (int)L;
        { const int q = nwg / NXCD, r = nwg % NXCD, xcd = wgid % NXCD, off = wgid / NXCD; wgid = (xcd < r ? xcd * (q + 1) : r * (q + 1) + (xcd - r) * q) + off; }
        u.pn = wgid % nN; u.pm = pm_lo + wgid / nN;
        int e = 0;
#pragma unroll
        for (int k = 1; k < 16; ++k) e += (tb[k] <= u.pm) ? 1 : 0;
        u.bofs = (size_t)e * bstride; u.rb = e * 8192 + (u.pm - tb[e]) * 256; return true;
    }
};

__device__ __forceinline__ unsigned cvt_pk_bf16(float lo, float hi) { unsigned r; asm volatile("v_cvt_pk_bf16_f32 %0, %1, %2" : "=v"(r) : "v"(lo), "v"(hi)); return r; }

template <class Epi, class Sched, bool GATHER = false>
__device__ __forceinline__ void gemm_phase(PG8_LAS unsigned char* lds, const Gemm g, const Sched& S, const Epi& E) {
    int tid = threadIdx.x; asm volatile("" : "+v"(tid));
    const int wid = __builtin_amdgcn_readfirstlane(tid >> 6), lane = tid & 63, wr = wid >> 2, wc = wid & 3, fr = lane & 15, fq = lane >> 4;
    const int K = g.K, nt = K / BK;
    unsigned voffA[2], voffB[2];
#pragma unroll
    for (int i = 0; i < 2; ++i) { int R, C; stage_rc(tid * 16 + i * 8192, R, C); const int Rb = ((R & ~31) + perm32(R & 31));
        voffA[i] = (unsigned)(R * g.lda + C) * 2u; voffB[i] = (unsigned)(Rb * g.ldb + C) * 2u; }
    int gR[2], gC[2];
#pragma unroll
    for (int i = 0; i < 2; ++i) stage_rc(tid * 16 + i * 8192, gR[i], gC[i]);
    unsigned cvA[2][2] = {{0u, 0u}, {0u, 0u}}, nvA[2][2] = {{0u, 0u}, {0u, 0u}};
#define PG8_GLOAD(dst, rb_) do { _Pragma("unroll") for (int h_ = 0; h_ < 2; ++h_) _Pragma("unroll") for (int i_ = 0; i_ < 2; ++i_) { \
        const int rt_ = g.rowsrc[(rb_) + h_ * HALF + gR[i_]]; dst[h_][i_] = (unsigned)((rt_ >= 0 ? rt_ >> 1 : 0) * g.lda + gC[i_]) * 2u; } } while (0)
    const size_t kstep = (size_t)(BK * 2);
    const size_t hstepA = (size_t)HALF * g.lda * 2, hstepB = (size_t)HALF * g.ldb * 2;
    const size_t tstepA = 2 * hstepA, tstepB = 2 * hstepB;
    const unsigned ldsw = (unsigned)wid * 1024u;
    const int aoff = lds_byte(wr * 64 + fr, fq * 8), boff = lds_byte(wc * 32 + fr, fq * 8);
#define PG8_SA(b, h) (((b) * 2 + (h)) * HTB)
#define PG8_SB(b, h) ((4 + (b) * 2 + (h)) * HTB)
#define PG8_STAGE(bufoff, gbase, voff) do { _Pragma("unroll") for (int _i = 0; _i < 2; ++_i) \
        __builtin_amdgcn_global_load_lds((const unsigned*)((const char*)(gbase) + (voff)[_i]), (PG8_LAS unsigned*)(lds + (bufoff) + ldsw + _i * 8192), 16, 0, 0); } while (0)
#define PG8_LDA(dst, b, h) do { _Pragma("unroll") for (int m = 0; m < 4; ++m) _Pragma("unroll") for (int k = 0; k < 2; ++k) dst[m][k] = *(const PG8_LAS bf16x8*)(lds + PG8_SA(b, h) + aoff + m * 2048 + k * 1024); } while (0)
#define PG8_LDB(dst, b, h) do { _Pragma("unroll") for (int n = 0; n < 2; ++n) _Pragma("unroll") for (int k = 0; k < 2; ++k) dst[n][k] = *(const PG8_LAS bf16x8*)(lds + PG8_SB(b, h) + boff + n * 2048 + k * 1024); } while (0)
#define PG8_MMA(ai, bj, At, Bt) do { __builtin_amdgcn_s_setprio(1); _Pragma("unroll") for (int m = 0; m < 4; ++m) _Pragma("unroll") for (int n = 0; n < 2; ++n) _Pragma("unroll") for (int k = 0; k < 2; ++k) \
        acc[ai][bj][m][n] = __builtin_amdgcn_mfma_f32_16x16x32_bf16(Bt[n][k], At[m][k], acc[ai][bj][m][n], 0, 0, 0); __builtin_amdgcn_s_setprio(0); } while (0)
#define PG8_WAIT_V(n) asm volatile("s_waitcnt vmcnt(" #n ")" ::: "memory")
#define PG8_WAIT_L(n) asm volatile("s_waitcnt lgkmcnt(" #n ")" ::: "memory")
#define PG8_BAR __builtin_amdgcn_s_barrier()
#define PG8_SCHED __builtin_amdgcn_sched_barrier(0)
    Unit cur, nxt; int ui = 0;
    if (!S.next(0, cur)) return;
    f32x4 acc[2][2][4][2];
#pragma unroll
    for (int a = 0; a < 2; ++a)
#pragma unroll
        for (int b = 0; b < 2; ++b)
#pragma unroll
            for (int m = 0; m < 4; ++m)
#pragma unroll
                for (int n = 0; n < 2; ++n) acc[a][b][m][n] = (f32x4){0.f, 0.f, 0.f, 0.f};
    bf16x8 At[4][2], B0[2][2], B1[2][2];
    const char* cA = (const char*)g.A + (size_t)cur.pm * tstepA; const char* cB = (const char*)g.Bt + cur.bofs + (size_t)cur.pn * tstepB;
    const char* gA = (const char*)g.A;
    if constexpr (GATHER) { PG8_GLOAD(cvA, cur.rb); }
    {
        PG8_STAGE(PG8_SB(0, 0), cB, voffB); PG8_STAGE(PG8_SB(0, 1), cB + hstepB, voffB);
        if constexpr (GATHER) { PG8_STAGE(PG8_SA(0, 0), gA, cvA[0]); PG8_STAGE(PG8_SA(0, 1), gA, cvA[1]); } else { PG8_STAGE(PG8_SA(0, 0), cA, voffA); PG8_STAGE(PG8_SA(0, 1), cA + hstepA, voffA); }
        if (wr == 1) PG8_BAR;
        PG8_WAIT_V(2); PG8_BAR;
        PG8_STAGE(PG8_SB(1, 0), cB + kstep, voffB);
        if constexpr (GATHER) { PG8_STAGE(PG8_SA(1, 0), gA + kstep, cvA[0]); } else { PG8_STAGE(PG8_SA(1, 0), cA + kstep, voffA); }
        PG8_STAGE(PG8_SB(1, 1), cB + hstepB + kstep, voffB);
        PG8_WAIT_V(6); PG8_BAR;
    }
    for (;;) {
        const bool has_next = S.next(ui + 1, nxt);
        const char* nA = has_next ? (const char*)g.A + (size_t)nxt.pm * tstepA : cA; const char* nB = has_next ? (const char*)g.Bt + nxt.bofs + (size_t)nxt.pn * tstepB : cB;
        if constexpr (GATHER) { if (has_next) { PG8_GLOAD(nvA, nxt.rb); } else {
#pragma unroll
            for (int h_ = 0; h_ < 2; ++h_) { nvA[h_][0] = cvA[h_][0]; nvA[h_][1] = cvA[h_][1]; } } }
        for (int t = 0; t < nt; t += 2) {
            if constexpr (Epi::HAS_MID) { if (t == nt / 2) E.mid(acc, cur, wr, wc, fr, fq); }
            const bool last = (t == nt - 2);
            const char* a1 = cA + (size_t)(t + 1) * kstep;
            const char* a2 = last ? nA : cA + (size_t)(t + 2) * kstep; const char* b2 = last ? nB : cB + (size_t)(t + 2) * kstep;
            const char* a3 = a2 + kstep; const char* b3 = b2 + kstep;
            unsigned sv[2][2]; const char* g2 = gA;
            if constexpr (GATHER) { g2 = last ? gA : gA + (size_t)(t + 2) * kstep;
#pragma unroll
                for (int h_ = 0; h_ < 2; ++h_) { sv[h_][0] = last ? nvA[h_][0] : cvA[h_][0]; sv[h_][1] = last ? nvA[h_][1] : cvA[h_][1]; } }
            PG8_LDB(B0, 0, 0); PG8_LDB(B1, 0, 1); PG8_SCHED; PG8_LDA(At, 0, 0);
            if constexpr (GATHER) { PG8_STAGE(PG8_SA(1, 1), gA + (size_t)(t + 1) * kstep, cvA[1]); } else { PG8_STAGE(PG8_SA(1, 1), a1 + hstepA, voffA); }
            PG8_WAIT_V(8); PG8_WAIT_L(0); PG8_BAR; PG8_MMA(0, 0, At, B0); PG8_MMA(0, 1, At, B1); PG8_BAR; PG8_SCHED;
            PG8_LDA(At, 0, 1); PG8_STAGE(PG8_SB(0, 0), b2, voffB); PG8_STAGE(PG8_SB(0, 1), b2 + hstepB, voffB);
            if constexpr (GATHER) { PG8_STAGE(PG8_SA(0, 0), g2, sv[0]); } else { PG8_STAGE(PG8_SA(0, 0), a2, voffA); }
            PG8_WAIT_V(8); PG8_WAIT_L(0); PG8_BAR; PG8_MMA(1, 0, At, B0); PG8_MMA(1, 1, At, B1); PG8_BAR; PG8_SCHED;
            PG8_LDB(B0, 1, 0); PG8_LDB(B1, 1, 1); PG8_SCHED; PG8_LDA(At, 1, 0);
            if constexpr (GATHER) { PG8_STAGE(PG8_SA(0, 1), g2, sv[1]); } else { PG8_STAGE(PG8_SA(0, 1), a2 + hstepA, voffA); }
            PG8_WAIT_V(8); PG8_WAIT_L(0); PG8_BAR; PG8_MMA(0, 0, At, B0); PG8_MMA(0, 1, At, B1); PG8_BAR; PG8_SCHED;
            PG8_LDA(At, 1, 1); PG8_STAGE(PG8_SB(1, 0), b3, voffB); PG8_STAGE(PG8_SB(1, 1), b3 + hstepB, voffB);
            if constexpr (GATHER) { PG8_STAGE(PG8_SA(1, 0), g2 + kstep, sv[0]); } else { PG8_STAGE(PG8_SA(1, 0), a3, voffA); }
            PG8_WAIT_V(8); PG8_WAIT_L(0); PG8_BAR; PG8_MMA(1, 0, At, B0); PG8_MMA(1, 1, At, B1); PG8_BAR; PG8_SCHED;
        }
        if (wr == 0) PG8_BAR;
        E(acc, cur, wr, wc, fr, fq);
        if (!has_next) break;
#pragma unroll
        for (int a = 0; a < 2; ++a)
#pragma unroll
            for (int b = 0; b < 2; ++b)
#pragma unroll
                for (int m = 0; m < 4; ++m)
#pragma unroll
                    for (int n = 0; n < 2; ++n) acc[a][b][m][n] = (f32x4){0.f, 0.f, 0.f, 0.f};
        cur = nxt; cA = nA; cB = nB; ++ui;
        if constexpr (GATHER) {
#pragma unroll
            for (int h_ = 0; h_ < 2; ++h_) { cvA[h_][0] = nvA[h_][0]; cvA[h_][1] = nvA[h_][1]; } }
        if (wr == 1) PG8_BAR;
    }
    PG8_WAIT_V(0);
    PG8_BAR;
#undef PG8_GLOAD
#undef PG8_SA
#undef PG8_SB
#undef PG8_STAGE
#undef PG8_LDA
#undef PG8_LDB
#undef PG8_MMA
#undef PG8_WAIT_V
#undef PG8_WAIT_L
#undef PG8_BAR
#undef PG8_SCHED
}
}

constexpr int NWAVES = 8;
constexpr int DM = 2048, SEQ = 8192, NMETA = 16, LTOK = SEQ + NMETA, LP = 8448;
constexpr int HD = 128, NH = 8, KVR = 512, IH = 16, IDD = 64, TOPK = 256;
constexpr int INW = 9816, PW = 9984;
constexpr int PC_QA = 0, PC_CKV = 1024, PC_QI = 1536, PC_KI = 2560, PC_WI = 2624, PC_FB = 2640, PC_QB = 2688, PC_KB = 3712, PC_VB = 4736, PC_GA = 5760, PC_GB = 7808, PC_END = 9856;
constexpr int NE = 16, DFF = 512, TSROWS = 20480;
constexpr float EPS = 1e-6f;
constexpr float LOG2E = 1.4426950408889634f;
constexpr float ATT_SCALE = 0.08838834764831845f;
constexpr int NTILE64 = 129;
constexpr int NPHASE = 14;


namespace att {
typedef short bf16x8 __attribute__((ext_vector_type(8)));
typedef short s16x4 __attribute__((ext_vector_type(4)));
typedef float f32x16 __attribute__((ext_vector_type(16)));
typedef float f32x4 __attribute__((ext_vector_type(4)));
typedef unsigned u32x4 __attribute__((ext_vector_type(4)));
typedef unsigned short bf16;
constexpr int NW = 8, QBLK = 32, KVBLK = 64, QB = NW * QBLK, D = 128;
constexpr int SHM_V = KVBLK * D * 2, SHM_K = KVBLK * D * 2;
constexpr int NVS = 3;
constexpr int OFF_WS = NVS * SHM_V + 2 * SHM_K, OFF_BIAS = OFF_WS + NW * 64 * 4, OFF_Q = OFF_BIAS + 2 * 64 * 4, LDS_TOTAL = OFF_Q + NW * 8192;
constexpr float SCALE = 0.08838834764831845f, THR = 8.f;
#define KSWZ(row, colB) ((row) * 256 + ((colB) ^ (((row) & 7) << 4)))
#define SBAR() __builtin_amdgcn_sched_barrier(0)
__device__ __forceinline__ int v_st(int k, int c) { const int kk = (k & ~0xC) | ((k & 4) << 1) | ((k & 8) >> 1); return ((kk >> 3) * 4 + (c >> 5)) * 512 + ((kk & 7) * 32 + (c & 31)) * 2; }
__device__ __forceinline__ int v_rd_base(int lane) { return ((lane & 3) << 3) | (((lane >> 2) & 3) << 6) | (((lane >> 4) & 1) << 5) | (((lane >> 5) & 1) << 8); }
constexpr int v_rd_off(int d0, int ks, int half) { return d0 * 512 + ks * 4096 + half * 2048; }
__device__ __forceinline__ int crow(int r, int hi) { return (r & 3) + 8 * (r >> 2) + 4 * hi; }
__device__ __forceinline__ unsigned cvtpk(float lo, float hi) { unsigned r; asm volatile("v_cvt_pk_bf16_f32 %0, %1, %2" : "=v"(r) : "v"(lo), "v"(hi)); return r; }
__device__ __forceinline__ void mask_causal(f32x16& p0, f32x16& p1, int dq) {
    const float NEG = -__builtin_inff();
#pragma unroll
    for (int r = 0; r < 16; ++r) { const int c = (r & 3) + 8 * (r >> 2); if (dq - c < 0) p0[r] = NEG; if (dq - c - 32 < 0) p1[r] = NEG; }
}
__device__ __forceinline__ void mask_bits(f32x16& p0, f32x16& p1, unsigned long long w, int hi) {
    const float NEG = -__builtin_inff();
    const unsigned wl = (unsigned)w >> (4 * hi), wh = (unsigned)(w >> 32) >> (4 * hi);
#pragma unroll
    for (int r = 0; r < 16; ++r) { const int c = (r & 3) + 8 * (r >> 2);
        const unsigned m0 = (unsigned)__builtin_amdgcn_sbfe((int)wl, c, 1), m1 = (unsigned)__builtin_amdgcn_sbfe((int)wh, c, 1);
        p0[r] = __uint_as_float((__float_as_uint(p0[r]) & m0) | (__float_as_uint(NEG) & ~m0)); p1[r] = __uint_as_float((__float_as_uint(p1[r]) & m1) | (__float_as_uint(NEG) & ~m1)); }
}
__device__ __forceinline__ void partialSM(f32x16& p0, f32x16& p1, float& m_reg, float& mn, float& alpha) {
    float pmax = p0[0];
#pragma unroll
    for (int r = 1; r < 16; ++r) pmax = fmaxf(pmax, p0[r]);
#pragma unroll
    for (int r = 0; r < 16; ++r) pmax = fmaxf(pmax, p1[r]);
    { auto rr = __builtin_amdgcn_permlane32_swap(__float_as_uint(pmax), __float_as_uint(pmax), false, false);
      pmax = fmaxf(__uint_as_float(rr[0]), __uint_as_float(rr[1])); }
    constexpr float C2 = 1.4426950408889634f * SCALE;
    if (__builtin_expect(__all((pmax - m_reg) * SCALE <= THR), 1)) { mn = m_reg; alpha = 1.f; }
    else { mn = fmaxf(m_reg, pmax); alpha = __builtin_amdgcn_exp2f((m_reg - mn) * C2); m_reg = mn; }
    const float mnL = -mn * C2;
#pragma unroll
    for (int r = 0; r < 16; ++r) p0[r] = fmaf(p0[r], C2, mnL);
#pragma unroll
    for (int r = 0; r < 16; ++r) p1[r] = fmaf(p1[r], C2, mnL);
#pragma unroll
    for (int r = 0; r < 16; ++r) p0[r] = __builtin_amdgcn_exp2f(p0[r]);
}
__device__ __forceinline__ void finishSM(f32x16& p0, f32x16& p1, float alpha, float& l_reg, bf16x8& pa0, bf16x8& pa1, bf16x8& pa2, bf16x8& pa3) {
#pragma unroll
    for (int r = 0; r < 16; ++r) p1[r] = __builtin_amdgcn_exp2f(p1[r]);
    float ps = 0;
#pragma unroll
    for (int r = 0; r < 16; ++r) ps += p0[r];
#pragma unroll
    for (int r = 0; r < 16; ++r) ps += p1[r];
    { auto rr = __builtin_amdgcn_permlane32_swap(__float_as_uint(ps), __float_as_uint(ps), false, false);
      ps = __uint_as_float(rr[0]) + __uint_as_float(rr[1]); }
    l_reg = l_reg * alpha + ps;
#define PK4(P, B_, OUT) do { unsigned a0 = cvtpk(P[B_+0], P[B_+1]), a1 = cvtpk(P[B_+2], P[B_+3]);                          \
        unsigned b0 = cvtpk(P[B_+4], P[B_+5]), b1 = cvtpk(P[B_+6], P[B_+7]);                                             \
        auto r0 = __builtin_amdgcn_permlane32_swap(a0, b0, false, false); auto r1 = __builtin_amdgcn_permlane32_swap(a1, b1, false, false); \
        u32x4 w = {r0[0], r1[0], r0[1], r1[1]}; OUT = *reinterpret_cast<bf16x8*>(&w); } while (0)
    PK4(p0, 0, pa0); PK4(p0, 8, pa1); PK4(p1, 0, pa2); PK4(p1, 8, pa3);
#undef PK4
}
template <int KB, int MODE>
__device__ __forceinline__ void qkt(f32x16& p0, f32x16& p1, const char* lds, int r32, int hi, const char* qsp) {
    const char* K_lds = lds + NVS * SHM_V;
    if (MODE == 0) { const float* bb = (const float*)(lds + OFF_BIAS + KB * 256) + 4 * hi;
#pragma unroll
        for (int g = 0; g < 4; ++g) { const f32x4 b0 = *(const f32x4*)(bb + 8 * g), b1 = *(const f32x4*)(bb + 32 + 8 * g);
            p0[4 * g] = b0[0]; p0[4 * g + 1] = b0[1]; p0[4 * g + 2] = b0[2]; p0[4 * g + 3] = b0[3];
            p1[4 * g] = b1[0]; p1[4 * g + 1] = b1[1]; p1[4 * g + 2] = b1[2]; p1[4 * g + 3] = b1[3]; } }
    else { p0 = f32x16{}; p1 = f32x16{}; }
    const char* kb[4];
#pragma unroll
    for (int dd = 0; dd < 4; ++dd) kb[dd] = K_lds + KB * SHM_K + KSWZ(r32, (dd * 16 + hi * 8) * 2);
#pragma unroll
    for (int d0 = 0; d0 < 8; ++d0) { const char* a = kb[d0 & 3] + (d0 >> 2) * 128;
        bf16x8 b0 = *reinterpret_cast<const bf16x8*>(a);
        bf16x8 b1 = *reinterpret_cast<const bf16x8*>(a + 32 * 256);
        const bf16x8 q = *reinterpret_cast<const bf16x8*>(qsp + d0 * 1024);
        p0 = __builtin_amdgcn_mfma_f32_32x32x16_bf16(b0, q, p0, 0, 0, 0);
        p1 = __builtin_amdgcn_mfma_f32_32x32x16_bf16(b1, q, p1, 0, 0, 0); }
}
__device__ __forceinline__ void pv_tile(f32x16* o, int vb0, bf16x8 pa0, bf16x8 pa1, bf16x8 pa2, bf16x8 pa3) {
#define TRRD(dst, off) asm volatile("ds_read_b64_tr_b16 %0, %1 offset:%2" : "=&v"(dst) : "v"(vb0), "i"(off) : "memory")
#define PV_D0(d0) do { s16x4 l0, l1, l2, l3, h0, h1, h2, h3; constexpr int b_ = v_rd_off(d0, 0, 0); \
        TRRD(l0, b_); TRRD(h0, b_ + 2048); TRRD(l1, b_ + 4096); TRRD(h1, b_ + 6144); TRRD(l2, b_ + 8192); TRRD(h2, b_ + 10240); TRRD(l3, b_ + 12288); TRRD(h3, b_ + 14336); \
        asm volatile("s_waitcnt lgkmcnt(0)" ::: "memory"); SBAR(); \
        o[d0] = __builtin_amdgcn_mfma_f32_32x32x16_bf16(pa0, (bf16x8){l0[0], l0[1], l0[2], l0[3], h0[0], h0[1], h0[2], h0[3]}, o[d0], 0, 0, 0);   \
        o[d0] = __builtin_amdgcn_mfma_f32_32x32x16_bf16(pa1, (bf16x8){l1[0], l1[1], l1[2], l1[3], h1[0], h1[1], h1[2], h1[3]}, o[d0], 0, 0, 0);   \
        o[d0] = __builtin_amdgcn_mfma_f32_32x32x16_bf16(pa2, (bf16x8){l2[0], l2[1], l2[2], l2[3], h2[0], h2[1], h2[2], h2[3]}, o[d0], 0, 0, 0);   \
        o[d0] = __builtin_amdgcn_mfma_f32_32x32x16_bf16(pa3, (bf16x8){l3[0], l3[1], l3[2], l3[3], h3[0], h3[1], h3[2], h3[3]}, o[d0], 0, 0, 0); } while (0)
    PV_D0(0); PV_D0(1); PV_D0(2); PV_D0(3);
#undef PV_D0
#undef TRRD
}
struct ItemRef { const bf16* Q; const bf16* K; const bf16* V; bf16* O; int P0, t_lo, t_hi; const float* cb; float cref; const unsigned long long* mk; float* part; float kn2; };
constexpr float FOX_TAU = 30.5f;
constexpr int PART_FLOATS = 256 * 128 + 512;
struct Seam { bf16x8 st_v0, st_v1, st_k0, st_k1; float st_b; };
#define ROWP(p, k0, rr) ((p) + (size_t)((k0) + (rr)) * LDKV + sc)
#define VMW() asm volatile("s_waitcnt vmcnt(0)" ::: "memory")
#define LD8(p) (*reinterpret_cast<const bf16x8*>(p))
#define SLOAD_H(R, k0) do { S.st_v0 = LD8(ROWP((R).V, k0, sr)); S.st_v1 = LD8(ROWP((R).V, k0, 32 + sr)); S.st_k0 = LD8(ROWP((R).K, k0, sr)); S.st_k1 = LD8(ROWP((R).K, k0, 32 + sr)); \
        if (MODE == 0 && wid == 0) S.st_b = ((R).cref - (R).cb[(k0) + lane]) * (1.0f / SCALE); } while (0)
#define SWRITE_HK(bf) do { *(bf16x8*)(K_lds + (bf) * SHM_K + kws) = S.st_k0; *(bf16x8*)(K_lds + (bf) * SHM_K + kws + 32 * 256) = S.st_k1; \
        if (MODE == 0 && wid == 0) ((float*)(lds + OFF_BIAS))[(bf) * 64 + lane] = S.st_b; } while (0)
#define SWRITE_HV(bf) do { *(bf16x8*)(V_lds + (bf) * SHM_V + vst0) = S.st_v0; *(bf16x8*)(V_lds + (bf) * SHM_V + vst1) = S.st_v1; } while (0)
#define SWRITE_H(bf) do { SWRITE_HV(bf); SWRITE_HK(bf); } while (0)
template <int MODE, int LDQ, int LDKV, int LDO>
__device__ __forceinline__ void run_item(const ItemRef& cur, char* lds, unsigned* qh, unsigned& nxt) {
    int tid = threadIdx.x; asm volatile("" : "+v"(tid));
    const int wid = __builtin_amdgcn_readfirstlane(tid >> 6), lane = tid & 63, r32 = lane & 31, hi = lane >> 5;
    int t_lo = cur.t_lo;
    const int qlo = cur.P0 + wid * QBLK, qm = qlo + r32 - 4 * hi;
    char* V_lds = lds; char* K_lds = lds + NVS * SHM_V;
    float* wsf = (float*)(lds + OFF_WS) + wid * 64; float* li_l = wsf, * al_l = wsf + 32;
    char* qsp = lds + OFF_Q + wid * 8192 + lane * 16;
    float m_reg = -1e30f, l_reg = 0; f32x16 o[4] = {};
    const int sr = tid >> 4, sc = (tid & 15) * 8, vst0 = v_st(sr, sc), vst1 = v_st(32 + sr, sc), kws = KSWZ(sr, sc * 2);
    const int vb0 = (int)(uintptr_t)V_lds + v_rd_base(lane);
    const unsigned long long* mkl = cur.mk + wid * QBLK + r32;
    Seam S;
#define RESC(a) do { if (__any((a) < 1.f)) { if (hi == 0) al_l[r32] = (a); asm volatile("s_waitcnt lgkmcnt(0)" ::: "memory");              \
                     _Pragma("unroll") for (int d_ = 0; d_ < 4; ++d_) _Pragma("unroll") for (int r = 0; r < 16; ++r) o[d_][r] *= al_l[crow(r, hi)]; } } while (0)
#define KBASE(t) ((t_lo + (t)) * KVBLK)
#define MLOAD(t) (MODE == 1 ? mkl[(size_t)(t_lo + (t)) * SEQ] : 0ull)
#define MASKT(P0_, P1_, t, w_) do { if (MODE == 1) mask_bits(P0_, P1_, w_, hi); else { const int kb_ = KBASE(t); if (kb_ + KVBLK - 1 > qlo) mask_causal(P0_, P1_, qm - kb_); } } while (0)
    { bf16x8 tq[8];
#pragma unroll
      for (int d0 = 0; d0 < 8; ++d0) tq[d0] = LD8(cur.Q + (size_t)(wid * QBLK + r32) * LDQ + d0 * 16 + hi * 8);
      if (MODE == 0) {
          float cbe[3];
#pragma unroll
          for (int i = 0; i < 3; ++i) { const int t = lane + 64 * i; cbe[i] = t < cur.t_hi ? cur.cb[t * KVBLK + KVBLK - 1] : -__builtin_inff(); }
          float q2 = 0.f;
#pragma unroll
          for (int d0 = 0; d0 < 8; ++d0)
#pragma unroll
              for (int j = 0; j < 8; ++j) { const float x = __uint_as_float((unsigned)(unsigned short)tq[d0][j] << 16); q2 = fmaf(x, x, q2); }
          q2 += __shfl_xor(q2, 32);
#pragma unroll
          for (int ofs = 1; ofs < 32; ofs <<= 1) q2 = fmaxf(q2, __shfl_xor(q2, ofs));
          if (lane == 0) al_l[0] = q2;
          __syncthreads();
          float Q2 = 0.f;
#pragma unroll
          for (int w = 0; w < NW; ++w) Q2 = fmaxf(Q2, ((const float*)(lds + OFF_WS))[w * 64 + 32]);
          const float D = FOX_TAU + 2.002f * SCALE * sqrtf(Q2 * cur.kn2);
          const float cthr = cur.cb[cur.P0] + D; int cntskip = 0;
#pragma unroll
          for (int i = 0; i < 3; ++i) { const bool sk = cbe[i] >= cthr; cntskip += __popcll(__ballot(sk)); }
          t_lo = cntskip < cur.t_hi - 1 ? cntskip : cur.t_hi - 1;
          __syncthreads();
      }
      SLOAD_H(cur, KBASE(0)); VMW();
#pragma unroll
      for (int d0 = 0; d0 < 8; ++d0) *(bf16x8*)(qsp + d0 * 1024) = tq[d0];
      SWRITE_HK(0); }
    const int NT = cur.t_hi - t_lo;
    __syncthreads();
    f32x16 pA0, pA1, pB0, pB1; float mnA, mnB, alA, alB; bf16x8 pa0, pa1, pa2, pa3;
    unsigned long long mw = MLOAD(0);
    SWRITE_HV(0); SBAR();
    if (NT > 1) { SLOAD_H(cur, KBASE(1)); }
    SBAR(); qkt<0, MODE>(pA0, pA1, lds, r32, hi, qsp);
    MASKT(pA0, pA1, 0, mw); partialSM(pA0, pA1, m_reg, mnA, alA);
    if (NT > 1) { VMW(); SWRITE_H(1); }
    __syncthreads();
    int vs = 0;
#define HALF_STEP(PX0, PX1, mnX, alX, PY0, PY1, alY, t, KB, SB) do {                                                          \
        SBAR(); mw = MLOAD(t); qkt<KB, MODE>(PX0, PX1, lds, r32, hi, qsp);                                                    \
        finishSM(PY0, PY1, alY, l_reg, pa0, pa1, pa2, pa3); SBAR();                                                           \
        if ((t) + 1 < NT) { SLOAD_H(cur, KBASE((t) + 1)); SBAR(); }                                                           \
        pv_tile(o, vb0 + vs * SHM_V, pa0, pa1, pa2, pa3); MASKT(PX0, PX1, (t), mw); partialSM(PX0, PX1, m_reg, mnX, alX);     \
        if ((t) + 1 < NT) { const int vn_ = vs >= 1 ? vs - 1 : 2; VMW(); SWRITE_HK(SB); SWRITE_HV(vn_); }                      \
        RESC(alX); vs = vs == 2 ? 0 : vs + 1; __syncthreads(); } while (0)
    for (int t = 1; t + 1 < NT; t += 2) {
        HALF_STEP(pB0, pB1, mnB, alB, pA0, pA1, alA, t, 1, 0);
        HALF_STEP(pA0, pA1, mnA, alA, pB0, pB1, alB, t + 1, 0, 1);
    }
    const bool even = (NT & 1) == 0;
    if (even) { SBAR(); mw = MLOAD(NT - 1); qkt<1, MODE>(pB0, pB1, lds, r32, hi, qsp); SBAR(); }
    finishSM(pA0, pA1, alA, l_reg, pa0, pa1, pa2, pa3); SBAR();
    pv_tile(o, vb0 + vs * SHM_V, pa0, pa1, pa2, pa3);
    if (even) { MASKT(pB0, pB1, NT - 1, mw); partialSM(pB0, pB1, m_reg, mnB, alB); __syncthreads(); RESC(alB);
        finishSM(pB0, pB1, alB, l_reg, pa0, pa1, pa2, pa3); SBAR(); pv_tile(o, vb0 + (vs == 2 ? 0 : vs + 1) * SHM_V, pa0, pa1, pa2, pa3); }
    SBAR();
    if (qh && threadIdx.x == 0) nxt = __hip_atomic_fetch_add(qh, 1u, __ATOMIC_RELAXED, __HIP_MEMORY_SCOPE_AGENT);
    if (cur.part) {
        float* po = cur.part + (size_t)wid * 4096 + lane * 4;
#pragma unroll
        for (int d0 = 0; d0 < 4; ++d0)
#pragma unroll
            for (int g = 0; g < 4; ++g) *(f32x4*)(po + (d0 * 4 + g) * 256) = (f32x4){o[d0][4 * g], o[d0][4 * g + 1], o[d0][4 * g + 2], o[d0][4 * g + 3]};
        if (hi == 0) { cur.part[256 * 128 + wid * QBLK + r32] = m_reg; cur.part[256 * 128 + 256 + wid * QBLK + r32] = l_reg; }
    } else {
        if (hi == 0) li_l[r32] = l_reg; asm volatile("s_waitcnt lgkmcnt(0)" ::: "memory");
        float rli[16];
#pragma unroll
        for (int r = 0; r < 16; ++r) rli[r] = __builtin_amdgcn_rcpf(li_l[crow(r, hi)]);
        bf16* Ow = cur.O + (size_t)(wid * QBLK) * LDO;
        char* ost = lds + OFF_Q + wid * 8192;
#pragma unroll
        for (int r = 0; r < 16; ++r) { const int orow = crow(r, hi);
#pragma unroll
            for (int d0 = 0; d0 < 4; ++d0) { const float v = o[d0][r] * rli[r];
                const float vn = __int_as_float(__builtin_amdgcn_mov_dpp(__float_as_int(v), 0xB1, 0xf, 0xf, false));
                if ((r32 & 1) == 0) *(unsigned*)(ost + orow * 256 + (d0 * 32 + r32) * 2) = cvtpk(v, vn); } }
        asm volatile("s_waitcnt lgkmcnt(0)" ::: "memory");
#pragma unroll
        for (int i = 0; i < 8; ++i) { const int row = i * 4 + (lane >> 4), c16 = lane & 15;
            const u32x4 x = *(const u32x4*)(ost + row * 256 + c16 * 16);
            *(u32x4*)(Ow + (size_t)row * LDO + c16 * 8) = x; }
    }
    __syncthreads();
#undef RESC
#undef KBASE
#undef MLOAD
#undef MASKT
#undef HALF_STEP
}
template <int LDO>
__device__ __forceinline__ void combine_item(const float* p1, const float* p2, bf16* O, char* lds) {
    int tid = threadIdx.x; asm volatile("" : "+v"(tid));
    const int wid = __builtin_amdgcn_readfirstlane(tid >> 6), lane = tid & 63, r32 = lane & 31, hi = lane >> 5;
    float* wsf = (float*)(lds + OFF_WS) + wid * 64;
    constexpr float C2 = 1.4426950408889634f * SCALE;
    { const int row = wid * QBLK + r32; const float m1 = p1[256 * 128 + row], m2 = p2[256 * 128 + row], l1 = p1[256 * 128 + 256 + row], l2 = p2[256 * 128 + 256 + row];
      const float m = fmaxf(m1, m2), f1 = __builtin_amdgcn_exp2f((m1 - m) * C2), f2 = __builtin_amdgcn_exp2f((m2 - m) * C2); const float rl = 1.f / (l1 * f1 + l2 * f2);
      if (hi == 0) { wsf[r32] = f1 * rl; wsf[32 + r32] = f2 * rl; } }
    asm volatile("s_waitcnt lgkmcnt(0)" ::: "memory");
    const float* q1 = p1 + (size_t)wid * 4096 + lane * 4; const float* q2 = p2 + (size_t)wid * 4096 + lane * 4;
    bf16* Ow = O + (size_t)(wid * QBLK) * LDO;
    char* ost = lds + OFF_Q + wid * 8192;
    const int r32e = (r32 & 1) == 0;
#pragma unroll
    for (int d0 = 0; d0 < 4; ++d0)
#pragma unroll
        for (int g = 0; g < 4; ++g) { const f32x4 a = *(const f32x4*)(q1 + (d0 * 4 + g) * 256), b = *(const f32x4*)(q2 + (d0 * 4 + g) * 256);
#pragma unroll
            for (int j = 0; j < 4; ++j) { const int r = 4 * g + j, orow = crow(r, hi); const float v = a[j] * wsf[orow] + b[j] * wsf[32 + orow];
                const float vn = __int_as_float(__builtin_amdgcn_mov_dpp(__float_as_int(v), 0xB1, 0xf, 0xf, false));
                if (r32e) *(unsigned*)(ost + orow * 256 + (d0 * 32 + r32) * 2) = cvtpk(v, vn); } }
    asm volatile("s_waitcnt lgkmcnt(0)" ::: "memory");
#pragma unroll
    for (int i = 0; i < 8; ++i) { const int row = i * 4 + (lane >> 4), c16 = lane & 15;
        const u32x4 x = *(const u32x4*)(ost + row * 256 + c16 * 16);
        *(u32x4*)(Ow + (size_t)row * LDO + c16 * 8) = x; }
    __syncthreads();
}
#undef ROWP
#undef VMW
#undef LD8
#undef SLOAD_H
#undef SWRITE_HK
#undef SWRITE_HV
#undef SWRITE_H
#undef KSWZ
#undef SBAR
}

constexpr size_t MiB = 1u << 20;
constexpr size_t WS_CTL = 0, CTL_ZERO_BYTES = 32 * 1024;
constexpr size_t WS_ROPE128 = 1 * MiB;
constexpr size_t WS_ROPE64 = 5 * MiB + 256 * 1024;
constexpr size_t WS_GWH = 9 * MiB + 512 * 1024, WS_GWL = 9 * MiB + 640 * 1024;
constexpr size_t WS_WRT = 7 * MiB + 288 * 1024;
constexpr size_t WS_KI = 7 * MiB + 512 * 1024;
constexpr size_t WS_WI = 8 * MiB + 768 * 1024;
constexpr size_t WS_LOGF = 9 * MiB + 512 * 1024;
constexpr size_t WS_CC = 9 * MiB + 896 * 1024;
constexpr size_t WS_ROUTE = 10 * MiB + 256 * 1024;
constexpr size_t WS_ROWTOK = 7 * MiB + 512 * 1024;
constexpr size_t WS_ROWR = 8 * MiB + 512 * 1024;
constexpr size_t WS_ROWW = 8 * MiB;
constexpr size_t WS_CCT = 11 * MiB;
constexpr size_t WS_WAT = 12 * MiB, WS_WBT = 16 * MiB, WS_WOT = 20 * MiB, WS_WKVT = 28 * MiB;
constexpr size_t WS_PROJ = 30 * MiB;
constexpr size_t WS_KVA = 191 * MiB;
constexpr size_t WS_CKVN = 224 * MiB;
constexpr size_t WS_MASK = 224 * MiB;
constexpr size_t WS_R = 233 * MiB;
constexpr size_t WS_HN = WS_R, WS_WINT = WS_R + 33 * MiB, WS_SMALL = WS_R + 73 * MiB;
constexpr size_t WS_S = WS_R;
constexpr size_t WS_YA = WS_R, WS_YB = WS_R + 16 * MiB, WS_MERGED = WS_R + 32 * MiB, WS_M1 = WS_R + 64 * MiB;
constexpr size_t WS_H2 = 30 * MiB, WS_T = 94 * MiB, WS_ACT = 126 * MiB, WS_WDT = 190 * MiB;
constexpr size_t WS_WGUT = WS_R + 66 * MiB;
constexpr size_t WS_SQ2 = 222 * MiB;
constexpr size_t WS_TS = WS_R, WS_Y = WS_R;
constexpr size_t WS_NEED = WS_R + 134 * MiB;
static_assert(WS_PROJ + (size_t)LP * PW * 2 <= WS_KVA && WS_KVA + (size_t)LP * 2048 * 2 <= WS_CKVN && WS_CKVN + (size_t)LP * 512 * 2 <= WS_R, "ws map");
static_assert(WS_WDT + (size_t)NE * 2048 * 512 * 2 <= WS_MASK && WS_M1 + (size_t)SEQ * 2048 * 4 <= WS_NEED && WS_ACT + (size_t)TSROWS * 512 * 2 <= WS_WDT && WS_WGUT + (size_t)NE * 1024 * 2048 * 2 <= WS_NEED, "ws map 2");
constexpr size_t WS_SSQ = 11 * MiB + 288 * 1024;
constexpr int CW_CNT = 64;
constexpr int CW_KMAX = 2112;
constexpr int CW_BAR = 4096;

constexpr int RING_OFF = 0, RING_BYTES = 131072;
constexpr int LDSCTL_OFF = 155648, MISC_OFF = LDSCTL_OFF + 320;
constexpr int LDS_BYTES = 159744;

#define GAS __attribute__((address_space(1)))
#define LAS __attribute__((address_space(3)))
typedef unsigned short bf16;
typedef unsigned v4u __attribute__((ext_vector_type(4)));
typedef unsigned v2u __attribute__((ext_vector_type(2)));
typedef float f32x4 __attribute__((ext_vector_type(4)));
typedef float f32x2 __attribute__((ext_vector_type(2)));
typedef short bf16x8 __attribute__((ext_vector_type(8)));
typedef GAS unsigned gu32;
#define RLX_AGENT __ATOMIC_RELAXED, __HIP_MEMORY_SCOPE_AGENT
#define LDS_WAIT() asm volatile("s_waitcnt lgkmcnt(0)" ::: "memory")
#define VM_WAIT() asm volatile("s_waitcnt vmcnt(0)" ::: "memory")
__device__ __forceinline__ unsigned f2bf(float f) { unsigned u = __builtin_bit_cast(unsigned, f); return (u + 0x7fffu + ((u >> 16) & 1u)) >> 16; }
__device__ __forceinline__ unsigned pk2(float lo, float hi) { return f2bf(lo) | (f2bf(hi) << 16); }
__device__ __forceinline__ float bf2f(unsigned h) { return __builtin_bit_cast(float, h << 16); }
__device__ __forceinline__ float bflo(unsigned w) { return __builtin_bit_cast(float, w << 16); }
__device__ __forceinline__ float bfhi(unsigned w) { return __builtin_bit_cast(float, w & 0xffff0000u); }

#define XB_TMO      128
#define XB_XCNT(j)  (256  + 64 * (j))
#define XB_XSUB(j)  (1280 + 64 * (j))
#define XB_XGEN(j)  (2304 + 64 * (j))
#define XB_TOP      3328
#define XB_TOPGEN   3392
#define XCD_BAR_WORDS 3456
#define XB_SPIN_CAP (1u << 22)
__device__ __forceinline__ unsigned xb_ld(unsigned* p)              { return __hip_atomic_load(p, __ATOMIC_RELAXED, __HIP_MEMORY_SCOPE_AGENT); }
__device__ __forceinline__ unsigned xb_add(unsigned* p, unsigned v) { return __hip_atomic_fetch_add(p, v, __ATOMIC_RELAXED, __HIP_MEMORY_SCOPE_AGENT); }
__device__ __forceinline__ unsigned xb_xcc_id() { return (unsigned)__builtin_amdgcn_s_getreg((3 << 11) | 20) & 0xFu; }
#define XB_SPIN(cond, bar) do { unsigned _sp = 0; while (cond) { __builtin_amdgcn_s_sleep(1); \
    if ((++_sp & 255u) == 0u) { if (xb_ld(&(bar)[XB_TMO])) break; if (_sp > XB_SPIN_CAP) { atomicAdd(&(bar)[XB_TMO], 1u); break; } } } } while (0)
struct XcdBarrier { unsigned* bar; unsigned x; volatile LAS unsigned* st; };
__device__ __forceinline__ XcdBarrier xcd_barrier_post(unsigned* bar, volatile LAS unsigned* st) {
    XcdBarrier b; b.bar = bar; b.x = xb_xcc_id(); b.st = st;
    if (threadIdx.x == 0) (void)xb_add(&bar[XB_XCNT(b.x)], 1u);
    return b;
}
__device__ __forceinline__ void xcd_barrier_complete(unsigned* bar, unsigned x, unsigned& nloc, unsigned& nx) {
    const unsigned G = gridDim.x * gridDim.y * gridDim.z;
    unsigned sum, cnt, mine, sp = 0u;
    for (;;) {
        sum = 0u; cnt = 0u; mine = 0u;
#pragma unroll
        for (unsigned j = 0; j < 16; ++j) { const unsigned c = xb_ld(&bar[XB_XCNT(j)]); sum += c; cnt += (c > 0u) ? 1u : 0u; mine = (j == x) ? c : mine; }
        if (sum == G) break;
        __builtin_amdgcn_s_sleep(1);
        if ((++sp & 255u) == 0u) { if (xb_ld(&bar[XB_TMO])) break; if (sp > XB_SPIN_CAP) { atomicAdd(&bar[XB_TMO], 1u); break; } }
    }
    nloc = mine > 0u ? mine : 1u; nx = cnt > 0u ? cnt : 1u;
}
__device__ __forceinline__ void xcd_barrier(const XcdBarrier& b) {
    asm volatile("s_waitcnt vmcnt(0)" ::: "memory");
    __syncthreads();
    if (threadIdx.x == 64) asm volatile("buffer_inv sc1\n\ts_waitcnt vmcnt(0)" ::: "memory");
    if (threadIdx.x == 0) {
        unsigned* bar = b.bar;
        __builtin_amdgcn_s_waitcnt(0);
        unsigned nloc = b.st[0], nx = b.st[1];
        if (nloc == 0u) { xcd_barrier_complete(bar, b.x, nloc, nx); b.st[0] = nloc; b.st[1] = nx; }
        const unsigned old = xb_add(&bar[XB_XSUB(b.x)], 1u);
        const unsigned gen = old / nloc;
        if (old + 1u == (gen + 1u) * nloc) {
            __builtin_amdgcn_fence(__ATOMIC_RELEASE, "agent");
            asm volatile("s_waitcnt vmcnt(0)" ::: "memory");
            const unsigned og = xb_add(&bar[XB_TOP], 1u);
            const unsigned tg = og / nx;
            if (og + 1u == (tg + 1u) * nx) xb_add(&bar[XB_TOPGEN], 1u);
            else XB_SPIN(xb_ld(&bar[XB_TOPGEN]) == tg, bar);
            xb_add(&bar[XB_XGEN(b.x)], 1u);
            asm volatile("s_waitcnt vmcnt(0)" ::: "memory");
        } else {
            XB_SPIN(xb_ld(&bar[XB_XGEN(b.x)]) == gen, bar);
            asm volatile("s_waitcnt vmcnt(0)" ::: "memory");
        }
    }
    __syncthreads();
}

struct Args { const float* in[20]; float* out; unsigned char* ws; int ph_lo, ph_hi, li, pad; };
enum { I_X = 0, I_META, I_GMIX, I_WIN, I_GKV, I_WKVUP, I_GIDXK, I_BF, I_WBA, I_WBB, I_WOUT, I_GFFN, I_WGROUP, I_BGROUP, I_WEXPERT, I_BEXPERT, I_WGATE, I_WUP, I_WDOWN, I_GFINAL };

__device__ __forceinline__ float wave_sum(float v) {
#pragma unroll
    for (int o = 1; o < 64; o <<= 1) v += __shfl_xor(v, o);
    return v;
}
__device__ __forceinline__ int wave_isum(int v) {
#pragma unroll
    for (int o = 1; o < 64; o <<= 1) v += __shfl_xor(v, o);
    return __builtin_amdgcn_readfirstlane(v);
}
__device__ __forceinline__ float wave_max(float v) {
#pragma unroll
    for (int o = 1; o < 64; o <<= 1) v = fmaxf(v, __shfl_xor(v, o));
    return v;
}

__device__ __forceinline__ void transpose_item(const float* colp, size_t ldsrc, bf16* WT, int ldwt, int k0, int n0, LAS float* scr, int lane, const float* rowscale = nullptr) {
    float v[32];
#pragma unroll
    for (int i = 0; i < 32; ++i) { const int kk = 2 * i + (lane >> 5); v[i] = colp ? colp[(size_t)(k0 + kk) * ldsrc] : 0.f; }
#pragma unroll
    for (int i = 0; i < 32; i += 8) asm volatile("" : "+v"(v[i]), "+v"(v[i + 1]), "+v"(v[i + 2]), "+v"(v[i + 3]), "+v"(v[i + 4]), "+v"(v[i + 5]), "+v"(v[i + 6]), "+v"(v[i + 7]));
#pragma unroll
    for (int i = 0; i < 32; ++i) { const int kk = 2 * i + (lane >> 5); scr[kk * 33 + (lane & 31)] = rowscale ? v[i] * rowscale[k0 + kk] : v[i]; }
    LDS_WAIT(); asm volatile("" ::: "memory");
    const int c = lane & 7;
#pragma unroll
    for (int j = 0; j < 4; ++j) { const int n = (lane >> 3) + 8 * j; const LAS float* s = scr + (8 * c) * 33 + n;
        v4u o; o.x = pk2(s[0 * 33], s[1 * 33]); o.y = pk2(s[2 * 33], s[3 * 33]); o.z = pk2(s[4 * 33], s[5 * 33]); o.w = pk2(s[6 * 33], s[7 * 33]);
        *(GAS v4u*)(WT + (size_t)(n0 + n) * ldwt + k0 + 8 * c) = o; }
    LDS_WAIT(); asm volatile("" ::: "memory");
}
__device__ __forceinline__ void tr_load(float (&v)[32], const float* colp, size_t ldsrc, int k0, int lane) {
#pragma unroll
    for (int i = 0; i < 32; ++i) { const int kk = 2 * i + (lane >> 5); v[i] = colp ? colp[(size_t)(k0 + kk) * ldsrc] : 0.f; }
}
__device__ __forceinline__ void tr_fence(float (&v)[32]) {
#pragma unroll
    for (int i = 0; i < 32; i += 8) asm volatile("" : "+v"(v[i]), "+v"(v[i + 1]), "+v"(v[i + 2]), "+v"(v[i + 3]), "+v"(v[i + 4]), "+v"(v[i + 5]), "+v"(v[i + 6]), "+v"(v[i + 7]));
}
__device__ __forceinline__ void tr_store(const float (&v)[32], bf16* WT, int ldwt, int k0, int n0, LAS float* scr, int lane, const float* rowscale = nullptr) {
#pragma unroll
    for (int i = 0; i < 32; ++i) { const int kk = 2 * i + (lane >> 5); scr[kk * 33 + (lane & 31)] = rowscale ? v[i] * rowscale[k0 + kk] : v[i]; }
    LDS_WAIT(); asm volatile("" ::: "memory");
    const int c = lane & 7;
#pragma unroll
    for (int j = 0; j < 4; ++j) { const int n = (lane >> 3) + 8 * j; const LAS float* s = scr + (8 * c) * 33 + n;
        v4u o; o.x = pk2(s[0 * 33], s[1 * 33]); o.y = pk2(s[2 * 33], s[3 * 33]); o.z = pk2(s[4 * 33], s[5 * 33]); o.w = pk2(s[6 * 33], s[7 * 33]);
        *(GAS v4u*)(WT + (size_t)(n0 + n) * ldwt + k0 + 8 * c) = o; }
    LDS_WAIT(); asm volatile("" ::: "memory");
}
__device__ __forceinline__ int rope_dim(int c, int half) { return (c & 1) ? half + (c >> 1) : (c >> 1); }
__device__ __forceinline__ int win_src(int n) {
    if (n < 1024) return (n & ~127) + rope_dim(n & 127, 64);
    if (n < PC_QI) return n;
    if (n < PC_KI) return PC_QI + ((n - PC_QI) & ~63) + rope_dim((n - PC_QI) & 63, 32);
    if (n < PC_FB) return n;
    if (n < PC_FB + 8) return 5712 + (n - PC_FB);
    if (n < PC_QB) return -1;
    if (n < PC_GA) return 2640 + (n - PC_QB);
    if (n < PC_END) return 5720 + (n - PC_GA);
    return -1;
}

using pg8::Unit;
typedef pg8::f32x4 (AccT)[2][2][4][2];
#define EPI_FOREACH(...) \
    _Pragma("unroll") for (int ai = 0; ai < 2; ++ai) _Pragma("unroll") for (int m = 0; m < 4; ++m) _Pragma("unroll") for (int bj = 0; bj < 2; ++bj) { \
        const int row = u.pm * 256 + ai * 128 + wr * 64 + m * 16 + fr; const int col = u.pn * 256 + bj * 128 + wc * 32 + 8 * fq; \
        const f32x4 v0 = acc[ai][bj][m][0], v1 = acc[ai][bj][m][1]; __VA_ARGS__ }

#define PACK8(v0, v1) (v4u){pg8::cvt_pk_bf16((v0)[0], (v0)[1]), pg8::cvt_pk_bf16((v0)[2], (v0)[3]), pg8::cvt_pk_bf16((v1)[0], (v1)[1]), pg8::cvt_pk_bf16((v1)[2], (v1)[3])}
__device__ __forceinline__ void rope8(f32x4& v0, f32x4& v1, const f32x4 cs0, const f32x4 cs1) {
    const f32x4 a = v0, b = v1;
    v0[0] = a[0] * cs0[0] - a[1] * cs0[1]; v0[1] = a[1] * cs0[0] + a[0] * cs0[1]; v0[2] = a[2] * cs0[2] - a[3] * cs0[3]; v0[3] = a[3] * cs0[2] + a[2] * cs0[3];
    v1[0] = b[0] * cs1[0] - b[1] * cs1[1]; v1[1] = b[1] * cs1[0] + b[0] * cs1[1]; v1[2] = b[2] * cs1[2] - b[3] * cs1[3]; v1[3] = b[3] * cs1[2] + b[2] * cs1[3];
}
struct EpiProj { static constexpr bool HAS_MID = false;
    bf16* P; float* SM; const float* R128; const float* R64; float* SSQ;
    __device__ __forceinline__ void operator()(const AccT& acc, const Unit& u, int wr, int wc, int fr, int fq) const {
        const int kind = u.pn < 4 ? 1 : (u.pn < 6 ? 2 : (u.pn < 10 ? 3 : (u.pn == 10 ? 4 : 0)));
#pragma unroll
        for (int ai = 0; ai < 2; ++ai)
#pragma unroll
            for (int mp = 0; mp < 2; ++mp) {
                f32x4 cs[2][2];
                if (kind == 1 || kind == 3) {
#pragma unroll
                    for (int mm = 0; mm < 2; ++mm) { const int pos = NMETA + u.pm * 256 + ai * 128 + wr * 64 + (2 * mp + mm) * 16 + fr;
                        const float* t = kind == 1 ? R128 + ((size_t)pos * 64 + 16 * wc + 4 * fq) * 2 : R64 + ((size_t)pos * 32 + 16 * (wc & 1) + 4 * fq) * 2;
                        cs[mm][0] = *(const f32x4*)t; cs[mm][1] = *(const f32x4*)(t + 4); }
                    asm volatile("" : "+v"(cs[0][0]), "+v"(cs[0][1]), "+v"(cs[1][0]), "+v"(cs[1][1]));
                }
#pragma unroll
                for (int mm = 0; mm < 2; ++mm)
#pragma unroll
                    for (int bj = 0; bj < 2; ++bj) { const int m = 2 * mp + mm;
                        const int row = NMETA + u.pm * 256 + ai * 128 + wr * 64 + m * 16 + fr; const int col = u.pn * 256 + bj * 128 + wc * 32 + 8 * fq;
                        f32x4 v0 = acc[ai][bj][m][0], v1 = acc[ai][bj][m][1];
                        if (kind == 1 || kind == 3) rope8(v0, v1, cs[mm][0], cs[mm][1]);
                        if (kind == 2) { float q = (v0[0] * v0[0] + v0[1] * v0[1]) + (v0[2] * v0[2] + v0[3] * v0[3]) + (v1[0] * v1[0] + v1[1] * v1[1]) + (v1[2] * v1[2] + v1[3] * v1[3]);
                            q += __shfl_xor(q, 16); q += __shfl_xor(q, 32); if (fq == 0) SSQ[(size_t)row * 16 + (u.pn - 4) * 8 + bj * 4 + wc] = q; }
                        if (kind == 4 && bj == 0) { float* sm = SM + (size_t)row * 128 + (col - 2560); *(f32x4*)sm = v0; *(f32x4*)(sm + 4) = v1; }
                        *(v4u*)(P + (size_t)row * PW + col) = PACK8(v0, v1);
                    }
            }
    }
};
struct EpiKvUp { static constexpr bool HAS_MID = false;
    bf16* O; const float* R128; const float* SSQ;
    __device__ __forceinline__ void operator()(const AccT& acc, const Unit& u, int wr, int wc, int fr, int fq) const {
        const bool isk = u.pn < 4;
#pragma unroll
        for (int ai = 0; ai < 2; ++ai)
#pragma unroll
            for (int mp = 0; mp < 2; ++mp) {
                f32x4 cs[2][2], sq[2][4];
#pragma unroll
                for (int mm = 0; mm < 2; ++mm) { const int pos = NMETA + u.pm * 256 + ai * 128 + wr * 64 + (2 * mp + mm) * 16 + fr;
                    const f32x4* sp = (const f32x4*)(SSQ + (size_t)pos * 16); sq[mm][0] = sp[0]; sq[mm][1] = sp[1]; sq[mm][2] = sp[2]; sq[mm][3] = sp[3];
                    if (isk) { const float* t = R128 + ((size_t)pos * 64 + 16 * wc + 4 * fq) * 2; cs[mm][0] = *(const f32x4*)t; cs[mm][1] = *(const f32x4*)(t + 4); } }
                asm volatile("" : "+v"(sq[0][0]), "+v"(sq[0][1]), "+v"(sq[0][2]), "+v"(sq[0][3]), "+v"(sq[1][0]), "+v"(sq[1][1]), "+v"(sq[1][2]), "+v"(sq[1][3]));
                if (isk) asm volatile("" : "+v"(cs[0][0]), "+v"(cs[0][1]), "+v"(cs[1][0]), "+v"(cs[1][1]));
#pragma unroll
                for (int mm = 0; mm < 2; ++mm) { const int m = 2 * mp + mm;
                    const f32x4 s0 = sq[mm][0], s1 = sq[mm][1], s2 = sq[mm][2], s3 = sq[mm][3];
                    const float ss = (((s0[0] + s0[1]) + (s0[2] + s0[3])) + ((s1[0] + s1[1]) + (s1[2] + s1[3]))) + (((s2[0] + s2[1]) + (s2[2] + s2[3])) + ((s3[0] + s3[1]) + (s3[2] + s3[3])));
                    const float rstd = 1.f / sqrtf(ss * (1.f / 512.f) + EPS);
#pragma unroll
                    for (int bj = 0; bj < 2; ++bj) {
                        const int row = NMETA + u.pm * 256 + ai * 128 + wr * 64 + m * 16 + fr; const int col = u.pn * 256 + bj * 128 + wc * 32 + 8 * fq;
                        f32x4 v0 = acc[ai][bj][m][0] * rstd, v1 = acc[ai][bj][m][1] * rstd;
                        if (isk) rope8(v0, v1, cs[mm][0], cs[mm][1]);
                        *(v4u*)(O + (size_t)row * 2048 + col) = PACK8(v0, v1);
                    } }
            }
    }
};
template <int UNR>
__device__ __forceinline__ void gemm16(const bf16* A, int lda, const bf16* Bt, int ldb, int K, int lane, f32x4 (&out)[4]) {
    const int fr = lane & 15, fq = lane >> 4;
    const bf16* ap = A + (size_t)fr * lda + 8 * fq; const bf16* bp = Bt + (size_t)fr * ldb + 8 * fq;
#pragma unroll
    for (int t = 0; t < 4; ++t) out[t] = (f32x4){0.f, 0.f, 0.f, 0.f};
#pragma unroll UNR
    for (int k0 = 0; k0 < K; k0 += 32) {
        const bf16x8 av = *(const bf16x8*)(ap + k0);
#pragma unroll
        for (int t = 0; t < 4; ++t) { const bf16x8 bv = *(const bf16x8*)(bp + (size_t)(16 * t) * ldb + k0); out[t] = __builtin_amdgcn_mfma_f32_16x16x32_bf16(av, bv, out[t], 0, 0, 0); }
    }
}
struct EpiBf16Plain { static constexpr bool HAS_MID = false;
    bf16* O; int ldc;
    __device__ __forceinline__ void operator()(const AccT& acc, const Unit& u, int wr, int wc, int fr, int fq) const {
        EPI_FOREACH({ v4u w; w.x = pg8::cvt_pk_bf16(v0[0], v0[1]); w.y = pg8::cvt_pk_bf16(v0[2], v0[3]); w.z = pg8::cvt_pk_bf16(v1[0], v1[1]); w.w = pg8::cvt_pk_bf16(v1[2], v1[3]);
            *(v4u*)(O + (size_t)row * ldc + col) = w; })
    }
};
__device__ __forceinline__ float sigmoidf_(float x) { return 1.f / (1.f + __expf(-x)); }
#define EPI_ROWCOL(ai, m, bj) const int row = u.pm * 256 + (ai) * 128 + wr * 64 + (m) * 16 + fr; const int col = u.pn * 256 + (bj) * 128 + wc * 32 + 8 * fq
struct EpiBranchA { static constexpr bool HAS_MID = false;
    const bf16* P; float* M1;
    __device__ __forceinline__ void operator()(const AccT& acc, const Unit& u, int wr, int wc, int fr, int fq) const {
#pragma unroll
        for (int ai = 0; ai < 2; ++ai) {
            v4u gw[4][2];
#pragma unroll
            for (int m = 0; m < 4; ++m)
#pragma unroll
                for (int bj = 0; bj < 2; ++bj) { EPI_ROWCOL(ai, m, bj); gw[m][bj] = *(const v4u*)(P + (size_t)(row + NMETA) * PW + PC_GA + col); }
#pragma unroll
            for (int m = 0; m < 4; ++m) asm volatile("" : "+v"(gw[m][0]), "+v"(gw[m][1]));
#pragma unroll
            for (int m = 0; m < 4; ++m)
#pragma unroll
                for (int bj = 0; bj < 2; ++bj) { EPI_ROWCOL(ai, m, bj); const v4u g = gw[m][bj]; const f32x4 v0 = acc[ai][bj][m][0], v1 = acc[ai][bj][m][1];
                    f32x4 o0, o1;
                    o0[0] = sigmoidf_(bflo(g.x)) * v0[0]; o0[1] = sigmoidf_(bfhi(g.x)) * v0[1]; o0[2] = sigmoidf_(bflo(g.y)) * v0[2]; o0[3] = sigmoidf_(bfhi(g.y)) * v0[3];
                    o1[0] = sigmoidf_(bflo(g.z)) * v1[0]; o1[1] = sigmoidf_(bfhi(g.z)) * v1[1]; o1[2] = sigmoidf_(bflo(g.w)) * v1[2]; o1[3] = sigmoidf_(bfhi(g.w)) * v1[3];
                    float* d = M1 + (size_t)row * 2048 + col; *(f32x4*)d = o0; *(f32x4*)(d + 4) = o1; }
        }
    }
};
struct EpiBranchB { static constexpr bool HAS_MID = false;
    const bf16* P; const float* M1; bf16* MG;
    __device__ __forceinline__ void operator()(const AccT& acc, const Unit& u, int wr, int wc, int fr, int fq) const {
#pragma unroll
        for (int ai = 0; ai < 2; ++ai)
#pragma unroll
            for (int mp = 0; mp < 2; ++mp) {
                v4u gw[2][2]; f32x4 a0[2][2], a1[2][2];
#pragma unroll
                for (int mm = 0; mm < 2; ++mm)
#pragma unroll
                    for (int bj = 0; bj < 2; ++bj) { EPI_ROWCOL(ai, 2 * mp + mm, bj); gw[mm][bj] = *(const v4u*)(P + (size_t)(row + NMETA) * PW + PC_GB + col);
                        const float* d = M1 + (size_t)row * 2048 + col; a0[mm][bj] = *(const f32x4*)d; a1[mm][bj] = *(const f32x4*)(d + 4); }
#pragma unroll
                for (int mm = 0; mm < 2; ++mm) asm volatile("" : "+v"(gw[mm][0]), "+v"(gw[mm][1]), "+v"(a0[mm][0]), "+v"(a0[mm][1]), "+v"(a1[mm][0]), "+v"(a1[mm][1]));
#pragma unroll
                for (int mm = 0; mm < 2; ++mm)
#pragma unroll
                    for (int bj = 0; bj < 2; ++bj) { EPI_ROWCOL(ai, 2 * mp + mm, bj); const v4u g = gw[mm][bj]; const f32x4 v0 = acc[ai][bj][2 * mp + mm][0], v1 = acc[ai][bj][2 * mp + mm][1];
                        const f32x4 b0 = a0[mm][bj], b1 = a1[mm][bj]; f32x4 o0, o1;
                        o0[0] = b0[0] + sigmoidf_(bflo(g.x)) * v0[0]; o0[1] = b0[1] + sigmoidf_(bfhi(g.x)) * v0[1]; o0[2] = b0[2] + sigmoidf_(bflo(g.y)) * v0[2]; o0[3] = b0[3] + sigmoidf_(bfhi(g.y)) * v0[3];
                        o1[0] = b1[0] + sigmoidf_(bflo(g.z)) * v1[0]; o1[1] = b1[1] + sigmoidf_(bfhi(g.z)) * v1[1]; o1[2] = b1[2] + sigmoidf_(bflo(g.w)) * v1[2]; o1[3] = b1[3] + sigmoidf_(bfhi(g.w)) * v1[3];
                        v4u w; w.x = pg8::cvt_pk_bf16(o0[0], o0[1]); w.y = pg8::cvt_pk_bf16(o0[2], o0[3]); w.z = pg8::cvt_pk_bf16(o1[0], o1[1]); w.w = pg8::cvt_pk_bf16(o1[2], o1[3]);
                        *(v4u*)(MG + (size_t)row * 2048 + col) = w; }
            }
    }
};
__device__ __forceinline__ float sig_ratio(float ga, float gbc) { return (1.f + __expf(-gbc)) / (1.f + __expf(-ga)); }
struct EpiBranchFused { static constexpr bool HAS_MID = true;
    const bf16* P; bf16* MG;
    __device__ __forceinline__ void mid(AccT& acc, const Unit& u, int wr, int wc, int fr_in, int fq) const {
        int fr = fr_in; asm volatile("" : "+v"(fr));
#pragma unroll
        for (int ai = 0; ai < 2; ++ai)
#pragma unroll
            for (int mp = 0; mp < 2; ++mp) {
                v4u ga[2][2], gb[2][2];
#pragma unroll
                for (int mm = 0; mm < 2; ++mm)
#pragma unroll
                    for (int bj = 0; bj < 2; ++bj) { EPI_ROWCOL(ai, 2 * mp + mm, bj); const bf16* gp = P + (size_t)(row + NMETA) * PW + col; ga[mm][bj] = *(const v4u*)(gp + PC_GA); gb[mm][bj] = *(const v4u*)(gp + PC_GB); }
#pragma unroll
                for (int mm = 0; mm < 2; ++mm) asm volatile("" : "+v"(ga[mm][0]), "+v"(ga[mm][1]), "+v"(gb[mm][0]), "+v"(gb[mm][1]));
#pragma unroll
                for (int mm = 0; mm < 2; ++mm)
#pragma unroll
                    for (int bj = 0; bj < 2; ++bj) { const int m = 2 * mp + mm; const v4u a = ga[mm][bj], b = gb[mm][bj];
                        acc[ai][bj][m][0][0] *= sig_ratio(bflo(a.x), fmaxf(bflo(b.x), -80.f)); acc[ai][bj][m][0][1] *= sig_ratio(bfhi(a.x), fmaxf(bfhi(b.x), -80.f));
                        acc[ai][bj][m][0][2] *= sig_ratio(bflo(a.y), fmaxf(bflo(b.y), -80.f)); acc[ai][bj][m][0][3] *= sig_ratio(bfhi(a.y), fmaxf(bfhi(b.y), -80.f));
                        acc[ai][bj][m][1][0] *= sig_ratio(bflo(a.z), fmaxf(bflo(b.z), -80.f)); acc[ai][bj][m][1][1] *= sig_ratio(bfhi(a.z), fmaxf(bfhi(b.z), -80.f));
                        acc[ai][bj][m][1][2] *= sig_ratio(bflo(a.w), fmaxf(bflo(b.w), -80.f)); acc[ai][bj][m][1][3] *= sig_ratio(bfhi(a.w), fmaxf(bfhi(b.w), -80.f)); }
            }
    }
    __device__ __forceinline__ void operator()(const AccT& acc, const Unit& u, int wr, int wc, int fr, int fq) const {
#pragma unroll
        for (int ai = 0; ai < 2; ++ai) {
            v4u gb[4][2];
#pragma unroll
            for (int m = 0; m < 4; ++m)
#pragma unroll
                for (int bj = 0; bj < 2; ++bj) { EPI_ROWCOL(ai, m, bj); gb[m][bj] = *(const v4u*)(P + (size_t)(row + NMETA) * PW + PC_GB + col); }
#pragma unroll
            for (int m = 0; m < 4; ++m) asm volatile("" : "+v"(gb[m][0]), "+v"(gb[m][1]));
#pragma unroll
            for (int m = 0; m < 4; ++m)
#pragma unroll
                for (int bj = 0; bj < 2; ++bj) { EPI_ROWCOL(ai, m, bj); const v4u g = gb[m][bj]; const f32x4 v0 = acc[ai][bj][m][0], v1 = acc[ai][bj][m][1]; f32x4 o0, o1;
                    o0[0] = sigmoidf_(fmaxf(bflo(g.x), -80.f)) * v0[0]; o0[1] = sigmoidf_(fmaxf(bfhi(g.x), -80.f)) * v0[1]; o0[2] = sigmoidf_(fmaxf(bflo(g.y), -80.f)) * v0[2]; o0[3] = sigmoidf_(fmaxf(bfhi(g.y), -80.f)) * v0[3];
                    o1[0] = sigmoidf_(fmaxf(bflo(g.z), -80.f)) * v1[0]; o1[1] = sigmoidf_(fmaxf(bfhi(g.z), -80.f)) * v1[1]; o1[2] = sigmoidf_(fmaxf(bflo(g.w), -80.f)) * v1[2]; o1[3] = sigmoidf_(fmaxf(bfhi(g.w), -80.f)) * v1[3];
                    *(v4u*)(MG + (size_t)row * 2048 + col) = PACK8(o0, o1); }
        }
    }
};
struct EpiOut { static constexpr bool HAS_MID = false;
    const float* X; bf16* H2; float* SQ;
    __device__ __forceinline__ void operator()(const AccT& acc, const Unit& u, int wr, int wc, int fr, int fq) const {
#pragma unroll
        for (int ai = 0; ai < 2; ++ai)
#pragma unroll
            for (int mp = 0; mp < 2; ++mp) {
                f32x4 a0[2][2], a1[2][2];
#pragma unroll
                for (int mm = 0; mm < 2; ++mm)
#pragma unroll
                    for (int bj = 0; bj < 2; ++bj) { EPI_ROWCOL(ai, 2 * mp + mm, bj); const float* xs = X + (size_t)row * 2048 + col; a0[mm][bj] = *(const f32x4*)xs; a1[mm][bj] = *(const f32x4*)(xs + 4); }
#pragma unroll
                for (int mm = 0; mm < 2; ++mm) asm volatile("" : "+v"(a0[mm][0]), "+v"(a0[mm][1]), "+v"(a1[mm][0]), "+v"(a1[mm][1]));
#pragma unroll
                for (int mm = 0; mm < 2; ++mm)
#pragma unroll
                    for (int bj = 0; bj < 2; ++bj) { EPI_ROWCOL(ai, 2 * mp + mm, bj); bf16* d = H2 + (size_t)row * 2048 + col;
                        const f32x4 h0 = a0[mm][bj] + acc[ai][bj][2 * mp + mm][0], h1 = a1[mm][bj] + acc[ai][bj][2 * mp + mm][1];
                        *(v4u*)d = PACK8(h0, h1);
                        float q = ((h0[0] * h0[0] + h0[1] * h0[1]) + (h0[2] * h0[2] + h0[3] * h0[3])) + ((h1[0] * h1[0] + h1[1] * h1[1]) + (h1[2] * h1[2] + h1[3] * h1[3]));
                        q += __shfl_xor(q, 16); q += __shfl_xor(q, 32); if (fq == 0) SQ[(size_t)row * 64 + u.pn * 8 + bj * 4 + wc] = q; }
            }
    }
};
struct EpiGateUp { static constexpr bool HAS_MID = false;
    bf16* ACT; const float* ROWW; const float* ROWR;
    __device__ __forceinline__ void operator()(const AccT& acc, const Unit& u, int wr, int wc, int fr, int fq) const {
        float rwv[2][4], rrv[2][4];
#pragma unroll
        for (int ai = 0; ai < 2; ++ai)
#pragma unroll
            for (int m = 0; m < 4; ++m) { rwv[ai][m] = ROWW[u.rb + ai * 128 + wr * 64 + m * 16 + fr]; rrv[ai][m] = ROWR[u.rb + ai * 128 + wr * 64 + m * 16 + fr]; }
        asm volatile("" : "+v"(rwv[0][0]), "+v"(rwv[0][1]), "+v"(rwv[0][2]), "+v"(rwv[0][3]), "+v"(rwv[1][0]), "+v"(rwv[1][1]), "+v"(rwv[1][2]), "+v"(rwv[1][3]));
        asm volatile("" : "+v"(rrv[0][0]), "+v"(rrv[0][1]), "+v"(rrv[0][2]), "+v"(rrv[0][3]), "+v"(rrv[1][0]), "+v"(rrv[1][1]), "+v"(rrv[1][2]), "+v"(rrv[1][3]));
#pragma unroll
        for (int ai = 0; ai < 2; ++ai)
#pragma unroll
            for (int m = 0; m < 4; ++m) {
                const int row = u.pm * 256 + ai * 128 + wr * 64 + m * 16 + fr; const int col = u.pn * 128 + wc * 32 + 8 * fq;
                const float rw = rwv[ai][m], rr = rrv[ai][m];
                float o[8];
#pragma unroll
                for (int n = 0; n < 2; ++n)
#pragma unroll
                    for (int j = 0; j < 4; ++j) { const float gv = acc[ai][0][m][n][j] * rr, uv = acc[ai][1][m][n][j] * rr; o[n * 4 + j] = gv * sigmoidf_(gv) * uv * rw; }
                v4u w; w.x = pg8::cvt_pk_bf16(o[0], o[1]); w.y = pg8::cvt_pk_bf16(o[2], o[3]); w.z = pg8::cvt_pk_bf16(o[4], o[5]); w.w = pg8::cvt_pk_bf16(o[6], o[7]);
                *(v4u*)(ACT + (size_t)row * 512 + col) = w;
            }
    }
};
struct EpiDown { static constexpr bool HAS_MID = false;
    bf16* Y; const int* ROWTOK;
    __device__ __forceinline__ void operator()(const AccT& acc, const Unit& u, int wr, int wc, int fr, int fq) const {
        int rtv[2][4];
#pragma unroll
        for (int ai = 0; ai < 2; ++ai)
#pragma unroll
            for (int m = 0; m < 4; ++m) rtv[ai][m] = ROWTOK[u.rb + ai * 128 + wr * 64 + m * 16 + fr];
        asm volatile("" : "+v"(rtv[0][0]), "+v"(rtv[0][1]), "+v"(rtv[0][2]), "+v"(rtv[0][3]), "+v"(rtv[1][0]), "+v"(rtv[1][1]), "+v"(rtv[1][2]), "+v"(rtv[1][3]));
#pragma unroll
        for (int ai = 0; ai < 2; ++ai)
#pragma unroll
            for (int m = 0; m < 4; ++m) {
                const int rt = rtv[ai][m];
                if (rt >= 0) { bf16* d = Y + ((size_t)(rt & 1) * SEQ + (rt >> 1)) * 2048 + u.pn * 256 + wc * 32 + 8 * fq;
#pragma unroll
                    for (int bj = 0; bj < 2; ++bj) { const f32x4 v0 = acc[ai][bj][m][0], v1 = acc[ai][bj][m][1];
                        v4u w; w.x = pg8::cvt_pk_bf16(v0[0], v0[1]); w.y = pg8::cvt_pk_bf16(v0[2], v0[3]); w.z = pg8::cvt_pk_bf16(v1[0], v1[1]); w.w = pg8::cvt_pk_bf16(v1[2], v1[3]);
                        *(v4u*)(d + bj * 128) = w; } }
            }
    }
};

__device__ __forceinline__ size_t s_row_off(int qr) { const int b = qr >> 8; const size_t pitch = 320 + 256 * b; return (size_t)256 * (320 * (size_t)b + 128 * (size_t)b * (b - 1)) + (size_t)(qr & 255) * pitch; }
__device__ __forceinline__ unsigned f2key(float f) { const unsigned u = __builtin_bit_cast(unsigned, f); return u ^ ((u >> 31) ? 0xFFFFFFFFu : 0x80000000u); }

constexpr int PC_I_IN = 32 * (PW / 32), PC_I_KV = 8 * 64, PC_I_A = 16 * 64, PC_I_O = 32 * 64, PC_NITEMS = PC_I_IN + PC_I_KV + 2 * PC_I_A + PC_I_O;
__device__ __forceinline__ void copy_items(const Args& a, LAS unsigned char* lds, int it_lo, int it_hi, int gw, int NGW, int wave, int lane) {
    unsigned char* ws = a.ws;
    LAS float* scr = (LAS float*)(lds + RING_OFF + wave * 16384);
    constexpr int I_IN = PC_I_IN, I_KV = PC_I_KV, I_A = PC_I_A;
    auto item = [&](int it, const float*& src, size_t& ldsrc, bf16*& dst, int& ldwt, int& k0, int& n0, const float*& rsc) {
        int r = it; rsc = nullptr;
        if (r < I_IN) { const int nblk = PW / 32, kb = r / nblk, nb = r % nblk; const int sc = win_src(nb * 32 + (lane & 31));
            src = sc >= 0 ? a.in[I_WIN] + sc : nullptr; ldsrc = INW; dst = (bf16*)(ws + WS_WINT); ldwt = 2048; k0 = 64 * kb; n0 = 32 * nb; return; } r -= I_IN;
        if (r < I_KV) { const int kb = r / 64, nb = r % 64; const int n = nb * 32 + (lane & 31); const int sc = n < 1024 ? (n & ~127) + rope_dim(n & 127, 64) : n;
            src = a.in[I_WKVUP] + sc; ldsrc = 2048; dst = (bf16*)(ws + WS_WKVT); ldwt = 512; k0 = 64 * kb; n0 = 32 * nb; rsc = a.in[I_GKV]; return; } r -= I_KV;
        if (r < I_A) { const int kb = r / 64, nb = r % 64; src = a.in[I_WBA] + nb * 32 + (lane & 31); ldsrc = 2048; dst = (bf16*)(ws + WS_WAT); ldwt = 2048; k0 = 64 * kb; n0 = 32 * nb; return; } r -= I_A;
        if (r < I_A) { const int kb = r / 64, nb = r % 64; src = a.in[I_WBB] + nb * 32 + (lane & 31); ldsrc = 2048; dst = (bf16*)(ws + WS_WAT) + 1024; ldwt = 2048; k0 = 64 * kb; n0 = 32 * nb; return; } r -= I_A;
        { const int kb = r / 64, nb = r % 64; src = a.in[I_WOUT] + nb * 32 + (lane & 31); ldsrc = 2048; dst = (bf16*)(ws + WS_WOT); ldwt = 2048; k0 = 64 * kb; n0 = 32 * nb; }
    };
#pragma unroll 1
    for (int it = it_lo + gw; it < it_hi; it += 2 * NGW) {
        const float* s0; size_t l0; bf16* d0; int w0, k0, n0; const float* r0; item(it, s0, l0, d0, w0, k0, n0, r0);
        const bool two = it + NGW < it_hi;
        const float* s1; size_t l1; bf16* d1; int w1, k1, n1; const float* r1; item(two ? it + NGW : it, s1, l1, d1, w1, k1, n1, r1);
        float va[32], vb[32];
        tr_load(va, s0, l0, k0, lane); tr_load(vb, s1, l1, k1, lane);
        tr_fence(va); tr_fence(vb);
        tr_store(va, d0, w0, k0, n0, scr, lane, r0);
        if (two) tr_store(vb, d1, w1, k1, n1, scr, lane, r1);
    }
}
__device__ __forceinline__ void phase_prologue(const Args& a, LAS unsigned char* lds, int gw, int NGW, int wave, int lane, int it_hi) {
    unsigned char* ws = a.ws;
    copy_items(a, lds, 0, it_hi, gw, NGW, wave, lane);
    const f32x4* gm = (const f32x4*)a.in[I_GMIX];
    for (int p = gw; p < LP; p += NGW) {
        bf16* orow = (bf16*)(ws + WS_HN) + (size_t)p * 2048;
        if (p >= LTOK) { for (int j = 0; j < 8; ++j) *(v2u*)(orow + 4 * (lane + 64 * j)) = (v2u){0u, 0u}; continue; }
        const float* xrow = p < NMETA ? a.in[I_META] + (size_t)p * 2048 : a.in[I_X] + (size_t)(p - NMETA) * 2048;
        f32x4 v[8]; float s = 0.f;
#pragma unroll
        for (int j = 0; j < 8; ++j) { v[j] = ((const f32x4*)xrow)[lane + 64 * j]; s += (v[j][0] * v[j][0] + v[j][1] * v[j][1]) + (v[j][2] * v[j][2] + v[j][3] * v[j][3]); }
        const float rstd = 1.f / sqrtf(wave_sum(s) * (1.f / 2048.f) + EPS);
#pragma unroll
        for (int j = 0; j < 8; ++j) { const f32x4 g = gm[lane + 64 * j]; v2u o; o.x = pk2(v[j][0] * rstd * g[0], v[j][1] * rstd * g[1]); o.y = pk2(v[j][2] * rstd * g[2], v[j][3] * rstd * g[3]);
            *(v2u*)(orow + 4 * (lane + 64 * j)) = o; }
    }
    const int gt = gw * 64 + lane, NGT = NGW * 64;
    for (int i = gt; i < LTOK * 64; i += NGT) { const int p = i >> 6, f = i & 63; const double inv = exp(-9.210340371976184 * (double)f / 64.0); const double ang = (double)p * inv;
        double sn, cs; sincos(ang, &sn, &cs); ((f32x2*)(ws + WS_ROPE128))[i] = (f32x2){(float)cs, (float)sn}; }
    for (int i = gt; i < LTOK * 32; i += NGT) { const int p = i >> 5, f = i & 31; const double inv = exp(-9.210340371976184 * (double)f / 32.0); const double ang = (double)p * inv;
        double sn, cs; sincos(ang, &sn, &cs); ((f32x2*)(ws + WS_ROPE64))[i] = (f32x2){(float)cs, (float)sn}; }
}

__device__ __forceinline__ void phase_minipost(const Args& a, volatile LAS unsigned* lmax  , int gw, int NGW, int lane) {
    unsigned char* ws = a.ws;
    const float* SM = (const float*)(ws + WS_SMALL); const f32x2* R64 = (const f32x2*)(ws + WS_ROPE64);
    if (threadIdx.x < 8) lmax[threadIdx.x] = 0u;
    __syncthreads();
    float kmx = 0.f;
    for (int p = gw; p < LP; p += NGW) {
        if (p < LTOK) { const v4u* kr = (const v4u*)((const bf16*)(ws + WS_PROJ) + (size_t)p * PW + PC_KB + 16 * lane); const v4u k0 = kr[0], k1 = kr[1];
            float q = bflo(k0.x) * bflo(k0.x) + bfhi(k0.x) * bfhi(k0.x) + bflo(k0.y) * bflo(k0.y) + bfhi(k0.y) * bfhi(k0.y) + bflo(k0.z) * bflo(k0.z) + bfhi(k0.z) * bfhi(k0.z) + bflo(k0.w) * bflo(k0.w) + bfhi(k0.w) * bfhi(k0.w)
                    + bflo(k1.x) * bflo(k1.x) + bfhi(k1.x) * bfhi(k1.x) + bflo(k1.y) * bflo(k1.y) + bfhi(k1.y) * bfhi(k1.y) + bflo(k1.z) * bflo(k1.z) + bfhi(k1.z) * bfhi(k1.z) + bflo(k1.w) * bflo(k1.w) + bfhi(k1.w) * bfhi(k1.w);
            q += __shfl_xor(q, 1); q += __shfl_xor(q, 2); q += __shfl_xor(q, 4); kmx = fmaxf(kmx, q); }
        bf16* ki = (bf16*)(ws + WS_KI) + (size_t)p * 64;
        if (p >= LTOK) { if (lane < 8) *(v4u*)(ki + 8 * lane) = (v4u){0u, 0u, 0u, 0u};
            if (lane < 16) ((float*)(ws + WS_WI))[(size_t)p * 16 + lane] = 0.f; if (lane < 8) ((float*)(ws + WS_LOGF))[(size_t)lane * LP + p] = 0.f;
            if (p < LTOK + 64) { v4u* kv = (v4u*)((bf16*)(ws + WS_PROJ) + (size_t)p * PW + PC_KB); v4u* ka = (v4u*)((bf16*)(ws + WS_KVA) + (size_t)p * 2048);
#pragma unroll
                for (int j = 0; j < 4; ++j) { kv[lane + 64 * j] = (v4u){0u, 0u, 0u, 0u}; ka[lane + 64 * j] = (v4u){0u, 0u, 0u, 0u}; } }
            continue; }
        { const float v = SM[(size_t)p * 128 + lane]; const float rstd = 1.f / sqrtf(wave_sum(v * v) * (1.f / 64.f) + EPS);
          const float n = v * rstd * a.in[I_GIDXK][lane]; const float pr = __shfl_xor(n, 32); const f32x2 c2 = R64[(size_t)p * 32 + (lane & 31)];
          const float y = lane < 32 ? n * c2[0] - pr * c2[1] : n * c2[0] + pr * c2[1];
          ki[lane < 32 ? 2 * lane : 2 * (lane - 32) + 1] = (bf16)f2bf(y); }
        if (lane < 16) ((float*)(ws + WS_WI))[(size_t)p * 16 + lane] = SM[(size_t)p * 128 + 64 + lane] * (0.25f * 0.125f);
        if (lane < 8) { const float z = SM[(size_t)p * 128 + 80 + lane] + a.in[I_BF][lane]; ((float*)(ws + WS_LOGF))[(size_t)lane * LP + p] = fminf(z, 0.f) - log1pf(expf(-fabsf(z))); }
    }
    if ((lane & 7) == 0) __hip_atomic_fetch_max((LAS unsigned*)lmax + (lane >> 3), __float_as_uint(kmx), __ATOMIC_RELAXED, __HIP_MEMORY_SCOPE_WORKGROUP);
    __syncthreads();
    if (threadIdx.x < 8) __hip_atomic_fetch_max((unsigned*)(ws + WS_CTL) + CW_KMAX + threadIdx.x, lmax[threadIdx.x], RLX_AGENT);
}
__device__ __forceinline__ void meta_inproj(const Args& a, int mw, int NGW, int lane) {
    unsigned char* ws = a.ws; const int fr = lane & 15, fq = lane >> 4;
    bf16* PROJ = (bf16*)(ws + WS_PROJ); float* SM = (float*)(ws + WS_SMALL); float* SSQ = (float*)(ws + WS_SSQ);
    for (int it = mw; it < 42; it += NGW) {
        const int n0 = it < 8 ? PC_CKV + 64 * it : (it < 10 ? PC_KI + 64 * (it - 8) : PC_KB + 64 * (it - 10));
        f32x4 o[4]; gemm16<8>((const bf16*)(ws + WS_HN), 2048, (const bf16*)(ws + WS_WINT) + (size_t)n0 * 2048, 2048, 2048, lane, o);
#pragma unroll
        for (int r = 0; r < 4; ++r) { const int m = 4 * fq + r; float q = 0.f;
#pragma unroll
            for (int t = 0; t < 4; ++t) { const int n = n0 + 16 * t + fr; const float v = o[t][r]; PROJ[(size_t)m * PW + n] = (bf16)f2bf(v); q += v * v;
                if (it >= 8 && it < 10) SM[(size_t)m * 128 + (n - PC_KI)] = v; }
            if (it < 8) { q += __shfl_xor(q, 1); q += __shfl_xor(q, 2); q += __shfl_xor(q, 4); q += __shfl_xor(q, 8); if (fr == 0) { SSQ[(size_t)m * 16 + 2 * it] = q; SSQ[(size_t)m * 16 + 2 * it + 1] = 0.f; } } }
    }
}
__device__ __forceinline__ void meta_kvup(const Args& a, int gw, int NGW, int lane) {
    unsigned char* ws = a.ws; const int fr = lane & 15, fq = lane >> 4;
    const float* SSQ = (const float*)(ws + WS_SSQ); const f32x2* R128 = (const f32x2*)(ws + WS_ROPE128); bf16* KVA = (bf16*)(ws + WS_KVA);
    for (int it = gw; it < 32; it += NGW) {
        const int n0 = 64 * it;
        f32x4 o[4]; gemm16<16>((const bf16*)(ws + WS_PROJ) + PC_CKV, PW, (const bf16*)(ws + WS_WKVT) + (size_t)n0 * 512, 512, 512, lane, o);
#pragma unroll
        for (int r = 0; r < 4; ++r) { const int m = 4 * fq + r; float sq = 0.f;
#pragma unroll
            for (int i = 0; i < 16; ++i) sq += SSQ[(size_t)m * 16 + i];
            const float rstd = 1.f / sqrtf(sq * (1.f / 512.f) + EPS);
#pragma unroll
            for (int t = 0; t < 4; ++t) { const int n = n0 + 16 * t + fr; float v = o[t][r] * rstd;
                if (n0 < 1024) { const float pr = __shfl_xor(v, 1); const int cl = n & 127; const f32x2 cs = R128[(size_t)m * 64 + (cl >> 1)]; v = (cl & 1) ? v * cs[0] + pr * cs[1] : v * cs[0] - pr * cs[1]; }
                KVA[(size_t)m * 2048 + n] = (bf16)f2bf(v); } }
    }
}
__device__ __forceinline__ void phase_cumsum(const Args& a, int wave, int lane) {
    unsigned char* ws = a.ws;
    const f32x4* LF = (const f32x4*)((const float*)(ws + WS_LOGF) + (size_t)wave * LP) + lane * 33;
    f32x4* CT = (f32x4*)((float*)(ws + WS_CCT) + (size_t)wave * LP) + lane * 33;
    f32x4 v[33]; float s = 0.f;
#pragma unroll
    for (int i = 0; i < 33; ++i) { v[i] = LF[i]; }
#pragma unroll
    for (int i = 0; i < 33; ++i) { s += (v[i][0] + v[i][1]) + (v[i][2] + v[i][3]); }
    float inc = s;
#pragma unroll
    for (int o = 1; o < 64; o <<= 1) { const float t = __shfl_up(inc, o); if (lane >= o) inc += t; }
    float run = inc - s;
#pragma unroll
    for (int i = 0; i < 33; ++i) { f32x4 o; run += v[i][0]; o[0] = run; run += v[i][1]; o[1] = run; run += v[i][2]; o[2] = run; run += v[i][3]; o[3] = run; CT[i] = o; }
}

__device__ __forceinline__ void phase_indexer(const Args& a, LAS unsigned char* lds, int gw, int NGW, int wave, int lane) {
    unsigned char* ws = a.ws;
    const bf16* PROJ = (const bf16*)(ws + WS_PROJ); const bf16* KI = (const bf16*)(ws + WS_KI); const float* WI = (const float*)(ws + WS_WI); float* S = (float*)(ws + WS_S);
    LAS float* qs = (LAS float*)(lds + wave * 8192);
    for (int qr = gw; qr < SEQ; qr += NGW) {
        const int pos = qr + NMETA;
        { const bf16* qrow = PROJ + (size_t)pos * PW + PC_QI + 16 * lane; const v4u w0 = *(const v4u*)qrow, w1 = *(const v4u*)(qrow + 8);
          LAS float* d = qs + 16 * lane;
          d[0] = bflo(w0.x); d[1] = bfhi(w0.x); d[2] = bflo(w0.y); d[3] = bfhi(w0.y); d[4] = bflo(w0.z); d[5] = bfhi(w0.z); d[6] = bflo(w0.w); d[7] = bfhi(w0.w);
          d[8] = bflo(w1.x); d[9] = bfhi(w1.x); d[10] = bflo(w1.y); d[11] = bfhi(w1.y); d[12] = bflo(w1.z); d[13] = bfhi(w1.z); d[14] = bflo(w1.w); d[15] = bfhi(w1.w);
          if (lane < 16) qs[1024 + lane] = WI[(size_t)pos * 16 + lane]; }
        LDS_WAIT(); asm volatile("" ::: "memory");
        float* Srow = S + s_row_off(qr);
        const int ntile = pos / 64 + 1;
        for (int j = 0; j < ntile; ++j) {
            const int key = j * 64 + lane;
            float kf[64];
            { const v4u* kp = (const v4u*)(KI + (size_t)key * 64);
#pragma unroll
              for (int c = 0; c < 8; ++c) { const v4u w = kp[c]; kf[8 * c] = bflo(w.x); kf[8 * c + 1] = bfhi(w.x); kf[8 * c + 2] = bflo(w.y); kf[8 * c + 3] = bfhi(w.y);
                  kf[8 * c + 4] = bflo(w.z); kf[8 * c + 5] = bfhi(w.z); kf[8 * c + 6] = bflo(w.w); kf[8 * c + 7] = bfhi(w.w); } }
            float score = 0.f;
#pragma unroll 1
            for (int h = 0; h < 16; ++h) { float d = 0.f;
#pragma unroll
                for (int c = 0; c < 16; ++c) { const f32x4 q = *(const LAS f32x4*)(qs + h * 64 + 4 * c); d += q[0] * kf[4 * c] + q[1] * kf[4 * c + 1] + q[2] * kf[4 * c + 2] + q[3] * kf[4 * c + 3]; }
                score += qs[1024 + h] * fmaxf(d, 0.f); }
            if (key <= pos) Srow[key] = score;
        }
        LDS_WAIT(); asm volatile("" ::: "memory");
    }
}


__device__ __forceinline__ void phase_indexer_mfma(const Args& a, LAS unsigned char* lds, int vcu, int G) {
    typedef float f32x16 __attribute__((ext_vector_type(16)));
    unsigned char* ws = a.ws;
    const bf16* PROJ = (const bf16*)(ws + WS_PROJ); const bf16* KI = (const bf16*)(ws + WS_KI); const float* WI = (const float*)(ws + WS_WI); float* S = (float*)(ws + WS_S);
    const int tid = threadIdx.x, wid = __builtin_amdgcn_readfirstlane(tid >> 6), lane = tid & 63, r32 = lane & 31, hi = lane >> 5;
    const int keyrow = 16 * ((r32 >> 2) & 1) + 4 * (r32 >> 3) + (r32 & 3);
    for (int sub = 0; sub < 2; ++sub)
    for (int it = vcu; it < 256; it += G) {
        const int qt = sub == 0 ? it : 255 - it;
        const int q0 = qt * 32, pos0 = q0 + NMETA, nkt = (pos0 + 31) / 32 + 1;
        const int klo = sub == 0 ? 0 : nkt / 2, khi = sub == 0 ? nkt / 2 : nkt;
        __syncthreads();
#pragma unroll
        for (int i = 0; i < 8; ++i) { const int c = tid + 512 * i, row = c >> 7, ch = c & 127;
            const v4u v = *(const v4u*)(PROJ + (size_t)(pos0 + row) * PW + PC_QI + ch * 8);
            *(LAS v4u*)(lds + (ch >> 1) * 1024 + (row + 32 * (ch & 1)) * 16) = v; }
        float w[16];
        { const f32x4* wp = (const f32x4*)(WI + (size_t)(pos0 + r32) * 16);
#pragma unroll
          for (int i = 0; i < 4; ++i) { const f32x4 t = wp[i]; w[4 * i] = t[0]; w[4 * i + 1] = t[1]; w[4 * i + 2] = t[2]; w[4 * i + 3] = t[3]; } }
        __syncthreads();
        float* Srow = S + s_row_off(q0 + r32) + 16 * hi;
        bf16x8 afn[4];
        { const int kt0 = klo + wid < khi ? klo + wid : 0;
#pragma unroll
          for (int ks = 0; ks < 4; ++ks) afn[ks] = *(const bf16x8*)(KI + (size_t)(kt0 * 32 + keyrow) * 64 + ks * 16 + 8 * hi); }
        for (int kt = klo + wid; kt < khi; kt += 8) {
            const int kb = kt * 32;
            bf16x8 af[4];
#pragma unroll
            for (int ks = 0; ks < 4; ++ks) af[ks] = afn[ks];
            { const int ktn = kt + 8 < khi ? kt + 8 : kt;
#pragma unroll
              for (int ks = 0; ks < 4; ++ks) afn[ks] = *(const bf16x8*)(KI + (size_t)(ktn * 32 + keyrow) * 64 + ks * 16 + 8 * hi); }
            f32x16 acc = {};
            bf16x8 bq[2][4]; f32x16 d[2];
            unsigned qoff = lane * 16; asm volatile("" : "+v"(qoff));
            const LAS unsigned char* qk = lds + qoff;
#pragma unroll
            for (int ks = 0; ks < 4; ++ks) bq[0][ks] = *(const LAS bf16x8*)(qk + ks * 1024);
#pragma unroll
            for (int h = 0; h < 17; ++h) {
                __builtin_amdgcn_sched_barrier(0);
                if (h < 16) { d[h & 1] = f32x16{};
#pragma unroll
                    for (int ks = 0; ks < 4; ++ks) d[h & 1] = __builtin_amdgcn_mfma_f32_32x32x16_bf16(af[ks], bq[h & 1][ks], d[h & 1], 0, 0, 0); }
                if (h < 15) {
#pragma unroll
                    for (int ks = 0; ks < 4; ++ks) bq[(h + 1) & 1][ks] = *(const LAS bf16x8*)(qk + ((h + 1) * 4 + ks) * 1024); }
                if (h > 0) {
#pragma unroll
                    for (int r = 0; r < 16; ++r) { const float dv = d[(h - 1) & 1][r]; const int xi = __float_as_int(dv); const float rl = __int_as_float(xi > 0 ? xi : 0);
                        float ar = acc[r]; asm("v_fmac_f32 %0, %1, %2" : "+v"(ar) : "v"(rl), "v"(w[h - 1])); acc[r] = ar; } }
            }
            __builtin_amdgcn_sched_barrier(0);
#pragma unroll
            for (int g = 0; g < 4; ++g) { const float x0 = acc[4 * g], x1 = acc[4 * g + 1], x2 = acc[4 * g + 2], x3 = acc[4 * g + 3]; *(v4u*)(Srow + kb + 4 * g) = (v4u){f2key(x0), f2key(x1), f2key(x2), f2key(x3)}; }
        }
    }
}

__device__ __forceinline__ int wave_incl_scan(int x) {
    x += __builtin_amdgcn_update_dpp(0, x, 0x111, 0xf, 0xf, false);
    x += __builtin_amdgcn_update_dpp(0, x, 0x112, 0xf, 0xf, false);
    x += __builtin_amdgcn_update_dpp(0, x, 0x114, 0xf, 0xf, false);
    x += __builtin_amdgcn_update_dpp(0, x, 0x118, 0xf, 0xf, false);
    x += __builtin_amdgcn_update_dpp(0, x, 0x142, 0xa, 0xf, false);
    x += __builtin_amdgcn_update_dpp(0, x, 0x143, 0xc, 0xf, false);
    return x;
}
#define SEL_CNT6(OP, c0, c1, c2, k0, k1, k2, k3, k4, k5, cand) do { unsigned long long m1_, m2_, m3_, m4_, m5_; \
    asm volatile(OP " vcc, %8, %9\n\t" OP " %3, %8, %10\n\t" OP " %4, %8, %11\n\t" OP " %5, %8, %12\n\t" OP " %6, %8, %13\n\t" OP " %7, %8, %14\n\t" \
                 "v_addc_co_u32 %0, vcc, 0, %0, vcc\n\tv_addc_co_u32 %1, %3, 0, %1, %3\n\tv_addc_co_u32 %2, %4, 0, %2, %4\n\t" \
                 "v_addc_co_u32 %0, %5, 0, %0, %5\n\tv_addc_co_u32 %1, %6, 0, %1, %6\n\tv_addc_co_u32 %2, %7, 0, %2, %7" \
                 : "+v"(c0), "+v"(c1), "+v"(c2), "=&s"(m1_), "=&s"(m2_), "=&s"(m3_), "=&s"(m4_), "=&s"(m5_) \
                 : "s"(cand), "v"(k0), "v"(k1), "v"(k2), "v"(k3), "v"(k4), "v"(k5) : "vcc"); } while (0)
__device__ __forceinline__ int sel_wave_total(int c) {
    int t = 0;
#pragma unroll
    for (int b = 0; b < 8; ++b) t += __popcll(__ballot((c >> b) & 1)) << b;
    return t;
}
__device__ __forceinline__ int sel_count_ge(const unsigned (&key)[NTILE64], unsigned cand, int nreg) {
    int c0 = 0, c1 = 0, c2 = 0;
#define SEL_G(g) SEL_CNT6("v_cmp_le_u32", c0, c1, c2, key[6 * (g)], key[6 * (g) + 1], key[6 * (g) + 2], key[6 * (g) + 3], key[6 * (g) + 4], key[6 * (g) + 5], cand)
#pragma unroll
    for (int g = 0; g < 6; ++g) SEL_G(g);
    if (nreg > 36) {
#pragma unroll
        for (int g = 6; g < 11; ++g) SEL_G(g);
        if (nreg > 66) {
#pragma unroll
            for (int g = 11; g < 16; ++g) SEL_G(g);
            if (nreg > 96) {
#pragma unroll
                for (int g = 16; g < 21; ++g) SEL_G(g);
                { unsigned z = 0u; SEL_CNT6("v_cmp_le_u32", c0, c1, c2, key[126], key[127], key[128], z, z, z, cand); }
            }
        }
    }
#undef SEL_G
    return sel_wave_total(c0 + c1 + c2);
}
__device__ __forceinline__ void sel_hist(const unsigned (&key)[NTILE64], int nreg, LAS unsigned* hist, unsigned prefix, int shift) {
#define SEL_H(j) do { const unsigned k = key[j]; const unsigned addr = (k >> shift) & 0xffu; \
        const unsigned inc = (((k ^ prefix) >> shift) >> 8) == 0u ? 1u : 0u; \
        __hip_atomic_fetch_add(hist + addr, inc, __ATOMIC_RELAXED, __HIP_MEMORY_SCOPE_WORKGROUP); } while (0)
#pragma unroll
    for (int j = 0; j < 36; ++j) SEL_H(j);
    if (nreg > 36) {
#pragma unroll
        for (int j = 36; j < 66; ++j) SEL_H(j);
        if (nreg > 66) {
#pragma unroll
            for (int j = 66; j < 96; ++j) SEL_H(j);
            if (nreg > 96) {
#pragma unroll
                for (int j = 96; j < NTILE64; ++j) SEL_H(j);
            }
        }
    }
#undef SEL_H
}
__device__ __forceinline__ void phase_select(const Args& a, LAS unsigned char* lds, volatile LAS int* rowq, int gw, int NGW, int wave, int lane) {
    unsigned char* ws = a.ws;
    const unsigned* S = (const unsigned*)(ws + WS_S); unsigned long long* MASK = (unsigned long long*)(ws + WS_MASK);
    LAS unsigned* hist = (LAS unsigned*)(lds + wave * 1024);
    const int nkq = (SEQ + NGW - 1) / NGW, gw0 = gw - wave;
    if (threadIdx.x == 0) *rowq = 0;
    __syncthreads();
    for (;;) {
        int i = 0; if (lane == 0) i = __hip_atomic_fetch_add((LAS int*)rowq, 1, __ATOMIC_RELAXED, __HIP_MEMORY_SCOPE_WORKGROUP);
        i = __builtin_amdgcn_readfirstlane(i);
        if (i >= nkq * NWAVES) break;
        const int kq = nkq - 1 - i / NWAVES, gwr = gw0 + i % NWAVES;
        const int qr = kq * NGW + ((kq & 1) ? NGW - 1 - gwr : gwr);
        if (qr >= SEQ) continue;
        const int pos = qr + NMETA, n = pos + 1, nreg = __builtin_amdgcn_readfirstlane((n + 63) >> 6);
        const __amdgpu_buffer_rsrc_t rs = __builtin_amdgcn_make_buffer_rsrc((void*)(S + s_row_off(qr)), 0, n * 4, 0x00020000);
        unsigned key[NTILE64];
#define SEL_LD(j) key[j] = __builtin_amdgcn_raw_buffer_load_b32(rs, lane * 4, (j) * 256, 0)
#pragma unroll
        for (int j = 0; j < 36; ++j) SEL_LD(j);
        if (nreg > 36) {
#pragma unroll
            for (int j = 36; j < 66; ++j) SEL_LD(j);
            if (nreg > 66) {
#pragma unroll
                for (int j = 66; j < 96; ++j) SEL_LD(j);
                if (nreg > 96) {
#pragma unroll
                    for (int j = 96; j < NTILE64; ++j) SEL_LD(j);
                }
            }
        }
#undef SEL_LD
        unsigned T = 1u; int need = 0; bool ge_only = true;
        if (n > TOPK) {
            unsigned mx = 0u;
#pragma unroll
            for (int j = 0; j < 36; ++j) mx = key[j] > mx ? key[j] : mx;
            if (nreg > 36) {
#pragma unroll
                for (int j = 36; j < 66; ++j) mx = key[j] > mx ? key[j] : mx;
                if (nreg > 66) {
#pragma unroll
                    for (int j = 66; j < 96; ++j) mx = key[j] > mx ? key[j] : mx;
                    if (nreg > 96) {
#pragma unroll
                        for (int j = 96; j < NTILE64; ++j) mx = key[j] > mx ? key[j] : mx;
                    }
                }
            }
#pragma unroll
            for (int o = 1; o < 64; o <<= 1) { const unsigned t = (unsigned)__shfl_xor((int)mx, o); mx = t > mx ? t : mx; }
            int lo = (int)__builtin_amdgcn_readfirstlane((int)(mx >> 24)), hi = lo + 1, cge = 0, cabove = 0;
            for (int step = 1;; step *= 2) { const int c = sel_count_ge(key, (unsigned)lo << 24, nreg); if (c >= TOPK || lo == 0) { cge = c; break; } hi = lo; cabove = c; lo = lo - step > 0 ? lo - step : 0; }
            while (hi - lo > 1) { const int mid = (lo + hi) >> 1; const int c = sel_count_ge(key, (unsigned)mid << 24, nreg); if (c >= TOPK) { lo = mid; cge = c; } else { hi = mid; cabove = c; } }
            unsigned prefix = (unsigned)lo << 24;
            if (cge != TOPK) {
                for (int b = 23; b >= 0; --b) { const unsigned cand = prefix | (1u << b); const int c = sel_count_ge(key, cand, nreg); if (c >= TOPK) { prefix = cand; cge = c; if (c == TOPK) break; } }
            }
            T = prefix; ge_only = (cge == TOPK);
            if (!ge_only) need = TOPK - sel_count_ge(key, T + 1u, nreg);
        }
        unsigned w0l = 0u, w0h = 0u, w1l = 0u, w1h = 0u, w2l = 0u, w2h = 0u;
#define EM_WL2(dlo, dhi, vlo, vhi, l) asm volatile("s_nop 4\n\tv_writelane_b32 %0, %2, %4\n\tv_writelane_b32 %1, %3, %4" : "+v"(dlo), "+v"(dhi) : "s"(vlo), "s"(vhi), "n"(l))
#define EM_PUT(j, w) do { const unsigned lo_ = (unsigned)(w), hi_ = (unsigned)((w) >> 32); \
        if ((j) < 64) EM_WL2(w0l, w0h, lo_, hi_, (j)); else if ((j) < 128) EM_WL2(w1l, w1h, lo_, hi_, (j) - 64); else EM_WL2(w2l, w2h, lo_, hi_, (j) - 128); } while (0)
#define EM_GE(j) do { const unsigned long long w_ = __ballot(key[j] >= T); EM_PUT(j, w_); } while (0)
#define EM_TIE(j) do { unsigned long long w_ = __ballot(key[j] > T); \
        if (need > 0) { unsigned long long eq = __ballot(key[j] == T); int c = __popcll(eq); \
            while (c > need) { eq &= ~(1ull << (63 - __builtin_clzll(eq))); --c; } \
            w_ |= eq; need -= c; } \
        EM_PUT(j, w_); } while (0)
#define EM_TIERS(EM) do { _Pragma("unroll") for (int j = 0; j < 36; ++j) EM(j); \
        if (nreg > 36) { _Pragma("unroll") for (int j = 36; j < 66; ++j) EM(j); \
            if (nreg > 66) { _Pragma("unroll") for (int j = 66; j < 96; ++j) EM(j); \
                if (nreg > 96) { _Pragma("unroll") for (int j = 96; j < NTILE64; ++j) EM(j); } } } } while (0)
        if (ge_only) EM_TIERS(EM_GE); else EM_TIERS(EM_TIE);
#undef EM_TIERS
#undef EM_TIE
#undef EM_GE
#undef EM_PUT
#undef EM_WL2
        const unsigned long long w0 = ((unsigned long long)w0h << 32) | w0l, w1 = ((unsigned long long)w1h << 32) | w1l, w2 = ((unsigned long long)w2h << 32) | w2l;
        MASK[(size_t)lane * SEQ + qr] = w0; MASK[(size_t)(64 + lane) * SEQ + qr] = w1; if (lane == 0) MASK[(size_t)128 * SEQ + qr] = w2;
    }
}
#undef SEL_CNT6

template <bool DSAMODE>
__device__ __forceinline__ void attn_naive(const Args& a, LAS unsigned char* lds, int gw, int NGW, int wave, int lane) {
    unsigned char* ws = a.ws;
    const bf16* PROJ = (const bf16*)(ws + WS_PROJ); const bf16* KVA = (const bf16*)(ws + WS_KVA);
    const bf16* Q = DSAMODE ? PROJ + PC_QA : PROJ + PC_QB; const int ldq = PW;
    const bf16* Kp = DSAMODE ? KVA : PROJ + PC_KB; const int ldk = DSAMODE ? 2048 : PW;
    const bf16* Vp = DSAMODE ? KVA + 1024 : PROJ + PC_VB; const int ldv = DSAMODE ? 2048 : PW;
    bf16* O = (bf16*)(ws + (DSAMODE ? WS_YA : WS_YB));
    const unsigned long long* MASK = (const unsigned long long*)(ws + WS_MASK); const float* CC = (const float*)(ws + WS_CC);
    LAS float* qs = (LAS float*)(lds + wave * 1024);
    for (int item = gw; item < SEQ * NH; item += NGW) {
        const int qr = item >> 3, h = item & 7, pos = qr + NMETA;
        { const unsigned w = *(const unsigned*)(Q + (size_t)pos * ldq + h * 128 + 2 * lane); qs[2 * lane] = bflo(w) * (ATT_SCALE * LOG2E); qs[2 * lane + 1] = bfhi(w) * (ATT_SCALE * LOG2E); }
        LDS_WAIT(); asm volatile("" ::: "memory");
        const float cq = DSAMODE ? 0.f : CC[(size_t)pos * 8 + h];
        float m = -1e30f, l = 0.f, o0 = 0.f, o1 = 0.f;
        const int ntile = pos / 64 + 1;
        for (int j = 0; j < ntile; ++j) {
            const int key = j * 64 + lane; bool valid = key <= pos;
            if (DSAMODE) { const unsigned long long w = MASK[(size_t)j * SEQ + qr]; if (w == 0ull) continue; valid = valid && ((w >> lane) & 1ull); }
            float s = -__builtin_inff();
            if (valid) { const v4u* kp = (const v4u*)(Kp + (size_t)key * ldk + h * 128); float d = 0.f;
#pragma unroll
                for (int c = 0; c < 16; ++c) { const v4u w = kp[c]; const f32x4 q0 = *(const LAS f32x4*)(qs + 8 * c), q1 = *(const LAS f32x4*)(qs + 8 * c + 4);
                    d += q0[0] * bflo(w.x) + q0[1] * bfhi(w.x) + q0[2] * bflo(w.y) + q0[3] * bfhi(w.y) + q1[0] * bflo(w.z) + q1[1] * bfhi(w.z) + q1[2] * bflo(w.w) + q1[3] * bfhi(w.w); }
                s = d; if (!DSAMODE) s += (cq - CC[(size_t)key * 8 + h]) * LOG2E; }
            const float tmax = wave_max(s); const float mn = fmaxf(m, tmax); const float alpha = __builtin_amdgcn_exp2f(m - mn);
            const float p = valid ? __builtin_amdgcn_exp2f(s - mn) : 0.f;
            l = l * alpha + wave_sum(p); o0 *= alpha; o1 *= alpha; m = mn;
            unsigned long long pm = __ballot(p > 0.f);
            while (pm) { const int sl = __builtin_ctzll(pm); pm &= pm - 1; const float ps = __shfl(p, sl);
                const unsigned vv = *(const unsigned*)(Vp + (size_t)(j * 64 + sl) * ldv + h * 128 + 2 * lane); o0 += ps * bflo(vv); o1 += ps * bfhi(vv); }
        }
        const float rl = 1.f / l;
        *(unsigned*)(O + (size_t)qr * 1024 + h * 128 + 2 * lane) = pk2(o0 * rl, o1 * rl);
        LDS_WAIT(); asm volatile("" ::: "memory");
    }
}


constexpr int MOE_GU_ITEMS = NE * 32 * 32, MOE_D_ITEMS = NE * 8 * 64;
template <bool DOWN>
__device__ __forceinline__ void moe_item(const Args& a, int i, int lane, const float*& src, size_t& ldsrc, bf16*& dst, int& ldwt, int& k0, int& n0) {
    unsigned char* ws = a.ws;
    if (!DOWN) { const int e = i >> 10, r = i & 1023; const int kb = r / 32, nb = r % 32; const int n = nb * 32 + (lane & 31); const int pn = n >> 8, half = (n >> 7) & 1, j = n & 127;
        src = (half ? a.in[I_WUP] : a.in[I_WGATE]) + (size_t)e * 2048 * 512 + 128 * pn + j; ldsrc = 512; dst = (bf16*)(ws + WS_WGUT) + (size_t)e * 1024 * 2048; ldwt = 2048; k0 = 64 * kb; n0 = 32 * nb; }
    else { const int e = i >> 9, r = i & 511; const int kb = r / 64, nb = r % 64;
        src = a.in[I_WDOWN] + (size_t)e * 512 * 2048 + nb * 32 + (lane & 31); ldsrc = 2048; dst = (bf16*)(ws + WS_WDT) + (size_t)e * 2048 * 512; ldwt = 512; k0 = 64 * kb; n0 = 32 * nb; }
}
template <bool DOWN>
__device__ __forceinline__ void moe_copy_pair(const Args& a, LAS float* scr, int i0, int i1  , int lane) {
    const float* s0; size_t l0; bf16* d0; int w0, k0, n0; moe_item<DOWN>(a, i0, lane, s0, l0, d0, w0, k0, n0);
    const bool two = i1 >= 0;
    const float* s1; size_t l1; bf16* d1; int w1, k1, n1; moe_item<DOWN>(a, two ? i1 : i0, lane, s1, l1, d1, w1, k1, n1);
    float va[32], vb[32];
    tr_load(va, s0, l0, k0, lane); tr_load(vb, s1, l1, k1, lane);
    tr_fence(va); tr_fence(vb);
    const float* rsc = DOWN ? nullptr : a.in[I_GFFN];
    tr_store(va, d0, w0, k0, n0, scr, lane, rsc);
    if (two) tr_store(vb, d1, w1, k1, n1, scr, lane, rsc);
}

constexpr size_t WS_PART = WS_R + 32 * MiB;
constexpr int CW_AQ = 2048;
constexpr int N_DSA_ENT = 48, N_ATT_ITEMS = N_DSA_ENT * 8 + 256;
constexpr int N_COPY_POPS = MOE_GU_ITEMS / 64;
__device__ const unsigned char DSA_ENT[N_DSA_ENT] = {125, 60, 126, 121, 122, 117, 56, 118, 113, 114, 109, 52, 110, 105, 106, 101, 48, 102, 97, 98, 93, 44, 94, 89, 90, 85, 40, 86, 81, 82, 77, 36, 78, 73, 74, 69, 32, 70, 65, 66, 28, 24, 20, 16, 12, 8, 4, 0};
template <int MODE>
__device__ __forceinline__ void attn_item(unsigned char* ws, char* lds, int h, int b, int kind, unsigned* qh, unsigned& nxt) {
    constexpr int LDKV = MODE ? 2048 : PW;
    att::ItemRef r; r.P0 = NMETA + 256 * b;
    const bf16* PROJ = (const bf16*)(ws + WS_PROJ); const bf16* KVA = (const bf16*)(ws + WS_KVA);
    r.Q = PROJ + (size_t)r.P0 * PW + (MODE ? PC_QA : PC_QB) + h * 128;
    r.K = MODE ? KVA + h * 128 : PROJ + PC_KB + h * 128;
    r.V = MODE ? KVA + 1024 + h * 128 : PROJ + PC_VB + h * 128;
    r.O = (bf16*)(ws + WS_YA) + (size_t)(256 * b) * 2048 + (MODE ? 0 : 1024) + h * 128;
    r.cb = (const float*)(ws + WS_CCT) + (size_t)h * LP; r.cref = MODE ? 0.f : r.cb[r.P0];
    r.mk = (const unsigned long long*)(ws + WS_MASK) + 256 * b;
    const int NT = 4 * b + 5, half = (NT + 1) / 2;
    r.t_lo = kind == 2 ? half : 0; r.t_hi = kind == 1 ? half : NT;
    r.kn2 = MODE ? 0.f : __uint_as_float(((const unsigned*)(ws + WS_CTL))[CW_KMAX + h]);
    r.part = kind ? (float*)(ws + WS_PART) + (size_t)(((h * 16 + (b - 16)) * 2) + (kind - 1)) * att::PART_FLOATS : nullptr;
    att::run_item<MODE, PW, LDKV, 2048>(r, lds, qh, nxt);
}
__device__ __forceinline__ void phase_attn(const Args& a, char* lds, volatile LAS int* qslot) {
    unsigned* qh = (unsigned*)(a.ws + WS_CTL) + CW_AQ;
    unsigned nxt = 0u; bool have = false;
    for (;;) {
        if (threadIdx.x == 0) qslot[0] = have ? (int)nxt : (int)__hip_atomic_fetch_add(qh, 1u, RLX_AGENT);
        __syncthreads();
        const int it = qslot[0];
        __syncthreads();
        if (it >= N_ATT_ITEMS + N_COPY_POPS) break;
        int ai = it - N_COPY_POPS;
        if (it < 256) ai = it;
        else if (it < 256 + 2 * N_COPY_POPS) {
            const int r = it - 256;
            if (r & 1) {
                int tid_ = threadIdx.x; asm volatile("" : "+v"(tid_)); const int lane = tid_ & 63, wave = __builtin_amdgcn_readfirstlane(tid_ >> 6);
                LAS float* scr = (LAS float*)((LAS char*)lds + wave * 16384);
                const int c = r >> 1;
#pragma unroll 1
                for (int k = 0; k < 8; k += 2) moe_copy_pair<false>(a, scr, c * 64 + wave + 8 * k, c * 64 + wave + 8 * (k + 1), lane);
                have = false; continue;
            }
            ai = 256 + (r >> 1);
        }
        if (ai < N_DSA_ENT * 8) { const int e = DSA_ENT[ai >> 3]; attn_item<1>(a.ws, lds, ai & 7, e >> 2, e & 3, qh, nxt); }
        else { const int j = ai - N_DSA_ENT * 8; attn_item<0>(a.ws, lds, j & 7, 31 - (j >> 3), 0, qh, nxt); }
        have = true;
    }
}
__device__ __forceinline__ void phase_attn_combine(const Args& a, char* lds, int vcu, int G) {
    for (int sl = vcu; sl < 128; sl += G) { const int h = sl >> 4, b = 16 + (sl & 15);
        const float* p1 = (const float*)(a.ws + WS_PART) + (size_t)(sl * 2) * att::PART_FLOATS;
        att::combine_item<2048>(p1, p1 + att::PART_FLOATS, (bf16*)(a.ws + WS_YA) + (size_t)(256 * b) * 2048 + h * 128, lds); }
}

__device__ __forceinline__ float wave_total_f(float v) {
    v += __builtin_bit_cast(float, __builtin_amdgcn_update_dpp(0, __builtin_bit_cast(int, v), 0x111, 0xf, 0xf, false));
    v += __builtin_bit_cast(float, __builtin_amdgcn_update_dpp(0, __builtin_bit_cast(int, v), 0x112, 0xf, 0xf, false));
    v += __builtin_bit_cast(float, __builtin_amdgcn_update_dpp(0, __builtin_bit_cast(int, v), 0x114, 0xf, 0xf, false));
    v += __builtin_bit_cast(float, __builtin_amdgcn_update_dpp(0, __builtin_bit_cast(int, v), 0x118, 0xf, 0xf, false));
    v += __builtin_bit_cast(float, __builtin_amdgcn_update_dpp(0, __builtin_bit_cast(int, v), 0x142, 0xa, 0xf, false));
    v += __builtin_bit_cast(float, __builtin_amdgcn_update_dpp(0, __builtin_bit_cast(int, v), 0x143, 0xc, 0xf, false));
    return __builtin_bit_cast(float, __builtin_amdgcn_readlane(__builtin_bit_cast(int, v), 63));
}
__device__ __forceinline__ void phase_route_mfma(const Args& a, LAS unsigned char* lds, volatile LAS int* lcnt  , int vcu, int NGW) {
    typedef float f32x16 __attribute__((ext_vector_type(16)));
    typedef short bf16x8 __attribute__((ext_vector_type(8)));
    unsigned char* ws = a.ws;
    const bf16* H2 = (const bf16*)(ws + WS_H2); const bf16* GWH = (const bf16*)(ws + WS_GWH); const bf16* GWL = (const bf16*)(ws + WS_GWL);
    unsigned* cnt = (unsigned*)(ws + WS_CTL) + CW_CNT;
    LAS float* part = (LAS float*)lds;
    LAS float* tot = (LAS float*)(lds + 8 * 32 * 33 * 4);
    LAS float* rsl = tot + 32 * 33;
    const int ngroups = (SEQ + 4 * NGW - 1) / (4 * NGW);
    for (int grp = 0; grp < ngroups; ++grp) {
        int tid = threadIdx.x; asm volatile("" : "+v"(tid));
        const int wid = __builtin_amdgcn_readfirstlane(tid >> 6), lane = tid & 63, r32 = lane & 31, hi = lane >> 5;
#define RT_TOK(m) ((vcu * NWAVES + ((m) >> 2)) + (((m) & 3) + 4 * grp) * NGW)
        if (tid < 16) lcnt[tid] = 0;
        { const int m = tid >> 4, pt = tid & 15, tk = RT_TOK(m);
          const f32x4 sv = tk < SEQ ? *(const f32x4*)((const float*)(ws + WS_SQ2) + (size_t)tk * 64 + 4 * pt) : (f32x4){0.f, 0.f, 0.f, 0.f};
          float sq = (sv[0] + sv[1]) + (sv[2] + sv[3]); sq += __shfl_xor(sq, 1); sq += __shfl_xor(sq, 2); sq += __shfl_xor(sq, 4); sq += __shfl_xor(sq, 8);
          if (pt == 0) rsl[m] = 1.f / sqrtf(sq * (1.f / 2048.f) + EPS); }
        { const int tkb = RT_TOK(r32); const bf16* hrow = H2 + (size_t)(tkb < SEQ ? tkb : 0) * 2048 + 256 * wid + 8 * hi;
          const bf16* ghr = GWH + (size_t)r32 * 2048 + 256 * wid + 8 * hi; const bf16* glr = GWL + (size_t)r32 * 2048 + 256 * wid + 8 * hi;
          f32x16 acc = {};
#pragma unroll
          for (int hf = 0; hf < 2; ++hf) { bf16x8 ah[8], al[8], bh[8];
#pragma unroll
              for (int st = 0; st < 8; ++st) { const int ko = 128 * hf + 16 * st; ah[st] = *(const bf16x8*)(ghr + ko); al[st] = *(const bf16x8*)(glr + ko); bh[st] = *(const bf16x8*)(hrow + ko); }
#pragma unroll
              for (int st = 0; st < 8; ++st) asm volatile("" : "+v"(ah[st]), "+v"(al[st]), "+v"(bh[st]));
#pragma unroll
              for (int st = 0; st < 8; ++st) { acc = __builtin_amdgcn_mfma_f32_32x32x16_bf16(ah[st], bh[st], acc, 0, 0, 0); acc = __builtin_amdgcn_mfma_f32_32x32x16_bf16(al[st], bh[st], acc, 0, 0, 0); } }
#pragma unroll
          for (int r = 0; r < 16; ++r) part[(wid * 32 + r32) * 33 + ((r & 3) + 8 * (r >> 2) + 4 * hi)] = acc[r]; }
        __syncthreads();
#pragma unroll
        for (int i = 0; i < 2; ++i) { const int idx = tid + 512 * i, m = idx >> 5, e = idx & 31; float sm = 0.f;
#pragma unroll
            for (int w = 0; w < 8; ++w) sm += part[(w * 32 + m) * 33 + e];
            tot[m * 33 + e] = sm; }
        __syncthreads();
        int e0 = 0, e1 = 0, s0 = 0, s1 = 0; float w0 = 0.f, w1 = 0.f, rs = 0.f; const int tk = RT_TOK(tid & 31); const bool mine = tid < 32 && tk < SEQ;
        if (mine) { const int m = tid; rs = rsl[m];
            float l20[20];
#pragma unroll
            for (int i = 0; i < 20; ++i) l20[i] = tot[m * 33 + i] * rs;
            float gl[4];
#pragma unroll
            for (int i = 0; i < 4; ++i) gl[i] = l20[i] + a.in[I_BGROUP][i];
            int gs = 0; float gmx = gl[0];
#pragma unroll
            for (int i = 1; i < 4; ++i) if (gl[i] > gmx) { gmx = gl[i]; gs = i; }
            float den = 0.f;
#pragma unroll
            for (int i = 0; i < 4; ++i) den += expf(gl[i] - gmx);
            const float pg = 1.f / den;
            float el[4];
#pragma unroll
            for (int i = 0; i < 4; ++i) { el[i] = 0.f;
#pragma unroll
                for (int g = 0; g < 4; ++g) if (gs == g) el[i] = l20[4 + 4 * g + i] + a.in[I_BEXPERT][4 * g + i]; }
            int i0 = 0; float m0 = el[0];
#pragma unroll
            for (int i = 1; i < 4; ++i) if (el[i] > m0) { m0 = el[i]; i0 = i; }
            int i1 = -1; float m1 = -__builtin_inff();
#pragma unroll
            for (int i = 0; i < 4; ++i) if (i != i0 && el[i] > m1) { m1 = el[i]; i1 = i; }
            const float ex = expf(m1 - m0); const float p0 = 1.f / (1.f + ex), p1 = ex / (1.f + ex);
            e0 = gs * 4 + i0; e1 = gs * 4 + i1; w0 = pg * p0; w1 = pg * p1;
            s0 = __hip_atomic_fetch_add((LAS int*)lcnt + e0, 1, __ATOMIC_RELAXED, __HIP_MEMORY_SCOPE_WORKGROUP);
            s1 = __hip_atomic_fetch_add((LAS int*)lcnt + e1, 1, __ATOMIC_RELAXED, __HIP_MEMORY_SCOPE_WORKGROUP); }
        __syncthreads();
        if (tid < 16) { const int c = lcnt[tid]; lcnt[16 + tid] = c ? (int)__hip_atomic_fetch_add(cnt + 64 * tid, (unsigned)c, RLX_AGENT) : 0; }
        __syncthreads();
        if (mine) { int* RT = (int*)(ws + WS_ROWTOK); float* RW = (float*)(ws + WS_ROWW); float* RR = (float*)(ws + WS_ROWR);
            const int i0 = e0 * 8192 + lcnt[16 + e0] + s0, i1 = e1 * 8192 + lcnt[16 + e1] + s1;
            RT[i0] = tk * 2; RW[i0] = w0; RT[i1] = tk * 2 + 1; RW[i1] = w1; RR[i0] = rs; RR[i1] = rs; }
        __syncthreads();
#undef RT_TOK
    }
}
__device__ __forceinline__ void phase_route(const Args& a, volatile LAS int* lcnt  , int gw, int NGW, int lane_in) {
    unsigned char* ws = a.ws;
    const bf16* H2 = (const bf16*)(ws + WS_H2); unsigned* cnt = (unsigned*)(ws + WS_CTL) + CW_CNT;
    const f32x4* gf = (const f32x4*)a.in[I_GFFN]; const __amdgpu_buffer_rsrc_t wrs = __builtin_amdgcn_make_buffer_rsrc((void*)(ws + WS_WRT), 0, 20 * 2048 * 4, 0x00020000);
    const int ngroups = (SEQ + 4 * NGW - 1) / (4 * NGW);
    for (int grp = 0; grp < ngroups; ++grp) {
        (void)lane_in; int tl_ = threadIdx.x; asm volatile("" : "+v"(tl_)); const int lane = tl_ & 63;
        const int t0 = gw + grp * 4 * NGW;
        int tok[4]; float rstd[4]; bool live[4];
#pragma unroll
        for (int q = 0; q < 4; ++q) { tok[q] = t0 + q * NGW; live[q] = tok[q] < SEQ; if (!live[q]) tok[q] = 0; }
        { int tx0 = threadIdx.x; asm volatile("" : "+v"(tx0)); if (tx0 < 16) lcnt[tx0] = 0; }
        __syncthreads();
        { float sv[4];
#pragma unroll
          for (int q = 0; q < 4; ++q) sv[q] = ((const float*)(ws + WS_SQ2))[(size_t)tok[q] * 64 + lane];
#pragma unroll
          for (int q = 0; q < 4; ++q) rstd[q] = 1.f / sqrtf(wave_total_f(sv[q]) * (1.f / 2048.f) + EPS); }
        float lg[4][20];
#pragma unroll
        for (int q = 0; q < 4; ++q)
#pragma unroll
            for (int i = 0; i < 20; ++i) lg[q][i] = 0.f;
#pragma unroll 1
        for (int j = 0; j < 8; ++j) {
            int ln = lane + 64 * j; asm volatile("" : "+v"(ln));
            f32x4 hv[4], wt[20]; const f32x4 g = gf[ln];
#pragma unroll
            for (int q = 0; q < 4; ++q) { const v2u hb = ((const v2u*)(H2 + (size_t)tok[q] * 2048))[ln]; hv[q] = (f32x4){bflo(hb.x), bfhi(hb.x), bflo(hb.y), bfhi(hb.y)}; }
#pragma unroll
            for (int e = 0; e < 20; ++e) wt[e] = __builtin_bit_cast(f32x4, __builtin_amdgcn_raw_buffer_load_b128(wrs, ln * 16, e * 8192, 0));
            asm volatile("" : "+v"(hv[0]), "+v"(hv[1]), "+v"(hv[2]), "+v"(hv[3]));
#pragma unroll
            for (int e = 0; e < 20; e += 5) asm volatile("" : "+v"(wt[e]), "+v"(wt[e + 1]), "+v"(wt[e + 2]), "+v"(wt[e + 3]), "+v"(wt[e + 4]));
            f32x4 t[4];
#pragma unroll
            for (int q = 0; q < 4; ++q) {
                t[q][0] = hv[q][0] * rstd[q] * g[0]; t[q][1] = hv[q][1] * rstd[q] * g[1]; t[q][2] = hv[q][2] * rstd[q] * g[2]; t[q][3] = hv[q][3] * rstd[q] * g[3]; }
#pragma unroll
            for (int c = 0; c < 4; ++c)
#pragma unroll
                for (int q = 0; q < 4; ++q)
#pragma unroll
                    for (int e = 0; e < 20; ++e) lg[q][e] += t[q][c] * wt[e][c]; }
        int e0v[4], e1v[4], s0v[4], s1v[4]; float w0v[4], w1v[4];
#pragma unroll
        for (int q = 0; q < 4; ++q) {
            float l20[20];
#pragma unroll
            for (int i = 0; i < 20; ++i) l20[i] = wave_total_f(lg[q][i]);
            float gl[4];
#pragma unroll
            for (int i = 0; i < 4; ++i) gl[i] = l20[i] + a.in[I_BGROUP][i];
            int gs = 0; float gmx = gl[0];
#pragma unroll
            for (int i = 1; i < 4; ++i) if (gl[i] > gmx) { gmx = gl[i]; gs = i; }
            float den = 0.f;
#pragma unroll
            for (int i = 0; i < 4; ++i) den += expf(gl[i] - gmx);
            const float pg = 1.f / den;
            float el[4];
#pragma unroll
            for (int i = 0; i < 4; ++i) { el[i] = 0.f;
#pragma unroll
                for (int g = 0; g < 4; ++g) if (gs == g) el[i] = l20[4 + 4 * g + i] + a.in[I_BEXPERT][4 * g + i]; }
            int i0 = 0; float m0 = el[0];
#pragma unroll
            for (int i = 1; i < 4; ++i) if (el[i] > m0) { m0 = el[i]; i0 = i; }
            int i1 = -1; float m1 = -__builtin_inff();
#pragma unroll
            for (int i = 0; i < 4; ++i) if (i != i0 && el[i] > m1) { m1 = el[i]; i1 = i; }
            const float ex = expf(m1 - m0); const float p0 = 1.f / (1.f + ex), p1 = ex / (1.f + ex);
            e0v[q] = gs * 4 + i0; e1v[q] = gs * 4 + i1; w0v[q] = pg * p0; w1v[q] = pg * p1; s0v[q] = 0; s1v[q] = 0;
            if (lane == 0 && live[q]) { s0v[q] = __hip_atomic_fetch_add((LAS int*)lcnt + e0v[q], 1, __ATOMIC_RELAXED, __HIP_MEMORY_SCOPE_WORKGROUP);
                                        s1v[q] = __hip_atomic_fetch_add((LAS int*)lcnt + e1v[q], 1, __ATOMIC_RELAXED, __HIP_MEMORY_SCOPE_WORKGROUP); }
        }
        __syncthreads();
        { int tx = threadIdx.x; asm volatile("" : "+v"(tx));
          if (tx < 16) { const int c = lcnt[tx]; lcnt[16 + tx] = c ? (int)__hip_atomic_fetch_add(cnt + 64 * tx, (unsigned)c, RLX_AGENT) : 0; } }
        __syncthreads();
        if (lane == 0) {
#pragma unroll
            for (int q = 0; q < 4; ++q) if (live[q]) { int* RT = (int*)(ws + WS_ROWTOK); float* RW = (float*)(ws + WS_ROWW);
                const int i0 = e0v[q] * 8192 + lcnt[16 + e0v[q]] + s0v[q], i1 = e1v[q] * 8192 + lcnt[16 + e1v[q]] + s1v[q];
                RT[i0] = tok[q] * 2; RW[i0] = w0v[q]; RT[i1] = tok[q] * 2 + 1; RW[i1] = w1v[q];
                { float* RR = (float*)(ws + WS_ROWR); RR[i0] = rstd[q]; RR[i1] = rstd[q]; }        }
        }
        __syncthreads();
    }
}
__device__ __forceinline__ void moe_tile_bases(const Args& a, volatile LAS int* tb) {
    if (threadIdx.x < 64) { const int l = threadIdx.x; const unsigned* cnt = (const unsigned*)(a.ws + WS_CTL) + CW_CNT;
        const int t = l < 16 ? (int)((__hip_atomic_load(cnt + 64 * (l & 15), RLX_AGENT) + 255u) >> 8) : 0;
        int inc = t;
#pragma unroll
        for (int o = 1; o < 16; o <<= 1) { const int u = __shfl_up(inc, o); if (l >= o) inc += u; }
        if (l < 16) tb[l] = inc - t;
        if (l == 15) tb[16] = inc; }
    __syncthreads();
}
__device__ __forceinline__ void phase_final(const Args& a, int gw, int NGW, int lane) {
    unsigned char* ws = a.ws;
    const bf16* H2 = (const bf16*)(ws + WS_H2); const bf16* Y = (const bf16*)(ws + WS_Y); const f32x4* gf = (const f32x4*)a.in[I_GFINAL];
    for (int tok = gw; tok < SEQ; tok += NGW) {
        const v2u* hr = (const v2u*)(H2 + (size_t)tok * 2048); const v2u* y0 = (const v2u*)(Y + (size_t)tok * 2048); const v2u* y1 = (const v2u*)(Y + ((size_t)SEQ + tok) * 2048);
        f32x4 v[8]; float s = 0.f;
#pragma unroll
        for (int j = 0; j < 8; ++j) { const v2u hb = hr[lane + 64 * j]; const f32x4 hv = (f32x4){bflo(hb.x), bfhi(hb.x), bflo(hb.y), bfhi(hb.y)}; const v2u a0 = y0[lane + 64 * j], a1 = y1[lane + 64 * j];
            v[j][0] = hv[0] + bflo(a0.x) + bflo(a1.x); v[j][1] = hv[1] + bfhi(a0.x) + bfhi(a1.x); v[j][2] = hv[2] + bflo(a0.y) + bflo(a1.y); v[j][3] = hv[3] + bfhi(a0.y) + bfhi(a1.y);
            s += (v[j][0] * v[j][0] + v[j][1] * v[j][1]) + (v[j][2] * v[j][2] + v[j][3] * v[j][3]); }
        const float rstd = 1.f / sqrtf(wave_sum(s) * (1.f / 2048.f) + EPS);
        f32x4* orow = (f32x4*)(a.out + (size_t)tok * 2048);
        float pscale = 1.f;
        if (PROBE_TS_A >= 0) { const unsigned long long* tsp = (const unsigned long long*)(a.ws + WS_CTL + 65536); const float tq = floorf((float)(tsp[PROBE_TS_B] - tsp[PROBE_TS_A]) * (0.01f / 16.f) + 0.5f) * 16.f; pscale = 1.f + tq / PROBE_TS_SCALE_US; }
        const float rs2 = rstd * pscale;
#pragma unroll
        for (int j = 0; j < 8; ++j) { const f32x4 g = gf[lane + 64 * j]; orow[lane + 64 * j] = (f32x4){v[j][0] * rs2 * g[0], v[j][1] * rs2 * g[1], v[j][2] * rs2 * g[2], v[j][3] * rs2 * g[3]}; }
    }
}

__global__ void __launch_bounds__(NWAVES * 64, 2) mk_fwd(Args args) {
    extern __shared__ __attribute__((aligned(16))) unsigned char lds_raw[];
    LAS unsigned char* lds = (LAS unsigned char*)lds_raw;
    volatile LAS unsigned* MISC = (volatile LAS unsigned*)(lds + MISC_OFF);
    volatile LAS int* TB = (volatile LAS int*)(lds + MISC_OFF + 64);
    const int tid = threadIdx.x;
    const int G = gridDim.x; const int bx = blockIdx.x; const int vcu = (G % 8 == 0) ? (bx % 8) * (G / 8) + bx / 8 : bx;
    const int NGW = G * NWAVES;
#define TIDS() int tid_ = threadIdx.x; asm volatile("" : "+v"(tid_)); const int lane = tid_ & 63, wave = __builtin_amdgcn_readfirstlane(tid_ >> 6), gw = vcu * NWAVES + wave; (void)lane; (void)gw;
    unsigned char* ws = args.ws;
    gu32* ctl = (gu32*)(ws + WS_CTL);
    for (int u = tid; u < (LDS_BYTES - LDSCTL_OFF) / 4; u += NWAVES * 64) ((LAS unsigned*)(lds + LDSCTL_OFF))[u] = 0u;
    __syncthreads();
    XcdBarrier bar; bar.bar = (unsigned*)(ctl + CW_BAR); bar.x = 0; bar.st = nullptr;
    if (MK_ONE_LAUNCH) bar = xcd_barrier_post((unsigned*)(ctl + CW_BAR), MISC + 8);
    const int lo = args.ph_lo, hi = args.ph_hi;
#ifndef PHASE_MASK
#define PHASE_MASK 0x3fff
#endif

#define REP(k) for (int rep_ = 0; rep_ < ((PROBE_DOUBLE == (k)) ? 2 : 1); ++rep_)
#define IN(k) (((PHASE_MASK >> (k)) & 1) && lo <= (k) && (k) < hi)
#define SEAM(k) do { if (IN(k) && IN((k) + 1)) xcd_barrier(bar); } while (0)

    const int nfull = ((SEQ / 256) * (PW / 256)) % G; const bool late_copies = nfull > 0 && G - nfull >= 16; const int cb0 = late_copies ? nfull + 6 : 0;
    TS(0); if (IN(0)) REP(0) { TIDS(); phase_prologue(args, lds, gw, NGW, wave, lane, late_copies ? PC_I_IN : PC_NITEMS); } SEAM(0);
    TS(1); if (IN(1)) REP(1) {
        pg8::Gemm g{(const bf16*)(ws + WS_HN) + (size_t)NMETA * 2048, (const bf16*)(ws + WS_WINT), 2048, 2048, 2048, nullptr}; pg8::StaticOrder S; S.init(SEQ / 256, PW / 256, G, bx);
        EpiProj E{(bf16*)(ws + WS_PROJ), (float*)(ws + WS_SMALL), (const float*)(ws + WS_ROPE128), (const float*)(ws + WS_ROPE64), (float*)(ws + WS_SSQ)};
        pg8::gemm_phase(lds + RING_OFF, g, S, E);
        { TIDS(); meta_inproj(args, ((bx + 32) % G) * NWAVES + wave, NGW, lane);
          if (late_copies && bx >= cb0) { __syncthreads(); copy_items(args, lds, PC_I_IN, PC_NITEMS, (bx - cb0) * NWAVES + wave, (G - cb0) * NWAVES, wave, lane); } }
    } SEAM(1);
    TS(2); if (IN(2)) REP(2) {
        { TIDS(); phase_minipost(args, (volatile LAS unsigned*)(lds + MISC_OFF + 640), gw, NGW, lane); }
        pg8::Gemm g{(const bf16*)(ws + WS_PROJ) + (size_t)NMETA * PW + PC_CKV, (const bf16*)(ws + WS_WKVT), PW, 512, 512, nullptr}; pg8::StaticOrder S; S.init(SEQ / 256, 8, G, bx);
        EpiKvUp E{(bf16*)(ws + WS_KVA), (const float*)(ws + WS_ROPE128), (const float*)(ws + WS_SSQ)};
        pg8::gemm_phase(lds + RING_OFF, g, S, E);
    } SEAM(2);
    TS(3); if (IN(3)) REP(3) { if (vcu < 8) { TIDS(); if (wave == 0) phase_cumsum(args, vcu, lane); else if (wave <= 4) meta_kvup(args, vcu * 4 + (wave - 1), 32, lane); } phase_indexer_mfma(args, lds + RING_OFF, vcu, G); } SEAM(3);
    TS(4); if (IN(4)) REP(4) { TIDS(); phase_select(args, lds + RING_OFF, (volatile LAS int*)(lds + MISC_OFF + 704), gw, NGW, wave, lane); } SEAM(4);
    TS(5); if (IN(5)) REP(5) { phase_attn(args, (char*)lds_raw + RING_OFF, (volatile LAS int*)(lds + MISC_OFF + 512)); } SEAM(5);
    TS(6); if (IN(6)) REP(6) { phase_attn_combine(args, (char*)lds_raw + RING_OFF, vcu, G);
        { const int c0 = G >= 256 ? 128 : 0;
          if (vcu >= c0) { TIDS(); __syncthreads(); LAS float* scr = (LAS float*)(lds + RING_OFF + wave * 16384); const int gwv = (vcu - c0) * NWAVES + wave, ngwv = (G - c0) * NWAVES;
#pragma unroll 1
              for (int i = gwv; i < MOE_D_ITEMS; i += 2 * ngwv) moe_copy_pair<true>(args, scr, i, i + ngwv < MOE_D_ITEMS ? i + ngwv : -1, lane); } }
    } SEAM(6);
    TS(7); if (IN(7)) REP(7) {
        pg8::Gemm g{(const bf16*)(ws + WS_YA), (const bf16*)(ws + WS_WAT), 2048, 2048, 2048, nullptr}; pg8::StaticOrder S; S.init(SEQ / 256, 8, G, bx);
        EpiBranchFused E{(const bf16*)(ws + WS_PROJ), (bf16*)(ws + WS_MERGED)};
        pg8::gemm_phase(lds + RING_OFF, g, S, E);
    } SEAM(7);
    TS(8); if (IN(8)) REP(8) {
        { TIDS(); for (int i = gw * 64 + lane; i < 32 * 2048; i += NGW * 64) { const int e = i >> 11, k = i & 2047;
              const float v = e < 20 ? args.in[I_GFFN][k] * (e < 4 ? args.in[I_WGROUP][k * 4 + e] : args.in[I_WEXPERT][k * 16 + (e - 4)]) : 0.f;
              const unsigned hb = f2bf(v), lb = f2bf(v - bf2f(hb)); ((bf16*)(ws + WS_GWH))[i] = (bf16)hb; ((bf16*)(ws + WS_GWL))[i] = (bf16)lb; }
          for (int i = gw * 64 + lane; i < 16 * 8192; i += NGW * 64) ((int*)(ws + WS_ROWTOK))[i] = -1; }
        pg8::Gemm g{(const bf16*)(ws + WS_MERGED), (const bf16*)(ws + WS_WOT), 2048, 2048, 2048, nullptr}; pg8::StaticOrder S; S.init(SEQ / 256, 8, G, bx);
        EpiOut E{args.in[I_X], (bf16*)(ws + WS_H2), (float*)(ws + WS_SQ2)};
        pg8::gemm_phase(lds + RING_OFF, g, S, E);
    } SEAM(8);
    TS(9); if (IN(9)) REP(9) { phase_route_mfma(args, lds + RING_OFF, (volatile LAS int*)(lds + MISC_OFF + 256), vcu, NGW); } SEAM(9);
    TS(10); if (IN(10)) REP(10) {
        moe_tile_bases(args, TB); const int nrt = TB[16];
        pg8::Gemm g{(const bf16*)(ws + WS_H2), (const bf16*)(ws + WS_WGUT), 2048, 2048, 2048, (const int*)(ws + WS_ROWTOK)}; pg8::MoeOrder S; S.init(0, nrt < 64 ? nrt : 64, 4, G, bx, (const LAS int*)TB, (size_t)1024 * 2048 * 2);
        EpiGateUp E{(bf16*)(ws + WS_ACT), (const float*)(ws + WS_ROWW), (const float*)(ws + WS_ROWR)};
        pg8::gemm_phase<EpiGateUp, pg8::MoeOrder, true>(lds + RING_OFF, g, S, E);
    } SEAM(10);
    TS(11); if (IN(11)) REP(11) {
        moe_tile_bases(args, TB); const int nrt = TB[16]; const int ngu = nrt > 64 ? (nrt - 64) * 4 : 0; const int ngb = ngu < G / 2 ? ngu : G / 2;
        { pg8::Gemm g{(const bf16*)(ws + WS_H2), (const bf16*)(ws + WS_WGUT), 2048, 2048, 2048, (const int*)(ws + WS_ROWTOK)}; pg8::MoeOrder S; S.init(64, nrt - 64, 4, ngb, bx < ngb ? bx : -1, (const LAS int*)TB, (size_t)1024 * 2048 * 2);
          EpiGateUp E{(bf16*)(ws + WS_ACT), (const float*)(ws + WS_ROWW), (const float*)(ws + WS_ROWR)};
          pg8::gemm_phase<EpiGateUp, pg8::MoeOrder, true>(lds + RING_OFF, g, S, E); }
        { pg8::Gemm g{(const bf16*)(ws + WS_ACT), (const bf16*)(ws + WS_WDT), 512, 512, 512, nullptr}; pg8::MoeOrder S; S.init(0, nrt < 64 ? nrt : 64, 8, G - ngb, bx - ngb, (const LAS int*)TB, (size_t)2048 * 512 * 2);
          EpiDown E{(bf16*)(ws + WS_Y), (const int*)(ws + WS_ROWTOK)};
          pg8::gemm_phase(lds + RING_OFF, g, S, E); }
    } SEAM(11);
    TS(12); if (IN(12)) REP(12) {
        moe_tile_bases(args, TB); const int nrt = TB[16];
        pg8::Gemm g{(const bf16*)(ws + WS_ACT), (const bf16*)(ws + WS_WDT), 512, 512, 512, nullptr}; pg8::MoeOrder S; S.init(64, nrt - 64, 8, G, bx, (const LAS int*)TB, (size_t)2048 * 512 * 2);
        EpiDown E{(bf16*)(ws + WS_Y), (const int*)(ws + WS_ROWTOK)};
        pg8::gemm_phase(lds + RING_OFF, g, S, E);
    } SEAM(12);
    TS(13); if (IN(13)) REP(13) { TIDS(); phase_final(args, gw, NGW, lane); }
    TS(14);
#undef IN
#undef SEAM
}

extern "C" void kernel_launch(void* const* d_in, const int* in_sizes, int n_in, void* d_out, int out_size, void* d_ws, size_t ws_size, hipStream_t stream) {
    static int grid = 0;
    if (grid == 0) {
        if (n_in != 20 || out_size != SEQ * DM || ws_size < WS_NEED) { fprintf(stderr, "kernel_launch: unexpected shapes (n_in %d, out %d, ws %zu need %zu)\n", n_in, out_size, ws_size, (size_t)WS_NEED); grid = -1; return; }
        int dev = 0, cus = 0;
        if (hipGetDevice(&dev) != hipSuccess || hipDeviceGetAttribute(&cus, hipDeviceAttributeMultiprocessorCount, dev) != hipSuccess) { grid = -1; return; }
        if (hipFuncSetAttribute((const void*)mk_fwd, hipFuncAttributeMaxDynamicSharedMemorySize, LDS_BYTES) != hipSuccess) { fprintf(stderr, "kernel_launch: hipFuncSetAttribute failed\n"); grid = -1; return; }
        int per_cu = 0;
        if (hipOccupancyMaxActiveBlocksPerMultiprocessor(&per_cu, (const void*)mk_fwd, NWAVES * 64, LDS_BYTES) != hipSuccess || per_cu < 1) fprintf(stderr, "kernel_launch: occupancy query says %d\n", per_cu);
        (void)hipGetLastError();
        grid = cus;
    }
    if (grid < 0) return;
    (void)hipMemsetAsync((char*)d_ws + WS_CTL, 0, CTL_ZERO_BYTES, stream);
    Args a{};
    for (int i = 0; i < 20; ++i) a.in[i] = (const float*)d_in[i];
    a.out = (float*)d_out; a.ws = (unsigned char*)d_ws;
    if (MK_ONE_LAUNCH) {
        a.ph_lo = 0; a.ph_hi = NPHASE; a.li = 0;
        hipLaunchKernelGGL(mk_fwd, dim3(grid), dim3(NWAVES * 64), LDS_BYTES, stream, a);
    } else {
        for (int p = 0; p < NPHASE; ++p) { a.ph_lo = p; a.ph_hi = p + 1; a.li = p; hipLaunchKernelGGL(mk_fwd, dim3(grid), dim3(NWAVES * 64), LDS_BYTES, stream, a); }
    }
}
```
